# Optimizing an MI355X kernel written in HIP

```python
import jax, jax.numpy as jnp
from jax import lax
import numpy as np

D_MODEL = 1024
BATCH = 8
SEQ = 4096
DEPTH = 1

D_MIX = D_MODEL
D_GMLP = D_MIX // 2
GMLP_GROUPS = 4
GMLP_GROUP_DIM = D_GMLP // GMLP_GROUPS
CHUNK = 128
D_SB = D_MIX - D_GMLP
SB_HEADS = 8
SB_HEAD_DIM = D_SB // SB_HEADS
Q_BLOCK = 128
D_IN = 2 * D_GMLP + 3 * D_SB
N_EXPERTS = 32
TOP_K = 4
D_FF = D_MODEL
SWIGLU_LIMIT = 7.0
SWIGLU_ALPHA = 1.702
MOE_BLOCK = 512
EPS = 1e-5

kernel_name = "hymba_gmlp_stickbreaking_moe_block"


def rms_norm(x, w):
    xf = x.astype(jnp.float32)
    y = xf * lax.rsqrt(jnp.mean(xf * xf, axis=-1, keepdims=True) + EPS)
    return (y * w.astype(jnp.float32)).astype(x.dtype)


def group_rms_norm(x, w, groups):
    shp = x.shape
    xg = x.reshape(shp[:-1] + (groups, shp[-1] // groups))
    return rms_norm(xg, w.reshape(groups, -1)).reshape(shp)


def chunked_spatial_gating(uv, sgu_norm_w, sgu_w, sgu_b):
    B, S, _ = uv.shape
    z = jax.nn.gelu(uv)
    u, v = jnp.split(z, 2, axis=-1)
    v = group_rms_norm(v, sgu_norm_w, GMLP_GROUPS)
    v = v.reshape(B, S // CHUNK, CHUNK, GMLP_GROUPS, GMLP_GROUP_DIM)
    causal = jnp.tril(jnp.ones((CHUNK, CHUNK), sgu_w.dtype))
    w = sgu_w * causal[None]
    mixed = jnp.einsum("gts,bnsgc->bntgc", w, v) + sgu_b.T[:, :, None]
    return u * mixed.reshape(B, S, D_GMLP)


def stick_breaking_attention(q, k, v, q_norm_w, k_norm_w):
    B, S, _ = q.shape

    def heads(t):
        return t.reshape(B, S, SB_HEADS, SB_HEAD_DIM)

    qh = rms_norm(heads(q), q_norm_w).transpose(0, 2, 1, 3)
    kh = rms_norm(heads(k), k_norm_w).transpose(0, 2, 1, 3)
    vh = heads(v).transpose(0, 2, 1, 3)
    scale = SB_HEAD_DIM ** -0.5
    outs = []
    for i in range(S // Q_BLOCK):
        L = (i + 1) * Q_BLOCK
        qb = qh[:, :, i * Q_BLOCK:L]
        z = jnp.einsum("bhtd,bhsd->bhts", qb, kh[:, :, :L]).astype(jnp.float32) * scale
        t_pos = i * Q_BLOCK + jnp.arange(Q_BLOCK)
        s_pos = jnp.arange(L)
        causal = s_pos[None, :] < t_pos[:, None]
        log_beta = jax.nn.log_sigmoid(z)
        log_1m_beta = jnp.where(causal, jax.nn.log_sigmoid(-z), 0.0)
        survive = lax.cumsum(log_1m_beta, axis=log_1m_beta.ndim - 1, reverse=True) - log_1m_beta
        a = jnp.where(causal, jnp.exp(log_beta + survive), 0.0)
        outs.append(jnp.einsum("bhts,bhsd->bhtd", a.astype(vh.dtype), vh[:, :, :L]))
    o = jnp.concatenate(outs, axis=2)
    return o.transpose(0, 2, 1, 3).reshape(B, S, D_SB)


def moe(h, router_w, router_b, w_gate_up, b_gate_up, w_down, b_down):
    B, S, D = h.shape
    xt = h.reshape(-1, D)
    N = xt.shape[0]
    logits = xt.astype(jnp.float32) @ router_w.astype(jnp.float32) + router_b.astype(jnp.float32)
    top_logits, top_idx = lax.top_k(logits, TOP_K)
    gates = jax.nn.softmax(top_logits, axis=-1)
    n_assign = N * TOP_K
    flat_e = top_idx.reshape(-1)
    flat_tok = jnp.arange(n_assign, dtype=jnp.int32) // TOP_K
    order = jnp.argsort(flat_e)
    sorted_e = flat_e[order]
    counts = jnp.bincount(flat_e, length=N_EXPERTS)
    start = jnp.cumsum(counts) - counts
    padded = (counts + MOE_BLOCK - 1) // MOE_BLOCK * MOE_BLOCK
    pad_end = jnp.cumsum(padded)
    pad_start = pad_end - padded
    dest = pad_start[sorted_e] + (jnp.arange(n_assign) - start[sorted_e])
    n_blocks = -(-n_assign // MOE_BLOCK) + N_EXPERTS
    P = n_blocks * MOE_BLOCK
    slot_tok = jnp.zeros((P,), jnp.int32).at[dest].set(flat_tok[order])
    slot_w = jnp.zeros((P,), gates.dtype).at[dest].set(gates.reshape(-1)[order])
    block_start = jnp.arange(n_blocks) * MOE_BLOCK
    block_expert = jnp.minimum(jnp.searchsorted(pad_end, block_start, side="right"), N_EXPERTS - 1)

    def expert_block(args):
        tok, e = args
        xb = xt[tok]
        gu = xb @ w_gate_up[e] + b_gate_up[e]
        gate = jnp.minimum(gu[:, 0::2], SWIGLU_LIMIT)
        up = jnp.clip(gu[:, 1::2], -SWIGLU_LIMIT, SWIGLU_LIMIT)
        glu = gate * jax.nn.sigmoid(SWIGLU_ALPHA * gate)
        return ((up + 1.0) * glu) @ w_down[e] + b_down[e]

    y_slots = lax.map(expert_block, (slot_tok.reshape(n_blocks, MOE_BLOCK), block_expert))
    y_slots = y_slots.reshape(P, D).astype(jnp.float32) * slot_w[:, None]
    y = jax.ops.segment_sum(y_slots, slot_tok, num_segments=N)
    return y.reshape(B, S, D).astype(h.dtype)


def setup_inputs(seed: int = 0) -> dict:
    key = jax.random.key(seed)
    ks = jax.random.split(key, 18)
    f32 = jnp.float32

    def nrm(k, shape, scale):
        return jax.random.normal(k, shape, f32) * scale

    def gain(k, shape):
        return 1.0 + 0.05 * jax.random.normal(k, shape, f32)

    return {
        "x": jax.random.normal(ks[0], (BATCH, SEQ, D_MODEL), f32),
        "norm1_w": gain(ks[1], (DEPTH, D_MODEL)),
        "w_in": nrm(ks[2], (DEPTH, D_MODEL, D_IN), D_MODEL ** -0.5),
        "sgu_norm_w": gain(ks[3], (DEPTH, D_GMLP)),
        "sgu_w": nrm(ks[4], (DEPTH, GMLP_GROUPS, CHUNK, CHUNK), 0.5 * CHUNK ** -0.5),
        "sgu_b": gain(ks[5], (DEPTH, GMLP_GROUPS, CHUNK)),
        "q_norm_w": gain(ks[6], (DEPTH, SB_HEAD_DIM)),
        "k_norm_w": gain(ks[7], (DEPTH, SB_HEAD_DIM)),
        "out_norm_a_w": gain(ks[8], (DEPTH, D_GMLP)),
        "out_norm_b_w": gain(ks[9], (DEPTH, D_SB)),
        "w_out": nrm(ks[10], (DEPTH, D_MIX, D_MODEL), D_MIX ** -0.5),
        "norm2_w": gain(ks[11], (DEPTH, D_MODEL)),
        "router_w": nrm(ks[12], (DEPTH, D_MODEL, N_EXPERTS), D_MODEL ** -0.5),
        "router_b": nrm(ks[13], (DEPTH, N_EXPERTS), 0.01),
        "w_gate_up": nrm(ks[14], (DEPTH, N_EXPERTS, D_MODEL, 2 * D_FF), D_MODEL ** -0.5),
        "b_gate_up": nrm(ks[15], (DEPTH, N_EXPERTS, 2 * D_FF), 0.01),
        "w_down": nrm(ks[16], (DEPTH, N_EXPERTS, D_FF, D_MODEL), D_FF ** -0.5),
        "b_down": nrm(ks[17], (DEPTH, N_EXPERTS, D_MODEL), 0.01),
    }


def reference(x, norm1_w, w_in, sgu_norm_w, sgu_w, sgu_b, q_norm_w, k_norm_w,
              out_norm_a_w, out_norm_b_w, w_out, norm2_w, router_w, router_b,
              w_gate_up, b_gate_up, w_down, b_down):
    for l in range(DEPTH):
        h = rms_norm(x, norm1_w[l])
        proj = h @ w_in[l]
        uv, q, k, v = jnp.split(proj, [2 * D_GMLP, 2 * D_GMLP + D_SB, 2 * D_GMLP + 2 * D_SB], axis=-1)
        y_a = chunked_spatial_gating(uv, sgu_norm_w[l], sgu_w[l], sgu_b[l])
        y_b = stick_breaking_attention(q, k, v, q_norm_w[l], k_norm_w[l])
        y_a = group_rms_norm(y_a, out_norm_a_w[l], GMLP_GROUPS)
        y_b = group_rms_norm(y_b, out_norm_b_w[l], SB_HEADS)
        x = x + jnp.concatenate([y_a, y_b], axis=-1) @ w_out[l]
        x = x + moe(rms_norm(x, norm2_w[l]), router_w[l], router_b[l],
                    w_gate_up[l], b_gate_up[l], w_down[l], b_down[l])
    return x
```

```cpp
#include <hip/hip_runtime.h>
#include <cstdio>
#include <cstdint>

namespace nv {
constexpr int NTOK = 32768, DM = 1024, BATCH = 8, SEQ = 4096, DIN = 2560, DG = 512, DSB = 512, NH = 8, HD = 64, NE = 32, TOPK = 4, DFF = 1024, CHUNK = 128, NG = 4;
constexpr float EPS = 1e-5f;

__device__ __forceinline__ float block_sum256(float v, float* red) {
    for (int o = 32; o > 0; o >>= 1) v += __shfl_xor(v, o);
    __syncthreads();
    if ((threadIdx.x & 63) == 0) red[threadIdx.x >> 6] = v;
    __syncthreads();
    return red[0] + red[1] + red[2] + red[3];
}

__global__ void __launch_bounds__(256) k_rmsnorm(const float* __restrict__ x, const float* __restrict__ w, float* __restrict__ y) {
    __shared__ float red[4];
    const size_t row = blockIdx.x; const float* xr = x + row * DM; float v[4]; float s = 0.f;
    for (int i = 0; i < 4; ++i) { v[i] = xr[threadIdx.x + 256 * i]; s += v[i] * v[i]; }
    const float tot = block_sum256(s, red); const float rs = 1.0f / sqrtf(tot / DM + EPS);
    for (int i = 0; i < 4; ++i) y[row * DM + threadIdx.x + 256 * i] = v[i] * rs * w[threadIdx.x + 256 * i];
}

template <int MODE>
__global__ void __launch_bounds__(256) k_gemm(const float* __restrict__ A, const int* __restrict__ rowidx, const int* __restrict__ sidx, const int* __restrict__ cntp, const float* __restrict__ B,
                                              const float* __restrict__ bias, const float* __restrict__ R, const float* __restrict__ gate, float* __restrict__ C,
                                              int M, int N, int K, int lda, int ldc) {
    __shared__ float As[16][65];
    __shared__ float Bs[16][64];
    const int Mv = cntp ? *cntp : M;
    const int m0 = blockIdx.y * 64, n0 = blockIdx.x * 64;
    if (m0 >= Mv) return;
    const int tx = threadIdx.x & 15, ty = threadIdx.x >> 4;
    float acc[4][4] = {};
    const int ar = threadIdx.x >> 2, ak = (threadIdx.x & 3) * 4;
    int arow = m0 + ar; if (arow >= Mv) arow = Mv - 1;
    const size_t abase = (size_t)(rowidx ? rowidx[arow] : arow) * lda;
    const int bk = threadIdx.x >> 4, bn = (threadIdx.x & 15) * 4;
    for (int k0 = 0; k0 < K; k0 += 16) {
        const float4 av = *(const float4*)(A + abase + k0 + ak);
        const float4 bv = *(const float4*)(B + (size_t)(k0 + bk) * N + n0 + bn);
        __syncthreads();
        As[ak + 0][ar] = av.x; As[ak + 1][ar] = av.y; As[ak + 2][ar] = av.z; As[ak + 3][ar] = av.w;
        *(float4*)&Bs[bk][bn] = bv;
        __syncthreads();
#pragma unroll
        for (int kk = 0; kk < 16; ++kk) {
            float a[4], b[4];
#pragma unroll
            for (int i = 0; i < 4; ++i) a[i] = As[kk][ty * 4 + i];
#pragma unroll
            for (int j = 0; j < 4; ++j) b[j] = Bs[kk][tx * 4 + j];
#pragma unroll
            for (int i = 0; i < 4; ++i)
#pragma unroll
                for (int j = 0; j < 4; ++j) acc[i][j] = fmaf(a[i], b[j], acc[i][j]);
        }
    }
#pragma unroll
    for (int i = 0; i < 4; ++i) {
        const int r = m0 + ty * 4 + i; if (r >= Mv) continue;
#pragma unroll
        for (int j = 0; j < 4; ++j) {
            const int c = n0 + tx * 4 + j; float v = acc[i][j];
            if (MODE == 0) { if (bias) v += bias[c]; C[(size_t)r * ldc + c] = v; }
            if (MODE == 1) { C[(size_t)r * ldc + c] = R[(size_t)r * ldc + c] + v; }
            if (MODE == 3) { v = (v + bias[c]) * gate[r]; atomicAdd(&C[(size_t)sidx[r] * ldc + c], v); }
        }
    }
}

__device__ __forceinline__ float gelu_tanh(float x) { const float c = 0.7978845608028654f; const float t = tanhf(c * (x + 0.044715f * x * x * x)); return 0.5f * x * (1.0f + t); }

__global__ void __launch_bounds__(256) k_gmlp(const float* __restrict__ proj, const float* __restrict__ sgu_norm_w, const float* __restrict__ sgu_w, const float* __restrict__ sgu_b,
                                              const float* __restrict__ out_norm_a_w, float* __restrict__ Y) {
    __shared__ float vn[128 * 128];
    const int chunk = blockIdx.x, g = blockIdx.y; const size_t tok0 = (size_t)chunk * CHUNK; const int lane = threadIdx.x & 63, wv = threadIdx.x >> 6;
    for (int s = wv; s < 128; s += 4) {
        const float* pr = proj + (tok0 + s) * DIN + DG + g * 128;
        const float a = gelu_tanh(pr[lane]), b = gelu_tanh(pr[lane + 64]); float ss = a * a + b * b;
        for (int o = 32; o > 0; o >>= 1) ss += __shfl_xor(ss, o);
        const float rs = 1.0f / sqrtf(ss / 128.0f + EPS);
        vn[s * 128 + lane] = a * rs * sgu_norm_w[g * 128 + lane]; vn[s * 128 + lane + 64] = b * rs * sgu_norm_w[g * 128 + lane + 64];
    }
    __syncthreads();
    for (int t = wv; t < 128; t += 4) {
        const float* wr = sgu_w + ((size_t)g * 128 + t) * 128; float a0 = 0.f, a1 = 0.f;
        for (int s = 0; s <= t; ++s) { const float w = wr[s]; a0 = fmaf(w, vn[s * 128 + lane], a0); a1 = fmaf(w, vn[s * 128 + lane + 64], a1); }
        const float bb = sgu_b[g * 128 + t];
        const float y0 = gelu_tanh(proj[(tok0 + t) * DIN + g * 128 + lane]) * (a0 + bb), y1 = gelu_tanh(proj[(tok0 + t) * DIN + g * 128 + lane + 64]) * (a1 + bb);
        float ss = y0 * y0 + y1 * y1;
        for (int o = 32; o > 0; o >>= 1) ss += __shfl_xor(ss, o);
        const float rs = 1.0f / sqrtf(ss / 128.0f + EPS);
        Y[(tok0 + t) * DM + g * 128 + lane] = y0 * rs * out_norm_a_w[g * 128 + lane];
        Y[(tok0 + t) * DM + g * 128 + lane + 64] = y1 * rs * out_norm_a_w[g * 128 + lane + 64];
    }
}

__global__ void __launch_bounds__(256) k_qknorm(float* __restrict__ proj, const float* __restrict__ qw, const float* __restrict__ kw) {
    const size_t gw = (size_t)blockIdx.x * 4 + (threadIdx.x >> 6); const int lane = threadIdx.x & 63;
    const size_t tok = gw / 16; const int hh = (int)(gw % 16); const int isk = hh >> 3, h = hh & 7;
    float* p = proj + tok * DIN + 2 * DG + isk * DSB + h * HD; const float v = p[lane]; float ss = v * v;
    for (int o = 32; o > 0; o >>= 1) ss += __shfl_xor(ss, o);
    p[lane] = v * (1.0f / sqrtf(ss / 64.0f + EPS)) * (isk ? kw[lane] : qw[lane]);
}

__global__ void __launch_bounds__(256) k_sbattn(const float* __restrict__ proj, const float* __restrict__ out_norm_b_w, float* __restrict__ Y) {
    const int gw = blockIdx.x * 4 + (threadIdx.x >> 6); const int lane = threadIdx.x & 63;
    const int qb = gw % (SEQ / 64), bh = gw / (SEQ / 64), h = bh % NH, b = bh / NH;
    const int t = qb * 64 + lane; const size_t tok = (size_t)b * SEQ + t;
    float q[64]; const float* qp = proj + tok * DIN + 2 * DG + h * HD;
#pragma unroll
    for (int d = 0; d < 64; ++d) q[d] = qp[d] * 0.125f;
    float o[64];
#pragma unroll
    for (int d = 0; d < 64; ++d) o[d] = 0.f;
    float carry = 0.f;
    for (int s = qb * 64 + 63; s >= 0; --s) {
        const float* kp = proj + ((size_t)b * SEQ + s) * DIN + 2 * DG + DSB + h * HD;
        const float* vp = proj + ((size_t)b * SEQ + s) * DIN + 2 * DG + 2 * DSB + h * HD;
        float z = 0.f;
#pragma unroll
        for (int d = 0; d < 64; ++d) z = fmaf(q[d], kp[d], z);
        if (s < t) {
            const float spz = (z > 0.f ? z : 0.f) + log1pf(expf(-fabsf(z)));
            const float lb = z - spz;
            const float a = expf(lb + carry);
#pragma unroll
            for (int d = 0; d < 64; ++d) o[d] = fmaf(a, vp[d], o[d]);
            carry -= spz;
        }
    }
    float ss = 0.f;
#pragma unroll
    for (int d = 0; d < 64; ++d) ss += o[d] * o[d];
    const float rs = 1.0f / sqrtf(ss / 64.0f + EPS);
#pragma unroll
    for (int d = 0; d < 64; ++d) Y[tok * DM + DG + h * HD + d] = o[d] * rs * out_norm_b_w[h * HD + d];
}

__global__ void __launch_bounds__(256) k_router(const float* __restrict__ x1, const float* __restrict__ w2, const float* __restrict__ rw, const float* __restrict__ rb,
                                                float* __restrict__ H2, int* __restrict__ cnt, int* __restrict__ list_tok, float* __restrict__ list_gate) {
    __shared__ float red[4]; __shared__ float hs[DM]; __shared__ float part[8][NE]; __shared__ float lg[NE];
    const size_t tok = blockIdx.x; const float* xr = x1 + tok * DM; float v[4]; float s = 0.f;
    for (int i = 0; i < 4; ++i) { v[i] = xr[threadIdx.x + 256 * i]; s += v[i] * v[i]; }
    const float tot = block_sum256(s, red); const float rs = 1.0f / sqrtf(tot / DM + EPS);
    for (int i = 0; i < 4; ++i) { const int j = threadIdx.x + 256 * i; const float hv = v[i] * rs * w2[j]; hs[j] = hv; H2[tok * DM + j] = hv; }
    __syncthreads();
    { const int e = threadIdx.x & 31, seg = threadIdx.x >> 5; float acc = 0.f;
      for (int j = seg * 128; j < seg * 128 + 128; ++j) acc = fmaf(hs[j], rw[(size_t)j * NE + e], acc);
      part[seg][e] = acc; }
    __syncthreads();
    if (threadIdx.x < NE) { float a = rb[threadIdx.x]; for (int sgm = 0; sgm < 8; ++sgm) a += part[sgm][threadIdx.x]; lg[threadIdx.x] = a; }
    __syncthreads();
    if (threadIdx.x == 0) {
        int idx[4]; float val[4]; unsigned used = 0u;
        for (int k = 0; k < 4; ++k) { int bi = -1; float bv = -INFINITY; for (int e = 0; e < NE; ++e) if (!((used >> e) & 1u) && lg[e] > bv) { bv = lg[e]; bi = e; } used |= 1u << bi; idx[k] = bi; val[k] = bv; }
        float den = 0.f, ex[4]; for (int k = 0; k < 4; ++k) { ex[k] = expf(val[k] - val[0]); den += ex[k]; }
        for (int k = 0; k < 4; ++k) { const int pos = atomicAdd(&cnt[idx[k]], 1); list_tok[(size_t)idx[k] * NTOK + pos] = (int)tok; list_gate[(size_t)idx[k] * NTOK + pos] = ex[k] / den; }
    }
}

__global__ void __launch_bounds__(256) k_swiglu(const float* __restrict__ gu, const int* __restrict__ cntp, float* __restrict__ act) {
    const int r = blockIdx.x; if (r >= *cntp) return;
    for (int j = threadIdx.x; j < DFF; j += 256) {
        float gt = gu[(size_t)r * 2 * DFF + 2 * j], up = gu[(size_t)r * 2 * DFF + 2 * j + 1];
        gt = fminf(gt, 7.0f); up = fminf(fmaxf(up, -7.0f), 7.0f);
        const float glu = gt / (1.0f + expf(-1.702f * gt));
        act[(size_t)r * DFF + j] = (up + 1.0f) * glu;
    }
}
}

extern "C" void kernel_launch(void* const* d_in, const int* in_sizes, int n_in, void* d_out, int out_size, void* d_ws, size_t ws_size, hipStream_t stream) {
    using namespace nv;
    const float* x = (const float*)d_in[0]; const float* norm1_w = (const float*)d_in[1]; const float* w_in = (const float*)d_in[2];
    const float* sgu_norm_w = (const float*)d_in[3]; const float* sgu_w = (const float*)d_in[4]; const float* sgu_b = (const float*)d_in[5];
    const float* q_norm_w = (const float*)d_in[6]; const float* k_norm_w = (const float*)d_in[7]; const float* out_norm_a_w = (const float*)d_in[8];
    const float* out_norm_b_w = (const float*)d_in[9]; const float* w_out = (const float*)d_in[10]; const float* norm2_w = (const float*)d_in[11];
    const float* router_w = (const float*)d_in[12]; const float* router_b = (const float*)d_in[13]; const float* w_gate_up = (const float*)d_in[14];
    const float* b_gate_up = (const float*)d_in[15]; const float* w_down = (const float*)d_in[16]; const float* b_down = (const float*)d_in[17];
    float* out = (float*)d_out;
    char* ws = (char*)d_ws; const size_t MiB = 1u << 20;
    if (ws_size < 800 * MiB) { fprintf(stderr, "kernel_launch: workspace too small: %zu\n", ws_size); return; }
    int* cnt = (int*)ws;
    int* list_tok = (int*)(ws + 1 * MiB);
    float* list_gate = (float*)(ws + 5 * MiB);
    float* hn = (float*)(ws + 16 * MiB);
    float* Y = (float*)(ws + 144 * MiB);
    float* proj = (float*)(ws + 272 * MiB);
    float* gu = proj; float* act = (float*)(ws + (272 + 256) * MiB);
    hipMemsetAsync(cnt, 0, 4096, stream);
    k_rmsnorm<<<NTOK, 256, 0, stream>>>(x, norm1_w, hn);
    k_gemm<0><<<dim3(DIN / 64, NTOK / 64), 256, 0, stream>>>(hn, nullptr, nullptr, nullptr, w_in, nullptr, nullptr, nullptr, proj, NTOK, DIN, DM, DM, DIN);
    k_gmlp<<<dim3(NTOK / CHUNK, NG), 256, 0, stream>>>(proj, sgu_norm_w, sgu_w, sgu_b, out_norm_a_w, Y);
    k_qknorm<<<NTOK * 16 / 4, 256, 0, stream>>>(proj, q_norm_w, k_norm_w);
    k_sbattn<<<BATCH * NH * (SEQ / 64) / 4, 256, 0, stream>>>(proj, out_norm_b_w, Y);
    k_gemm<1><<<dim3(DM / 64, NTOK / 64), 256, 0, stream>>>(Y, nullptr, nullptr, nullptr, w_out, nullptr, x, nullptr, out, NTOK, DM, DM, DM, DM);
    k_router<<<NTOK, 256, 0, stream>>>(out, norm2_w, router_w, router_b, hn, cnt, list_tok, list_gate);
    for (int e = 0; e < NE; ++e) {
        const int* lt = list_tok + (size_t)e * NTOK; const float* lgp = list_gate + (size_t)e * NTOK;
        k_gemm<0><<<dim3(2 * DFF / 64, NTOK / 64), 256, 0, stream>>>(hn, lt, nullptr, cnt + e, w_gate_up + (size_t)e * DM * 2 * DFF, b_gate_up + (size_t)e * 2 * DFF, nullptr, nullptr, gu, NTOK, 2 * DFF, DM, DM, 2 * DFF);
        k_swiglu<<<NTOK, 256, 0, stream>>>(gu, cnt + e, act);
        k_gemm<3><<<dim3(DM / 64, NTOK / 64), 256, 0, stream>>>(act, nullptr, lt, cnt + e, w_down + (size_t)e * DFF * DM, b_down + (size_t)e * DM, nullptr, lgp, out, NTOK, DM, DFF, DFF, DM);
    }
}
```

```cpp
#include <hip/hip_runtime.h>
#include <cstdio>
#include <cstdint>
namespace mk {
#define LAS __attribute__((address_space(3)))
#define GAS __attribute__((address_space(1)))
typedef unsigned short bf16_t;
typedef short bf16x8 __attribute__((ext_vector_type(8)));
typedef short s16x4 __attribute__((ext_vector_type(4)));
typedef float f32x4 __attribute__((ext_vector_type(4)));
typedef float f32x2 __attribute__((ext_vector_type(2)));
typedef float f32x16 __attribute__((ext_vector_type(16)));
typedef unsigned u32x4 __attribute__((ext_vector_type(4)));
typedef unsigned u32x2 __attribute__((ext_vector_type(2)));

constexpr int NTOK = 32768, DM = 1024, SEQ = 4096, NB = 8, NH = 8, HD = 64, NE = 32, DFF = 1024, KD = 1024;
constexpr float EPS = 1e-5f;
constexpr float LOG2E = 1.4426950408889634f;
constexpr float QSCALE = 0.125f * LOG2E;
constexpr float SB_THR = 64.0f;
constexpr int NWAVES = 8;
constexpr int SLOTS = NTOK * 4 + NE * 256;

constexpr size_t MiB = 1u << 20;
constexpr size_t WS_CTL = 0, CTL_ZERO_BYTES = 1 * MiB;
constexpr size_t WS_LISTTOK = 1 * MiB;
constexpr size_t WS_LISTGATE = 5 * MiB;
constexpr size_t WS_TOKINFO = 9 * MiB;
constexpr size_t WS_RSTD1 = 10 * MiB;
constexpr size_t WS_SSPART = 11 * MiB;
constexpr size_t WS_RT = 13 * MiB;
constexpr size_t WS_WGU = 16 * MiB;
constexpr size_t WS_WD = 144 * MiB;
constexpr size_t WS_HB = 208 * MiB;
constexpr size_t WS_YS = 272 * MiB;
constexpr size_t WS_EARLY = 544 * MiB;
constexpr size_t WS_XB = WS_EARLY;
constexpr size_t WS_WIN = WS_EARLY + 64 * MiB;
constexpr size_t WS_WOUT = WS_EARLY + 70 * MiB;
constexpr size_t WS_UV = WS_EARLY + 72 * MiB;
constexpr size_t WS_Q = WS_EARLY + 136 * MiB;
constexpr size_t WS_K = WS_EARLY + 168 * MiB;
constexpr size_t WS_VT = WS_EARLY + 200 * MiB;
constexpr size_t WS_Y = WS_EARLY + 232 * MiB;
constexpr size_t WS_ACT = WS_EARLY;
constexpr size_t WS_END = WS_EARLY + 296 * MiB;
constexpr int CW_CNT = 64;
constexpr int CW_BAR = 4096;

constexpr int RING_BYTES = 131072;
constexpr int LDSCTL_OFF = RING_BYTES, MISC_OFF = LDSCTL_OFF + 320, TAB_OFF = LDSCTL_OFF + 1024;
constexpr int LDS_BYTES = 147456;

__device__ __forceinline__ unsigned cvt_pk_bf16(float lo, float hi) { unsigned r; asm volatile("v_cvt_pk_bf16_f32 %0, %1, %2" : "=v"(r) : "v"(lo), "v"(hi)); return r; }
__device__ __forceinline__ float bf2f(unsigned short h) { return __uint_as_float((unsigned)h << 16); }
__device__ __forceinline__ float bflo(unsigned w) { return __uint_as_float(w << 16); }
__device__ __forceinline__ float bfhi(unsigned w) { return __uint_as_float(w & 0xffff0000u); }
__device__ __forceinline__ float wave_sum(float v) {
#pragma unroll
    for (int o = 1; o < 64; o <<= 1) v += __shfl_xor(v, o);
    return v;
}
__device__ __forceinline__ float gelu_tanh_f(float x) {
    const float u = 0.7978845608028654f * (x + 0.044715f * x * x * x);
    return x * __builtin_amdgcn_rcpf(1.0f + __builtin_amdgcn_exp2f(-2.0f * LOG2E * u));
}

constexpr int BM = 256, BK = 64, HALF = 128, HTB = HALF * BK * 2;
__device__ __forceinline__ int lds_byte(int r, int c) { const int st = (r >> 4) * 2 + (c >> 5), rr = r & 15, cc = c & 31, ob = rr * 64 + cc * 2; return st * 1024 + (ob ^ (((ob >> 9) & 1) << 5)); }
__device__ __forceinline__ void stage_rc(int b, int& R, int& C) { const int st = b / 1024, sb = b % 1024, swz = sb ^ (((sb >> 9) & 1) << 5); R = (st >> 1) * 16 + swz / 64; C = (st & 1) * 32 + (swz % 64) / 2; }
__device__ __forceinline__ int perm32(int rho) { const int n = rho >> 4, i = rho & 15; return 8 * (i >> 2) + 4 * n + (i & 3); }

struct Unit { const char* A; const char* B; int kind, pm, pn, e, r0; };

template <class Prog>
__device__ __forceinline__ void gemm_phase(LAS unsigned char* lds, const Prog& P) {
    const int tid = threadIdx.x, wid = __builtin_amdgcn_readfirstlane(tid >> 6), lane = tid & 63, wr = wid >> 2, wc = wid & 3, fr = lane & 15, fq = lane >> 4;
    constexpr int K = KD, nt = K / BK;
    int Rr[2], Cc[2]; unsigned voffB[2];
#pragma unroll
    for (int i = 0; i < 2; ++i) { stage_rc(tid * 16 + i * 8192, Rr[i], Cc[i]); const int Rb = (Rr[i] & ~31) + perm32(Rr[i] & 31); voffB[i] = (unsigned)(Rb * K + Cc[i]) * 2u; }
    constexpr size_t kstep = (size_t)(BK * 2);
    constexpr size_t hstep = (size_t)HALF * K * 2;
    const unsigned ldsw = (unsigned)wid * 1024u;
    const int aoff = lds_byte(wr * 64 + fr, fq * 8), boff = lds_byte(wc * 32 + fr, fq * 8);
#define MK_SA(b, h) (((b) * 2 + (h)) * HTB)
#define MK_SB(b, h) ((4 + (b) * 2 + (h)) * HTB)
#define MK_STAGE(bufoff, gbase, voff) do { _Pragma("unroll") for (int _i = 0; _i < 2; ++_i) \
        __builtin_amdgcn_global_load_lds((const unsigned*)((const char*)(gbase) + (voff)[_i]), (LAS unsigned*)(lds + (bufoff) + ldsw + _i * 8192), 16, 0, 0); } while (0)
#define MK_LDA(dst, b, h) do { _Pragma("unroll") for (int m = 0; m < 4; ++m) _Pragma("unroll") for (int k = 0; k < 2; ++k) dst[m][k] = *(const LAS bf16x8*)(lds + MK_SA(b, h) + aoff + m * 2048 + k * 1024); } while (0)
#define MK_LDB(dst, b, h) do { _Pragma("unroll") for (int n = 0; n < 2; ++n) _Pragma("unroll") for (int k = 0; k < 2; ++k) dst[n][k] = *(const LAS bf16x8*)(lds + MK_SB(b, h) + boff + n * 2048 + k * 1024); } while (0)
#define MK_MMA(ai, bj, At, Bt) do { __builtin_amdgcn_s_setprio(1); _Pragma("unroll") for (int m = 0; m < 4; ++m) _Pragma("unroll") for (int n = 0; n < 2; ++n) _Pragma("unroll") for (int k = 0; k < 2; ++k) \
        acc[ai][bj][m][n] = __builtin_amdgcn_mfma_f32_16x16x32_bf16(Bt[n][k], At[m][k], acc[ai][bj][m][n], 0, 0, 0); __builtin_amdgcn_s_setprio(0); } while (0)
#define MK_WAIT_V(n) asm volatile("s_waitcnt vmcnt(" #n ")" ::: "memory")
#define MK_WAIT_L(n) asm volatile("s_waitcnt lgkmcnt(" #n ")" ::: "memory")
#define MK_BAR __builtin_amdgcn_s_barrier()
#define MK_SCHED __builtin_amdgcn_sched_barrier(0)
    Unit cur, nxt; int ui = 0;
    if (!P.next(0, cur)) return;
    unsigned voC[2][2], voN[2][2];
    P.aoffs(cur, Rr, Cc, voC);
    f32x4 acc[2][2][4][2];
#pragma unroll
    for (int a = 0; a < 2; ++a)
#pragma unroll
        for (int b = 0; b < 2; ++b)
#pragma unroll
            for (int m = 0; m < 4; ++m)
#pragma unroll
                for (int n = 0; n < 2; ++n) acc[a][b][m][n] = (f32x4){0.f, 0.f, 0.f, 0.f};
    bf16x8 At[4][2], B0[2][2], B1[2][2];
    const char* cA = cur.A; const char* cB = cur.B;
    MK_STAGE(MK_SB(0, 0), cB, voffB); MK_STAGE(MK_SB(0, 1), cB + hstep, voffB); MK_STAGE(MK_SA(0, 0), cA, voC[0]); MK_STAGE(MK_SA(0, 1), cA, voC[1]);
    if (wr == 1) MK_BAR;
    MK_WAIT_V(2); MK_BAR;
    MK_STAGE(MK_SB(1, 0), cB + kstep, voffB); MK_STAGE(MK_SA(1, 0), cA + kstep, voC[0]); MK_STAGE(MK_SB(1, 1), cB + hstep + kstep, voffB);
    MK_WAIT_V(6); MK_BAR;
    for (;;) {
        const bool has_next = P.next(ui + 1, nxt);
        if (has_next) P.aoffs(nxt, Rr, Cc, voN);
        else { nxt = cur; voN[0][0] = voC[0][0]; voN[0][1] = voC[0][1]; voN[1][0] = voC[1][0]; voN[1][1] = voC[1][1]; }
        const char* nA = nxt.A; const char* nB = nxt.B;
        for (int t = 0; t < nt; t += 2) {
            const bool last = (t == nt - 2);
            const char* a1 = cA + (size_t)(t + 1) * kstep;
            const char* a2 = last ? nA : cA + (size_t)(t + 2) * kstep; const char* b2 = last ? nB : cB + (size_t)(t + 2) * kstep;
            const char* a3 = a2 + kstep; const char* b3 = b2 + kstep;
            unsigned o2[2][2];
            o2[0][0] = last ? voN[0][0] : voC[0][0]; o2[0][1] = last ? voN[0][1] : voC[0][1]; o2[1][0] = last ? voN[1][0] : voC[1][0]; o2[1][1] = last ? voN[1][1] : voC[1][1];
            MK_LDB(B0, 0, 0); MK_LDB(B1, 0, 1); MK_SCHED; MK_LDA(At, 0, 0); MK_STAGE(MK_SA(1, 1), a1, voC[1]);
            MK_WAIT_V(8); MK_WAIT_L(0); MK_BAR; MK_MMA(0, 0, At, B0); MK_MMA(0, 1, At, B1); MK_BAR; MK_SCHED;
            MK_LDA(At, 0, 1); MK_STAGE(MK_SB(0, 0), b2, voffB); MK_STAGE(MK_SB(0, 1), b2 + hstep, voffB); MK_STAGE(MK_SA(0, 0), a2, o2[0]);
            MK_WAIT_V(8); MK_WAIT_L(0); MK_BAR; MK_MMA(1, 0, At, B0); MK_MMA(1, 1, At, B1); MK_BAR; MK_SCHED;
            MK_LDB(B0, 1, 0); MK_LDB(B1, 1, 1); MK_SCHED; MK_LDA(At, 1, 0); MK_STAGE(MK_SA(0, 1), a2, o2[1]);
            MK_WAIT_V(8); MK_WAIT_L(0); MK_BAR; MK_MMA(0, 0, At, B0); MK_MMA(0, 1, At, B1); MK_BAR; MK_SCHED;
            MK_LDA(At, 1, 1); MK_STAGE(MK_SB(1, 0), b3, voffB); MK_STAGE(MK_SB(1, 1), b3 + hstep, voffB); MK_STAGE(MK_SA(1, 0), a3, o2[0]);
            MK_WAIT_V(8); MK_WAIT_L(0); MK_BAR; MK_MMA(1, 0, At, B0); MK_MMA(1, 1, At, B1); MK_BAR; MK_SCHED;
        }
        if (wr == 0) MK_BAR;
        P.epi(acc, cur, wr, wc, fr, fq);
        if (!has_next) break;
#pragma unroll
        for (int a = 0; a < 2; ++a)
#pragma unroll
            for (int b = 0; b < 2; ++b)
#pragma unroll
                for (int m = 0; m < 4; ++m)
#pragma unroll
                    for (int n = 0; n < 2; ++n) acc[a][b][m][n] = (f32x4){0.f, 0.f, 0.f, 0.f};
        cur = nxt; cA = nA; cB = nB; ++ui;
        voC[0][0] = voN[0][0]; voC[0][1] = voN[0][1]; voC[1][0] = voN[1][0]; voC[1][1] = voN[1][1];
        if (wr == 1) MK_BAR;
    }
    MK_WAIT_V(0);
    MK_BAR;
#undef MK_SA
#undef MK_SB
#undef MK_STAGE
#undef MK_LDA
#undef MK_LDB
#undef MK_MMA
}
typedef f32x4 Acc[2][2][4][2];

#define XB_TMO      128
#define XB_XCNT(j)  (256  + 64 * (j))
#define XB_XSUB(j)  (1280 + 64 * (j))
#define XB_XGEN(j)  (2304 + 64 * (j))
#define XB_TOP      3328
#define XB_TOPGEN   3392
#define XCD_BAR_WORDS 3456
#define XB_SPIN_CAP (1u << 18)
__device__ __forceinline__ unsigned xb_ld(unsigned* p)              { return __hip_atomic_load(p, __ATOMIC_RELAXED, __HIP_MEMORY_SCOPE_AGENT); }
__device__ __forceinline__ unsigned xb_add(unsigned* p, unsigned v) { return __hip_atomic_fetch_add(p, v, __ATOMIC_RELAXED, __HIP_MEMORY_SCOPE_AGENT); }
__device__ __forceinline__ unsigned xb_xcc_id() { return (unsigned)__builtin_amdgcn_s_getreg((3 << 11) | 20) & 0xFu; }
#define XB_SPIN(cond, bar) do { unsigned _sp = 0; while (cond) { __builtin_amdgcn_s_sleep(1); \
    if ((++_sp & 255u) == 0u) { if (xb_ld(&(bar)[XB_TMO])) break; if (_sp > XB_SPIN_CAP) { atomicAdd(&(bar)[XB_TMO], 1u); break; } } } } while (0)
struct XcdBarrier { unsigned* bar; unsigned x; volatile LAS unsigned* st; };
__device__ __forceinline__ XcdBarrier xcd_barrier_post(unsigned* bar, volatile LAS unsigned* st) {
    XcdBarrier b; b.bar = bar; b.x = xb_xcc_id(); b.st = st;
    if (threadIdx.x == 0) (void)xb_add(&bar[XB_XCNT(b.x)], 1u);
    return b;
}
__device__ __forceinline__ void xcd_barrier_complete(unsigned* bar, unsigned x, unsigned& nloc, unsigned& nx) {
    const unsigned G = gridDim.x * gridDim.y * gridDim.z;
    unsigned sum, cnt, mine, sp = 0u;
    for (;;) {
        sum = 0u; cnt = 0u; mine = 0u;
#pragma unroll
        for (unsigned j = 0; j < 16; ++j) { const unsigned c = xb_ld(&bar[XB_XCNT(j)]); sum += c; cnt += (c > 0u) ? 1u : 0u; mine = (j == x) ? c : mine; }
        if (sum == G) break;
        __builtin_amdgcn_s_sleep(1);
        if ((++sp & 255u) == 0u) { if (xb_ld(&bar[XB_TMO])) break; if (sp > XB_SPIN_CAP) { atomicAdd(&bar[XB_TMO], 1u); break; } }
    }
    nloc = mine > 0u ? mine : 1u; nx = cnt > 0u ? cnt : 1u;
}
__device__ __forceinline__ void xcd_barrier(const XcdBarrier& b) {
    asm volatile("s_waitcnt vmcnt(0)" ::: "memory");
    __syncthreads();
    if (threadIdx.x == 0) {
        unsigned* bar = b.bar;
        __builtin_amdgcn_s_waitcnt(0);
        unsigned nloc = b.st[0], nx = b.st[1];
        if (nloc == 0u) { xcd_barrier_complete(bar, b.x, nloc, nx); b.st[0] = nloc; b.st[1] = nx; }
        const unsigned old = xb_add(&bar[XB_XSUB(b.x)], 1u);
        const unsigned gen = old / nloc;
        if (old + 1u == (gen + 1u) * nloc) {
            __builtin_amdgcn_fence(__ATOMIC_RELEASE, "agent");
            asm volatile("s_waitcnt vmcnt(0)" ::: "memory");
            const unsigned og = xb_add(&bar[XB_TOP], 1u);
            const unsigned tg = og / nx;
            if (og + 1u == (tg + 1u) * nx) xb_add(&bar[XB_TOPGEN], 1u);
            else XB_SPIN(xb_ld(&bar[XB_TOPGEN]) == tg, bar);
            __builtin_amdgcn_fence(__ATOMIC_ACQUIRE, "agent");
            xb_add(&bar[XB_XGEN(b.x)], 1u);
            asm volatile("s_waitcnt vmcnt(0)" ::: "memory");
        } else {
            XB_SPIN(xb_ld(&bar[XB_XGEN(b.x)]) == gen, bar);
            __builtin_amdgcn_fence(__ATOMIC_ACQUIRE, "agent");
            asm volatile("s_waitcnt vmcnt(0)" ::: "memory");
        }
    }
    __syncthreads();
}

struct Args {
    const float* in[18]; float* out; unsigned char* ws; int ph_lo, ph_hi;
};
struct Frame {
    LAS unsigned char* lds; int tid, lane, wave, vcu, G;
    const float *x, *norm1_w, *w_in, *sgu_norm_w, *sgu_w, *sgu_b, *q_norm_w, *k_norm_w, *out_norm_a_w, *out_norm_b_w, *w_out, *norm2_w, *router_w, *router_b, *w_gate_up, *b_gate_up, *w_down, *b_down;
    float* out; unsigned char* ws;
    bf16_t *XB, *WIN, *WOUT, *UV, *Q, *K, *VT, *Y, *HB, *WGU, *WD, *ACT, *YS, *RT;
    float *RSTD1, *SSPART, *LISTGATE; int *LISTTOK, *TOKINFO; unsigned* ctl;
};

__device__ __forceinline__ void p0_transpose_item(const float* W, int K, int N, bf16_t* WT, int k0, int n0, int drow0, const float* kscale, LAS float* scr, int lane) {
#pragma unroll 8
    for (int i = 0; i < 32; ++i) { const int kk = 2 * i + (lane >> 5); float v = W[(size_t)(k0 + kk) * N + n0 + (lane & 31)]; if (kscale) v *= kscale[k0 + kk]; scr[kk * 33 + (lane & 31)] = v; }
    asm volatile("s_waitcnt lgkmcnt(0)" ::: "memory");
    const int c = lane & 7;
#pragma unroll
    for (int j = 0; j < 4; ++j) { const int n = (lane >> 3) + 8 * j; const LAS float* s = scr + (8 * c) * 33 + n;
        u32x4 o; o.x = cvt_pk_bf16(s[0 * 33], s[1 * 33]); o.y = cvt_pk_bf16(s[2 * 33], s[3 * 33]); o.z = cvt_pk_bf16(s[4 * 33], s[5 * 33]); o.w = cvt_pk_bf16(s[6 * 33], s[7 * 33]);
        *(u32x4*)(WT + (size_t)(drow0 + n) * K + k0 + 8 * c) = o; }
    asm volatile("s_waitcnt lgkmcnt(0)" ::: "memory");
}
__device__ __forceinline__ int win_drow(int n0) {
    if (n0 < 1024 || n0 >= 2048) return n0;
    const int rel = n0 - 1024, isk = rel >> 9, head = (rel & 511) >> 6, dh = (rel & 63) >> 5;
    return 256 * (4 + 2 * isk + (head >> 2)) + 128 * dh + 32 * (head & 3);
}
__device__ __forceinline__ void p0_prologue(Frame& F) {
    LAS float* scr = (LAS float*)(F.lds + F.wave * 16384);
    const int gw = F.vcu * NWAVES + F.wave, NGW = F.G * NWAVES, lane = F.lane;
    for (int m = gw; m < NTOK; m += NGW) {
        const f32x4* xr = (const f32x4*)(F.x + (size_t)m * DM) + lane; f32x4 v[4]; float s = 0.f;
#pragma unroll
        for (int j = 0; j < 4; ++j) { v[j] = xr[64 * j]; s += (v[j].x * v[j].x + v[j].y * v[j].y) + (v[j].z * v[j].z + v[j].w * v[j].w); }
        const float tot = wave_sum(s);
        if (lane == 0) F.RSTD1[m] = 1.0f / sqrtf(tot * (1.0f / DM) + EPS);
        u32x2* o8 = (u32x2*)(F.XB + (size_t)m * DM) + lane;
#pragma unroll
        for (int j = 0; j < 4; ++j) { u32x2 w; w.x = cvt_pk_bf16(v[j].x, v[j].y); w.y = cvt_pk_bf16(v[j].z, v[j].w); o8[64 * j] = w; }
    }
    constexpr int I_IN = 16 * 80, I_OUT = 16 * 32, I_GU = 16 * 64, I_D = 16 * 32;
    constexpr int NITEMS = I_IN + I_OUT + NE * I_GU + NE * I_D;
    for (int it = gw; it < NITEMS; it += NGW) {
        int r = it;
        if (r < I_IN) { const int kb = r / 80, nb = r % 80; p0_transpose_item(F.w_in, KD, 2560, F.WIN, 64 * kb, 32 * nb, win_drow(32 * nb), F.norm1_w, scr, lane); continue; } r -= I_IN;
        if (r < I_OUT) { const int kb = r / 32, nb = r % 32; p0_transpose_item(F.w_out, KD, 1024, F.WOUT, 64 * kb, 32 * nb, 32 * nb, nullptr, scr, lane); continue; } r -= I_OUT;
        if (r < NE * I_GU) { const int e = r / I_GU, q = r % I_GU, kb = q / 64, nb = q % 64;
            p0_transpose_item(F.w_gate_up + (size_t)e * KD * 2048, KD, 2048, F.WGU + (size_t)e * 2048 * KD, 64 * kb, 32 * nb, 32 * nb, nullptr, scr, lane); continue; } r -= NE * I_GU;
        { const int e = r / I_D, q = r % I_D, kb = q / 32, nb = q % 32;
            p0_transpose_item(F.w_down + (size_t)e * KD * 1024, KD, 1024, F.WD + (size_t)e * 1024 * KD, 64 * kb, 32 * nb, 32 * nb, nullptr, scr, lane); }
    }
    for (int idx = gw * 64 + lane; idx < NE * KD; idx += NGW * 64) {
        const int e = idx >> 10, k = idx & 1023; const float w = F.router_w[(size_t)k * NE + e];
        const unsigned hi = cvt_pk_bf16(w, 0.f) & 0xffffu; const float rem = w - __uint_as_float(hi << 16);
        F.RT[idx] = (bf16_t)hi; F.RT[NE * KD + idx] = (bf16_t)(cvt_pk_bf16(rem, 0.f) & 0xffffu);
    }
}

struct ProgIn {
    const Frame* F;
    __device__ __forceinline__ bool next(int i, Unit& u) const {
        const int v = F->vcu;
        if (i < 4) { const int uu = i * 256 + v, grp = uu >> 5, w = uu & 31; u.pm = grp * 4 + (w & 3); u.pn = w >> 2; u.kind = u.pn < 4 ? 0 : 1;
            u.A = (const char*)F->XB; u.B = (const char*)(F->WIN + (size_t)u.pn * 256 * KD); u.e = 0; u.r0 = 0; return true; }
        if (i == 4) { u.kind = 2; u.pm = v & 1; u.pn = v >> 1; u.A = (const char*)(F->WIN + (size_t)2048 * KD); u.B = (const char*)(F->XB + (size_t)u.pn * 256 * KD); u.e = 0; u.r0 = 0; return true; }
        return false;
    }
    __device__ __forceinline__ void aoffs(const Unit& u, const int (&R)[2], const int (&C)[2], unsigned (&vo)[2][2]) const {
#pragma unroll
        for (int h = 0; h < 2; ++h)
#pragma unroll
            for (int i = 0; i < 2; ++i) vo[h][i] = (unsigned)((u.pm * 256 + h * 128 + R[i]) * KD + C[i]) * 2u;
    }
    __device__ __forceinline__ void epi(const Acc& acc, const Unit& u, int wr, int wc, int fr, int fq) const {
        asm volatile("" : "+v"(fr), "+v"(fq));
        if (u.kind == 2) {
            const int tk0 = u.pn * 256 + wc * 32 + 8 * fq;
            f32x4 rs[2][2];
#pragma unroll
            for (int bj = 0; bj < 2; ++bj)
#pragma unroll
                for (int n = 0; n < 2; ++n) rs[bj][n] = *(const f32x4*)(F->RSTD1 + tk0 + bj * 128 + 4 * n);
#pragma unroll
            for (int ai = 0; ai < 2; ++ai)
#pragma unroll
                for (int m = 0; m < 4; ++m) { const int cp = u.pm * 256 + ai * 128 + wr * 64 + m * 16 + fr; bf16_t* rowp = F->VT + (size_t)cp * NTOK + tk0;
#pragma unroll
                    for (int bj = 0; bj < 2; ++bj) { const f32x4 v0 = acc[ai][bj][m][0] * rs[bj][0], v1 = acc[ai][bj][m][1] * rs[bj][1];
                        u32x4 w; w.x = cvt_pk_bf16(v0[0], v0[1]); w.y = cvt_pk_bf16(v0[2], v0[3]); w.z = cvt_pk_bf16(v1[0], v1[1]); w.w = cvt_pk_bf16(v1[2], v1[3]);
                        *(u32x4*)(rowp + bj * 128) = w; } }
            return;
        }
        float rsr[2][4];
#pragma unroll
        for (int ai = 0; ai < 2; ++ai)
#pragma unroll
            for (int m = 0; m < 4; ++m) rsr[ai][m] = F->RSTD1[u.pm * 256 + ai * 128 + wr * 64 + m * 16 + fr];
        if (u.kind == 0) {
#pragma unroll
            for (int ai = 0; ai < 2; ++ai)
#pragma unroll
                for (int m = 0; m < 4; ++m) { const int r = u.pm * 256 + ai * 128 + wr * 64 + m * 16 + fr; bf16_t* rowp = F->UV + (size_t)r * 1024 + u.pn * 256 + wc * 32 + 8 * fq; const float rs = rsr[ai][m];
#pragma unroll
                    for (int bj = 0; bj < 2; ++bj) { f32x4 v0 = acc[ai][bj][m][0] * rs, v1 = acc[ai][bj][m][1] * rs;
#pragma unroll
                        for (int j = 0; j < 4; ++j) { v0[j] = gelu_tanh_f(v0[j]); v1[j] = gelu_tanh_f(v1[j]); }
                        u32x4 w; w.x = cvt_pk_bf16(v0[0], v0[1]); w.y = cvt_pk_bf16(v0[2], v0[3]); w.z = cvt_pk_bf16(v1[0], v1[1]); w.w = cvt_pk_bf16(v1[2], v1[3]);
                        *(u32x4*)(rowp + bj * 128) = w; } }
            return;
        }
        {
            const int isk = (u.pn - 4) >> 1, head = 4 * (u.pn & 1) + wc; const float* nw = isk ? F->k_norm_w : F->q_norm_w; bf16_t* dst = isk ? F->K : F->Q;
            const float osc = isk ? 1.0f : QSCALE;
            f32x4 nwv[2][2];
#pragma unroll
            for (int bj = 0; bj < 2; ++bj)
#pragma unroll
                for (int n = 0; n < 2; ++n) nwv[bj][n] = *(const f32x4*)(nw + 32 * bj + 8 * fq + 4 * n);
#pragma unroll
            for (int ai = 0; ai < 2; ++ai)
#pragma unroll
                for (int m = 0; m < 4; ++m) { const int r = u.pm * 256 + ai * 128 + wr * 64 + m * 16 + fr; const float rs = rsr[ai][m];
                    f32x4 t[2][2]; float ss = 0.f;
#pragma unroll
                    for (int bj = 0; bj < 2; ++bj)
#pragma unroll
                        for (int n = 0; n < 2; ++n) { t[bj][n] = acc[ai][bj][m][n] * rs; ss += (t[bj][n][0] * t[bj][n][0] + t[bj][n][1] * t[bj][n][1]) + (t[bj][n][2] * t[bj][n][2] + t[bj][n][3] * t[bj][n][3]); }
                    ss += __shfl_xor(ss, 16); ss += __shfl_xor(ss, 32);
                    const float rn = osc / sqrtf(ss * (1.0f / 64.0f) + EPS);
                    bf16_t* rowp = dst + (size_t)r * 512 + head * 64 + 8 * fq;
#pragma unroll
                    for (int bj = 0; bj < 2; ++bj) { const f32x4 v0 = t[bj][0] * nwv[bj][0] * rn, v1 = t[bj][1] * nwv[bj][1] * rn;
                        u32x4 w; w.x = cvt_pk_bf16(v0[0], v0[1]); w.y = cvt_pk_bf16(v0[2], v0[3]); w.z = cvt_pk_bf16(v1[0], v1[1]); w.w = cvt_pk_bf16(v1[2], v1[3]);
                        *(u32x4*)(rowp + bj * 32) = w; } }
        }
    }
};

constexpr int VN_PITCH = 136, YT_PITCH = 132, YT_OFF = 36864;
__device__ __forceinline__ void gmlp_unit(const Frame& F, int chunk, int g) {
    const int tid = F.tid, lane = F.lane, wid = F.wave;
    LAS bf16_t* vn = (LAS bf16_t*)F.lds; LAS float* yt = (LAS float*)(F.lds + YT_OFF);
    const size_t tok0 = (size_t)chunk * 128;
    {
        const int row = tid >> 2, qd = tid & 3; const bf16_t* src = F.UV + (tok0 + row) * 1024 + 512 + g * 128 + qd * 32;
        u32x4 w[4]; float v[32]; float ss = 0.f;
#pragma unroll
        for (int i = 0; i < 4; ++i) w[i] = *(const u32x4*)(src + 8 * i);
#pragma unroll
        for (int i = 0; i < 4; ++i)
#pragma unroll
            for (int j = 0; j < 4; ++j) { v[8 * i + 2 * j] = bflo(w[i][j]); v[8 * i + 2 * j + 1] = bfhi(w[i][j]); }
#pragma unroll
        for (int i = 0; i < 32; ++i) ss += v[i] * v[i];
        ss += __shfl_xor(ss, 1); ss += __shfl_xor(ss, 2);
        const float rs = 1.0f / sqrtf(ss * (1.0f / 128.0f) + EPS);
        const float* nw = F.sgu_norm_w + g * 128 + qd * 32;
#pragma unroll
        for (int i = 0; i < 4; ++i) { const f32x4 n0 = *(const f32x4*)(nw + 8 * i), n1 = *(const f32x4*)(nw + 8 * i + 4);
            u32x4 o; o.x = cvt_pk_bf16(v[8 * i] * rs * n0[0], v[8 * i + 1] * rs * n0[1]); o.y = cvt_pk_bf16(v[8 * i + 2] * rs * n0[2], v[8 * i + 3] * rs * n0[3]);
            o.z = cvt_pk_bf16(v[8 * i + 4] * rs * n1[0], v[8 * i + 5] * rs * n1[1]); o.w = cvt_pk_bf16(v[8 * i + 6] * rs * n1[2], v[8 * i + 7] * rs * n1[3]);
            *(LAS u32x4*)(vn + row * VN_PITCH + qd * 32 + 8 * i) = o; }
    }
    __syncthreads();
    {
        const int tb = wid >> 1, cb0 = 2 * (wid & 1), r32 = lane & 31, hh = lane >> 5;
        f32x16 a0 = {}, a1 = {};
        const int t = 32 * tb + r32; const float* wrow = F.sgu_w + ((size_t)g * 128 + t) * 128;
        for (int ks = 0; ks < 2 * (tb + 1); ++ks) {
            const int s0 = 16 * ks + 8 * hh;
            const f32x4 w0 = *(const f32x4*)(wrow + s0), w1 = *(const f32x4*)(wrow + s0 + 4);
            float wv[8] = {w0[0], w0[1], w0[2], w0[3], w1[0], w1[1], w1[2], w1[3]};
#pragma unroll
            for (int j = 0; j < 8; ++j) if (s0 + j > t) wv[j] = 0.f;
            u32x4 aw; aw.x = cvt_pk_bf16(wv[0], wv[1]); aw.y = cvt_pk_bf16(wv[2], wv[3]); aw.z = cvt_pk_bf16(wv[4], wv[5]); aw.w = cvt_pk_bf16(wv[6], wv[7]);
            const bf16x8 af = __builtin_bit_cast(bf16x8, aw);
            bf16x8 b0, b1;
#pragma unroll
            for (int j = 0; j < 8; ++j) { b0[j] = (short)vn[(s0 + j) * VN_PITCH + 32 * cb0 + r32]; b1[j] = (short)vn[(s0 + j) * VN_PITCH + 32 * (cb0 + 1) + r32]; }
            a0 = __builtin_amdgcn_mfma_f32_32x32x16_bf16(af, b0, a0, 0, 0, 0);
            a1 = __builtin_amdgcn_mfma_f32_32x32x16_bf16(af, b1, a1, 0, 0, 0);
        }
#pragma unroll
        for (int reg = 0; reg < 16; ++reg) {
            const int tt = 32 * tb + (reg & 3) + 8 * (reg >> 2) + 4 * hh; const float bb = F.sgu_b[g * 128 + tt];
            const bf16_t* up = F.UV + (tok0 + tt) * 1024 + g * 128;
            const int c0 = 32 * cb0 + r32, c1 = c0 + 32;
            yt[tt * YT_PITCH + c0] = bf2f(up[c0]) * (a0[reg] + bb);
            yt[tt * YT_PITCH + c1] = bf2f(up[c1]) * (a1[reg] + bb);
        }
    }
    __syncthreads();
    {
        const int row = tid >> 2, qd = tid & 3; const LAS float* src = yt + row * YT_PITCH + qd * 32; f32x4 v[8]; float ss = 0.f;
#pragma unroll
        for (int i = 0; i < 8; ++i) { v[i] = *(const LAS f32x4*)(src + 4 * i); ss += (v[i][0] * v[i][0] + v[i][1] * v[i][1]) + (v[i][2] * v[i][2] + v[i][3] * v[i][3]); }
        ss += __shfl_xor(ss, 1); ss += __shfl_xor(ss, 2);
        const float rs = 1.0f / sqrtf(ss * (1.0f / 128.0f) + EPS);
        const float* nw = F.out_norm_a_w + g * 128 + qd * 32; bf16_t* dst = F.Y + (tok0 + row) * 1024 + g * 128 + qd * 32;
#pragma unroll
        for (int i = 0; i < 4; ++i) { const f32x4 n0 = *(const f32x4*)(nw + 8 * i), n1 = *(const f32x4*)(nw + 8 * i + 4); const f32x4 x0 = v[2 * i] * n0 * rs, x1 = v[2 * i + 1] * n1 * rs;
            u32x4 o; o.x = cvt_pk_bf16(x0[0], x0[1]); o.y = cvt_pk_bf16(x0[2], x0[3]); o.z = cvt_pk_bf16(x1[0], x1[1]); o.w = cvt_pk_bf16(x1[2], x1[3]);
            *(u32x4*)(dst + 8 * i) = o; }
    }
    __syncthreads();
}

__device__ __forceinline__ void attn_wave_unit(const Frame& F, int b, int h, int qblk) {
    const int lane = F.lane, r32 = lane & 31, hi = lane >> 5;
    const size_t tokq = (size_t)b * SEQ + 32 * qblk + r32;
    bf16x8 qr[4];
#pragma unroll
    for (int d0 = 0; d0 < 4; ++d0) qr[d0] = *(const bf16x8*)(F.Q + tokq * 512 + h * 64 + 16 * d0 + 8 * hi);
    f32x16 o0 = {}, o1 = {};
    float carry = 0.f;
    const bf16_t* Kb = F.K + ((size_t)b * SEQ + r32) * 512 + h * 64 + 8 * hi;
    const bf16_t* V0 = F.VT + (size_t)(h * 64 + r32) * NTOK + (size_t)b * SEQ + 4 * hi;
    bf16x8 kf[4]; s16x4 vf[2][2][2];
    auto load_tile = [&](int j, bf16x8 (&kk)[4], s16x4 (&vv)[2][2][2]) {
#pragma unroll
        for (int d0 = 0; d0 < 4; ++d0) kk[d0] = *(const bf16x8*)(Kb + (size_t)(32 * j) * 512 + 16 * d0);
#pragma unroll
        for (int dh = 0; dh < 2; ++dh)
#pragma unroll
            for (int ks = 0; ks < 2; ++ks) { const bf16_t* p = V0 + (size_t)dh * 32 * NTOK + 32 * j + 16 * ks; vv[dh][ks][0] = *(const s16x4*)p; vv[dh][ks][1] = *(const s16x4*)(p + 8); }
    };
    load_tile(qblk, kf, vf);
    for (int j = qblk; j >= 0; --j) {
        bf16x8 kn[4]; s16x4 vn2[2][2][2];
        if (j > 0) load_tile(j - 1, kn, vn2);
        else {
#pragma unroll
            for (int d0 = 0; d0 < 4; ++d0) kn[d0] = kf[d0];
#pragma unroll
            for (int dh = 0; dh < 2; ++dh)
#pragma unroll
                for (int ks = 0; ks < 2; ++ks) { vn2[dh][ks][0] = vf[dh][ks][0]; vn2[dh][ks][1] = vf[dh][ks][1]; }
        }
        f32x16 s = {};
#pragma unroll
        for (int d0 = 0; d0 < 4; ++d0) s = __builtin_amdgcn_mfma_f32_32x32x16_bf16(kf[d0], qr[d0], s, 0, 0, 0);
        float sp[16];
        const bool diag = (j == qblk);
#pragma unroll
        for (int r = 0; r < 16; ++r) {
            const int kvl = (r & 3) + 8 * (r >> 2) + 4 * hi;
            const float z = s[r];
            float v = fmaxf(z, 0.f) + __builtin_amdgcn_logf(1.0f + __builtin_amdgcn_exp2f(-fabsf(z)));
            if (diag && kvl >= r32) v = 0.f;
            sp[r] = v;
        }
        float G[4], Gp[4];
#pragma unroll
        for (int k = 0; k < 4; ++k) { G[k] = (sp[4 * k] + sp[4 * k + 1]) + (sp[4 * k + 2] + sp[4 * k + 3]); Gp[k] = __shfl_xor(G[k], 32); }
        const float T3 = G[3] + Gp[3], T2 = G[2] + Gp[2], T1 = G[1] + Gp[1], T0 = G[0] + Gp[0];
        float off[4];
        off[3] = 0.f; off[2] = T3; off[1] = T3 + T2; off[0] = T3 + T2 + T1;
        const float tile_total = off[0] + T0;
#pragma unroll
        for (int k = 0; k < 4; ++k) off[k] += carry + (hi == 0 ? Gp[k] : 0.f);
        float a[16];
#pragma unroll
        for (int k = 0; k < 4; ++k) {
            float c = off[k];
#pragma unroll
            for (int i = 3; i >= 0; --i) { const int r = 4 * k + i; c += sp[r]; float av = __builtin_amdgcn_exp2f(s[r] - c);
                if (diag && ((r & 3) + 8 * (r >> 2) + 4 * hi) >= r32) av = 0.f;
                a[r] = av; }
        }
        carry += tile_total;
        u32x4 p0, p1;
        p0.x = cvt_pk_bf16(a[0], a[1]); p0.y = cvt_pk_bf16(a[2], a[3]); p0.z = cvt_pk_bf16(a[4], a[5]); p0.w = cvt_pk_bf16(a[6], a[7]);
        p1.x = cvt_pk_bf16(a[8], a[9]); p1.y = cvt_pk_bf16(a[10], a[11]); p1.z = cvt_pk_bf16(a[12], a[13]); p1.w = cvt_pk_bf16(a[14], a[15]);
        const bf16x8 pf0 = __builtin_bit_cast(bf16x8, p0), pf1 = __builtin_bit_cast(bf16x8, p1);
#define MK_VF(dh, ks) (bf16x8){vf[dh][ks][0][0], vf[dh][ks][0][1], vf[dh][ks][0][2], vf[dh][ks][0][3], vf[dh][ks][1][0], vf[dh][ks][1][1], vf[dh][ks][1][2], vf[dh][ks][1][3]}
        o0 = __builtin_amdgcn_mfma_f32_32x32x16_bf16(MK_VF(0, 0), pf0, o0, 0, 0, 0);
        o0 = __builtin_amdgcn_mfma_f32_32x32x16_bf16(MK_VF(0, 1), pf1, o0, 0, 0, 0);
        o1 = __builtin_amdgcn_mfma_f32_32x32x16_bf16(MK_VF(1, 0), pf0, o1, 0, 0, 0);
        o1 = __builtin_amdgcn_mfma_f32_32x32x16_bf16(MK_VF(1, 1), pf1, o1, 0, 0, 0);
#undef MK_VF
        if (__all(carry > SB_THR)) break;
#pragma unroll
        for (int d0 = 0; d0 < 4; ++d0) kf[d0] = kn[d0];
#pragma unroll
        for (int dh = 0; dh < 2; ++dh)
#pragma unroll
            for (int ks = 0; ks < 2; ++ks) { vf[dh][ks][0] = vn2[dh][ks][0]; vf[dh][ks][1] = vn2[dh][ks][1]; }
    }
    float ss = 0.f;
#pragma unroll
    for (int r = 0; r < 16; ++r) ss += o0[r] * o0[r] + o1[r] * o1[r];
    ss += __shfl_xor(ss, 32);
    const float rs = 1.0f / sqrtf(ss * (1.0f / 64.0f) + EPS);
    const float* nw = F.out_norm_b_w + h * 64 + 4 * hi; bf16_t* dst = F.Y + tokq * 1024 + 512 + h * 64 + 4 * hi;
#pragma unroll
    for (int dh = 0; dh < 2; ++dh)
#pragma unroll
        for (int g = 0; g < 4; ++g) { const f32x4 w = *(const f32x4*)(nw + 32 * dh + 8 * g); const f32x16& o = dh ? o1 : o0;
            u32x2 pk; pk.x = cvt_pk_bf16(o[4 * g] * rs * w[0], o[4 * g + 1] * rs * w[1]); pk.y = cvt_pk_bf16(o[4 * g + 2] * rs * w[2], o[4 * g + 3] * rs * w[3]);
            *(u32x2*)(dst + 32 * dh + 8 * g) = pk; }
}
__device__ __forceinline__ void p2_mixers(Frame& F) {
    for (int i = 0; i < 4; ++i) { const int u = i * 256 + F.vcu; gmlp_unit(F, u >> 2, u & 3); }
    const int gw = F.vcu * NWAVES + F.wave;
    for (int i = 0; i < 4; ++i) { const int u = i * 2048 + gw; const int qblk = u & 127, bh = u >> 7; attn_wave_unit(F, bh >> 3, bh & 7, qblk); }
}

struct ProgOut {
    const Frame* F;
    __device__ __forceinline__ bool next(int i, Unit& u) const {
        if (i >= 2) return false;
        const int uu = i * 256 + F->vcu, grp = uu >> 5, w = uu & 31; u.pm = grp * 8 + (w & 7); u.pn = w >> 3; u.kind = 0; u.e = 0; u.r0 = 0;
        u.A = (const char*)F->Y; u.B = (const char*)(F->WOUT + (size_t)u.pn * 256 * KD); return true;
    }
    __device__ __forceinline__ void aoffs(const Unit& u, const int (&R)[2], const int (&C)[2], unsigned (&vo)[2][2]) const {
#pragma unroll
        for (int h = 0; h < 2; ++h)
#pragma unroll
            for (int i = 0; i < 2; ++i) vo[h][i] = (unsigned)((u.pm * 256 + h * 128 + R[i]) * KD + C[i]) * 2u;
    }
    __device__ __forceinline__ void epi(const Acc& acc, const Unit& u, int wr, int wc, int fr, int fq) const {
        asm volatile("" : "+v"(fr), "+v"(fq));
#pragma unroll
        for (int ai = 0; ai < 2; ++ai)
#pragma unroll
            for (int m = 0; m < 4; ++m) { const int r = u.pm * 256 + ai * 128 + wr * 64 + m * 16 + fr; const size_t off = (size_t)r * DM + u.pn * 256 + wc * 32 + 8 * fq; float ss = 0.f;
#pragma unroll
                for (int bj = 0; bj < 2; ++bj)
#pragma unroll
                    for (int n = 0; n < 2; ++n) { const f32x4 xv = *(const f32x4*)(F->x + off + bj * 128 + 4 * n); const f32x4 o = xv + acc[ai][bj][m][n];
                        ss += (o[0] * o[0] + o[1] * o[1]) + (o[2] * o[2] + o[3] * o[3]); *(f32x4*)(F->out + off + bj * 128 + 4 * n) = o; }
                ss += __shfl_xor(ss, 16); ss += __shfl_xor(ss, 32);
                if (fq == 0) F->SSPART[(size_t)r * 16 + u.pn * 4 + wc] = ss; }
    }
};

__device__ __forceinline__ void router_wave_unit(Frame& F, int unit) {
    const int lane = F.lane, r32 = lane & 31, hh = lane >> 5; const int tok = unit * 32 + r32;
    float ssum = 0.f;
    { const f32x4* sp = (const f32x4*)(F.SSPART + (size_t)tok * 16);
#pragma unroll
      for (int i = 0; i < 4; ++i) { const f32x4 v = sp[i]; ssum += v[0]; ssum += v[1]; ssum += v[2]; ssum += v[3]; } }
    const float rs = 1.0f / sqrtf(ssum * (1.0f / DM) + EPS);
    f32x16 acc = {};
    const float* xrow = F.out + (size_t)tok * DM + 8 * hh; const float* w2 = F.norm2_w + 8 * hh; bf16_t* hrow = F.HB + (size_t)tok * DM + 8 * hh;
    const bf16_t* rth = F.RT + (size_t)r32 * KD + 8 * hh; const bf16_t* rtl = rth + NE * KD;
#pragma unroll 4
    for (int s = 0; s < 64; ++s) {
        const f32x4 x0 = *(const f32x4*)(xrow + 16 * s), x1 = *(const f32x4*)(xrow + 16 * s + 4);
        const f32x4 g0 = *(const f32x4*)(w2 + 16 * s), g1 = *(const f32x4*)(w2 + 16 * s + 4);
        const f32x4 h0 = x0 * g0 * rs, h1 = x1 * g1 * rs;
        u32x4 hw; hw.x = cvt_pk_bf16(h0[0], h0[1]); hw.y = cvt_pk_bf16(h0[2], h0[3]); hw.z = cvt_pk_bf16(h1[0], h1[1]); hw.w = cvt_pk_bf16(h1[2], h1[3]);
        *(u32x4*)(hrow + 16 * s) = hw;
        u32x4 lw; lw.x = cvt_pk_bf16(h0[0] - bflo(hw.x), h0[1] - bfhi(hw.x)); lw.y = cvt_pk_bf16(h0[2] - bflo(hw.y), h0[3] - bfhi(hw.y));
        lw.z = cvt_pk_bf16(h1[0] - bflo(hw.z), h1[1] - bfhi(hw.z)); lw.w = cvt_pk_bf16(h1[2] - bflo(hw.w), h1[3] - bfhi(hw.w));
        const bf16x8 bh = __builtin_bit_cast(bf16x8, hw), bl = __builtin_bit_cast(bf16x8, lw);
        const bf16x8 ah = *(const bf16x8*)(rth + 16 * s), al = *(const bf16x8*)(rtl + 16 * s);
        acc = __builtin_amdgcn_mfma_f32_32x32x16_bf16(ah, bh, acc, 0, 0, 0);
        acc = __builtin_amdgcn_mfma_f32_32x32x16_bf16(al, bh, acc, 0, 0, 0);
        acc = __builtin_amdgcn_mfma_f32_32x32x16_bf16(ah, bl, acc, 0, 0, 0);
    }
    float lv[16];
#pragma unroll
    for (int r = 0; r < 16; ++r) lv[r] = acc[r] + F.router_b[(r & 3) + 8 * (r >> 2) + 4 * hh];
    float cv[8]; int ce[8];
#pragma unroll
    for (int k = 0; k < 4; ++k) { float bv = -INFINITY; int be = 0;
#pragma unroll
        for (int r = 0; r < 16; ++r) { const int e = (r & 3) + 8 * (r >> 2) + 4 * hh; if (lv[r] > bv) { bv = lv[r]; be = e; } }
#pragma unroll
        for (int r = 0; r < 16; ++r) { const int e = (r & 3) + 8 * (r >> 2) + 4 * hh; if (e == be) lv[r] = -INFINITY; }
        cv[k] = bv; ce[k] = be; }
#pragma unroll
    for (int k = 0; k < 4; ++k) { cv[4 + k] = __shfl_xor(cv[k], 32); ce[4 + k] = __shfl_xor(ce[k], 32); }
    float tv[4]; int te[4];
#pragma unroll
    for (int k = 0; k < 4; ++k) { float bv = -INFINITY; int be = 1 << 20;
#pragma unroll
        for (int c = 0; c < 8; ++c) if (cv[c] > bv || (cv[c] == bv && ce[c] < be)) { bv = cv[c]; be = ce[c]; }
#pragma unroll
        for (int c = 0; c < 8; ++c) if (ce[c] == be) cv[c] = -INFINITY;
        tv[k] = bv; te[k] = be; }
    float ex[4], den = 0.f;
#pragma unroll
    for (int k = 0; k < 4; ++k) { ex[k] = __builtin_amdgcn_exp2f((tv[k] - tv[0]) * LOG2E); den += ex[k]; }
    const float rden = 1.0f / den;
    const int e0 = hh ? te[2] : te[0], e1 = hh ? te[3] : te[1]; const float g0 = (hh ? ex[2] : ex[0]) * rden, g1 = (hh ? ex[3] : ex[1]) * rden;
    int myc = 0; int rank0 = 0, rank1 = 0;
    const unsigned long long ltmask = (1ull << lane) - 1ull;
    for (int e = 0; e < NE; ++e) {
        const unsigned long long m0 = __ballot(e0 == e), m1 = __ballot(e1 == e);
        const int c0 = __popcll(m0), c1 = __popcll(m1);
        if (lane == e) myc = c0 + c1;
        if (e0 == e) rank0 = __popcll(m0 & ltmask);
        if (e1 == e) rank1 = c0 + __popcll(m1 & ltmask);
    }
    int base = 0;
    if (lane < NE && myc > 0) base = (int)__hip_atomic_fetch_add(F.ctl + CW_CNT + lane, (unsigned)myc, __ATOMIC_RELAXED, __HIP_MEMORY_SCOPE_AGENT);
    const int p0 = __shfl(base, e0) + rank0, p1 = __shfl(base, e1) + rank1;
    F.LISTTOK[(size_t)e0 * NTOK + p0] = tok; F.LISTGATE[(size_t)e0 * NTOK + p0] = g0;
    F.LISTTOK[(size_t)e1 * NTOK + p1] = tok; F.LISTGATE[(size_t)e1 * NTOK + p1] = g1;
    F.TOKINFO[tok * 4 + 2 * hh] = (e0 << 16) | p0; F.TOKINFO[tok * 4 + 2 * hh + 1] = (e1 << 16) | p1;
}

__device__ __forceinline__ void moe_build_table(Frame& F) {
    LAS int* tab = (LAS int*)(F.lds + TAB_OFF);
    if (F.tid < NE) tab[F.tid] = (int)__hip_atomic_load(F.ctl + CW_CNT + F.tid, __ATOMIC_RELAXED, __HIP_MEMORY_SCOPE_AGENT);
    __syncthreads();
    if (F.tid == 0) { int acc = 0; for (int e = 0; e < NE; ++e) { tab[32 + e] = acc; acc += (tab[e] + 255) >> 8; } tab[64] = acc; }
    __syncthreads();
}
template <int WGM, int NN>
__device__ __forceinline__ bool moe_decode(const Frame* F, int i, Unit& u) {
    const LAS int* tab = (const LAS int*)(F->lds + TAB_OFF);
    const int uu = i * 256 + F->vcu, grp = uu >> 5, w = uu & 31; const int mt = grp * WGM + (w % WGM); u.pn = w / WGM;
    if (mt >= tab[64]) return false;
    int e = 0;
    for (int k = 1; k < NE; ++k) if (tab[32 + k] <= mt) e = k;
    u.e = e; u.pm = mt; u.r0 = (mt - tab[32 + e]) * 256; u.kind = 0; return true;
}
struct ProgMoe1 {
    const Frame* F;
    __device__ __forceinline__ bool next(int i, Unit& u) const {
        if (!moe_decode<4, 8>(F, i, u)) return false;
        u.A = (const char*)F->HB; u.B = (const char*)(F->WGU + ((size_t)u.e * 2048 + (size_t)u.pn * 256) * KD); return true;
    }
    __device__ __forceinline__ void aoffs(const Unit& u, const int (&R)[2], const int (&C)[2], unsigned (&vo)[2][2]) const {
        const LAS int* tab = (const LAS int*)(F->lds + TAB_OFF); const int cnt = tab[u.e];
#pragma unroll
        for (int h = 0; h < 2; ++h)
#pragma unroll
            for (int i = 0; i < 2; ++i) { const int idx = u.r0 + h * 128 + R[i]; const int tok = idx < cnt ? F->LISTTOK[(size_t)u.e * NTOK + idx] : 0; vo[h][i] = (unsigned)(tok * KD + C[i]) * 2u; }
    }
    __device__ __forceinline__ void epi(const Acc& acc, const Unit& u, int wr, int wc, int fr, int fq) const {
        asm volatile("" : "+v"(fr), "+v"(fq));
        const float* bp = F->b_gate_up + (size_t)u.e * 2048 + u.pn * 256 + wc * 32 + 8 * fq;
        f32x4 bv[2][2];
#pragma unroll
        for (int bj = 0; bj < 2; ++bj)
#pragma unroll
            for (int n = 0; n < 2; ++n) bv[bj][n] = *(const f32x4*)(bp + bj * 128 + 4 * n);
#pragma unroll
        for (int ai = 0; ai < 2; ++ai)
#pragma unroll
            for (int m = 0; m < 4; ++m) { const size_t slot = (size_t)u.pm * 256 + ai * 128 + wr * 64 + m * 16 + fr; bf16_t* rowp = F->ACT + slot * 1024 + u.pn * 128 + wc * 16 + 4 * fq;
#pragma unroll
                for (int bj = 0; bj < 2; ++bj) { const f32x4 v0 = acc[ai][bj][m][0] + bv[bj][0], v1 = acc[ai][bj][m][1] + bv[bj][1];
                    float r4[4];
#pragma unroll
                    for (int p = 0; p < 4; ++p) { float gt = (p < 2) ? v0[2 * p] : v1[2 * (p - 2)]; float up = (p < 2) ? v0[2 * p + 1] : v1[2 * (p - 2) + 1];
                        gt = fminf(gt, 7.0f); up = fminf(fmaxf(up, -7.0f), 7.0f);
                        const float glu = gt * __builtin_amdgcn_rcpf(1.0f + __builtin_amdgcn_exp2f(-1.702f * LOG2E * gt)); r4[p] = (up + 1.0f) * glu; }
                    u32x2 w; w.x = cvt_pk_bf16(r4[0], r4[1]); w.y = cvt_pk_bf16(r4[2], r4[3]);
                    *(u32x2*)(rowp + bj * 64) = w; } }
    }
};
struct ProgMoe2 {
    const Frame* F;
    __device__ __forceinline__ bool next(int i, Unit& u) const {
        if (!moe_decode<8, 4>(F, i, u)) return false;
        u.A = (const char*)F->ACT; u.B = (const char*)(F->WD + ((size_t)u.e * 1024 + (size_t)u.pn * 256) * KD); return true;
    }
    __device__ __forceinline__ void aoffs(const Unit& u, const int (&R)[2], const int (&C)[2], unsigned (&vo)[2][2]) const {
#pragma unroll
        for (int h = 0; h < 2; ++h)
#pragma unroll
            for (int i = 0; i < 2; ++i) vo[h][i] = (unsigned)((u.pm * 256 + h * 128 + R[i]) * KD + C[i]) * 2u;
    }
    __device__ __forceinline__ void epi(const Acc& acc, const Unit& u, int wr, int wc, int fr, int fq) const {
        asm volatile("" : "+v"(fr), "+v"(fq));
        const LAS int* tab = (const LAS int*)(F->lds + TAB_OFF); const int cnt = tab[u.e];
        const float* bp = F->b_down + (size_t)u.e * 1024 + u.pn * 256 + wc * 32 + 8 * fq;
        f32x4 bv[2][2];
#pragma unroll
        for (int bj = 0; bj < 2; ++bj)
#pragma unroll
            for (int n = 0; n < 2; ++n) bv[bj][n] = *(const f32x4*)(bp + bj * 128 + 4 * n);
#pragma unroll
        for (int ai = 0; ai < 2; ++ai)
#pragma unroll
            for (int m = 0; m < 4; ++m) { const int rl = ai * 128 + wr * 64 + m * 16 + fr; const int idx = u.r0 + rl; const float gate = idx < cnt ? F->LISTGATE[(size_t)u.e * NTOK + idx] : 0.f;
                bf16_t* rowp = F->YS + ((size_t)u.pm * 256 + rl) * 1024 + u.pn * 256 + wc * 32 + 8 * fq;
#pragma unroll
                for (int bj = 0; bj < 2; ++bj) { const f32x4 v0 = (acc[ai][bj][m][0] + bv[bj][0]) * gate, v1 = (acc[ai][bj][m][1] + bv[bj][1]) * gate;
                    u32x4 w; w.x = cvt_pk_bf16(v0[0], v0[1]); w.y = cvt_pk_bf16(v0[2], v0[3]); w.z = cvt_pk_bf16(v1[0], v1[1]); w.w = cvt_pk_bf16(v1[2], v1[3]);
                    *(u32x4*)(rowp + bj * 128) = w; } }
    }
};

__device__ __forceinline__ void p7_combine(Frame& F) {
    const LAS int* tab = (const LAS int*)(F.lds + TAB_OFF);
    const int gw = F.vcu * NWAVES + F.wave, NGW = F.G * NWAVES, lane = F.lane;
    for (int tok = gw; tok < NTOK; tok += NGW) {
        f32x4* orow = (f32x4*)(F.out + (size_t)tok * DM) + lane; f32x4 v[4];
#pragma unroll
        for (int j = 0; j < 4; ++j) v[j] = orow[64 * j];
#pragma unroll
        for (int k = 0; k < 4; ++k) { const int info = F.TOKINFO[tok * 4 + k]; const int e = info >> 16, pos = info & 0xffff; const size_t slot = (size_t)tab[32 + e] * 256 + pos;
            const u32x2* yr = (const u32x2*)(F.YS + slot * 1024) + lane;
#pragma unroll
            for (int j = 0; j < 4; ++j) { const u32x2 w = yr[64 * j]; v[j][0] += bflo(w.x); v[j][1] += bfhi(w.x); v[j][2] += bflo(w.y); v[j][3] += bfhi(w.y); } }
#pragma unroll
        for (int j = 0; j < 4; ++j) orow[64 * j] = v[j];
    }
}

__global__ void __launch_bounds__(NWAVES * 64, 2) mk_fwd(Args args) {
    extern __shared__ __attribute__((aligned(16))) unsigned char lds_raw[];
    Frame F;
    F.lds = (LAS unsigned char*)lds_raw;
    F.tid = threadIdx.x; F.lane = F.tid & 63; F.wave = __builtin_amdgcn_readfirstlane(F.tid >> 6);
    F.G = gridDim.x; { const int bx = blockIdx.x; F.vcu = (bx % 8) * (F.G / 8) + bx / 8; }
    F.x = args.in[0]; F.norm1_w = args.in[1]; F.w_in = args.in[2]; F.sgu_norm_w = args.in[3]; F.sgu_w = args.in[4]; F.sgu_b = args.in[5]; F.q_norm_w = args.in[6]; F.k_norm_w = args.in[7];
    F.out_norm_a_w = args.in[8]; F.out_norm_b_w = args.in[9]; F.w_out = args.in[10]; F.norm2_w = args.in[11]; F.router_w = args.in[12]; F.router_b = args.in[13];
    F.w_gate_up = args.in[14]; F.b_gate_up = args.in[15]; F.w_down = args.in[16]; F.b_down = args.in[17];
    F.out = args.out; F.ws = args.ws; unsigned char* ws = args.ws;
    F.ctl = (unsigned*)(ws + WS_CTL);
    F.XB = (bf16_t*)(ws + WS_XB); F.WIN = (bf16_t*)(ws + WS_WIN); F.WOUT = (bf16_t*)(ws + WS_WOUT); F.UV = (bf16_t*)(ws + WS_UV); F.Q = (bf16_t*)(ws + WS_Q); F.K = (bf16_t*)(ws + WS_K);
    F.VT = (bf16_t*)(ws + WS_VT); F.Y = (bf16_t*)(ws + WS_Y); F.HB = (bf16_t*)(ws + WS_HB); F.WGU = (bf16_t*)(ws + WS_WGU); F.WD = (bf16_t*)(ws + WS_WD); F.ACT = (bf16_t*)(ws + WS_ACT);
    F.YS = (bf16_t*)(ws + WS_YS); F.RT = (bf16_t*)(ws + WS_RT);
    F.RSTD1 = (float*)(ws + WS_RSTD1); F.SSPART = (float*)(ws + WS_SSPART); F.LISTGATE = (float*)(ws + WS_LISTGATE); F.LISTTOK = (int*)(ws + WS_LISTTOK); F.TOKINFO = (int*)(ws + WS_TOKINFO);
    for (int u = F.tid; u < (LDS_BYTES - LDSCTL_OFF) / 4; u += NWAVES * 64) ((LAS unsigned*)(F.lds + LDSCTL_OFF))[u] = 0u;
    __syncthreads();
    XcdBarrier bar = xcd_barrier_post(F.ctl + CW_BAR, (volatile LAS unsigned*)(F.lds + MISC_OFF) + 8);
    const int lo = args.ph_lo, hi = args.ph_hi;
#define IN(k) (lo <= (k) && (k) < hi)
#define SEAM(k) do { if (IN(k) && IN((k) + 1)) xcd_barrier(bar); } while (0)
    if (IN(0)) { p0_prologue(F); } SEAM(0);
    if (IN(1)) { ProgIn P{&F}; gemm_phase(F.lds, P); } SEAM(1);
    if (IN(2)) { p2_mixers(F); } SEAM(2);
    if (IN(3)) { ProgOut P{&F}; gemm_phase(F.lds, P); } SEAM(3);
    if (IN(4)) { if (F.wave < 4) router_wave_unit(F, F.wave * 256 + F.vcu); } SEAM(4);
    if (lo <= 7 && hi > 5) moe_build_table(F);
    if (IN(5)) { ProgMoe1 P{&F}; gemm_phase(F.lds, P); } SEAM(5);
    if (IN(6)) { ProgMoe2 P{&F}; gemm_phase(F.lds, P); } SEAM(6);
    if (IN(7)) { p7_combine(F); }
#undef IN
#undef SEAM
}
}
#ifndef MK_CUT
#define MK_CUT 8
#endif
extern "C" void kernel_launch(void* const* d_in, const int* in_sizes, int n_in, void* d_out, int out_size, void* d_ws, size_t ws_size, hipStream_t stream) {
    static int ready = 0;
    if (ready == 0) {
        if (n_in != 18 || out_size != mk::NTOK * mk::DM || ws_size < mk::WS_END) { fprintf(stderr, "kernel_launch: unexpected problem (n_in %d out %d ws %zu)\n", n_in, out_size, ws_size); ready = -1; return; }
        if (hipFuncSetAttribute((const void*)mk::mk_fwd, hipFuncAttributeMaxDynamicSharedMemorySize, mk::LDS_BYTES) != hipSuccess) { fprintf(stderr, "kernel_launch: hipFuncSetAttribute failed\n"); ready = -1; return; }
        ready = 1;
    }
    if (ready < 0) return;
    (void)hipMemsetAsync((char*)d_ws + mk::WS_CTL, 0, mk::CTL_ZERO_BYTES, stream);
    mk::Args a{};
    for (int i = 0; i < 18; ++i) a.in[i] = (const float*)d_in[i];
    a.out = (float*)d_out; a.ws = (unsigned char*)d_ws; a.ph_lo = 0; a.ph_hi = MK_CUT;
    hipLaunchKernelGGL(mk::mk_fwd, dim3(256), dim3(mk::NWAVES * 64), mk::LDS_BYTES, stream, a);
#if MK_CUT < 8
    {
        using namespace nv;
        const float* x = (const float*)d_in[0]; const float* w_out = (const float*)d_in[10]; const float* norm2_w = (const float*)d_in[11];
        const float* router_w = (const float*)d_in[12]; const float* router_b = (const float*)d_in[13]; const float* w_gate_up = (const float*)d_in[14];
        const float* b_gate_up = (const float*)d_in[15]; const float* w_down = (const float*)d_in[16]; const float* b_down = (const float*)d_in[17];
        float* out = (float*)d_out; char* ws = (char*)d_ws; const size_t MiB = 1u << 20;
        int* cnt = (int*)ws + mk::CW_CNT; int* list_tok = (int*)(ws + mk::WS_LISTTOK); float* list_gate = (float*)(ws + mk::WS_LISTGATE);
        float* hn = (float*)(ws + 16 * MiB); float* gu = (float*)(ws + 272 * MiB); float* act = (float*)(ws + (272 + 256) * MiB);
#if MK_CUT <= 3
        k_gemm<1, true><<<dim3(DM / 64, NTOK / 64), 256, 0, stream>>>((const void*)(ws + mk::WS_Y), nullptr, nullptr, nullptr, w_out, nullptr, x, nullptr, out, NTOK, DM, DM, DM, DM);
#endif
#if MK_CUT <= 4
        k_router<<<NTOK, 256, 0, stream>>>(out, norm2_w, router_w, router_b, hn, cnt, list_tok, list_gate);
#else
        k_bf2f<<<4096, 256, 0, stream>>>((const unsigned short*)(ws + mk::WS_HB), hn, (size_t)NTOK * DM);
#endif
        for (int e = 0; e < NE; ++e) {
            const int* lt = list_tok + (size_t)e * NTOK; const float* lgp = list_gate + (size_t)e * NTOK;
            k_gemm<0, false><<<dim3(2 * DFF / 64, NTOK / 64), 256, 0, stream>>>(hn, lt, nullptr, cnt + e, w_gate_up + (size_t)e * DM * 2 * DFF, b_gate_up + (size_t)e * 2 * DFF, nullptr, nullptr, gu, NTOK, 2 * DFF, DM, DM, 2 * DFF);
            k_swiglu<<<NTOK, 256, 0, stream>>>(gu, cnt + e, act);
            k_gemm<3, false><<<dim3(DM / 64, NTOK / 64), 256, 0, stream>>>(act, nullptr, lt, cnt + e, w_down + (size_t)e * DFF * DM, b_down + (size_t)e * DM, nullptr, lgp, out, NTOK, DM, DFF, DFF, DM);
        }
    }
#endif
}
```

```cpp
#include <hip/hip_runtime.h>
#include <cstdio>
#include <cstdint>
namespace mk {
#define LAS __attribute__((address_space(3)))
#define GAS __attribute__((address_space(1)))
typedef unsigned short bf16_t;
typedef short bf16x8 __attribute__((ext_vector_type(8)));
typedef short s16x4 __attribute__((ext_vector_type(4)));
typedef float f32x4 __attribute__((ext_vector_type(4)));
typedef float f32x2 __attribute__((ext_vector_type(2)));
typedef float f32x16 __attribute__((ext_vector_type(16)));
typedef unsigned u32x4 __attribute__((ext_vector_type(4)));
typedef unsigned u32x2 __attribute__((ext_vector_type(2)));
typedef int i32x4 __attribute__((ext_vector_type(4)));
typedef int i32x8 __attribute__((ext_vector_type(8)));

constexpr int NTOK = 32768, DM = 1024, SEQ = 4096, NB = 8, NH = 8, HD = 64, NE = 32, DFF = 1024, KD = 1024;
constexpr float EPS = 1e-5f;
constexpr float LOG2E = 1.4426950408889634f;
constexpr float QSCALE = 0.125f * LOG2E;
constexpr float SB_THR = 64.0f;
constexpr int NWAVES = 8;
constexpr int SLOTS = NTOK * 4 + NE * 256;

constexpr size_t MiB = 1u << 20;
constexpr size_t WS_CTL = 0, CTL_ZERO_BYTES = 1 * MiB;
constexpr size_t WS_LISTTOK = 1 * MiB;
constexpr size_t WS_LISTGATE = 5 * MiB;
constexpr size_t WS_TOKINFO = 9 * MiB;
constexpr size_t WS_RSTD1 = 10 * MiB;
constexpr size_t WS_SSPART = 11 * MiB;
constexpr size_t WS_RT = 13 * MiB;
constexpr size_t WS_WGU = 16 * MiB;
constexpr size_t WS_WD = 80 * MiB;
constexpr size_t WS_HB = 112 * MiB;
constexpr size_t WS_YS = 144 * MiB;
constexpr size_t WS_EARLY = 416 * MiB;
constexpr size_t WS_XB = WS_EARLY;
constexpr size_t WS_WIN = WS_EARLY + 64 * MiB;
constexpr size_t WS_WOUT = WS_EARLY + 70 * MiB;
constexpr size_t WS_UV = WS_EARLY + 72 * MiB;
constexpr size_t WS_Q = WS_EARLY + 136 * MiB;
constexpr size_t WS_K = WS_EARLY + 168 * MiB;
constexpr size_t WS_VT = WS_EARLY + 200 * MiB;
constexpr size_t WS_Y = WS_EARLY + 232 * MiB;
constexpr size_t WS_ACT = WS_EARLY;
constexpr size_t WS_END = WS_EARLY + 296 * MiB;
constexpr float WSCALE = 32.0f, WSCALE_INV = 1.0f / 32.0f;
constexpr int CW_CNT = 64;
constexpr int CW_BAR = 4096;

constexpr int RING_BYTES = 131072;
constexpr int LDSCTL_OFF = RING_BYTES, MISC_OFF = LDSCTL_OFF + 320, TAB_OFF = LDSCTL_OFF + 1024;
constexpr int LDS_BYTES = 147456;

__device__ __forceinline__ unsigned cvt_pk_bf16(float lo, float hi) { unsigned r; asm volatile("v_cvt_pk_bf16_f32 %0, %1, %2" : "=v"(r) : "v"(lo), "v"(hi)); return r; }
__device__ __forceinline__ unsigned pk4_fp8(float a, float b, float c, float d) { unsigned w = 0u; w = (unsigned)__builtin_amdgcn_cvt_pk_fp8_f32(a, b, (int)w, false); w = (unsigned)__builtin_amdgcn_cvt_pk_fp8_f32(c, d, (int)w, true); return w; }
__device__ __forceinline__ float bf2f(unsigned short h) { return __uint_as_float((unsigned)h << 16); }
__device__ __forceinline__ float bflo(unsigned w) { return __uint_as_float(w << 16); }
__device__ __forceinline__ float bfhi(unsigned w) { return __uint_as_float(w & 0xffff0000u); }
__device__ __forceinline__ int lane_id() { return (int)__builtin_amdgcn_mbcnt_hi(~0u, __builtin_amdgcn_mbcnt_lo(~0u, 0u)); }
__device__ __forceinline__ float wave_sum(float v) {
#pragma unroll
    for (int o = 1; o < 64; o <<= 1) v += __shfl_xor(v, o);
    return v;
}
__device__ __forceinline__ float gelu_tanh_f(float x) {
    const float u = 0.7978845608028654f * (x + 0.044715f * x * x * x);
    return x * __builtin_amdgcn_rcpf(1.0f + __builtin_amdgcn_exp2f(-2.0f * LOG2E * u));
}

constexpr int BM = 256, BK = 64, HALF = 128, HTB = HALF * BK * 2;
__device__ __forceinline__ int lds_byte(int r, int c) { const int st = (r >> 4) * 2 + (c >> 5), rr = r & 15, cc = c & 31, ob = rr * 64 + cc * 2; return st * 1024 + (ob ^ (((ob >> 9) & 1) << 5)); }
__device__ __forceinline__ void stage_rc(int b, int& R, int& C) { const int st = b / 1024, sb = b % 1024, swz = sb ^ (((sb >> 9) & 1) << 5); R = (st >> 1) * 16 + swz / 64; C = (st & 1) * 32 + (swz % 64) / 2; }
__device__ __forceinline__ int perm32(int rho) { const int n = rho >> 4, i = rho & 15; return 8 * (i >> 2) + 4 * n + (i & 3); }

struct Unit { const char* A; const char* B; int kind, pm, pn, e, r0; };

template <class Prog>
__device__ __forceinline__ void gemm_phase(LAS unsigned char* lds, const Prog& P) {
    const int wid = P.F->wave, lane = lane_id(), tid = wid * 64 + lane, wr = wid >> 2, wc = wid & 3;
    constexpr bool F8 = Prog::FP8;
    constexpr int K = KD, ESZ = F8 ? 1 : 2, nt = F8 ? K / 128 : K / BK;
    unsigned voffB[2];
#pragma unroll
    for (int i = 0; i < 2; ++i) { int R_, C_; stage_rc(tid * 16 + i * 8192, R_, C_); const int Rb = (R_ & ~31) + perm32(R_ & 31); voffB[i] = (unsigned)(Rb * K * ESZ + C_ * 2); }
    constexpr size_t kstep = (size_t)(BK * 2);
    constexpr size_t hstep = (size_t)HALF * K * ESZ;
    const unsigned ldsw = (unsigned)wid * 1024u;
    const int aoff = lds_byte(wr * 64 + (lane & 15), F8 ? (lane >> 4) * 16 : (lane >> 4) * 8), boff = lds_byte(wc * 32 + (lane & 15), F8 ? (lane >> 4) * 16 : (lane >> 4) * 8);
    constexpr int KOFF = F8 ? 16 : 1024;
#define MK_SA(b, h) (((b) * 2 + (h)) * HTB)
#define MK_SB(b, h) ((4 + (b) * 2 + (h)) * HTB)
#define MK_STAGE(bufoff, gbase, voff) do { _Pragma("unroll") for (int _i = 0; _i < 2; ++_i) { unsigned o_ = (voff)[_i]; asm volatile("" : "+v"(o_));     \
        __builtin_amdgcn_global_load_lds((const unsigned*)((const char*)(gbase) + o_), (LAS unsigned*)(lds + (bufoff) + ldsw + _i * 8192), 16, 0, 0); } } while (0)
#define MK_LDA(dst, b, h) do { _Pragma("unroll") for (int m = 0; m < 4; ++m) _Pragma("unroll") for (int k = 0; k < 2; ++k) dst[m][k] = *(const LAS bf16x8*)(lds + MK_SA(b, h) + aoff + m * 2048 + k * KOFF); } while (0)
#define MK_LDB(dst, b, h) do { _Pragma("unroll") for (int n = 0; n < 2; ++n) _Pragma("unroll") for (int k = 0; k < 2; ++k) dst[n][k] = *(const LAS bf16x8*)(lds + MK_SB(b, h) + boff + n * 2048 + k * KOFF); } while (0)
#define MK_CAT8(x) __builtin_shufflevector(__builtin_bit_cast(i32x4, (x)[0]), __builtin_bit_cast(i32x4, (x)[1]), 0, 1, 2, 3, 4, 5, 6, 7)
#define MK_MMA(ai, bj, At, Bt) do { __builtin_amdgcn_s_setprio(1); \
        if constexpr (F8) { _Pragma("unroll") for (int m = 0; m < 4; ++m) _Pragma("unroll") for (int n = 0; n < 2; ++n) \
            acc[ai][bj][m][n] = __builtin_amdgcn_mfma_scale_f32_16x16x128_f8f6f4(MK_CAT8(Bt[n]), MK_CAT8(At[m]), acc[ai][bj][m][n], 0, 0, 0, 0, 0, 0); } \
        else { _Pragma("unroll") for (int m = 0; m < 4; ++m) _Pragma("unroll") for (int n = 0; n < 2; ++n) _Pragma("unroll") for (int k = 0; k < 2; ++k) \
            acc[ai][bj][m][n] = __builtin_amdgcn_mfma_f32_16x16x32_bf16(Bt[n][k], At[m][k], acc[ai][bj][m][n], 0, 0, 0); } \
        __builtin_amdgcn_s_setprio(0); } while (0)
#define MK_WAIT_V(n) asm volatile("s_waitcnt vmcnt(" #n ")" ::: "memory")
#define MK_WAIT_L(n) asm volatile("s_waitcnt lgkmcnt(" #n ")" ::: "memory")
#define MK_BAR __builtin_amdgcn_s_barrier()
#define MK_SCHED __builtin_amdgcn_sched_barrier(0)
    Unit cur, nxt; int ui = 0;
    if (!P.next(0, cur)) return;
    constexpr bool GA = Prog::GATHER;
    unsigned voC[2][2];
    if constexpr (GA) P.aoffs(cur, wid, voC);
    else {
#pragma unroll
        for (int i = 0; i < 2; ++i) { int R_, C_; stage_rc(tid * 16 + i * 8192, R_, C_); voC[0][i] = (unsigned)(R_ * K * ESZ + C_ * 2); voC[1][i] = voC[0][i] + (unsigned)hstep; }
    }
    f32x4 acc[2][2][4][2];
#pragma unroll
    for (int a = 0; a < 2; ++a)
#pragma unroll
        for (int b = 0; b < 2; ++b)
#pragma unroll
            for (int m = 0; m < 4; ++m)
#pragma unroll
                for (int n = 0; n < 2; ++n) acc[a][b][m][n] = (f32x4){0.f, 0.f, 0.f, 0.f};
    bf16x8 At[4][2], B0[2][2], B1[2][2];
    const char* cA = cur.A; const char* cB = cur.B;
    MK_STAGE(MK_SB(0, 0), cB, voffB); MK_STAGE(MK_SB(0, 1), cB + hstep, voffB); MK_STAGE(MK_SA(0, 0), cA, voC[0]); MK_STAGE(MK_SA(0, 1), cA, voC[1]);
    if (wr == 1) MK_BAR;
    MK_WAIT_V(2); MK_BAR;
    MK_STAGE(MK_SB(1, 0), cB + kstep, voffB); MK_STAGE(MK_SA(1, 0), cA + kstep, voC[0]); MK_STAGE(MK_SB(1, 1), cB + hstep + kstep, voffB);
    MK_WAIT_V(6); MK_BAR;
    for (;;) {
        const bool has_next = P.next(ui + 1, nxt);
        if (!has_next) nxt = cur;
        const char* nA = nxt.A; const char* nB = nxt.B;
#pragma unroll 1
        for (int t = 0; t < nt; t += 2) {
            const bool last = (t == nt - 2);
            const char* a1 = cA + (size_t)(t + 1) * kstep;
            const char* a2 = last ? nA : cA + (size_t)(t + 2) * kstep; const char* b2 = last ? nB : cB + (size_t)(t + 2) * kstep;
            const char* a3 = a2 + kstep; const char* b3 = b2 + kstep;
            MK_LDB(B0, 0, 0); MK_LDB(B1, 0, 1); MK_SCHED; MK_LDA(At, 0, 0); MK_STAGE(MK_SA(1, 1), a1, voC[1]);
            if constexpr (GA) { if (last && has_next) P.aoffs(nxt, wid, voC); }
            MK_WAIT_V(8); MK_WAIT_L(0); MK_BAR; MK_MMA(0, 0, At, B0); MK_MMA(0, 1, At, B1); MK_BAR; MK_SCHED;
            MK_LDA(At, 0, 1); MK_STAGE(MK_SB(0, 0), b2, voffB); MK_STAGE(MK_SB(0, 1), b2 + hstep, voffB); MK_STAGE(MK_SA(0, 0), a2, voC[0]);
            MK_WAIT_V(8); MK_WAIT_L(0); MK_BAR; MK_MMA(1, 0, At, B0); MK_MMA(1, 1, At, B1); MK_BAR; MK_SCHED;
            MK_LDB(B0, 1, 0); MK_LDB(B1, 1, 1); MK_SCHED; MK_LDA(At, 1, 0); MK_STAGE(MK_SA(0, 1), a2, voC[1]);
            MK_WAIT_V(8); MK_WAIT_L(0); MK_BAR; MK_MMA(0, 0, At, B0); MK_MMA(0, 1, At, B1); MK_BAR; MK_SCHED;
            MK_LDA(At, 1, 1); MK_STAGE(MK_SB(1, 0), b3, voffB); MK_STAGE(MK_SB(1, 1), b3 + hstep, voffB); MK_STAGE(MK_SA(1, 0), a3, voC[0]);
            MK_WAIT_V(8); MK_WAIT_L(0); MK_BAR; MK_MMA(1, 0, At, B0); MK_MMA(1, 1, At, B1); MK_BAR; MK_SCHED;
        }
        if (wr == 0) MK_BAR;
        { const int l_ = lane_id(); P.epi(acc, cur, wr, wc, l_ & 15, l_ >> 4); }
        if (!has_next) break;
#pragma unroll
        for (int a = 0; a < 2; ++a)
#pragma unroll
            for (int b = 0; b < 2; ++b)
#pragma unroll
                for (int m = 0; m < 4; ++m)
#pragma unroll
                    for (int n = 0; n < 2; ++n) acc[a][b][m][n] = (f32x4){0.f, 0.f, 0.f, 0.f};
        cur = nxt; cA = nA; cB = nB; ++ui;
        if (wr == 1) MK_BAR;
    }
    MK_WAIT_V(0);
    MK_BAR;
#undef MK_SA
#undef MK_SB
#undef MK_STAGE
#undef MK_LDA
#undef MK_LDB
#undef MK_MMA
#undef MK_CAT8
}
typedef f32x4 Acc[2][2][4][2];

#define XB_TMO      128
#define XB_XCNT(j)  (256  + 64 * (j))
#define XB_XSUB(j)  (1280 + 64 * (j))
#define XB_XGEN(j)  (2304 + 64 * (j))
#define XB_TOP      3328
#define XB_TOPGEN   3392
#define XCD_BAR_WORDS 3456
#define XB_SPIN_CAP (1u << 18)
__device__ __forceinline__ unsigned xb_ld(unsigned* p)              { return __hip_atomic_load(p, __ATOMIC_RELAXED, __HIP_MEMORY_SCOPE_AGENT); }
__device__ __forceinline__ unsigned xb_add(unsigned* p, unsigned v) { return __hip_atomic_fetch_add(p, v, __ATOMIC_RELAXED, __HIP_MEMORY_SCOPE_AGENT); }
__device__ __forceinline__ unsigned xb_xcc_id() { return (unsigned)__builtin_amdgcn_s_getreg((3 << 11) | 20) & 0xFu; }
#define XB_SPIN(cond, bar) do { unsigned _sp = 0; while (cond) { __builtin_amdgcn_s_sleep(1); \
    if ((++_sp & 255u) == 0u) { if (xb_ld(&(bar)[XB_TMO])) break; if (_sp > XB_SPIN_CAP) { atomicAdd(&(bar)[XB_TMO], 1u); break; } } } } while (0)
struct XcdBarrier { unsigned* bar; unsigned x; volatile LAS unsigned* st; };
__device__ __forceinline__ XcdBarrier xcd_barrier_post(unsigned* bar, volatile LAS unsigned* st) {
    XcdBarrier b; b.bar = bar; b.x = xb_xcc_id(); b.st = st;
    if (threadIdx.x == 0) (void)xb_add(&bar[XB_XCNT(b.x)], 1u);
    return b;
}
__device__ __forceinline__ void xcd_barrier_complete(unsigned* bar, unsigned x, unsigned& nloc, unsigned& nx) {
    const unsigned G = gridDim.x * gridDim.y * gridDim.z;
    unsigned sum, cnt, mine, sp = 0u;
    for (;;) {
        sum = 0u; cnt = 0u; mine = 0u;
#pragma unroll
        for (unsigned j = 0; j < 16; ++j) { const unsigned c = xb_ld(&bar[XB_XCNT(j)]); sum += c; cnt += (c > 0u) ? 1u : 0u; mine = (j == x) ? c : mine; }
        if (sum == G) break;
        __builtin_amdgcn_s_sleep(1);
        if ((++sp & 255u) == 0u) { if (xb_ld(&bar[XB_TMO])) break; if (sp > XB_SPIN_CAP) { atomicAdd(&bar[XB_TMO], 1u); break; } }
    }
    nloc = mine > 0u ? mine : 1u; nx = cnt > 0u ? cnt : 1u;
}
__device__ __forceinline__ void xcd_barrier(const XcdBarrier& b, int wave) {
    asm volatile("s_waitcnt vmcnt(0)" ::: "memory");
    __syncthreads();
    if (wave == 0 && lane_id() == 0) {
        unsigned* bar = b.bar;
        __builtin_amdgcn_s_waitcnt(0);
        unsigned nloc = b.st[0], nx = b.st[1];
        if (nloc == 0u) { xcd_barrier_complete(bar, b.x, nloc, nx); b.st[0] = nloc; b.st[1] = nx; }
        const unsigned old = xb_add(&bar[XB_XSUB(b.x)], 1u);
        const unsigned gen = old / nloc;
        if (old + 1u == (gen + 1u) * nloc) {
            __builtin_amdgcn_fence(__ATOMIC_RELEASE, "agent");
            asm volatile("s_waitcnt vmcnt(0)" ::: "memory");
            const unsigned og = xb_add(&bar[XB_TOP], 1u);
            const unsigned tg = og / nx;
            if (og + 1u == (tg + 1u) * nx) xb_add(&bar[XB_TOPGEN], 1u);
            else XB_SPIN(xb_ld(&bar[XB_TOPGEN]) == tg, bar);
            __builtin_amdgcn_fence(__ATOMIC_ACQUIRE, "agent");
            xb_add(&bar[XB_XGEN(b.x)], 1u);
            asm volatile("s_waitcnt vmcnt(0)" ::: "memory");
        } else {
            XB_SPIN(xb_ld(&bar[XB_XGEN(b.x)]) == gen, bar);
            __builtin_amdgcn_fence(__ATOMIC_ACQUIRE, "agent");
            asm volatile("s_waitcnt vmcnt(0)" ::: "memory");
        }
    }
    __syncthreads();
}

struct Args {
    const float* in[18]; float* out; unsigned char* ws; int ph_lo, ph_hi;
};
#define CAS __attribute__((address_space(4)))
struct Frame {
    LAS unsigned char* lds; int tid, lane, wave, vcu, G;
    const CAS Args* ka;
    __device__ __forceinline__ const float* inp(int k) const { return ka->in[k]; }
    __device__ __forceinline__ unsigned char* ws() const { return ka->ws; }
    __device__ __forceinline__ float* out() const { return ka->out; }
    __device__ __forceinline__ const float* x() const { return inp(0); }
    __device__ __forceinline__ const float* norm1_w() const { return inp(1); }
    __device__ __forceinline__ const float* w_in() const { return inp(2); }
    __device__ __forceinline__ const float* sgu_norm_w() const { return inp(3); }
    __device__ __forceinline__ const float* sgu_w() const { return inp(4); }
    __device__ __forceinline__ const float* sgu_b() const { return inp(5); }
    __device__ __forceinline__ const float* q_norm_w() const { return inp(6); }
    __device__ __forceinline__ const float* k_norm_w() const { return inp(7); }
    __device__ __forceinline__ const float* out_norm_a_w() const { return inp(8); }
    __device__ __forceinline__ const float* out_norm_b_w() const { return inp(9); }
    __device__ __forceinline__ const float* w_out() const { return inp(10); }
    __device__ __forceinline__ const float* norm2_w() const { return inp(11); }
    __device__ __forceinline__ const float* router_w() const { return inp(12); }
    __device__ __forceinline__ const float* router_b() const { return inp(13); }
    __device__ __forceinline__ const float* w_gate_up() const { return inp(14); }
    __device__ __forceinline__ const float* b_gate_up() const { return inp(15); }
    __device__ __forceinline__ const float* w_down() const { return inp(16); }
    __device__ __forceinline__ const float* b_down() const { return inp(17); }
    __device__ __forceinline__ bf16_t* XB() const { return (bf16_t*)(ws() + WS_XB); }
    __device__ __forceinline__ bf16_t* WIN() const { return (bf16_t*)(ws() + WS_WIN); }
    __device__ __forceinline__ bf16_t* WOUT() const { return (bf16_t*)(ws() + WS_WOUT); }
    __device__ __forceinline__ bf16_t* UV() const { return (bf16_t*)(ws() + WS_UV); }
    __device__ __forceinline__ bf16_t* Q() const { return (bf16_t*)(ws() + WS_Q); }
    __device__ __forceinline__ bf16_t* K() const { return (bf16_t*)(ws() + WS_K); }
    __device__ __forceinline__ bf16_t* VT() const { return (bf16_t*)(ws() + WS_VT); }
    __device__ __forceinline__ bf16_t* Y() const { return (bf16_t*)(ws() + WS_Y); }
    __device__ __forceinline__ bf16_t* YS() const { return (bf16_t*)(ws() + WS_YS); }
    __device__ __forceinline__ bf16_t* RT() const { return (bf16_t*)(ws() + WS_RT); }
    __device__ __forceinline__ unsigned char* HB() const { return ws() + WS_HB; }
    __device__ __forceinline__ unsigned char* WGU() const { return ws() + WS_WGU; }
    __device__ __forceinline__ unsigned char* WD() const { return ws() + WS_WD; }
    __device__ __forceinline__ unsigned char* ACT() const { return ws() + WS_ACT; }
    __device__ __forceinline__ float* RSTD1() const { return (float*)(ws() + WS_RSTD1); }
    __device__ __forceinline__ float* SSPART() const { return (float*)(ws() + WS_SSPART); }
    __device__ __forceinline__ float* LISTGATE() const { return (float*)(ws() + WS_LISTGATE); }
    __device__ __forceinline__ int* LISTTOK() const { return (int*)(ws() + WS_LISTTOK); }
    __device__ __forceinline__ int* TOKINFO() const { return (int*)(ws() + WS_TOKINFO); }
    __device__ __forceinline__ unsigned* ctl() const { return (unsigned*)(ws() + WS_CTL); }
};

__device__ __forceinline__ void p0_transpose_item(const float* W, int K, int N, bf16_t* WT, int k0, int n0, int drow0, const float* kscale, LAS float* scr, int lane) {
#pragma unroll 8
    for (int i = 0; i < 32; ++i) { const int kk = 2 * i + (lane >> 5); float v = W[(size_t)(k0 + kk) * N + n0 + (lane & 31)]; if (kscale) v *= kscale[k0 + kk]; scr[kk * 33 + (lane & 31)] = v; }
    asm volatile("s_waitcnt lgkmcnt(0)" ::: "memory");
    const int c = lane & 7;
#pragma unroll
    for (int j = 0; j < 4; ++j) { const int n = (lane >> 3) + 8 * j; const LAS float* s = scr + (8 * c) * 33 + n;
        u32x4 o; o.x = cvt_pk_bf16(s[0 * 33], s[1 * 33]); o.y = cvt_pk_bf16(s[2 * 33], s[3 * 33]); o.z = cvt_pk_bf16(s[4 * 33], s[5 * 33]); o.w = cvt_pk_bf16(s[6 * 33], s[7 * 33]);
        *(u32x4*)(WT + (size_t)(drow0 + n) * K + k0 + 8 * c) = o; }
    asm volatile("s_waitcnt lgkmcnt(0)" ::: "memory");
}
__device__ __forceinline__ void p0_transpose_item_f8(const float* W, int K, int N, unsigned char* WT, int k0, int n0, LAS float* scr, int lane) {
#pragma unroll 8
    for (int i = 0; i < 32; ++i) { const int kk = 2 * i + (lane >> 5); scr[kk * 33 + (lane & 31)] = W[(size_t)(k0 + kk) * N + n0 + (lane & 31)] * WSCALE; }
    asm volatile("s_waitcnt lgkmcnt(0)" ::: "memory");
    const int c = lane & 7;
#pragma unroll
    for (int j = 0; j < 4; ++j) { const int n = (lane >> 3) + 8 * j; const LAS float* s = scr + (8 * c) * 33 + n;
        u32x2 o; o.x = pk4_fp8(s[0 * 33], s[1 * 33], s[2 * 33], s[3 * 33]); o.y = pk4_fp8(s[4 * 33], s[5 * 33], s[6 * 33], s[7 * 33]);
        *(u32x2*)(WT + (size_t)(n0 + n) * K + k0 + 8 * c) = o; }
    asm volatile("s_waitcnt lgkmcnt(0)" ::: "memory");
}
__device__ __forceinline__ int win_drow(int n0) {
    if (n0 < 1024 || n0 >= 2048) return n0;
    const int rel = n0 - 1024, isk = rel >> 9, head = (rel & 511) >> 6, dh = (rel & 63) >> 5;
    return 256 * (4 + 2 * isk + (head >> 2)) + 128 * dh + 32 * (head & 3);
}
__device__ __forceinline__ void p0_prologue(Frame& F) {
    LAS float* scr = (LAS float*)(F.lds + F.wave * 16384);
    const int gw = F.vcu * NWAVES + F.wave, NGW = F.G * NWAVES, lane = F.lane;
    for (int m = gw; m < NTOK; m += NGW) {
        const f32x4* xr = (const f32x4*)(F.x() + (size_t)m * DM) + lane; f32x4 v[4]; float s = 0.f;
#pragma unroll
        for (int j = 0; j < 4; ++j) { v[j] = xr[64 * j]; s += (v[j].x * v[j].x + v[j].y * v[j].y) + (v[j].z * v[j].z + v[j].w * v[j].w); }
        const float tot = wave_sum(s);
        if (lane == 0) F.RSTD1()[m] = 1.0f / sqrtf(tot * (1.0f / DM) + EPS);
        u32x2* o8 = (u32x2*)(F.XB() + (size_t)m * DM) + lane;
#pragma unroll
        for (int j = 0; j < 4; ++j) { u32x2 w; w.x = cvt_pk_bf16(v[j].x, v[j].y); w.y = cvt_pk_bf16(v[j].z, v[j].w); o8[64 * j] = w; }
    }
    constexpr int I_IN = 16 * 80, I_OUT = 16 * 32, I_GU = 16 * 64, I_D = 16 * 32;
    constexpr int NITEMS = I_IN + I_OUT + NE * I_GU + NE * I_D;
    for (int it = gw; it < NITEMS; it += NGW) {
        int r = it;
        if (r < I_IN) { const int kb = r / 80, nb = r % 80; p0_transpose_item(F.w_in(), KD, 2560, F.WIN(), 64 * kb, 32 * nb, win_drow(32 * nb), F.norm1_w(), scr, lane); continue; } r -= I_IN;
        if (r < I_OUT) { const int kb = r / 32, nb = r % 32; p0_transpose_item(F.w_out(), KD, 1024, F.WOUT(), 64 * kb, 32 * nb, 32 * nb, nullptr, scr, lane); continue; } r -= I_OUT;
        if (r < NE * I_GU) { const int e = r / I_GU, q = r % I_GU, kb = q / 64, nb = q % 64;
            p0_transpose_item_f8(F.w_gate_up() + (size_t)e * KD * 2048, KD, 2048, F.WGU() + (size_t)e * 2048 * KD, 64 * kb, 32 * nb, scr, lane); continue; } r -= NE * I_GU;
        { const int e = r / I_D, q = r % I_D, kb = q / 32, nb = q % 32;
            p0_transpose_item_f8(F.w_down() + (size_t)e * KD * 1024, KD, 1024, F.WD() + (size_t)e * 1024 * KD, 64 * kb, 32 * nb, scr, lane); }
    }
    for (int idx = gw * 64 + lane; idx < NE * KD; idx += NGW * 64) {
        const int e = idx >> 10, k = idx & 1023; const float w = F.router_w()[(size_t)k * NE + e];
        const unsigned hi = cvt_pk_bf16(w, 0.f) & 0xffffu; const float rem = w - __uint_as_float(hi << 16);
        F.RT()[idx] = (bf16_t)hi; F.RT()[NE * KD + idx] = (bf16_t)(cvt_pk_bf16(rem, 0.f) & 0xffffu);
    }
}

struct ProgIn {
    static constexpr bool GATHER = false, FP8 = false;
    const Frame* F;
    __device__ __forceinline__ bool next(int i, Unit& u) const {
        const int v = F->vcu;
        if (i < 4) { const int uu = i * 256 + v, grp = uu >> 5, w = uu & 31; u.pm = grp * 4 + (w & 3); u.pn = w >> 2; u.kind = u.pn < 4 ? 0 : 1;
            u.A = (const char*)(F->XB() + (size_t)u.pm * 256 * KD); u.B = (const char*)(F->WIN() + (size_t)u.pn * 256 * KD); u.e = 0; u.r0 = 0; return true; }
        if (i == 4) { u.kind = 2; u.pm = v & 1; u.pn = v >> 1; u.A = (const char*)(F->WIN() + (size_t)(2048 + u.pm * 256) * KD); u.B = (const char*)(F->XB() + (size_t)u.pn * 256 * KD); u.e = 0; u.r0 = 0; return true; }
        return false;
    }
    __device__ __forceinline__ void epi(const Acc& acc, const Unit& u, int wr, int wc, int fr, int fq) const {
        asm volatile("" : "+v"(fr), "+v"(fq));
        if (u.kind == 2) {
            const int tk0 = u.pn * 256 + wc * 32 + 8 * fq;
            f32x4 rs[2][2];
#pragma unroll
            for (int bj = 0; bj < 2; ++bj)
#pragma unroll
                for (int n = 0; n < 2; ++n) rs[bj][n] = *(const f32x4*)(F->RSTD1() + tk0 + bj * 128 + 4 * n);
#pragma unroll
            for (int ai = 0; ai < 2; ++ai)
#pragma unroll
                for (int m = 0; m < 4; ++m) { const int cp = u.pm * 256 + ai * 128 + wr * 64 + m * 16 + fr; bf16_t* rowp = F->VT() + (size_t)cp * NTOK + tk0;
#pragma unroll
                    for (int bj = 0; bj < 2; ++bj) { const f32x4 v0 = acc[ai][bj][m][0] * rs[bj][0], v1 = acc[ai][bj][m][1] * rs[bj][1];
                        u32x4 w; w.x = cvt_pk_bf16(v0[0], v0[1]); w.y = cvt_pk_bf16(v0[2], v0[3]); w.z = cvt_pk_bf16(v1[0], v1[1]); w.w = cvt_pk_bf16(v1[2], v1[3]);
                        *(u32x4*)(rowp + bj * 128) = w; } }
            return;
        }
        float rsr[2][4];
#pragma unroll
        for (int ai = 0; ai < 2; ++ai)
#pragma unroll
            for (int m = 0; m < 4; ++m) rsr[ai][m] = F->RSTD1()[u.pm * 256 + ai * 128 + wr * 64 + m * 16 + fr];
        if (u.kind == 0) {
#pragma unroll
            for (int ai = 0; ai < 2; ++ai)
#pragma unroll
                for (int m = 0; m < 4; ++m) { const int r = u.pm * 256 + ai * 128 + wr * 64 + m * 16 + fr; bf16_t* rowp = F->UV() + (size_t)r * 1024 + u.pn * 256 + wc * 32 + 8 * fq; const float rs = rsr[ai][m];
#pragma unroll
                    for (int bj = 0; bj < 2; ++bj) { f32x4 v0 = acc[ai][bj][m][0] * rs, v1 = acc[ai][bj][m][1] * rs;
#pragma unroll
                        for (int j = 0; j < 4; ++j) { v0[j] = gelu_tanh_f(v0[j]); v1[j] = gelu_tanh_f(v1[j]); }
                        u32x4 w; w.x = cvt_pk_bf16(v0[0], v0[1]); w.y = cvt_pk_bf16(v0[2], v0[3]); w.z = cvt_pk_bf16(v1[0], v1[1]); w.w = cvt_pk_bf16(v1[2], v1[3]);
                        *(u32x4*)(rowp + bj * 128) = w; } }
            return;
        }
        {
            const int isk = (u.pn - 4) >> 1, head = 4 * (u.pn & 1) + wc; const float* nw = isk ? F->k_norm_w() : F->q_norm_w(); bf16_t* dst = isk ? F->K() : F->Q();
            const float osc = isk ? 1.0f : QSCALE;
            f32x4 nwv[2][2];
#pragma unroll
            for (int bj = 0; bj < 2; ++bj)
#pragma unroll
                for (int n = 0; n < 2; ++n) nwv[bj][n] = *(const f32x4*)(nw + 32 * bj + 8 * fq + 4 * n);
#pragma unroll
            for (int ai = 0; ai < 2; ++ai)
#pragma unroll
                for (int m = 0; m < 4; ++m) { const int r = u.pm * 256 + ai * 128 + wr * 64 + m * 16 + fr; const float rs = rsr[ai][m];
                    f32x4 t[2][2]; float ss = 0.f;
#pragma unroll
                    for (int bj = 0; bj < 2; ++bj)
#pragma unroll
                        for (int n = 0; n < 2; ++n) { t[bj][n] = acc[ai][bj][m][n] * rs; ss += (t[bj][n][0] * t[bj][n][0] + t[bj][n][1] * t[bj][n][1]) + (t[bj][n][2] * t[bj][n][2] + t[bj][n][3] * t[bj][n][3]); }
                    ss += __shfl_xor(ss, 16); ss += __shfl_xor(ss, 32);
                    const float rn = osc / sqrtf(ss * (1.0f / 64.0f) + EPS);
                    bf16_t* rowp = dst + (size_t)r * 512 + head * 64 + 8 * fq;
#pragma unroll
                    for (int bj = 0; bj < 2; ++bj) { const f32x4 v0 = t[bj][0] * nwv[bj][0] * rn, v1 = t[bj][1] * nwv[bj][1] * rn;
                        u32x4 w; w.x = cvt_pk_bf16(v0[0], v0[1]); w.y = cvt_pk_bf16(v0[2], v0[3]); w.z = cvt_pk_bf16(v1[0], v1[1]); w.w = cvt_pk_bf16(v1[2], v1[3]);
                        *(u32x4*)(rowp + bj * 32) = w; } }
        }
    }
};

constexpr int VN_PITCH = 136, YT_PITCH = 132, YT_OFF = 36864;
__device__ __forceinline__ void gmlp_unit(const Frame& F, int chunk, int g) {
    const int tid = F.tid, lane = F.lane, wid = F.wave;
    LAS bf16_t* vn = (LAS bf16_t*)F.lds; LAS float* yt = (LAS float*)(F.lds + YT_OFF);
    const size_t tok0 = (size_t)chunk * 128;
    {
        const int row = tid >> 2, qd = tid & 3; const bf16_t* src = F.UV() + (tok0 + row) * 1024 + 512 + g * 128 + qd * 32;
        u32x4 w[4]; float v[32]; float ss = 0.f;
#pragma unroll
        for (int i = 0; i < 4; ++i) w[i] = *(const u32x4*)(src + 8 * i);
#pragma unroll
        for (int i = 0; i < 4; ++i)
#pragma unroll
            for (int j = 0; j < 4; ++j) { v[8 * i + 2 * j] = bflo(w[i][j]); v[8 * i + 2 * j + 1] = bfhi(w[i][j]); }
#pragma unroll
        for (int i = 0; i < 32; ++i) ss += v[i] * v[i];
        ss += __shfl_xor(ss, 1); ss += __shfl_xor(ss, 2);
        const float rs = 1.0f / sqrtf(ss * (1.0f / 128.0f) + EPS);
        const float* nw = F.sgu_norm_w() + g * 128 + qd * 32;
#pragma unroll
        for (int i = 0; i < 4; ++i) { const f32x4 n0 = *(const f32x4*)(nw + 8 * i), n1 = *(const f32x4*)(nw + 8 * i + 4);
            u32x4 o; o.x = cvt_pk_bf16(v[8 * i] * rs * n0[0], v[8 * i + 1] * rs * n0[1]); o.y = cvt_pk_bf16(v[8 * i + 2] * rs * n0[2], v[8 * i + 3] * rs * n0[3]);
            o.z = cvt_pk_bf16(v[8 * i + 4] * rs * n1[0], v[8 * i + 5] * rs * n1[1]); o.w = cvt_pk_bf16(v[8 * i + 6] * rs * n1[2], v[8 * i + 7] * rs * n1[3]);
            *(LAS u32x4*)(vn + row * VN_PITCH + qd * 32 + 8 * i) = o; }
    }
    __syncthreads();
    {
        const int tb = wid >> 1, cb0 = 2 * (wid & 1), r32 = lane & 31, hh = lane >> 5;
        f32x16 a0 = {}, a1 = {};
        const int t = 32 * tb + r32; const float* wrow = F.sgu_w() + ((size_t)g * 128 + t) * 128;
        for (int ks = 0; ks < 2 * (tb + 1); ++ks) {
            const int s0 = 16 * ks + 8 * hh;
            const f32x4 w0 = *(const f32x4*)(wrow + s0), w1 = *(const f32x4*)(wrow + s0 + 4);
            float wv[8] = {w0[0], w0[1], w0[2], w0[3], w1[0], w1[1], w1[2], w1[3]};
#pragma unroll
            for (int j = 0; j < 8; ++j) if (s0 + j > t) wv[j] = 0.f;
            u32x4 aw; aw.x = cvt_pk_bf16(wv[0], wv[1]); aw.y = cvt_pk_bf16(wv[2], wv[3]); aw.z = cvt_pk_bf16(wv[4], wv[5]); aw.w = cvt_pk_bf16(wv[6], wv[7]);
            const bf16x8 af = __builtin_bit_cast(bf16x8, aw);
            bf16x8 b0, b1;
#pragma unroll
            for (int j = 0; j < 8; ++j) { b0[j] = (short)vn[(s0 + j) * VN_PITCH + 32 * cb0 + r32]; b1[j] = (short)vn[(s0 + j) * VN_PITCH + 32 * (cb0 + 1) + r32]; }
            a0 = __builtin_amdgcn_mfma_f32_32x32x16_bf16(af, b0, a0, 0, 0, 0);
            a1 = __builtin_amdgcn_mfma_f32_32x32x16_bf16(af, b1, a1, 0, 0, 0);
        }
#pragma unroll
        for (int reg = 0; reg < 16; ++reg) {
            const int tt = 32 * tb + (reg & 3) + 8 * (reg >> 2) + 4 * hh; const float bb = F.sgu_b()[g * 128 + tt];
            const bf16_t* up = F.UV() + (tok0 + tt) * 1024 + g * 128;
            const int c0 = 32 * cb0 + r32, c1 = c0 + 32;
            yt[tt * YT_PITCH + c0] = bf2f(up[c0]) * (a0[reg] + bb);
            yt[tt * YT_PITCH + c1] = bf2f(up[c1]) * (a1[reg] + bb);
        }
    }
    __syncthreads();
    {
        const int row = tid >> 2, qd = tid & 3; const LAS float* src = yt + row * YT_PITCH + qd * 32; f32x4 v[8]; float ss = 0.f;
#pragma unroll
        for (int i = 0; i < 8; ++i) { v[i] = *(const LAS f32x4*)(src + 4 * i); ss += (v[i][0] * v[i][0] + v[i][1] * v[i][1]) + (v[i][2] * v[i][2] + v[i][3] * v[i][3]); }
        ss += __shfl_xor(ss, 1); ss += __shfl_xor(ss, 2);
        const float rs = 1.0f / sqrtf(ss * (1.0f / 128.0f) + EPS);
        const float* nw = F.out_norm_a_w() + g * 128 + qd * 32; bf16_t* dst = F.Y() + (tok0 + row) * 1024 + g * 128 + qd * 32;
#pragma unroll
        for (int i = 0; i < 4; ++i) { const f32x4 n0 = *(const f32x4*)(nw + 8 * i), n1 = *(const f32x4*)(nw + 8 * i + 4); const f32x4 x0 = v[2 * i] * n0 * rs, x1 = v[2 * i + 1] * n1 * rs;
            u32x4 o; o.x = cvt_pk_bf16(x0[0], x0[1]); o.y = cvt_pk_bf16(x0[2], x0[3]); o.z = cvt_pk_bf16(x1[0], x1[1]); o.w = cvt_pk_bf16(x1[2], x1[3]);
            *(u32x4*)(dst + 8 * i) = o; }
    }
    __syncthreads();
}

__device__ __forceinline__ void attn_wave_unit(const Frame& F, int b, int h, int qblk) {
    const int lane = F.lane, r32 = lane & 31, hi = lane >> 5;
    const size_t tokq = (size_t)b * SEQ + 32 * qblk + r32;
    bf16x8 qr[4];
#pragma unroll
    for (int d0 = 0; d0 < 4; ++d0) qr[d0] = *(const bf16x8*)(F.Q() + tokq * 512 + h * 64 + 16 * d0 + 8 * hi);
    f32x16 o0 = {}, o1 = {};
    float carry = 0.f;
    const bf16_t* Kb = F.K() + ((size_t)b * SEQ + r32) * 512 + h * 64 + 8 * hi;
    const bf16_t* V0 = F.VT() + (size_t)(h * 64 + r32) * NTOK + (size_t)b * SEQ + 4 * hi;
    bf16x8 kf[4]; s16x4 vf[2][2][2];
    auto load_tile = [&](int j, bf16x8 (&kk)[4], s16x4 (&vv)[2][2][2]) {
#pragma unroll
        for (int d0 = 0; d0 < 4; ++d0) kk[d0] = *(const bf16x8*)(Kb + (size_t)(32 * j) * 512 + 16 * d0);
#pragma unroll
        for (int dh = 0; dh < 2; ++dh)
#pragma unroll
            for (int ks = 0; ks < 2; ++ks) { const bf16_t* p = V0 + (size_t)dh * 32 * NTOK + 32 * j + 16 * ks; vv[dh][ks][0] = *(const s16x4*)p; vv[dh][ks][1] = *(const s16x4*)(p + 8); }
    };
    load_tile(qblk, kf, vf);
    for (int j = qblk; j >= 0; --j) {
        bf16x8 kn[4]; s16x4 vn2[2][2][2];
        if (j > 0) load_tile(j - 1, kn, vn2);
        else {
#pragma unroll
            for (int d0 = 0; d0 < 4; ++d0) kn[d0] = kf[d0];
#pragma unroll
            for (int dh = 0; dh < 2; ++dh)
#pragma unroll
                for (int ks = 0; ks < 2; ++ks) { vn2[dh][ks][0] = vf[dh][ks][0]; vn2[dh][ks][1] = vf[dh][ks][1]; }
        }
        f32x16 s = {};
#pragma unroll
        for (int d0 = 0; d0 < 4; ++d0) s = __builtin_amdgcn_mfma_f32_32x32x16_bf16(kf[d0], qr[d0], s, 0, 0, 0);
        float sp[16];
        const bool diag = (j == qblk);
#pragma unroll
        for (int r = 0; r < 16; ++r) {
            const int kvl = (r & 3) + 8 * (r >> 2) + 4 * hi;
            const float z = s[r];
            float v = fmaxf(z, 0.f) + __builtin_amdgcn_logf(1.0f + __builtin_amdgcn_exp2f(-fabsf(z)));
            if (diag && kvl >= r32) v = 0.f;
            sp[r] = v;
        }
        float G[4], Gp[4];
#pragma unroll
        for (int k = 0; k < 4; ++k) { G[k] = (sp[4 * k] + sp[4 * k + 1]) + (sp[4 * k + 2] + sp[4 * k + 3]); Gp[k] = __shfl_xor(G[k], 32); }
        const float T3 = G[3] + Gp[3], T2 = G[2] + Gp[2], T1 = G[1] + Gp[1], T0 = G[0] + Gp[0];
        float off[4];
        off[3] = 0.f; off[2] = T3; off[1] = T3 + T2; off[0] = T3 + T2 + T1;
        const float tile_total = off[0] + T0;
#pragma unroll
        for (int k = 0; k < 4; ++k) off[k] += carry + (hi == 0 ? Gp[k] : 0.f);
        float a[16];
#pragma unroll
        for (int k = 0; k < 4; ++k) {
            float c = off[k];
#pragma unroll
            for (int i = 3; i >= 0; --i) { const int r = 4 * k + i; c += sp[r]; float av = __builtin_amdgcn_exp2f(s[r] - c);
                if (diag && ((r & 3) + 8 * (r >> 2) + 4 * hi) >= r32) av = 0.f;
                a[r] = av; }
        }
        carry += tile_total;
        u32x4 p0, p1;
        p0.x = cvt_pk_bf16(a[0], a[1]); p0.y = cvt_pk_bf16(a[2], a[3]); p0.z = cvt_pk_bf16(a[4], a[5]); p0.w = cvt_pk_bf16(a[6], a[7]);
        p1.x = cvt_pk_bf16(a[8], a[9]); p1.y = cvt_pk_bf16(a[10], a[11]); p1.z = cvt_pk_bf16(a[12], a[13]); p1.w = cvt_pk_bf16(a[14], a[15]);
        const bf16x8 pf0 = __builtin_bit_cast(bf16x8, p0), pf1 = __builtin_bit_cast(bf16x8, p1);
#define MK_VF(dh, ks) (bf16x8){vf[dh][ks][0][0], vf[dh][ks][0][1], vf[dh][ks][0][2], vf[dh][ks][0][3], vf[dh][ks][1][0], vf[dh][ks][1][1], vf[dh][ks][1][2], vf[dh][ks][1][3]}
        o0 = __builtin_amdgcn_mfma_f32_32x32x16_bf16(MK_VF(0, 0), pf0, o0, 0, 0, 0);
        o0 = __builtin_amdgcn_mfma_f32_32x32x16_bf16(MK_VF(0, 1), pf1, o0, 0, 0, 0);
        o1 = __builtin_amdgcn_mfma_f32_32x32x16_bf16(MK_VF(1, 0), pf0, o1, 0, 0, 0);
        o1 = __builtin_amdgcn_mfma_f32_32x32x16_bf16(MK_VF(1, 1), pf1, o1, 0, 0, 0);
#undef MK_VF
        if (__all(carry > SB_THR)) break;
#pragma unroll
        for (int d0 = 0; d0 < 4; ++d0) kf[d0] = kn[d0];
#pragma unroll
        for (int dh = 0; dh < 2; ++dh)
#pragma unroll
            for (int ks = 0; ks < 2; ++ks) { vf[dh][ks][0] = vn2[dh][ks][0]; vf[dh][ks][1] = vn2[dh][ks][1]; }
    }
    float ss = 0.f;
#pragma unroll
    for (int r = 0; r < 16; ++r) ss += o0[r] * o0[r] + o1[r] * o1[r];
    ss += __shfl_xor(ss, 32);
    const float rs = 1.0f / sqrtf(ss * (1.0f / 64.0f) + EPS);
    const float* nw = F.out_norm_b_w() + h * 64 + 4 * hi; bf16_t* dst = F.Y() + tokq * 1024 + 512 + h * 64 + 4 * hi;
#pragma unroll
    for (int dh = 0; dh < 2; ++dh)
#pragma unroll
        for (int g = 0; g < 4; ++g) { const f32x4 w = *(const f32x4*)(nw + 32 * dh + 8 * g); const f32x16& o = dh ? o1 : o0;
            u32x2 pk; pk.x = cvt_pk_bf16(o[4 * g] * rs * w[0], o[4 * g + 1] * rs * w[1]); pk.y = cvt_pk_bf16(o[4 * g + 2] * rs * w[2], o[4 * g + 3] * rs * w[3]);
            *(u32x2*)(dst + 32 * dh + 8 * g) = pk; }
}
__device__ __forceinline__ void p2_mixers(Frame& F) {
    for (int i = 0; i < 4; ++i) { const int u = i * 256 + F.vcu; gmlp_unit(F, u >> 2, u & 3); }
    const int gw = F.vcu * NWAVES + F.wave;
    for (int i = 0; i < 4; ++i) { const int u = i * 2048 + gw; const int qblk = u & 127, bh = u >> 7; attn_wave_unit(F, bh >> 3, bh & 7, qblk); }
}

struct ProgOut {
    static constexpr bool GATHER = false, FP8 = false;
    const Frame* F;
    __device__ __forceinline__ bool next(int i, Unit& u) const {
        if (i >= 2) return false;
        const int uu = i * 256 + F->vcu, grp = uu >> 5, w = uu & 31; u.pm = grp * 8 + (w & 7); u.pn = w >> 3; u.kind = 0; u.e = 0; u.r0 = 0;
        u.A = (const char*)(F->Y() + (size_t)u.pm * 256 * KD); u.B = (const char*)(F->WOUT() + (size_t)u.pn * 256 * KD); return true;
    }
    __device__ __forceinline__ void epi(const Acc& acc, const Unit& u, int wr, int wc, int fr, int fq) const {
        asm volatile("" : "+v"(fr), "+v"(fq));
#pragma unroll
        for (int ai = 0; ai < 2; ++ai)
#pragma unroll
            for (int m = 0; m < 4; ++m) { const int r = u.pm * 256 + ai * 128 + wr * 64 + m * 16 + fr; const size_t off = (size_t)r * DM + u.pn * 256 + wc * 32 + 8 * fq; float ss = 0.f;
#pragma unroll
                for (int bj = 0; bj < 2; ++bj)
#pragma unroll
                    for (int n = 0; n < 2; ++n) { const f32x4 xv = *(const f32x4*)(F->x() + off + bj * 128 + 4 * n); const f32x4 o = xv + acc[ai][bj][m][n];
                        ss += (o[0] * o[0] + o[1] * o[1]) + (o[2] * o[2] + o[3] * o[3]); *(f32x4*)(F->out() + off + bj * 128 + 4 * n) = o; }
                ss += __shfl_xor(ss, 16); ss += __shfl_xor(ss, 32);
                if (fq == 0) F->SSPART()[(size_t)r * 16 + u.pn * 4 + wc] = ss; }
    }
};

__device__ __forceinline__ void router_wave_unit(Frame& F, int unit) {
    const int lane = F.lane, r32 = lane & 31, hh = lane >> 5; const int tok = unit * 32 + r32;
    float ssum = 0.f;
    { const f32x4* sp = (const f32x4*)(F.SSPART() + (size_t)tok * 16);
#pragma unroll
      for (int i = 0; i < 4; ++i) { const f32x4 v = sp[i]; ssum += v[0]; ssum += v[1]; ssum += v[2]; ssum += v[3]; } }
    const float rs = 1.0f / sqrtf(ssum * (1.0f / DM) + EPS);
    f32x16 acc = {};
    const float* xrow = F.out() + (size_t)tok * DM + 8 * hh; const float* w2 = F.norm2_w() + 8 * hh; unsigned char* hrow = F.HB() + (size_t)tok * DM + 8 * hh;
    const bf16_t* rth = F.RT() + (size_t)r32 * KD + 8 * hh; const bf16_t* rtl = rth + NE * KD;
#pragma unroll 4
    for (int s = 0; s < 64; ++s) {
        const f32x4 x0 = *(const f32x4*)(xrow + 16 * s), x1 = *(const f32x4*)(xrow + 16 * s + 4);
        const f32x4 g0 = *(const f32x4*)(w2 + 16 * s), g1 = *(const f32x4*)(w2 + 16 * s + 4);
        const f32x4 h0 = x0 * g0 * rs, h1 = x1 * g1 * rs;
        u32x4 hw; hw.x = cvt_pk_bf16(h0[0], h0[1]); hw.y = cvt_pk_bf16(h0[2], h0[3]); hw.z = cvt_pk_bf16(h1[0], h1[1]); hw.w = cvt_pk_bf16(h1[2], h1[3]);
        { u32x2 h8; h8.x = pk4_fp8(h0[0], h0[1], h0[2], h0[3]); h8.y = pk4_fp8(h1[0], h1[1], h1[2], h1[3]); *(u32x2*)(hrow + 16 * s) = h8; }
        u32x4 lw; lw.x = cvt_pk_bf16(h0[0] - bflo(hw.x), h0[1] - bfhi(hw.x)); lw.y = cvt_pk_bf16(h0[2] - bflo(hw.y), h0[3] - bfhi(hw.y));
        lw.z = cvt_pk_bf16(h1[0] - bflo(hw.z), h1[1] - bfhi(hw.z)); lw.w = cvt_pk_bf16(h1[2] - bflo(hw.w), h1[3] - bfhi(hw.w));
        const bf16x8 bh = __builtin_bit_cast(bf16x8, hw), bl = __builtin_bit_cast(bf16x8, lw);
        const bf16x8 ah = *(const bf16x8*)(rth + 16 * s), al = *(const bf16x8*)(rtl + 16 * s);
        acc = __builtin_amdgcn_mfma_f32_32x32x16_bf16(ah, bh, acc, 0, 0, 0);
        acc = __builtin_amdgcn_mfma_f32_32x32x16_bf16(al, bh, acc, 0, 0, 0);
        acc = __builtin_amdgcn_mfma_f32_32x32x16_bf16(ah, bl, acc, 0, 0, 0);
    }
    float lv[16];
#pragma unroll
    for (int r = 0; r < 16; ++r) lv[r] = acc[r] + F.router_b()[(r & 3) + 8 * (r >> 2) + 4 * hh];
    float cv[8]; int ce[8];
#pragma unroll
    for (int k = 0; k < 4; ++k) { float bv = -INFINITY; int be = 0;
#pragma unroll
        for (int r = 0; r < 16; ++r) { const int e = (r & 3) + 8 * (r >> 2) + 4 * hh; if (lv[r] > bv) { bv = lv[r]; be = e; } }
#pragma unroll
        for (int r = 0; r < 16; ++r) { const int e = (r & 3) + 8 * (r >> 2) + 4 * hh; if (e == be) lv[r] = -INFINITY; }
        cv[k] = bv; ce[k] = be; }
#pragma unroll
    for (int k = 0; k < 4; ++k) { cv[4 + k] = __shfl_xor(cv[k], 32); ce[4 + k] = __shfl_xor(ce[k], 32); }
    float tv[4]; int te[4];
#pragma unroll
    for (int k = 0; k < 4; ++k) { float bv = -INFINITY; int be = 1 << 20;
#pragma unroll
        for (int c = 0; c < 8; ++c) if (cv[c] > bv || (cv[c] == bv && ce[c] < be)) { bv = cv[c]; be = ce[c]; }
#pragma unroll
        for (int c = 0; c < 8; ++c) if (ce[c] == be) cv[c] = -INFINITY;
        tv[k] = bv; te[k] = be; }
    float ex[4], den = 0.f;
#pragma unroll
    for (int k = 0; k < 4; ++k) { ex[k] = __builtin_amdgcn_exp2f((tv[k] - tv[0]) * LOG2E); den += ex[k]; }
    const float rden = 1.0f / den;
    const int e0 = hh ? te[2] : te[0], e1 = hh ? te[3] : te[1]; const float g0 = (hh ? ex[2] : ex[0]) * rden, g1 = (hh ? ex[3] : ex[1]) * rden;
    int myc = 0; int rank0 = 0, rank1 = 0;
    const unsigned long long ltmask = (1ull << lane) - 1ull;
    for (int e = 0; e < NE; ++e) {
        const unsigned long long m0 = __ballot(e0 == e), m1 = __ballot(e1 == e);
        const int c0 = __popcll(m0), c1 = __popcll(m1);
        if (lane == e) myc = c0 + c1;
        if (e0 == e) rank0 = __popcll(m0 & ltmask);
        if (e1 == e) rank1 = c0 + __popcll(m1 & ltmask);
    }
    int base = 0;
    if (lane < NE && myc > 0) base = (int)__hip_atomic_fetch_add(F.ctl() + CW_CNT + lane, (unsigned)myc, __ATOMIC_RELAXED, __HIP_MEMORY_SCOPE_AGENT);
    const int p0 = __shfl(base, e0) + rank0, p1 = __shfl(base, e1) + rank1;
    F.LISTTOK()[(size_t)e0 * NTOK + p0] = tok; F.LISTGATE()[(size_t)e0 * NTOK + p0] = g0;
    F.LISTTOK()[(size_t)e1 * NTOK + p1] = tok; F.LISTGATE()[(size_t)e1 * NTOK + p1] = g1;
    F.TOKINFO()[tok * 4 + 2 * hh] = (e0 << 16) | p0; F.TOKINFO()[tok * 4 + 2 * hh + 1] = (e1 << 16) | p1;
}

__device__ __forceinline__ void moe_build_table(Frame& F) {
    LAS int* tab = (LAS int*)(F.lds + TAB_OFF);
    if (F.tid < NE) tab[F.tid] = (int)__hip_atomic_load(F.ctl() + CW_CNT + F.tid, __ATOMIC_RELAXED, __HIP_MEMORY_SCOPE_AGENT);
    __syncthreads();
    if (F.tid == 0) { int acc = 0; for (int e = 0; e < NE; ++e) { tab[32 + e] = acc; acc += (tab[e] + 255) >> 8; } tab[64] = acc; }
    __syncthreads();
}
__device__ __forceinline__ int sgpr(int v) { return __builtin_amdgcn_readfirstlane(v); }
template <int WGM, int NN>
__device__ __forceinline__ bool moe_decode(const Frame* F, int i, Unit& u) {
    const LAS int* tab = (const LAS int*)(F->lds + TAB_OFF);
    const int uu = i * 256 + F->vcu, grp = uu >> 5, w = uu & 31; const int mt = grp * WGM + (w % WGM); u.pn = w / WGM;
    if (mt >= sgpr(tab[64])) return false;
    int e = 0;
    for (int k = 1; k < NE; ++k) if (sgpr(tab[32 + k]) <= mt) e = k;
    u.e = e; u.pm = mt; u.r0 = (mt - sgpr(tab[32 + e])) * 256; u.kind = sgpr(tab[e]); return true;
}
struct ProgMoe1 {
    static constexpr bool GATHER = true, FP8 = true;
    const Frame* F;
    __device__ __forceinline__ bool next(int i, Unit& u) const {
        if (!moe_decode<4, 8>(F, i, u)) return false;
        u.A = (const char*)F->HB(); u.B = (const char*)(F->WGU() + ((size_t)u.e * 2048 + (size_t)u.pn * 256) * KD); return true;
    }
    __device__ __forceinline__ void aoffs(const Unit& u, int wid, unsigned (&vo)[2][2]) const {
        const int cnt = u.kind; const int tid = wid * 64 + lane_id();
#pragma unroll
        for (int i = 0; i < 2; ++i) { int R_, C_; stage_rc(tid * 16 + i * 8192, R_, C_);
#pragma unroll
            for (int h = 0; h < 2; ++h) { const int idx = u.r0 + h * 128 + R_; const int tok = idx < cnt ? F->LISTTOK()[(size_t)u.e * NTOK + idx] : 0; vo[h][i] = (unsigned)(tok * KD + C_ * 2); } }
    }
    __device__ __forceinline__ void epi(const Acc& acc, const Unit& u, int wr, int wc, int fr, int fq) const {
        asm volatile("" : "+v"(fr), "+v"(fq));
        const float* bp = F->b_gate_up() + (size_t)u.e * 2048 + u.pn * 256 + wc * 32 + 8 * fq;
        f32x4 bv[2][2];
#pragma unroll
        for (int bj = 0; bj < 2; ++bj)
#pragma unroll
            for (int n = 0; n < 2; ++n) bv[bj][n] = *(const f32x4*)(bp + bj * 128 + 4 * n);
#pragma unroll
        for (int ai = 0; ai < 2; ++ai)
#pragma unroll
            for (int m = 0; m < 4; ++m) { const size_t slot = (size_t)u.pm * 256 + ai * 128 + wr * 64 + m * 16 + fr; unsigned char* rowp = F->ACT() + slot * 1024 + u.pn * 128 + wc * 16 + 4 * fq;
#pragma unroll
                for (int bj = 0; bj < 2; ++bj) { const f32x4 v0 = acc[ai][bj][m][0] * WSCALE_INV + bv[bj][0], v1 = acc[ai][bj][m][1] * WSCALE_INV + bv[bj][1];
                    float r4[4];
#pragma unroll
                    for (int p = 0; p < 4; ++p) { float gt = (p < 2) ? v0[2 * p] : v1[2 * (p - 2)]; float up = (p < 2) ? v0[2 * p + 1] : v1[2 * (p - 2) + 1];
                        gt = fminf(gt, 7.0f); up = fminf(fmaxf(up, -7.0f), 7.0f);
                        const float glu = gt * __builtin_amdgcn_rcpf(1.0f + __builtin_amdgcn_exp2f(-1.702f * LOG2E * gt)); r4[p] = (up + 1.0f) * glu; }
                    *(unsigned*)(rowp + bj * 64) = pk4_fp8(r4[0], r4[1], r4[2], r4[3]); } }
    }
};
struct ProgMoe2 {
    static constexpr bool GATHER = false, FP8 = true;
    const Frame* F;
    __device__ __forceinline__ bool next(int i, Unit& u) const {
        if (!moe_decode<8, 4>(F, i, u)) return false;
        u.A = (const char*)(F->ACT() + (size_t)u.pm * 256 * KD); u.B = (const char*)(F->WD() + ((size_t)u.e * 1024 + (size_t)u.pn * 256) * KD); return true;
    }
    __device__ __forceinline__ void epi(const Acc& acc, const Unit& u, int wr, int wc, int fr, int fq) const {
        asm volatile("" : "+v"(fr), "+v"(fq));
        const int cnt = u.kind;
        const float* bp = F->b_down() + (size_t)u.e * 1024 + u.pn * 256 + wc * 32 + 8 * fq;
        f32x4 bv[2][2];
#pragma unroll
        for (int bj = 0; bj < 2; ++bj)
#pragma unroll
            for (int n = 0; n < 2; ++n) bv[bj][n] = *(const f32x4*)(bp + bj * 128 + 4 * n);
#pragma unroll
        for (int ai = 0; ai < 2; ++ai)
#pragma unroll
            for (int m = 0; m < 4; ++m) { const int rl = ai * 128 + wr * 64 + m * 16 + fr; const int idx = u.r0 + rl; const float gate = idx < cnt ? F->LISTGATE()[(size_t)u.e * NTOK + idx] : 0.f;
                bf16_t* rowp = F->YS() + ((size_t)u.pm * 256 + rl) * 1024 + u.pn * 256 + wc * 32 + 8 * fq;
#pragma unroll
                for (int bj = 0; bj < 2; ++bj) { const f32x4 v0 = (acc[ai][bj][m][0] * WSCALE_INV + bv[bj][0]) * gate, v1 = (acc[ai][bj][m][1] * WSCALE_INV + bv[bj][1]) * gate;
                    u32x4 w; w.x = cvt_pk_bf16(v0[0], v0[1]); w.y = cvt_pk_bf16(v0[2], v0[3]); w.z = cvt_pk_bf16(v1[0], v1[1]); w.w = cvt_pk_bf16(v1[2], v1[3]);
                    *(u32x4*)(rowp + bj * 128) = w; } }
    }
};

__device__ __forceinline__ void p7_combine(Frame& F) {
    const LAS int* tab = (const LAS int*)(F.lds + TAB_OFF);
    const int gw = F.vcu * NWAVES + F.wave, NGW = F.G * NWAVES, lane = F.lane;
    for (int tok = gw; tok < NTOK; tok += NGW) {
        f32x4* orow = (f32x4*)(F.out() + (size_t)tok * DM) + lane; f32x4 v[4];
#pragma unroll
        for (int j = 0; j < 4; ++j) v[j] = orow[64 * j];
#pragma unroll
        for (int k = 0; k < 4; ++k) { const int info = F.TOKINFO()[tok * 4 + k]; const int e = info >> 16, pos = info & 0xffff; const size_t slot = (size_t)tab[32 + e] * 256 + pos;
            const u32x2* yr = (const u32x2*)(F.YS() + slot * 1024) + lane;
#pragma unroll
            for (int j = 0; j < 4; ++j) { const u32x2 w = yr[64 * j]; v[j][0] += bflo(w.x); v[j][1] += bfhi(w.x); v[j][2] += bflo(w.y); v[j][3] += bfhi(w.y); } }
#pragma unroll
        for (int j = 0; j < 4; ++j) orow[64 * j] = v[j];
    }
}

__global__ void __launch_bounds__(NWAVES * 64, 2) mk_fwd(Args args) {
    extern __shared__ __attribute__((aligned(16))) unsigned char lds_raw[];
    Frame F;
    F.lds = (LAS unsigned char*)lds_raw;
    F.tid = threadIdx.x; F.lane = F.tid & 63; F.wave = __builtin_amdgcn_readfirstlane(F.tid >> 6);
    F.G = gridDim.x; { const int bx = blockIdx.x; F.vcu = (bx % 8) * (F.G / 8) + bx / 8; }
    F.ka = (const CAS Args*)__builtin_amdgcn_kernarg_segment_ptr();
    for (int u = F.tid; u < (LDS_BYTES - LDSCTL_OFF) / 4; u += NWAVES * 64) ((LAS unsigned*)(F.lds + LDSCTL_OFF))[u] = 0u;
    __syncthreads();
    XcdBarrier bar = xcd_barrier_post(F.ctl() + CW_BAR, (volatile LAS unsigned*)(F.lds + MISC_OFF) + 8);
    const int lo = F.ka->ph_lo, hi = F.ka->ph_hi;
#define IN(k) (lo <= (k) && (k) < hi)
#define REFRESH() do { int l_ = lane_id(); asm volatile("" : "+v"(l_)); F.lane = l_; F.tid = F.wave * 64 + l_; } while (0)
#define SEAM(k) do { if (IN(k) && IN((k) + 1)) xcd_barrier(bar, F.wave); } while (0)
#ifndef MK_REP
#define MK_REP -1
#endif
    if (IN(0)) { REFRESH(); p0_prologue(F); if (MK_REP == 0) p0_prologue(F); } SEAM(0);
    if (IN(1)) { { ProgIn P{&F}; gemm_phase(F.lds, P); } if (MK_REP == 1) { ProgIn P{&F}; gemm_phase(F.lds, P); } } SEAM(1);
    if (IN(2)) { REFRESH(); p2_mixers(F); if (MK_REP == 2) p2_mixers(F); } SEAM(2);
    if (IN(3)) { { ProgOut P{&F}; gemm_phase(F.lds, P); } if (MK_REP == 3) { ProgOut P{&F}; gemm_phase(F.lds, P); } } SEAM(3);
    if (IN(4)) { REFRESH(); if (F.wave < 4) router_wave_unit(F, F.wave * 256 + F.vcu); } SEAM(4);
    if (lo <= 7 && hi > 5) { REFRESH(); moe_build_table(F); }
    if (IN(5)) { { ProgMoe1 P{&F}; gemm_phase(F.lds, P); } if (MK_REP == 5) { ProgMoe1 P{&F}; gemm_phase(F.lds, P); } } SEAM(5);
    if (IN(6)) { { ProgMoe2 P{&F}; gemm_phase(F.lds, P); } if (MK_REP == 6) { ProgMoe2 P{&F}; gemm_phase(F.lds, P); } } SEAM(6);
    if (IN(7)) { REFRESH(); p7_combine(F); }
#undef IN
#undef SEAM
}
}
#ifndef MK_CUT
#define MK_CUT 8
#endif
extern "C" void kernel_launch(void* const* d_in, const int* in_sizes, int n_in, void* d_out, int out_size, void* d_ws, size_t ws_size, hipStream_t stream) {
    static int ready = 0;
    if (ready == 0) {
        if (n_in != 18 || out_size != mk::NTOK * mk::DM || ws_size < mk::WS_END) { fprintf(stderr, "kernel_launch: unexpected problem (n_in %d out %d ws %zu)\n", n_in, out_size, ws_size); ready = -1; return; }
        if (hipFuncSetAttribute((const void*)mk::mk_fwd, hipFuncAttributeMaxDynamicSharedMemorySize, mk::LDS_BYTES) != hipSuccess) { fprintf(stderr, "kernel_launch: hipFuncSetAttribute failed\n"); ready = -1; return; }
        ready = 1;
    }
    if (ready < 0) return;
    (void)hipMemsetAsync((char*)d_ws + mk::WS_CTL, 0, mk::CTL_ZERO_BYTES, stream);
    mk::Args a{};
    for (int i = 0; i < 18; ++i) a.in[i] = (const float*)d_in[i];
    a.out = (float*)d_out; a.ws = (unsigned char*)d_ws; a.ph_lo = 0; a.ph_hi = MK_CUT;
    hipLaunchKernelGGL(mk::mk_fwd, dim3(256), dim3(mk::NWAVES * 64), mk::LDS_BYTES, stream, a);
#if MK_CUT < 8
    {
        using namespace nv;
        const float* x = (const float*)d_in[0]; const float* w_out = (const float*)d_in[10]; const float* norm2_w = (const float*)d_in[11];
        const float* router_w = (const float*)d_in[12]; const float* router_b = (const float*)d_in[13]; const float* w_gate_up = (const float*)d_in[14];
        const float* b_gate_up = (const float*)d_in[15]; const float* w_down = (const float*)d_in[16]; const float* b_down = (const float*)d_in[17];
        float* out = (float*)d_out; char* ws = (char*)d_ws; const size_t MiB = 1u << 20;
        int* cnt = (int*)ws + mk::CW_CNT; int* list_tok = (int*)(ws + mk::WS_LISTTOK); float* list_gate = (float*)(ws + mk::WS_LISTGATE);
        float* hn = (float*)(ws + 16 * MiB); float* gu = (float*)(ws + 272 * MiB); float* act = (float*)(ws + (272 + 256) * MiB);
#if MK_CUT <= 3
        k_gemm<1, true><<<dim3(DM / 64, NTOK / 64), 256, 0, stream>>>((const void*)(ws + mk::WS_Y), nullptr, nullptr, nullptr, w_out, nullptr, x, nullptr, out, NTOK, DM, DM, DM, DM);
#endif
#if MK_CUT <= 4
        k_router<<<NTOK, 256, 0, stream>>>(out, norm2_w, router_w, router_b, hn, cnt, list_tok, list_gate);
#else
        k_bf2f<<<4096, 256, 0, stream>>>((const unsigned short*)(ws + mk::WS_HB), hn, (size_t)NTOK * DM);
#endif
        for (int e = 0; e < NE; ++e) {
            const int* lt = list_tok + (size_t)e * NTOK; const float* lgp = list_gate + (size_t)e * NTOK;
            k_gemm<0, false><<<dim3(2 * DFF / 64, NTOK / 64), 256, 0, stream>>>(hn, lt, nullptr, cnt + e, w_gate_up + (size_t)e * DM * 2 * DFF, b_gate_up + (size_t)e * 2 * DFF, nullptr, nullptr, gu, NTOK, 2 * DFF, DM, DM, 2 * DFF);
            k_swiglu<<<NTOK, 256, 0, stream>>>(gu, cnt + e, act);
            k_gemm<3, false><<<dim3(DM / 64, NTOK / 64), 256, 0, stream>>>(act, nullptr, lt, cnt + e, w_down + (size_t)e * DFF * DM, b_down + (size_t)e * DM, nullptr, lgp, out, NTOK, DM, DFF, DFF, DM);
        }
    }
#endif
}
```

```cpp
#include <hip/hip_runtime.h>
#include <cstdio>
#include <cstdint>
#ifndef MK_REP
#define MK_REP -1
#endif
namespace mk {
#define LAS __attribute__((address_space(3)))
#define GAS __attribute__((address_space(1)))
typedef unsigned short bf16_t;
typedef short bf16x8 __attribute__((ext_vector_type(8)));
typedef short s16x4 __attribute__((ext_vector_type(4)));
typedef float f32x4 __attribute__((ext_vector_type(4)));
typedef float f32x2 __attribute__((ext_vector_type(2)));
typedef float f32x16 __attribute__((ext_vector_type(16)));
typedef unsigned u32x4 __attribute__((ext_vector_type(4)));
typedef unsigned u32x2 __attribute__((ext_vector_type(2)));
typedef int i32x4 __attribute__((ext_vector_type(4)));
typedef int i32x8 __attribute__((ext_vector_type(8)));

constexpr int NTOK = 32768, DM = 1024, SEQ = 4096, NB = 8, NH = 8, HD = 64, NE = 32, DFF = 1024, KD = 1024;
constexpr float EPS = 1e-5f;
constexpr float LOG2E = 1.4426950408889634f;
constexpr float QSCALE = 0.125f * LOG2E;
constexpr float SB_THR = 64.0f;
constexpr int NWAVES = 8;
constexpr int SLOTS = NTOK * 4 + NE * 256;

constexpr size_t MiB = 1u << 20;
constexpr size_t WS_CTL = 0, CTL_ZERO_BYTES = 1 * MiB;
constexpr size_t WS_LISTTOK = 1 * MiB;
constexpr size_t WS_LISTGATE = 5 * MiB;
constexpr size_t WS_TOKINFO = 9 * MiB;
constexpr size_t WS_RSTD1 = 10 * MiB;
constexpr size_t WS_SSPART = 11 * MiB;
constexpr size_t WS_RT = 13 * MiB;
constexpr size_t WS_WGU = 16 * MiB;
constexpr size_t WS_WD = 80 * MiB;
constexpr size_t WS_HB = 112 * MiB;
constexpr size_t WS_YS = 144 * MiB;
constexpr size_t WS_EARLY = 416 * MiB;
constexpr size_t WS_XB = WS_EARLY;
constexpr size_t WS_WIN = WS_EARLY + 64 * MiB;
constexpr size_t WS_WOUT = WS_EARLY + 70 * MiB;
constexpr size_t WS_UV = WS_EARLY + 72 * MiB;
constexpr size_t WS_Q = WS_EARLY + 136 * MiB;
constexpr size_t WS_K = WS_EARLY + 168 * MiB;
constexpr size_t WS_VT = WS_EARLY + 200 * MiB;
constexpr size_t WS_Y = WS_EARLY + 232 * MiB;
constexpr size_t WS_ACT = WS_EARLY;
constexpr size_t WS_END = WS_EARLY + 296 * MiB;
constexpr float WSCALE = 32.0f, WSCALE_INV = 1.0f / 32.0f;
constexpr int CW_CNT = 64;
constexpr int CW_BAR = 4096;

constexpr int RING_BYTES = 131072;
constexpr int LDSCTL_OFF = RING_BYTES, MISC_OFF = LDSCTL_OFF + 320, TAB_OFF = LDSCTL_OFF + 1024;
constexpr int LDS_BYTES = 147456;

__device__ __forceinline__ unsigned cvt_pk_bf16(float lo, float hi) { unsigned r; asm volatile("v_cvt_pk_bf16_f32 %0, %1, %2" : "=v"(r) : "v"(lo), "v"(hi)); return r; }
__device__ __forceinline__ unsigned pk4_fp8(float a, float b, float c, float d) { unsigned w = 0u; w = (unsigned)__builtin_amdgcn_cvt_pk_fp8_f32(a, b, (int)w, false); w = (unsigned)__builtin_amdgcn_cvt_pk_fp8_f32(c, d, (int)w, true); return w; }
__device__ __forceinline__ float bf2f(unsigned short h) { return __uint_as_float((unsigned)h << 16); }
__device__ __forceinline__ float bflo(unsigned w) { return __uint_as_float(w << 16); }
__device__ __forceinline__ float bfhi(unsigned w) { return __uint_as_float(w & 0xffff0000u); }
__device__ __forceinline__ int lane_id() { return (int)__builtin_amdgcn_mbcnt_hi(~0u, __builtin_amdgcn_mbcnt_lo(~0u, 0u)); }
__device__ __forceinline__ int lane_id_fresh() { int l; asm volatile("v_mbcnt_lo_u32_b32 %0, -1, 0\n\tv_mbcnt_hi_u32_b32 %0, -1, %0" : "=v"(l)); return l; }
__device__ __forceinline__ float wave_sum(float v) {
#pragma unroll
    for (int o = 1; o < 64; o <<= 1) v += __shfl_xor(v, o);
    return v;
}
__device__ __forceinline__ float gelu_tanh_f(float x) {
    const float u = 0.7978845608028654f * (x + 0.044715f * x * x * x);
    return x * __builtin_amdgcn_rcpf(1.0f + __builtin_amdgcn_exp2f(-2.0f * LOG2E * u));
}

constexpr int BM = 256, BK = 64, HALF = 128, HTB = HALF * BK * 2;
__device__ __forceinline__ int lds_byte(int r, int c) { const int st = (r >> 4) * 2 + (c >> 5), rr = r & 15, cc = c & 31, ob = rr * 64 + cc * 2; return st * 1024 + (ob ^ (((ob >> 9) & 1) << 5)); }
__device__ __forceinline__ void stage_rc(int b, int& R, int& C) { const int st = b / 1024, sb = b % 1024, swz = sb ^ (((sb >> 9) & 1) << 5); R = (st >> 1) * 16 + swz / 64; C = (st & 1) * 32 + (swz % 64) / 2; }
__device__ __forceinline__ int perm32(int rho) { const int n = rho >> 4, i = rho & 15; return 8 * (i >> 2) + 4 * n + (i & 3); }

struct Unit { const char* A; const char* B; int kind, pm, pn, e, r0; };

template <class Prog>
__device__ __forceinline__ void gemm_phase(LAS unsigned char* lds, const Prog& P) {
    const int wid = P.F->wave, lane = lane_id(), tid = wid * 64 + lane, wr = wid >> 2, wc = wid & 3;
    constexpr bool F8 = Prog::FP8;
    constexpr int K = KD, ESZ = F8 ? 1 : 2, nt = F8 ? K / 128 : K / BK;
    unsigned voffB[2];
#pragma unroll
    for (int i = 0; i < 2; ++i) { int R_, C_; stage_rc(tid * 16 + i * 8192, R_, C_); const int Rb = (R_ & ~31) + perm32(R_ & 31); voffB[i] = (unsigned)(Rb * K * ESZ + C_ * 2); }
    constexpr size_t kstep = (size_t)(BK * 2);
    constexpr size_t hstep = (size_t)HALF * K * ESZ;
    const unsigned ldsw = (unsigned)wid * 1024u;
    const int aoff = lds_byte(wr * 64 + (lane & 15), F8 ? (lane >> 4) * 16 : (lane >> 4) * 8), boff = lds_byte(wc * 32 + (lane & 15), F8 ? (lane >> 4) * 16 : (lane >> 4) * 8);
    constexpr int KOFF = F8 ? 16 : 1024;
#define MK_SA(b, h) (((b) * 2 + (h)) * HTB)
#define MK_SB(b, h) ((4 + (b) * 2 + (h)) * HTB)
#define MK_STAGE(bufoff, gbase, voff) do { _Pragma("unroll") for (int _i = 0; _i < 2; ++_i) { unsigned o_ = (voff)[_i]; asm volatile("" : "+v"(o_));     \
        __builtin_amdgcn_global_load_lds((const unsigned*)((const char*)(gbase) + o_), (LAS unsigned*)(lds + (bufoff) + ldsw + _i * 8192), 16, 0, 0); } } while (0)
#define MK_STAGE_A(bufoff, gbase, h) do { if constexpr (GA) MK_STAGE(bufoff, gbase, voC[h]); else MK_STAGE(bufoff, (gbase) + (h) * hstep, voC[0]); } while (0)
#define MK_LDA(dst, b, h) do { _Pragma("unroll") for (int m = 0; m < 4; ++m) _Pragma("unroll") for (int k = 0; k < 2; ++k) dst[m][k] = *(const LAS bf16x8*)(lds + MK_SA(b, h) + aoff + m * 2048 + k * KOFF); } while (0)
#define MK_LDB(dst, b, h) do { _Pragma("unroll") for (int n = 0; n < 2; ++n) _Pragma("unroll") for (int k = 0; k < 2; ++k) dst[n][k] = *(const LAS bf16x8*)(lds + MK_SB(b, h) + boff + n * 2048 + k * KOFF); } while (0)
#define MK_CAT8(x) __builtin_shufflevector(__builtin_bit_cast(i32x4, (x)[0]), __builtin_bit_cast(i32x4, (x)[1]), 0, 1, 2, 3, 4, 5, 6, 7)
#define MK_MMA(ai, bj, At, Bt) do { __builtin_amdgcn_s_setprio(1); \
        if constexpr (F8) { _Pragma("unroll") for (int m = 0; m < 4; ++m) _Pragma("unroll") for (int n = 0; n < 2; ++n) \
            acc[ai][bj][m][n] = __builtin_amdgcn_mfma_scale_f32_16x16x128_f8f6f4(MK_CAT8(Bt[n]), MK_CAT8(At[m]), acc[ai][bj][m][n], 0, 0, 0, 0, 0, 0); } \
        else { _Pragma("unroll") for (int m = 0; m < 4; ++m) _Pragma("unroll") for (int n = 0; n < 2; ++n) _Pragma("unroll") for (int k = 0; k < 2; ++k) \
            acc[ai][bj][m][n] = __builtin_amdgcn_mfma_f32_16x16x32_bf16(Bt[n][k], At[m][k], acc[ai][bj][m][n], 0, 0, 0); } \
        __builtin_amdgcn_s_setprio(0); } while (0)
#define MK_WAIT_V(n) asm volatile("s_waitcnt vmcnt(" #n ")" ::: "memory")
#define MK_WAIT_L(n) asm volatile("s_waitcnt lgkmcnt(" #n ")" ::: "memory")
#define MK_BAR __builtin_amdgcn_s_barrier()
#define MK_SCHED __builtin_amdgcn_sched_barrier(0)
    Unit cur, nxt; int ui = 0;
    if (!P.next(0, cur)) return;
    constexpr bool GA = Prog::GATHER;
    unsigned voC[2][2];
    if constexpr (GA) P.aoffs(cur, wid, voC);
    else {
#pragma unroll
        for (int i = 0; i < 2; ++i) { int R_, C_; stage_rc(tid * 16 + i * 8192, R_, C_); voC[0][i] = (unsigned)(R_ * K * ESZ + C_ * 2); voC[1][i] = 0u; }
    }
    f32x4 acc[2][2][4][2];
#pragma unroll
    for (int a = 0; a < 2; ++a)
#pragma unroll
        for (int b = 0; b < 2; ++b)
#pragma unroll
            for (int m = 0; m < 4; ++m)
#pragma unroll
                for (int n = 0; n < 2; ++n) acc[a][b][m][n] = (f32x4){0.f, 0.f, 0.f, 0.f};
    bf16x8 At[4][2], B0[2][2], B1[2][2];
    const char* cA = cur.A; const char* cB = cur.B;
    MK_STAGE(MK_SB(0, 0), cB, voffB); MK_STAGE(MK_SB(0, 1), cB + hstep, voffB); MK_STAGE_A(MK_SA(0, 0), cA, 0); MK_STAGE_A(MK_SA(0, 1), cA, 1);
    if (wr == 1) MK_BAR;
    MK_WAIT_V(2); MK_BAR;
    MK_STAGE(MK_SB(1, 0), cB + kstep, voffB); MK_STAGE_A(MK_SA(1, 0), cA + kstep, 0); MK_STAGE(MK_SB(1, 1), cB + hstep + kstep, voffB);
    MK_WAIT_V(6); MK_BAR;
    for (;;) {
        const bool has_next = P.next(ui + 1, nxt);
        if (!has_next) nxt = cur;
        const char* nA = nxt.A; const char* nB = nxt.B;
#pragma unroll 1
        for (int t = 0; t < nt; t += 2) {
            const bool last = (t == nt - 2);
            const char* a1 = cA + (size_t)(t + 1) * kstep;
            const char* a2 = last ? nA : cA + (size_t)(t + 2) * kstep; const char* b2 = last ? nB : cB + (size_t)(t + 2) * kstep;
            const char* a3 = a2 + kstep; const char* b3 = b2 + kstep;
            MK_LDB(B0, 0, 0); MK_LDB(B1, 0, 1); MK_SCHED; MK_LDA(At, 0, 0); MK_STAGE_A(MK_SA(1, 1), a1, 1);
            if constexpr (GA) { if (last && has_next) P.aoffs(nxt, wid, voC); }
            MK_WAIT_V(8); MK_WAIT_L(0); MK_BAR; MK_MMA(0, 0, At, B0); MK_MMA(0, 1, At, B1); MK_BAR; MK_SCHED;
            MK_LDA(At, 0, 1); MK_STAGE(MK_SB(0, 0), b2, voffB); MK_STAGE(MK_SB(0, 1), b2 + hstep, voffB); MK_STAGE_A(MK_SA(0, 0), a2, 0);
            MK_WAIT_V(8); MK_WAIT_L(0); MK_BAR; MK_MMA(1, 0, At, B0); MK_MMA(1, 1, At, B1); MK_BAR; MK_SCHED;
            MK_LDB(B0, 1, 0); MK_LDB(B1, 1, 1); MK_SCHED; MK_LDA(At, 1, 0); MK_STAGE_A(MK_SA(0, 1), a2, 1);
            MK_WAIT_V(8); MK_WAIT_L(0); MK_BAR; MK_MMA(0, 0, At, B0); MK_MMA(0, 1, At, B1); MK_BAR; MK_SCHED;
            MK_LDA(At, 1, 1); MK_STAGE(MK_SB(1, 0), b3, voffB); MK_STAGE(MK_SB(1, 1), b3 + hstep, voffB); MK_STAGE_A(MK_SA(1, 0), a3, 0);
            MK_WAIT_V(8); MK_WAIT_L(0); MK_BAR; MK_MMA(1, 0, At, B0); MK_MMA(1, 1, At, B1); MK_BAR; MK_SCHED;
        }
        if (wr == 0) MK_BAR;
        { const int l_ = lane_id_fresh(); P.epi(acc, cur, wr, wc, l_ & 15, l_ >> 4); }
#ifdef MK_EPI2
        if (Prog::ID == MK_EPI2) { const int l_ = lane_id_fresh(); P.epi(acc, cur, wr, wc, l_ & 15, l_ >> 4); }
#endif
        if (!has_next) break;
#pragma unroll
        for (int a = 0; a < 2; ++a)
#pragma unroll
            for (int b = 0; b < 2; ++b)
#pragma unroll
                for (int m = 0; m < 4; ++m)
#pragma unroll
                    for (int n = 0; n < 2; ++n) acc[a][b][m][n] = (f32x4){0.f, 0.f, 0.f, 0.f};
        cur = nxt; cA = nA; cB = nB; ++ui;
        if (wr == 1) MK_BAR;
    }
    MK_WAIT_V(0);
    MK_BAR;
#undef MK_SA
#undef MK_SB
#undef MK_STAGE
#undef MK_STAGE_A
#undef MK_LDA
#undef MK_LDB
#undef MK_MMA
#undef MK_CAT8
}
typedef f32x4 Acc[2][2][4][2];

#define XB_TMO      128
#define XB_XCNT(j)  (256  + 64 * (j))
#define XB_XSUB(j)  (1280 + 64 * (j))
#define XB_XGEN(j)  (2304 + 64 * (j))
#define XB_TOP      3328
#define XB_TOPGEN   3392
#define XCD_BAR_WORDS 3456
#define XB_SPIN_CAP (1u << 18)
__device__ __forceinline__ unsigned xb_ld(unsigned* p)              { return __hip_atomic_load(p, __ATOMIC_RELAXED, __HIP_MEMORY_SCOPE_AGENT); }
__device__ __forceinline__ unsigned xb_add(unsigned* p, unsigned v) { return __hip_atomic_fetch_add(p, v, __ATOMIC_RELAXED, __HIP_MEMORY_SCOPE_AGENT); }
__device__ __forceinline__ unsigned xb_xcc_id() { return (unsigned)__builtin_amdgcn_s_getreg((3 << 11) | 20) & 0xFu; }
#define XB_SPIN(cond, bar) do { unsigned _sp = 0; while (cond) { __builtin_amdgcn_s_sleep(1); \
    if ((++_sp & 255u) == 0u) { if (xb_ld(&(bar)[XB_TMO])) break; if (_sp > XB_SPIN_CAP) { atomicAdd(&(bar)[XB_TMO], 1u); break; } } } } while (0)
struct XcdBarrier { unsigned* bar; unsigned x; volatile LAS unsigned* st; };
__device__ __forceinline__ XcdBarrier xcd_barrier_post(unsigned* bar, volatile LAS unsigned* st) {
    XcdBarrier b; b.bar = bar; b.x = xb_xcc_id(); b.st = st;
    if (threadIdx.x == 0) (void)xb_add(&bar[XB_XCNT(b.x)], 1u);
    return b;
}
__device__ __forceinline__ void xcd_barrier_complete(unsigned* bar, unsigned x, unsigned& nloc, unsigned& nx) {
    const unsigned G = gridDim.x * gridDim.y * gridDim.z;
    unsigned sum, cnt, mine, sp = 0u;
    for (;;) {
        sum = 0u; cnt = 0u; mine = 0u;
#pragma unroll
        for (unsigned j = 0; j < 16; ++j) { const unsigned c = xb_ld(&bar[XB_XCNT(j)]); sum += c; cnt += (c > 0u) ? 1u : 0u; mine = (j == x) ? c : mine; }
        if (sum == G) break;
        __builtin_amdgcn_s_sleep(1);
        if ((++sp & 255u) == 0u) { if (xb_ld(&bar[XB_TMO])) break; if (sp > XB_SPIN_CAP) { atomicAdd(&bar[XB_TMO], 1u); break; } }
    }
    nloc = mine > 0u ? mine : 1u; nx = cnt > 0u ? cnt : 1u;
}
__device__ __forceinline__ void xcd_barrier(const XcdBarrier& b, int wave) {
    asm volatile("s_waitcnt vmcnt(0)" ::: "memory");
    __syncthreads();
    if (wave == 0 && lane_id() == 0) {
        unsigned* bar = b.bar;
        __builtin_amdgcn_s_waitcnt(0);
        unsigned nloc = b.st[0], nx = b.st[1];
        if (nloc == 0u) { xcd_barrier_complete(bar, b.x, nloc, nx); b.st[0] = nloc; b.st[1] = nx; }
        const unsigned old = xb_add(&bar[XB_XSUB(b.x)], 1u);
        const unsigned gen = old / nloc;
        if (old + 1u == (gen + 1u) * nloc) {
            __builtin_amdgcn_fence(__ATOMIC_RELEASE, "agent");
            asm volatile("s_waitcnt vmcnt(0)" ::: "memory");
            const unsigned og = xb_add(&bar[XB_TOP], 1u);
            const unsigned tg = og / nx;
            if (og + 1u == (tg + 1u) * nx) xb_add(&bar[XB_TOPGEN], 1u);
            else XB_SPIN(xb_ld(&bar[XB_TOPGEN]) == tg, bar);
            __builtin_amdgcn_fence(__ATOMIC_ACQUIRE, "agent");
            xb_add(&bar[XB_XGEN(b.x)], 1u);
            asm volatile("s_waitcnt vmcnt(0)" ::: "memory");
        } else {
            XB_SPIN(xb_ld(&bar[XB_XGEN(b.x)]) == gen, bar);
            __builtin_amdgcn_fence(__ATOMIC_ACQUIRE, "agent");
            asm volatile("s_waitcnt vmcnt(0)" ::: "memory");
        }
    }
    __syncthreads();
}

struct Args {
    const float* in[18]; float* out; unsigned char* ws; int ph_lo, ph_hi;
};
#define CAS __attribute__((address_space(4)))
struct Frame {
    LAS unsigned char* lds; int tid, lane, wave, vcu, G;
    const CAS Args* ka;
    __device__ __forceinline__ const float* inp(int k) const { return ka->in[k]; }
    __device__ __forceinline__ unsigned char* ws() const { return ka->ws; }
    __device__ __forceinline__ float* out() const { return ka->out; }
    __device__ __forceinline__ const float* x() const { return inp(0); }
    __device__ __forceinline__ const float* norm1_w() const { return inp(1); }
    __device__ __forceinline__ const float* w_in() const { return inp(2); }
    __device__ __forceinline__ const float* sgu_norm_w() const { return inp(3); }
    __device__ __forceinline__ const float* sgu_w() const { return inp(4); }
    __device__ __forceinline__ const float* sgu_b() const { return inp(5); }
    __device__ __forceinline__ const float* q_norm_w() const { return inp(6); }
    __device__ __forceinline__ const float* k_norm_w() const { return inp(7); }
    __device__ __forceinline__ const float* out_norm_a_w() const { return inp(8); }
    __device__ __forceinline__ const float* out_norm_b_w() const { return inp(9); }
    __device__ __forceinline__ const float* w_out() const { return inp(10); }
    __device__ __forceinline__ const float* norm2_w() const { return inp(11); }
    __device__ __forceinline__ const float* router_w() const { return inp(12); }
    __device__ __forceinline__ const float* router_b() const { return inp(13); }
    __device__ __forceinline__ const float* w_gate_up() const { return inp(14); }
    __device__ __forceinline__ const float* b_gate_up() const { return inp(15); }
    __device__ __forceinline__ const float* w_down() const { return inp(16); }
    __device__ __forceinline__ const float* b_down() const { return inp(17); }
    __device__ __forceinline__ bf16_t* XB() const { return (bf16_t*)(ws() + WS_XB); }
    __device__ __forceinline__ bf16_t* WIN() const { return (bf16_t*)(ws() + WS_WIN); }
    __device__ __forceinline__ bf16_t* WOUT() const { return (bf16_t*)(ws() + WS_WOUT); }
    __device__ __forceinline__ bf16_t* UV() const { return (bf16_t*)(ws() + WS_UV); }
    __device__ __forceinline__ bf16_t* Q() const { return (bf16_t*)(ws() + WS_Q); }
    __device__ __forceinline__ bf16_t* K() const { return (bf16_t*)(ws() + WS_K); }
    __device__ __forceinline__ bf16_t* VT() const { return (bf16_t*)(ws() + WS_VT); }
    __device__ __forceinline__ bf16_t* Y() const { return (bf16_t*)(ws() + WS_Y); }
    __device__ __forceinline__ bf16_t* YS() const { return (bf16_t*)(ws() + WS_YS); }
    __device__ __forceinline__ bf16_t* RT() const { return (bf16_t*)(ws() + WS_RT); }
    __device__ __forceinline__ unsigned char* HB() const { return ws() + WS_HB; }
    __device__ __forceinline__ unsigned char* WGU() const { return ws() + WS_WGU; }
    __device__ __forceinline__ unsigned char* WD() const { return ws() + WS_WD; }
    __device__ __forceinline__ unsigned char* ACT() const { return ws() + WS_ACT; }
    __device__ __forceinline__ float* RSTD1() const { return (float*)(ws() + WS_RSTD1); }
    __device__ __forceinline__ float* SSPART() const { return (float*)(ws() + WS_SSPART); }
    __device__ __forceinline__ float* LISTGATE() const { return (float*)(ws() + WS_LISTGATE); }
    __device__ __forceinline__ int* LISTTOK() const { return (int*)(ws() + WS_LISTTOK); }
    __device__ __forceinline__ int* TOKINFO() const { return (int*)(ws() + WS_TOKINFO); }
    __device__ __forceinline__ unsigned* ctl() const { return (unsigned*)(ws() + WS_CTL); }
};

__device__ __forceinline__ void p0_transpose_item(const float* W, int K, int N, bf16_t* WT, int k0, int n0, int drow0, const float* kscale, LAS float* scr, int lane) {
#pragma unroll 8
    for (int i = 0; i < 32; ++i) { const int kk = 2 * i + (lane >> 5); float v = W[(size_t)(k0 + kk) * N + n0 + (lane & 31)]; if (kscale) v *= kscale[k0 + kk]; scr[kk * 33 + (lane & 31)] = v; }
    asm volatile("s_waitcnt lgkmcnt(0)" ::: "memory");
    const int c = lane & 7;
#pragma unroll
    for (int j = 0; j < 4; ++j) { const int n = (lane >> 3) + 8 * j; const LAS float* s = scr + (8 * c) * 33 + n;
        u32x4 o; o.x = cvt_pk_bf16(s[0 * 33], s[1 * 33]); o.y = cvt_pk_bf16(s[2 * 33], s[3 * 33]); o.z = cvt_pk_bf16(s[4 * 33], s[5 * 33]); o.w = cvt_pk_bf16(s[6 * 33], s[7 * 33]);
        *(u32x4*)(WT + (size_t)(drow0 + n) * K + k0 + 8 * c) = o; }
    asm volatile("s_waitcnt lgkmcnt(0)" ::: "memory");
}
__device__ __forceinline__ void p0_transpose_item_f8(const float* W, int K, int N, unsigned char* WT, int k0, int n0, LAS float* scr, int lane) {
#pragma unroll 8
    for (int i = 0; i < 32; ++i) { const int kk = 2 * i + (lane >> 5); scr[kk * 33 + (lane & 31)] = W[(size_t)(k0 + kk) * N + n0 + (lane & 31)] * WSCALE; }
    asm volatile("s_waitcnt lgkmcnt(0)" ::: "memory");
    const int c = lane & 7;
#pragma unroll
    for (int j = 0; j < 4; ++j) { const int n = (lane >> 3) + 8 * j; const LAS float* s = scr + (8 * c) * 33 + n;
        u32x2 o; o.x = pk4_fp8(s[0 * 33], s[1 * 33], s[2 * 33], s[3 * 33]); o.y = pk4_fp8(s[4 * 33], s[5 * 33], s[6 * 33], s[7 * 33]);
        *(u32x2*)(WT + (size_t)(n0 + n) * K + k0 + 8 * c) = o; }
    asm volatile("s_waitcnt lgkmcnt(0)" ::: "memory");
}
__device__ __forceinline__ int win_drow(int n0) {
    if (n0 < 1024 || n0 >= 2048) return n0;
    const int rel = n0 - 1024, isk = rel >> 9, head = (rel & 511) >> 6, dh = (rel & 63) >> 5;
    return 256 * (4 + 2 * isk + (head >> 2)) + 128 * dh + 32 * (head & 3);
}
__device__ __forceinline__ void p0_prologue(Frame& F) {
    LAS float* scr = (LAS float*)(F.lds + F.wave * 16384);
    const int gw = F.vcu * NWAVES + F.wave, NGW = F.G * NWAVES, lane = F.lane;
    for (int m = gw; m < NTOK; m += NGW) {
        const f32x4* xr = (const f32x4*)(F.x() + (size_t)m * DM) + lane; f32x4 v[4]; float s = 0.f;
#pragma unroll
        for (int j = 0; j < 4; ++j) { v[j] = xr[64 * j]; s += (v[j].x * v[j].x + v[j].y * v[j].y) + (v[j].z * v[j].z + v[j].w * v[j].w); }
        const float tot = wave_sum(s);
        if (lane == 0) F.RSTD1()[m] = 1.0f / sqrtf(tot * (1.0f / DM) + EPS);
        u32x2* o8 = (u32x2*)(F.XB() + (size_t)m * DM) + lane;
#pragma unroll
        for (int j = 0; j < 4; ++j) { u32x2 w; w.x = cvt_pk_bf16(v[j].x, v[j].y); w.y = cvt_pk_bf16(v[j].z, v[j].w); o8[64 * j] = w; }
    }
    constexpr int I_IN = 16 * 80, I_OUT = 16 * 32, I_GU = 16 * 64, I_D = 16 * 32;
    constexpr int NITEMS = I_IN + I_OUT + NE * I_GU + NE * I_D;
    for (int it = gw; it < NITEMS; it += NGW) {
        int r = it;
        if (r < I_IN) { const int kb = r / 80, nb = r % 80; p0_transpose_item(F.w_in(), KD, 2560, F.WIN(), 64 * kb, 32 * nb, win_drow(32 * nb), F.norm1_w(), scr, lane); continue; } r -= I_IN;
        if (r < I_OUT) { const int kb = r / 32, nb = r % 32; p0_transpose_item(F.w_out(), KD, 1024, F.WOUT(), 64 * kb, 32 * nb, 32 * nb, nullptr, scr, lane); continue; } r -= I_OUT;
        if (r < NE * I_GU) { const int e = r / I_GU, q = r % I_GU, kb = q / 64, nb = q % 64;
            p0_transpose_item_f8(F.w_gate_up() + (size_t)e * KD * 2048, KD, 2048, F.WGU() + (size_t)e * 2048 * KD, 64 * kb, 32 * nb, scr, lane); continue; } r -= NE * I_GU;
        { const int e = r / I_D, q = r % I_D, kb = q / 32, nb = q % 32;
            p0_transpose_item_f8(F.w_down() + (size_t)e * KD * 1024, KD, 1024, F.WD() + (size_t)e * 1024 * KD, 64 * kb, 32 * nb, scr, lane); }
    }
    for (int idx = gw * 64 + lane; idx < NE * KD; idx += NGW * 64) {
        const int e = idx >> 10, k = idx & 1023; const float w = F.router_w()[(size_t)k * NE + e];
        const unsigned hi = cvt_pk_bf16(w, 0.f) & 0xffffu; const float rem = w - __uint_as_float(hi << 16);
        F.RT()[idx] = (bf16_t)hi; F.RT()[NE * KD + idx] = (bf16_t)(cvt_pk_bf16(rem, 0.f) & 0xffffu);
    }
}

struct ProgIn {
    static constexpr bool GATHER = false, FP8 = false; static constexpr int ID = 1;
    const Frame* F;
    __device__ __forceinline__ bool next(int i, Unit& u) const {
        const int v = F->vcu;
        if (i < 4) { const int uu = i * 256 + v, grp = uu >> 5, w = uu & 31; u.pm = grp * 4 + (w & 3); u.pn = w >> 2; u.kind = u.pn < 4 ? 0 : 1;
            u.A = (const char*)(F->XB() + (size_t)u.pm * 256 * KD); u.B = (const char*)(F->WIN() + (size_t)u.pn * 256 * KD); u.e = 0; u.r0 = 0; return true; }
        if (i == 4) { u.kind = 2; u.pm = v & 1; u.pn = v >> 1; u.A = (const char*)(F->WIN() + (size_t)(2048 + u.pm * 256) * KD); u.B = (const char*)(F->XB() + (size_t)u.pn * 256 * KD); u.e = 0; u.r0 = 0; return true; }
        return false;
    }
    __device__ __forceinline__ void epi(const Acc& acc, const Unit& u, int wr, int wc, int fr, int fq) const {
        asm volatile("" : "+v"(fr), "+v"(fq));
        if (u.kind == 2) {
            const int tk0 = u.pn * 256 + wc * 32 + 8 * fq;
            f32x4 rs[2][2];
#pragma unroll
            for (int bj = 0; bj < 2; ++bj)
#pragma unroll
                for (int n = 0; n < 2; ++n) rs[bj][n] = *(const f32x4*)(F->RSTD1() + tk0 + bj * 128 + 4 * n);
#pragma unroll
            for (int ai = 0; ai < 2; ++ai)
#pragma unroll
                for (int m = 0; m < 4; ++m) { const int cp = u.pm * 256 + ai * 128 + wr * 64 + m * 16 + fr; bf16_t* rowp = F->VT() + (size_t)cp * NTOK + tk0;
#pragma unroll
                    for (int bj = 0; bj < 2; ++bj) { const f32x4 v0 = acc[ai][bj][m][0] * rs[bj][0], v1 = acc[ai][bj][m][1] * rs[bj][1];
                        u32x4 w; w.x = cvt_pk_bf16(v0[0], v0[1]); w.y = cvt_pk_bf16(v0[2], v0[3]); w.z = cvt_pk_bf16(v1[0], v1[1]); w.w = cvt_pk_bf16(v1[2], v1[3]);
                        *(u32x4*)(rowp + bj * 128) = w; } }
            return;
        }
        float rsr[2][4];
#pragma unroll
        for (int ai = 0; ai < 2; ++ai)
#pragma unroll
            for (int m = 0; m < 4; ++m) rsr[ai][m] = F->RSTD1()[u.pm * 256 + ai * 128 + wr * 64 + m * 16 + fr];
        if (u.kind == 0) {
#pragma unroll
            for (int ai = 0; ai < 2; ++ai)
#pragma unroll
                for (int m = 0; m < 4; ++m) { const int r = u.pm * 256 + ai * 128 + wr * 64 + m * 16 + fr; bf16_t* rowp = F->UV() + (size_t)r * 1024 + u.pn * 256 + wc * 32 + 8 * fq; const float rs = rsr[ai][m];
#pragma unroll
                    for (int bj = 0; bj < 2; ++bj) { f32x4 v0 = acc[ai][bj][m][0] * rs, v1 = acc[ai][bj][m][1] * rs;
#pragma unroll
                        for (int j = 0; j < 4; ++j) { v0[j] = gelu_tanh_f(v0[j]); v1[j] = gelu_tanh_f(v1[j]); }
                        u32x4 w; w.x = cvt_pk_bf16(v0[0], v0[1]); w.y = cvt_pk_bf16(v0[2], v0[3]); w.z = cvt_pk_bf16(v1[0], v1[1]); w.w = cvt_pk_bf16(v1[2], v1[3]);
                        *(u32x4*)(rowp + bj * 128) = w; } }
            return;
        }
        {
            const int isk = (u.pn - 4) >> 1, head = 4 * (u.pn & 1) + wc; const float* nw = isk ? F->k_norm_w() : F->q_norm_w(); bf16_t* dst = isk ? F->K() : F->Q();
            const float osc = isk ? 1.0f : QSCALE;
            f32x4 nwv[2][2];
#pragma unroll
            for (int bj = 0; bj < 2; ++bj)
#pragma unroll
                for (int n = 0; n < 2; ++n) nwv[bj][n] = *(const f32x4*)(nw + 32 * bj + 8 * fq + 4 * n);
#pragma unroll
            for (int ai = 0; ai < 2; ++ai)
#pragma unroll
                for (int m = 0; m < 4; ++m) { const int r = u.pm * 256 + ai * 128 + wr * 64 + m * 16 + fr; const float rs = rsr[ai][m];
                    f32x4 t[2][2]; float ss = 0.f;
#pragma unroll
                    for (int bj = 0; bj < 2; ++bj)
#pragma unroll
                        for (int n = 0; n < 2; ++n) { t[bj][n] = acc[ai][bj][m][n] * rs; ss += (t[bj][n][0] * t[bj][n][0] + t[bj][n][1] * t[bj][n][1]) + (t[bj][n][2] * t[bj][n][2] + t[bj][n][3] * t[bj][n][3]); }
                    ss += __shfl_xor(ss, 16); ss += __shfl_xor(ss, 32);
                    const float rn = osc / sqrtf(ss * (1.0f / 64.0f) + EPS);
                    bf16_t* rowp = dst + (size_t)r * 512 + head * 64 + 8 * fq;
#pragma unroll
                    for (int bj = 0; bj < 2; ++bj) { const f32x4 v0 = t[bj][0] * nwv[bj][0] * rn, v1 = t[bj][1] * nwv[bj][1] * rn;
                        u32x4 w; w.x = cvt_pk_bf16(v0[0], v0[1]); w.y = cvt_pk_bf16(v0[2], v0[3]); w.z = cvt_pk_bf16(v1[0], v1[1]); w.w = cvt_pk_bf16(v1[2], v1[3]);
                        *(u32x4*)(rowp + bj * 32) = w; } }
        }
    }
};

constexpr int VN_PITCH = 136, YT_PITCH = 132, YT_OFF = 36864;
__device__ __forceinline__ void gmlp_unit(const Frame& F, int chunk, int g) {
    const int tid = F.tid, lane = F.lane, wid = F.wave;
    LAS bf16_t* vn = (LAS bf16_t*)F.lds; LAS float* yt = (LAS float*)(F.lds + YT_OFF);
    const size_t tok0 = (size_t)chunk * 128;
    {
        const int row = tid >> 2, qd = tid & 3; const bf16_t* src = F.UV() + (tok0 + row) * 1024 + 512 + g * 128 + qd * 32;
        u32x4 w[4]; float v[32]; float ss = 0.f;
#pragma unroll
        for (int i = 0; i < 4; ++i) w[i] = *(const u32x4*)(src + 8 * i);
#pragma unroll
        for (int i = 0; i < 4; ++i)
#pragma unroll
            for (int j = 0; j < 4; ++j) { v[8 * i + 2 * j] = bflo(w[i][j]); v[8 * i + 2 * j + 1] = bfhi(w[i][j]); }
#pragma unroll
        for (int i = 0; i < 32; ++i) ss += v[i] * v[i];
        ss += __shfl_xor(ss, 1); ss += __shfl_xor(ss, 2);
        const float rs = 1.0f / sqrtf(ss * (1.0f / 128.0f) + EPS);
        const float* nw = F.sgu_norm_w() + g * 128 + qd * 32;
#pragma unroll
        for (int i = 0; i < 4; ++i) { const f32x4 n0 = *(const f32x4*)(nw + 8 * i), n1 = *(const f32x4*)(nw + 8 * i + 4);
            u32x4 o; o.x = cvt_pk_bf16(v[8 * i] * rs * n0[0], v[8 * i + 1] * rs * n0[1]); o.y = cvt_pk_bf16(v[8 * i + 2] * rs * n0[2], v[8 * i + 3] * rs * n0[3]);
            o.z = cvt_pk_bf16(v[8 * i + 4] * rs * n1[0], v[8 * i + 5] * rs * n1[1]); o.w = cvt_pk_bf16(v[8 * i + 6] * rs * n1[2], v[8 * i + 7] * rs * n1[3]);
            *(LAS u32x4*)(vn + row * VN_PITCH + qd * 32 + 8 * i) = o; }
    }
    __syncthreads();
    {
        const int tb = wid >> 1, cb0 = 2 * (wid & 1), r32 = lane & 31, hh = lane >> 5;
        f32x16 a0 = {}, a1 = {};
        const int t = 32 * tb + r32; const float* wrow = F.sgu_w() + ((size_t)g * 128 + t) * 128;
        for (int ks = 0; ks < 2 * (tb + 1); ++ks) {
            const int s0 = 16 * ks + 8 * hh;
            const f32x4 w0 = *(const f32x4*)(wrow + s0), w1 = *(const f32x4*)(wrow + s0 + 4);
            float wv[8] = {w0[0], w0[1], w0[2], w0[3], w1[0], w1[1], w1[2], w1[3]};
#pragma unroll
            for (int j = 0; j < 8; ++j) if (s0 + j > t) wv[j] = 0.f;
            u32x4 aw; aw.x = cvt_pk_bf16(wv[0], wv[1]); aw.y = cvt_pk_bf16(wv[2], wv[3]); aw.z = cvt_pk_bf16(wv[4], wv[5]); aw.w = cvt_pk_bf16(wv[6], wv[7]);
            const bf16x8 af = __builtin_bit_cast(bf16x8, aw);
            bf16x8 b0, b1;
#pragma unroll
            for (int j = 0; j < 8; ++j) { b0[j] = (short)vn[(s0 + j) * VN_PITCH + 32 * cb0 + r32]; b1[j] = (short)vn[(s0 + j) * VN_PITCH + 32 * (cb0 + 1) + r32]; }
            a0 = __builtin_amdgcn_mfma_f32_32x32x16_bf16(af, b0, a0, 0, 0, 0);
            a1 = __builtin_amdgcn_mfma_f32_32x32x16_bf16(af, b1, a1, 0, 0, 0);
        }
#pragma unroll
        for (int reg = 0; reg < 16; ++reg) {
            const int tt = 32 * tb + (reg & 3) + 8 * (reg >> 2) + 4 * hh; const float bb = F.sgu_b()[g * 128 + tt];
            const bf16_t* up = F.UV() + (tok0 + tt) * 1024 + g * 128;
            const int c0 = 32 * cb0 + r32, c1 = c0 + 32;
            yt[tt * YT_PITCH + c0] = bf2f(up[c0]) * (a0[reg] + bb);
            yt[tt * YT_PITCH + c1] = bf2f(up[c1]) * (a1[reg] + bb);
        }
    }
    __syncthreads();
    {
        const int row = tid >> 2, qd = tid & 3; const LAS float* src = yt + row * YT_PITCH + qd * 32; f32x4 v[8]; float ss = 0.f;
#pragma unroll
        for (int i = 0; i < 8; ++i) { v[i] = *(const LAS f32x4*)(src + 4 * i); ss += (v[i][0] * v[i][0] + v[i][1] * v[i][1]) + (v[i][2] * v[i][2] + v[i][3] * v[i][3]); }
        ss += __shfl_xor(ss, 1); ss += __shfl_xor(ss, 2);
        const float rs = 1.0f / sqrtf(ss * (1.0f / 128.0f) + EPS);
        const float* nw = F.out_norm_a_w() + g * 128 + qd * 32; bf16_t* dst = F.Y() + (tok0 + row) * 1024 + g * 128 + qd * 32;
#pragma unroll
        for (int i = 0; i < 4; ++i) { const f32x4 n0 = *(const f32x4*)(nw + 8 * i), n1 = *(const f32x4*)(nw + 8 * i + 4); const f32x4 x0 = v[2 * i] * n0 * rs, x1 = v[2 * i + 1] * n1 * rs;
            u32x4 o; o.x = cvt_pk_bf16(x0[0], x0[1]); o.y = cvt_pk_bf16(x0[2], x0[3]); o.z = cvt_pk_bf16(x1[0], x1[1]); o.w = cvt_pk_bf16(x1[2], x1[3]);
            *(u32x4*)(dst + 8 * i) = o; }
    }
    __syncthreads();
}

__device__ __forceinline__ void attn_wave_unit(const Frame& F, int b, int h, int qblk) {
    const int lane = F.lane, r32 = lane & 31, hi = lane >> 5;
    const size_t tokq = (size_t)b * SEQ + 32 * qblk + r32;
    bf16x8 qr[4];
#pragma unroll
    for (int d0 = 0; d0 < 4; ++d0) qr[d0] = *(const bf16x8*)(F.Q() + tokq * 512 + h * 64 + 16 * d0 + 8 * hi);
    f32x16 o0 = {}, o1 = {};
    float carry = 0.f;
    const bf16_t* Kb = F.K() + ((size_t)b * SEQ + r32) * 512 + h * 64 + 8 * hi;
    const bf16_t* V0 = F.VT() + (size_t)(h * 64 + r32) * NTOK + (size_t)b * SEQ + 4 * hi;
    bf16x8 kf[4]; s16x4 vf[2][2][2];
    auto load_tile = [&](int j, bf16x8 (&kk)[4], s16x4 (&vv)[2][2][2]) {
#pragma unroll
        for (int d0 = 0; d0 < 4; ++d0) kk[d0] = *(const bf16x8*)(Kb + (size_t)(32 * j) * 512 + 16 * d0);
#pragma unroll
        for (int dh = 0; dh < 2; ++dh)
#pragma unroll
            for (int ks = 0; ks < 2; ++ks) { const bf16_t* p = V0 + (size_t)dh * 32 * NTOK + 32 * j + 16 * ks; vv[dh][ks][0] = *(const s16x4*)p; vv[dh][ks][1] = *(const s16x4*)(p + 8); }
    };
    load_tile(qblk, kf, vf);
    for (int j = qblk; j >= 0; --j) {
        bf16x8 kn[4]; s16x4 vn2[2][2][2];
        if (j > 0) load_tile(j - 1, kn, vn2);
        else {
#pragma unroll
            for (int d0 = 0; d0 < 4; ++d0) kn[d0] = kf[d0];
#pragma unroll
            for (int dh = 0; dh < 2; ++dh)
#pragma unroll
                for (int ks = 0; ks < 2; ++ks) { vn2[dh][ks][0] = vf[dh][ks][0]; vn2[dh][ks][1] = vf[dh][ks][1]; }
        }
        f32x16 s = {};
#pragma unroll
        for (int d0 = 0; d0 < 4; ++d0) s = __builtin_amdgcn_mfma_f32_32x32x16_bf16(kf[d0], qr[d0], s, 0, 0, 0);
        float sp[16];
        const bool diag = (j == qblk);
#pragma unroll
        for (int r = 0; r < 16; ++r) {
            const int kvl = (r & 3) + 8 * (r >> 2) + 4 * hi;
            const float z = s[r];
            float v = fmaxf(z, 0.f) + __builtin_amdgcn_logf(1.0f + __builtin_amdgcn_exp2f(-fabsf(z)));
            if (diag && kvl >= r32) v = 0.f;
            sp[r] = v;
        }
        float G[4], Gp[4];
#pragma unroll
        for (int k = 0; k < 4; ++k) { G[k] = (sp[4 * k] + sp[4 * k + 1]) + (sp[4 * k + 2] + sp[4 * k + 3]); Gp[k] = __shfl_xor(G[k], 32); }
        const float T3 = G[3] + Gp[3], T2 = G[2] + Gp[2], T1 = G[1] + Gp[1], T0 = G[0] + Gp[0];
        float off[4];
        off[3] = 0.f; off[2] = T3; off[1] = T3 + T2; off[0] = T3 + T2 + T1;
        const float tile_total = off[0] + T0;
#pragma unroll
        for (int k = 0; k < 4; ++k) off[k] += carry + (hi == 0 ? Gp[k] : 0.f);
        float a[16];
#pragma unroll
        for (int k = 0; k < 4; ++k) {
            float c = off[k];
#pragma unroll
            for (int i = 3; i >= 0; --i) { const int r = 4 * k + i; c += sp[r]; float av = __builtin_amdgcn_exp2f(s[r] - c);
                if (diag && ((r & 3) + 8 * (r >> 2) + 4 * hi) >= r32) av = 0.f;
                a[r] = av; }
        }
        carry += tile_total;
        u32x4 p0, p1;
        p0.x = cvt_pk_bf16(a[0], a[1]); p0.y = cvt_pk_bf16(a[2], a[3]); p0.z = cvt_pk_bf16(a[4], a[5]); p0.w = cvt_pk_bf16(a[6], a[7]);
        p1.x = cvt_pk_bf16(a[8], a[9]); p1.y = cvt_pk_bf16(a[10], a[11]); p1.z = cvt_pk_bf16(a[12], a[13]); p1.w = cvt_pk_bf16(a[14], a[15]);
        const bf16x8 pf0 = __builtin_bit_cast(bf16x8, p0), pf1 = __builtin_bit_cast(bf16x8, p1);
#define MK_VF(dh, ks) (bf16x8){vf[dh][ks][0][0], vf[dh][ks][0][1], vf[dh][ks][0][2], vf[dh][ks][0][3], vf[dh][ks][1][0], vf[dh][ks][1][1], vf[dh][ks][1][2], vf[dh][ks][1][3]}
        o0 = __builtin_amdgcn_mfma_f32_32x32x16_bf16(MK_VF(0, 0), pf0, o0, 0, 0, 0);
        o0 = __builtin_amdgcn_mfma_f32_32x32x16_bf16(MK_VF(0, 1), pf1, o0, 0, 0, 0);
        o1 = __builtin_amdgcn_mfma_f32_32x32x16_bf16(MK_VF(1, 0), pf0, o1, 0, 0, 0);
        o1 = __builtin_amdgcn_mfma_f32_32x32x16_bf16(MK_VF(1, 1), pf1, o1, 0, 0, 0);
#undef MK_VF
        if (__all(carry > SB_THR)) break;
#pragma unroll
        for (int d0 = 0; d0 < 4; ++d0) kf[d0] = kn[d0];
#pragma unroll
        for (int dh = 0; dh < 2; ++dh)
#pragma unroll
            for (int ks = 0; ks < 2; ++ks) { vf[dh][ks][0] = vn2[dh][ks][0]; vf[dh][ks][1] = vn2[dh][ks][1]; }
    }
    float ss = 0.f;
#pragma unroll
    for (int r = 0; r < 16; ++r) ss += o0[r] * o0[r] + o1[r] * o1[r];
    ss += __shfl_xor(ss, 32);
    const float rs = 1.0f / sqrtf(ss * (1.0f / 64.0f) + EPS);
    const float* nw = F.out_norm_b_w() + h * 64 + 4 * hi; bf16_t* dst = F.Y() + tokq * 1024 + 512 + h * 64 + 4 * hi;
#pragma unroll
    for (int dh = 0; dh < 2; ++dh)
#pragma unroll
        for (int g = 0; g < 4; ++g) { const f32x4 w = *(const f32x4*)(nw + 32 * dh + 8 * g); const f32x16& o = dh ? o1 : o0;
            u32x2 pk; pk.x = cvt_pk_bf16(o[4 * g] * rs * w[0], o[4 * g + 1] * rs * w[1]); pk.y = cvt_pk_bf16(o[4 * g + 2] * rs * w[2], o[4 * g + 3] * rs * w[3]);
            *(u32x2*)(dst + 32 * dh + 8 * g) = pk; }
}
__device__ __forceinline__ void p2_mixers(Frame& F) {
    for (int i = 0; i < (MK_REP == 20 ? 8 : 4); ++i) { const int u = (i & 3) * 256 + F.vcu; gmlp_unit(F, u >> 2, u & 3); }
    const int gw = F.vcu * NWAVES + F.wave;
    for (int i = 0; i < (MK_REP == 21 ? 8 : 4); ++i) { const int u = (i & 3) * 2048 + gw; const int qblk = u & 127, bh = u >> 7; attn_wave_unit(F, bh >> 3, bh & 7, qblk); }
}

struct ProgOut {
    static constexpr bool GATHER = false, FP8 = false; static constexpr int ID = 3;
    const Frame* F;
    __device__ __forceinline__ bool next(int i, Unit& u) const {
        if (i >= 2) return false;
        const int uu = i * 256 + F->vcu, grp = uu >> 5, w = uu & 31; u.pm = grp * 8 + (w & 7); u.pn = w >> 3; u.kind = 0; u.e = 0; u.r0 = 0;
        u.A = (const char*)(F->Y() + (size_t)u.pm * 256 * KD); u.B = (const char*)(F->WOUT() + (size_t)u.pn * 256 * KD); return true;
    }
    __device__ __forceinline__ void epi(const Acc& acc, const Unit& u, int wr, int wc, int fr, int fq) const {
        asm volatile("" : "+v"(fr), "+v"(fq));
        const size_t off0 = (size_t)(u.pm * 256 + wr * 64 + fr) * DM + u.pn * 256 + wc * 32 + 8 * fq;
        const float* xb = F->x() + off0; float* ob = F->out() + off0;
        f32x4 xv[2][2][2];
#define MK_LDX(g, slot) do { const size_t go_ = (size_t)(((g) >> 2) * 128 + ((g) & 3) * 16) * DM; _Pragma("unroll") for (int bj = 0; bj < 2; ++bj) _Pragma("unroll") for (int n = 0; n < 2; ++n) xv[slot][bj][n] = *(const f32x4*)(xb + go_ + bj * 128 + 4 * n); } while (0)
        MK_LDX(0, 0);
#pragma unroll
        for (int g = 0; g < 8; ++g) { const int ai = g >> 2, m = g & 3; const size_t go = (size_t)(ai * 128 + m * 16) * DM; float ss = 0.f;
            if (g + 1 < 8) MK_LDX(g + 1, (g + 1) & 1);
#pragma unroll
            for (int bj = 0; bj < 2; ++bj)
#pragma unroll
                for (int n = 0; n < 2; ++n) { const f32x4 o = xv[g & 1][bj][n] + acc[ai][bj][m][n];
                    ss += (o[0] * o[0] + o[1] * o[1]) + (o[2] * o[2] + o[3] * o[3]); *(f32x4*)(ob + go + bj * 128 + 4 * n) = o; }
            ss += __shfl_xor(ss, 16); ss += __shfl_xor(ss, 32);
            if (fq == 0) F->SSPART()[(size_t)(u.pm * 256 + ai * 128 + wr * 64 + m * 16 + fr) * 16 + u.pn * 4 + wc] = ss; }
#undef MK_LDX
    }
};

template <bool DRY> __device__ __forceinline__ void router_wave_unit(Frame& F, int unit) {
    const int lane = F.lane, r32 = lane & 31, hh = lane >> 5; const int tok = unit * 32 + r32;
    float ssum = 0.f;
    { const f32x4* sp = (const f32x4*)(F.SSPART() + (size_t)tok * 16);
#pragma unroll
      for (int i = 0; i < 4; ++i) { const f32x4 v = sp[i]; ssum += v[0]; ssum += v[1]; ssum += v[2]; ssum += v[3]; } }
    const float rs = 1.0f / sqrtf(ssum * (1.0f / DM) + EPS);
    f32x16 acc = {};
    const float* xrow = F.out() + (size_t)tok * DM + 8 * hh; const float* w2 = F.norm2_w() + 8 * hh; unsigned char* hrow = F.HB() + (size_t)tok * DM + 8 * hh;
    const bf16_t* rth = F.RT() + (size_t)r32 * KD + 8 * hh; const bf16_t* rtl = rth + NE * KD;
#pragma unroll 4
    for (int s = 0; s < 64; ++s) {
        const f32x4 x0 = *(const f32x4*)(xrow + 16 * s), x1 = *(const f32x4*)(xrow + 16 * s + 4);
        const f32x4 g0 = *(const f32x4*)(w2 + 16 * s), g1 = *(const f32x4*)(w2 + 16 * s + 4);
        const f32x4 h0 = x0 * g0 * rs, h1 = x1 * g1 * rs;
        u32x4 hw; hw.x = cvt_pk_bf16(h0[0], h0[1]); hw.y = cvt_pk_bf16(h0[2], h0[3]); hw.z = cvt_pk_bf16(h1[0], h1[1]); hw.w = cvt_pk_bf16(h1[2], h1[3]);
        { u32x2 h8; h8.x = pk4_fp8(h0[0], h0[1], h0[2], h0[3]); h8.y = pk4_fp8(h1[0], h1[1], h1[2], h1[3]); *(u32x2*)(hrow + 16 * s) = h8; }
        u32x4 lw; lw.x = cvt_pk_bf16(h0[0] - bflo(hw.x), h0[1] - bfhi(hw.x)); lw.y = cvt_pk_bf16(h0[2] - bflo(hw.y), h0[3] - bfhi(hw.y));
        lw.z = cvt_pk_bf16(h1[0] - bflo(hw.z), h1[1] - bfhi(hw.z)); lw.w = cvt_pk_bf16(h1[2] - bflo(hw.w), h1[3] - bfhi(hw.w));
        const bf16x8 bh = __builtin_bit_cast(bf16x8, hw), bl = __builtin_bit_cast(bf16x8, lw);
        const bf16x8 ah = *(const bf16x8*)(rth + 16 * s), al = *(const bf16x8*)(rtl + 16 * s);
        acc = __builtin_amdgcn_mfma_f32_32x32x16_bf16(ah, bh, acc, 0, 0, 0);
        acc = __builtin_amdgcn_mfma_f32_32x32x16_bf16(al, bh, acc, 0, 0, 0);
        acc = __builtin_amdgcn_mfma_f32_32x32x16_bf16(ah, bl, acc, 0, 0, 0);
    }
    float lv[16];
#pragma unroll
    for (int r = 0; r < 16; ++r) lv[r] = acc[r] + F.router_b()[(r & 3) + 8 * (r >> 2) + 4 * hh];
    float cv[8]; int ce[8];
#pragma unroll
    for (int k = 0; k < 4; ++k) { float bv = -INFINITY; int be = 0;
#pragma unroll
        for (int r = 0; r < 16; ++r) { const int e = (r & 3) + 8 * (r >> 2) + 4 * hh; if (lv[r] > bv) { bv = lv[r]; be = e; } }
#pragma unroll
        for (int r = 0; r < 16; ++r) { const int e = (r & 3) + 8 * (r >> 2) + 4 * hh; if (e == be) lv[r] = -INFINITY; }
        cv[k] = bv; ce[k] = be; }
#pragma unroll
    for (int k = 0; k < 4; ++k) { cv[4 + k] = __shfl_xor(cv[k], 32); ce[4 + k] = __shfl_xor(ce[k], 32); }
    float tv[4]; int te[4];
#pragma unroll
    for (int k = 0; k < 4; ++k) { float bv = -INFINITY; int be = 1 << 20;
#pragma unroll
        for (int c = 0; c < 8; ++c) if (cv[c] > bv || (cv[c] == bv && ce[c] < be)) { bv = cv[c]; be = ce[c]; }
#pragma unroll
        for (int c = 0; c < 8; ++c) if (ce[c] == be) cv[c] = -INFINITY;
        tv[k] = bv; te[k] = be; }
    float ex[4], den = 0.f;
#pragma unroll
    for (int k = 0; k < 4; ++k) { ex[k] = __builtin_amdgcn_exp2f((tv[k] - tv[0]) * LOG2E); den += ex[k]; }
    const float rden = 1.0f / den;
    const int e0 = hh ? te[2] : te[0], e1 = hh ? te[3] : te[1]; const float g0 = (hh ? ex[2] : ex[0]) * rden, g1 = (hh ? ex[3] : ex[1]) * rden;
    if (DRY) { asm volatile("" :: "v"(e0), "v"(e1), "v"(g0), "v"(g1)); return; }
    int myc = 0; int rank0 = 0, rank1 = 0;
    const unsigned long long ltmask = (1ull << lane) - 1ull;
    for (int e = 0; e < NE; ++e) {
        const unsigned long long m0 = __ballot(e0 == e), m1 = __ballot(e1 == e);
        const int c0 = __popcll(m0), c1 = __popcll(m1);
        if (lane == e) myc = c0 + c1;
        if (e0 == e) rank0 = __popcll(m0 & ltmask);
        if (e1 == e) rank1 = c0 + __popcll(m1 & ltmask);
    }
    int base = 0;
    if (lane < NE && myc > 0) base = (int)__hip_atomic_fetch_add(F.ctl() + CW_CNT + lane, (unsigned)myc, __ATOMIC_RELAXED, __HIP_MEMORY_SCOPE_AGENT);
    const int p0 = __shfl(base, e0) + rank0, p1 = __shfl(base, e1) + rank1;
    F.LISTTOK()[(size_t)e0 * NTOK + p0] = tok; F.LISTGATE()[(size_t)e0 * NTOK + p0] = g0;
    F.LISTTOK()[(size_t)e1 * NTOK + p1] = tok; F.LISTGATE()[(size_t)e1 * NTOK + p1] = g1;
    F.TOKINFO()[tok * 4 + 2 * hh] = (e0 << 16) | p0; F.TOKINFO()[tok * 4 + 2 * hh + 1] = (e1 << 16) | p1;
}

__device__ __forceinline__ void moe_build_table(Frame& F) {
    LAS int* tab = (LAS int*)(F.lds + TAB_OFF);
    if (F.tid < NE) tab[F.tid] = (int)__hip_atomic_load(F.ctl() + CW_CNT + F.tid, __ATOMIC_RELAXED, __HIP_MEMORY_SCOPE_AGENT);
    __syncthreads();
    if (F.tid == 0) { int acc = 0; for (int e = 0; e < NE; ++e) { tab[32 + e] = acc; acc += (tab[e] + 255) >> 8; } tab[64] = acc; }
    __syncthreads();
}
__device__ __forceinline__ int sgpr(int v) { return __builtin_amdgcn_readfirstlane(v); }
template <int WGM, int NN>
__device__ __forceinline__ bool moe_decode(const Frame* F, int T, int i, Unit& u) {
    const LAS int* tab = (const LAS int*)(F->lds + TAB_OFF);
    const int uu = i * 256 + F->vcu, grp = uu >> 5, w = uu & 31; const int mt = grp * WGM + (w % WGM); u.pn = w / WGM;
    if (mt >= T) return false;
    int e = 0;
    for (int k = 1; k < NE; ++k) if (sgpr(tab[32 + k]) <= mt) e = k;
    u.e = e; u.pm = mt; u.r0 = (mt - sgpr(tab[32 + e])) * 256; u.kind = sgpr(tab[e]); return true;
}
struct ProgMoe1 {
    static constexpr bool GATHER = true, FP8 = true; static constexpr int ID = 5;
    const Frame* F; int T;
    __device__ __forceinline__ bool next(int i, Unit& u) const {
        if (!moe_decode<4, 8>(F, T, i, u)) return false;
        u.A = (const char*)F->HB(); u.B = (const char*)(F->WGU() + ((size_t)u.e * 2048 + (size_t)u.pn * 256) * KD); return true;
    }
    __device__ __forceinline__ void aoffs(const Unit& u, int wid, unsigned (&vo)[2][2]) const {
        const int cnt = u.kind; const int tid = wid * 64 + lane_id_fresh();
#pragma unroll
        for (int i = 0; i < 2; ++i) { int R_, C_; stage_rc(tid * 16 + i * 8192, R_, C_);
#pragma unroll
            for (int h = 0; h < 2; ++h) { const int idx = u.r0 + h * 128 + R_; const int tok = idx < cnt ? F->LISTTOK()[(size_t)u.e * NTOK + idx] : 0; vo[h][i] = (unsigned)(tok * KD + C_ * 2); } }
    }
    __device__ __forceinline__ void epi(const Acc& acc, const Unit& u, int wr, int wc, int fr, int fq) const {
        asm volatile("" : "+v"(fr), "+v"(fq));
        const float* bp = F->b_gate_up() + (size_t)u.e * 2048 + u.pn * 256 + wc * 32 + 8 * fq;
        f32x4 bv[2][2];
#pragma unroll
        for (int bj = 0; bj < 2; ++bj)
#pragma unroll
            for (int n = 0; n < 2; ++n) bv[bj][n] = *(const f32x4*)(bp + bj * 128 + 4 * n);
#pragma unroll
        for (int ai = 0; ai < 2; ++ai)
#pragma unroll
            for (int m = 0; m < 4; ++m) { const size_t slot = (size_t)u.pm * 256 + ai * 128 + wr * 64 + m * 16 + fr; unsigned char* rowp = F->ACT() + slot * 1024 + u.pn * 128 + wc * 16 + 4 * fq;
#pragma unroll
                for (int bj = 0; bj < 2; ++bj) { const f32x4 v0 = acc[ai][bj][m][0] * WSCALE_INV + bv[bj][0], v1 = acc[ai][bj][m][1] * WSCALE_INV + bv[bj][1];
                    float r4[4];
#pragma unroll
                    for (int p = 0; p < 4; ++p) { float gt = (p < 2) ? v0[2 * p] : v1[2 * (p - 2)]; float up = (p < 2) ? v0[2 * p + 1] : v1[2 * (p - 2) + 1];
                        gt = fminf(gt, 7.0f); up = fminf(fmaxf(up, -7.0f), 7.0f);
                        const float glu = gt * __builtin_amdgcn_rcpf(1.0f + __builtin_amdgcn_exp2f(-1.702f * LOG2E * gt)); r4[p] = (up + 1.0f) * glu; }
                    *(unsigned*)(rowp + bj * 64) = pk4_fp8(r4[0], r4[1], r4[2], r4[3]); } }
    }
};
struct ProgMoe2 {
    static constexpr bool GATHER = false, FP8 = true; static constexpr int ID = 6;
    const Frame* F; int T;
    __device__ __forceinline__ bool next(int i, Unit& u) const {
        if (!moe_decode<8, 4>(F, T, i, u)) return false;
        u.A = (const char*)(F->ACT() + (size_t)u.pm * 256 * KD); u.B = (const char*)(F->WD() + ((size_t)u.e * 1024 + (size_t)u.pn * 256) * KD); return true;
    }
    __device__ __forceinline__ void epi(const Acc& acc, const Unit& u, int wr, int wc, int fr, int fq) const {
        asm volatile("" : "+v"(fr), "+v"(fq));
        const int cnt = u.kind;
        const float* bp = F->b_down() + (size_t)u.e * 1024 + u.pn * 256 + wc * 32 + 8 * fq;
        f32x4 bv[2][2];
#pragma unroll
        for (int bj = 0; bj < 2; ++bj)
#pragma unroll
            for (int n = 0; n < 2; ++n) bv[bj][n] = *(const f32x4*)(bp + bj * 128 + 4 * n);
#pragma unroll
        for (int ai = 0; ai < 2; ++ai) {
            float gt[4];
#pragma unroll
            for (int m = 0; m < 4; ++m) { const int idx = u.r0 + ai * 128 + wr * 64 + m * 16 + fr; gt[m] = idx < cnt ? F->LISTGATE()[(size_t)u.e * NTOK + idx] : 0.f; }
#pragma unroll
            for (int m = 0; m < 4; ++m) { const int rl = ai * 128 + wr * 64 + m * 16 + fr; const float gate = gt[m];
                bf16_t* rowp = F->YS() + ((size_t)u.pm * 256 + rl) * 1024 + u.pn * 256 + wc * 32 + 8 * fq;
#pragma unroll
                for (int bj = 0; bj < 2; ++bj) { const f32x4 v0 = (acc[ai][bj][m][0] * WSCALE_INV + bv[bj][0]) * gate, v1 = (acc[ai][bj][m][1] * WSCALE_INV + bv[bj][1]) * gate;
                    u32x4 w; w.x = cvt_pk_bf16(v0[0], v0[1]); w.y = cvt_pk_bf16(v0[2], v0[3]); w.z = cvt_pk_bf16(v1[0], v1[1]); w.w = cvt_pk_bf16(v1[2], v1[3]);
                    *(u32x4*)(rowp + bj * 128) = w; } }
        }
    }
};

template <bool DRY> __device__ __forceinline__ void p7_combine(Frame& F) {
    const LAS int* tab = (const LAS int*)(F.lds + TAB_OFF);
    const int gw = F.vcu * NWAVES + F.wave, NGW = F.G * NWAVES, lane = F.lane;
    for (int tok = gw; tok < NTOK; tok += NGW) {
        f32x4* orow = (f32x4*)(F.out() + (size_t)tok * DM) + lane; f32x4 v[4];
#pragma unroll
        for (int j = 0; j < 4; ++j) v[j] = orow[64 * j];
#pragma unroll
        for (int k = 0; k < 4; ++k) { const int info = F.TOKINFO()[tok * 4 + k]; const int e = info >> 16, pos = info & 0xffff; const size_t slot = (size_t)tab[32 + e] * 256 + pos;
            const u32x2* yr = (const u32x2*)(F.YS() + slot * 1024) + lane;
#pragma unroll
            for (int j = 0; j < 4; ++j) { const u32x2 w = yr[64 * j]; v[j][0] += bflo(w.x); v[j][1] += bfhi(w.x); v[j][2] += bflo(w.y); v[j][3] += bfhi(w.y); } }
        f32x4* wrow = DRY ? (f32x4*)((float*)(F.ws() + WS_EARLY) + (size_t)tok * DM) + lane : orow;
#pragma unroll
        for (int j = 0; j < 4; ++j) wrow[64 * j] = v[j];
    }
}

__global__ void __launch_bounds__(NWAVES * 64, 2) mk_fwd(Args args) {
    extern __shared__ __attribute__((aligned(16))) unsigned char lds_raw[];
    Frame F;
    F.lds = (LAS unsigned char*)lds_raw;
    F.tid = threadIdx.x; F.lane = F.tid & 63; F.wave = __builtin_amdgcn_readfirstlane(F.tid >> 6);
    F.G = gridDim.x; { const int bx = blockIdx.x; F.vcu = (bx % 8) * (F.G / 8) + bx / 8; }
    F.ka = (const CAS Args*)__builtin_amdgcn_kernarg_segment_ptr();
    for (int u = F.tid; u < (LDS_BYTES - LDSCTL_OFF) / 4; u += NWAVES * 64) ((LAS unsigned*)(F.lds + LDSCTL_OFF))[u] = 0u;
    __syncthreads();
    XcdBarrier bar = xcd_barrier_post(F.ctl() + CW_BAR, (volatile LAS unsigned*)(F.lds + MISC_OFF) + 8);
    const int lo = F.ka->ph_lo, hi = F.ka->ph_hi;
#define IN(k) (lo <= (k) && (k) < hi)
#define REFRESH() do { int l_ = lane_id(); asm volatile("" : "+v"(l_)); F.lane = l_; F.tid = F.wave * 64 + l_; } while (0)
#define SEAM(k) do { if (IN(k) && IN((k) + 1)) xcd_barrier(bar, F.wave); } while (0)
    if (IN(0)) { REFRESH(); p0_prologue(F); if (MK_REP == 0) p0_prologue(F); } SEAM(0);
    if (IN(1)) { { ProgIn P{&F}; gemm_phase(F.lds, P); } if (MK_REP == 1) { ProgIn P{&F}; gemm_phase(F.lds, P); } } SEAM(1);
    if (IN(2)) { REFRESH(); p2_mixers(F); if (MK_REP == 2) p2_mixers(F); } SEAM(2);
    if (IN(3)) { { ProgOut P{&F}; gemm_phase(F.lds, P); } if (MK_REP == 3) { ProgOut P{&F}; gemm_phase(F.lds, P); } } SEAM(3);
    if (IN(4)) { REFRESH(); if (F.wave < 4) { if (MK_REP == 4) router_wave_unit<true>(F, F.wave * 256 + F.vcu); router_wave_unit<false>(F, F.wave * 256 + F.vcu); } } SEAM(4);
    if (lo <= 7 && hi > 5) { REFRESH(); moe_build_table(F); }
    if (IN(5)) { { ProgMoe1 P{&F, sgpr(((const LAS int*)(F.lds + TAB_OFF))[64])}; gemm_phase(F.lds, P); } if (MK_REP == 5) { ProgMoe1 P{&F, sgpr(((const LAS int*)(F.lds + TAB_OFF))[64])}; gemm_phase(F.lds, P); } } SEAM(5);
    if (IN(6)) { { ProgMoe2 P{&F, sgpr(((const LAS int*)(F.lds + TAB_OFF))[64])}; gemm_phase(F.lds, P); } if (MK_REP == 6) { ProgMoe2 P{&F, sgpr(((const LAS int*)(F.lds + TAB_OFF))[64])}; gemm_phase(F.lds, P); } } SEAM(6);
    if (IN(7)) { REFRESH(); if (MK_REP == 7) p7_combine<true>(F); p7_combine<false>(F); }
#undef IN
#undef SEAM
}
}
#ifndef MK_CUT
#define MK_CUT 8
#endif
extern "C" void kernel_launch(void* const* d_in, const int* in_sizes, int n_in, void* d_out, int out_size, void* d_ws, size_t ws_size, hipStream_t stream) {
    static int ready = 0;
    if (ready == 0) {
        if (n_in != 18 || out_size != mk::NTOK * mk::DM || ws_size < mk::WS_END) { fprintf(stderr, "kernel_launch: unexpected problem (n_in %d out %d ws %zu)\n", n_in, out_size, ws_size); ready = -1; return; }
        if (hipFuncSetAttribute((const void*)mk::mk_fwd, hipFuncAttributeMaxDynamicSharedMemorySize, mk::LDS_BYTES) != hipSuccess) { fprintf(stderr, "kernel_launch: hipFuncSetAttribute failed\n"); ready = -1; return; }
        ready = 1;
    }
    if (ready < 0) return;
    (void)hipMemsetAsync((char*)d_ws + mk::WS_CTL, 0, mk::CTL_ZERO_BYTES, stream);
    mk::Args a{};
    for (int i = 0; i < 18; ++i) a.in[i] = (const float*)d_in[i];
    a.out = (float*)d_out; a.ws = (unsigned char*)d_ws; a.ph_lo = 0; a.ph_hi = MK_CUT;
    hipLaunchKernelGGL(mk::mk_fwd, dim3(256), dim3(mk::NWAVES * 64), mk::LDS_BYTES, stream, a);
#if MK_CUT < 8
    {
        using namespace nv;
        const float* x = (const float*)d_in[0]; const float* w_out = (const float*)d_in[10]; const float* norm2_w = (const float*)d_in[11];
        const float* router_w = (const float*)d_in[12]; const float* router_b = (const float*)d_in[13]; const float* w_gate_up = (const float*)d_in[14];
        const float* b_gate_up = (const float*)d_in[15]; const float* w_down = (const float*)d_in[16]; const float* b_down = (const float*)d_in[17];
        float* out = (float*)d_out; char* ws = (char*)d_ws; const size_t MiB = 1u << 20;
        int* cnt = (int*)ws + mk::CW_CNT; int* list_tok = (int*)(ws + mk::WS_LISTTOK); float* list_gate = (float*)(ws + mk::WS_LISTGATE);
        float* hn = (float*)(ws + 16 * MiB); float* gu = (float*)(ws + 272 * MiB); float* act = (float*)(ws + (272 + 256) * MiB);
#if MK_CUT <= 3
        k_gemm<1, true><<<dim3(DM / 64, NTOK / 64), 256, 0, stream>>>((const void*)(ws + mk::WS_Y), nullptr, nullptr, nullptr, w_out, nullptr, x, nullptr, out, NTOK, DM, DM, DM, DM);
#endif
#if MK_CUT <= 4
        k_router<<<NTOK, 256, 0, stream>>>(out, norm2_w, router_w, router_b, hn, cnt, list_tok, list_gate);
#else
        k_bf2f<<<4096, 256, 0, stream>>>((const unsigned short*)(ws + mk::WS_HB), hn, (size_t)NTOK * DM);
#endif
        for (int e = 0; e < NE; ++e) {
            const int* lt = list_tok + (size_t)e * NTOK; const float* lgp = list_gate + (size_t)e * NTOK;
            k_gemm<0, false><<<dim3(2 * DFF / 64, NTOK / 64), 256, 0, stream>>>(hn, lt, nullptr, cnt + e, w_gate_up + (size_t)e * DM * 2 * DFF, b_gate_up + (size_t)e * 2 * DFF, nullptr, nullptr, gu, NTOK, 2 * DFF, DM, DM, 2 * DFF);
            k_swiglu<<<NTOK, 256, 0, stream>>>(gu, cnt + e, act);
            k_gemm<3, false><<<dim3(DM / 64, NTOK / 64), 256, 0, stream>>>(act, nullptr, lt, cnt + e, w_down + (size_t)e * DFF * DM, b_down + (size_t)e * DM, nullptr, lgp, out, NTOK, DM, DFF, DFF, DM);
        }
    }
#endif
}
```

```cpp
#include <hip/hip_runtime.h>
#include <cstdio>
#include <cstdint>
#ifndef MK_REP
#define MK_REP -1
#endif
namespace mk {
#define LAS __attribute__((address_space(3)))
#define GAS __attribute__((address_space(1)))
typedef unsigned short bf16_t;
typedef short bf16x8 __attribute__((ext_vector_type(8)));
typedef short s16x4 __attribute__((ext_vector_type(4)));
typedef float f32x4 __attribute__((ext_vector_type(4)));
typedef float f32x2 __attribute__((ext_vector_type(2)));
typedef float f32x16 __attribute__((ext_vector_type(16)));
typedef unsigned u32x4 __attribute__((ext_vector_type(4)));
typedef unsigned u32x2 __attribute__((ext_vector_type(2)));
typedef int i32x4 __attribute__((ext_vector_type(4)));
typedef int i32x8 __attribute__((ext_vector_type(8)));

constexpr int NTOK = 32768, DM = 1024, SEQ = 4096, NB = 8, NH = 8, HD = 64, NE = 32, DFF = 1024, KD = 1024;
constexpr float EPS = 1e-5f;
constexpr float LOG2E = 1.4426950408889634f;
constexpr float QSCALE = 0.125f * LOG2E;
constexpr float SB_THR = 64.0f;
constexpr int NWAVES = 8;
constexpr int SLOTS = NTOK * 4 + NE * 256;

constexpr size_t MiB = 1u << 20;
constexpr size_t WS_CTL = 0, CTL_ZERO_BYTES = 1 * MiB;
constexpr size_t WS_LISTTOK = 1 * MiB;
constexpr size_t WS_LISTGATE = 5 * MiB;
constexpr size_t WS_TOKINFO = 9 * MiB;
constexpr size_t WS_RSTD1 = 10 * MiB;
constexpr size_t WS_SSPART = 11 * MiB;
constexpr size_t WS_RT = 13 * MiB;
constexpr size_t WS_WGU = 16 * MiB;
constexpr size_t WS_WD = 80 * MiB;
constexpr size_t WS_HB = 112 * MiB;
constexpr size_t WS_YS = 144 * MiB;
constexpr size_t WS_EARLY = 416 * MiB;
constexpr size_t WS_XB = WS_EARLY;
constexpr size_t WS_WIN = WS_EARLY + 64 * MiB;
constexpr size_t WS_WOUT = WS_EARLY + 70 * MiB;
constexpr size_t WS_UV = WS_EARLY + 72 * MiB;
constexpr size_t WS_Q = WS_EARLY + 136 * MiB;
constexpr size_t WS_K = WS_EARLY + 168 * MiB;
constexpr size_t WS_VT = WS_EARLY + 200 * MiB;
constexpr size_t WS_Y = WS_EARLY + 232 * MiB;
constexpr size_t WS_ACT = WS_EARLY;
constexpr size_t WS_END = WS_EARLY + 296 * MiB;
constexpr float WSCALE = 32.0f, WSCALE_INV = 1.0f / 32.0f;
constexpr float YSCALE = 16.0f, YSCALE_INV = 1.0f / 16.0f;
constexpr int CW_CNT = 64;
constexpr int CW_BAR = 4096;

constexpr int RING_BYTES = 131072;
constexpr int LDSCTL_OFF = RING_BYTES, MISC_OFF = LDSCTL_OFF + 320, TAB_OFF = LDSCTL_OFF + 1024;
constexpr int LDS_BYTES = 147456;

__device__ __forceinline__ unsigned cvt_pk_bf16(float lo, float hi) { unsigned r; asm volatile("v_cvt_pk_bf16_f32 %0, %1, %2" : "=v"(r) : "v"(lo), "v"(hi)); return r; }
__device__ __forceinline__ unsigned pk4_fp8(float a, float b, float c, float d) { unsigned w = 0u; w = (unsigned)__builtin_amdgcn_cvt_pk_fp8_f32(a, b, (int)w, false); w = (unsigned)__builtin_amdgcn_cvt_pk_fp8_f32(c, d, (int)w, true); return w; }
__device__ __forceinline__ float bf2f(unsigned short h) { return __uint_as_float((unsigned)h << 16); }
__device__ __forceinline__ float bflo(unsigned w) { return __uint_as_float(w << 16); }
__device__ __forceinline__ float bfhi(unsigned w) { return __uint_as_float(w & 0xffff0000u); }
__device__ __forceinline__ int lane_id() { return (int)__builtin_amdgcn_mbcnt_hi(~0u, __builtin_amdgcn_mbcnt_lo(~0u, 0u)); }
__device__ __forceinline__ int lane_id_fresh() { int l; asm volatile("v_mbcnt_lo_u32_b32 %0, -1, 0\n\tv_mbcnt_hi_u32_b32 %0, -1, %0" : "=v"(l)); return l; }
__device__ __forceinline__ float wave_sum(float v) {
#pragma unroll
    for (int o = 1; o < 64; o <<= 1) v += __shfl_xor(v, o);
    return v;
}
__device__ __forceinline__ float gelu_tanh_f(float x) {
    const float u = 0.7978845608028654f * (x + 0.044715f * x * x * x);
    return x * __builtin_amdgcn_rcpf(1.0f + __builtin_amdgcn_exp2f(-2.0f * LOG2E * u));
}

constexpr int BM = 256, BK = 64, HALF = 128, HTB = HALF * BK * 2;
__device__ __forceinline__ int lds_byte(int r, int c) { const int st = (r >> 4) * 2 + (c >> 5), rr = r & 15, cc = c & 31, ob = rr * 64 + cc * 2; return st * 1024 + (ob ^ (((ob >> 9) & 1) << 5)); }
__device__ __forceinline__ void stage_rc(int b, int& R, int& C) { const int st = b / 1024, sb = b % 1024, swz = sb ^ (((sb >> 9) & 1) << 5); R = (st >> 1) * 16 + swz / 64; C = (st & 1) * 32 + (swz % 64) / 2; }
__device__ __forceinline__ int perm32(int rho) { const int n = rho >> 4, i = rho & 15; return 8 * (i >> 2) + 4 * n + (i & 3); }

struct Unit { const char* A; const char* B; int kind, pm, pn, e, r0; };

template <class Prog>
__device__ __forceinline__ void gemm_phase(LAS unsigned char* lds, const Prog& P) {
    const int wid = P.F->wave, lane = lane_id(), tid = wid * 64 + lane, wr = wid >> 2, wc = wid & 3;
    constexpr bool F8 = Prog::FP8;
    constexpr int K = KD, ESZ = F8 ? 1 : 2, nt = F8 ? K / 128 : K / BK;
    unsigned voffB[2];
#pragma unroll
    for (int i = 0; i < 2; ++i) { int R_, C_; stage_rc(tid * 16 + i * 8192, R_, C_); const int Rb = (R_ & ~31) + perm32(R_ & 31); voffB[i] = (unsigned)(Rb * K * ESZ + C_ * 2); }
    constexpr size_t kstep = (size_t)(BK * 2);
    constexpr size_t hstep = (size_t)HALF * K * ESZ;
    const unsigned ldsw = (unsigned)wid * 1024u;
    const int aoff = lds_byte(wr * 64 + (lane & 15), F8 ? (lane >> 4) * 16 : (lane >> 4) * 8), boff = lds_byte(wc * 32 + (lane & 15), F8 ? (lane >> 4) * 16 : (lane >> 4) * 8);
    constexpr int KOFF = F8 ? 16 : 1024;
#define MK_SA(b, h) (((b) * 2 + (h)) * HTB)
#define MK_SB(b, h) ((4 + (b) * 2 + (h)) * HTB)
#define MK_STAGE(bufoff, gbase, voff) do { _Pragma("unroll") for (int _i = 0; _i < 2; ++_i) { unsigned o_ = (voff)[_i]; asm volatile("" : "+v"(o_));     \
        __builtin_amdgcn_global_load_lds((const unsigned*)((const char*)(gbase) + o_), (LAS unsigned*)(lds + (bufoff) + ldsw + _i * 8192), 16, 0, 0); } } while (0)
#define MK_STAGE_A(bufoff, gbase, h) do { if constexpr (GA) MK_STAGE(bufoff, gbase, voC[h]); else MK_STAGE(bufoff, (gbase) + (h) * hstep, voC[0]); } while (0)
#define MK_LDA(dst, b, h) do { _Pragma("unroll") for (int m = 0; m < 4; ++m) _Pragma("unroll") for (int k = 0; k < 2; ++k) dst[m][k] = *(const LAS bf16x8*)(lds + MK_SA(b, h) + aoff + m * 2048 + k * KOFF); } while (0)
#define MK_LDB(dst, b, h) do { _Pragma("unroll") for (int n = 0; n < 2; ++n) _Pragma("unroll") for (int k = 0; k < 2; ++k) dst[n][k] = *(const LAS bf16x8*)(lds + MK_SB(b, h) + boff + n * 2048 + k * KOFF); } while (0)
#define MK_CAT8(x) __builtin_shufflevector(__builtin_bit_cast(i32x4, (x)[0]), __builtin_bit_cast(i32x4, (x)[1]), 0, 1, 2, 3, 4, 5, 6, 7)
#define MK_MMA(ai, bj, At, Bt) do { __builtin_amdgcn_s_setprio(1); \
        if constexpr (F8) { _Pragma("unroll") for (int m = 0; m < 4; ++m) _Pragma("unroll") for (int n = 0; n < 2; ++n) \
            acc[ai][bj][m][n] = __builtin_amdgcn_mfma_scale_f32_16x16x128_f8f6f4(MK_CAT8(Bt[n]), MK_CAT8(At[m]), acc[ai][bj][m][n], 0, 0, 0, 0, 0, 0); } \
        else { _Pragma("unroll") for (int m = 0; m < 4; ++m) _Pragma("unroll") for (int n = 0; n < 2; ++n) _Pragma("unroll") for (int k = 0; k < 2; ++k) \
            acc[ai][bj][m][n] = __builtin_amdgcn_mfma_f32_16x16x32_bf16(Bt[n][k], At[m][k], acc[ai][bj][m][n], 0, 0, 0); } \
        __builtin_amdgcn_s_setprio(0); } while (0)
#define MK_WAIT_V(n) asm volatile("s_waitcnt vmcnt(" #n ")" ::: "memory")
#define MK_WAIT_L(n) asm volatile("s_waitcnt lgkmcnt(" #n ")" ::: "memory")
#define MK_BAR __builtin_amdgcn_s_barrier()
#define MK_SCHED __builtin_amdgcn_sched_barrier(0)
    Unit cur, nxt; int ui = 0;
    if (!P.next(0, cur)) return;
    constexpr bool GA = Prog::GATHER;
    unsigned voC[2][2];
    if constexpr (GA) P.aoffs(cur, wid, voC);
    else {
#pragma unroll
        for (int i = 0; i < 2; ++i) { int R_, C_; stage_rc(tid * 16 + i * 8192, R_, C_); voC[0][i] = (unsigned)(R_ * K * ESZ + C_ * 2); voC[1][i] = 0u; }
    }
    f32x4 acc[2][2][4][2];
#pragma unroll
    for (int a = 0; a < 2; ++a)
#pragma unroll
        for (int b = 0; b < 2; ++b)
#pragma unroll
            for (int m = 0; m < 4; ++m)
#pragma unroll
                for (int n = 0; n < 2; ++n) acc[a][b][m][n] = (f32x4){0.f, 0.f, 0.f, 0.f};
    bf16x8 At[4][2], B0[2][2], B1[2][2];
    const char* cA = cur.A; const char* cB = cur.B;
    MK_STAGE(MK_SB(0, 0), cB, voffB); MK_STAGE(MK_SB(0, 1), cB + hstep, voffB); MK_STAGE_A(MK_SA(0, 0), cA, 0); MK_STAGE_A(MK_SA(0, 1), cA, 1);
    if (wr == 1) MK_BAR;
    MK_WAIT_V(2); MK_BAR;
    MK_STAGE(MK_SB(1, 0), cB + kstep, voffB); MK_STAGE_A(MK_SA(1, 0), cA + kstep, 0); MK_STAGE(MK_SB(1, 1), cB + hstep + kstep, voffB);
    MK_WAIT_V(6); MK_BAR;
    for (;;) {
        const bool has_next = P.next(ui + 1, nxt);
        if (!has_next) nxt = cur;
        const char* nA = nxt.A; const char* nB = nxt.B;
#pragma unroll 1
        for (int t = 0; t < nt; t += 2) {
            const bool last = (t == nt - 2);
            const char* a1 = cA + (size_t)(t + 1) * kstep;
            const char* a2 = last ? nA : cA + (size_t)(t + 2) * kstep; const char* b2 = last ? nB : cB + (size_t)(t + 2) * kstep;
            const char* a3 = a2 + kstep; const char* b3 = b2 + kstep;
            MK_LDB(B0, 0, 0); MK_LDB(B1, 0, 1); MK_SCHED; MK_LDA(At, 0, 0); MK_STAGE_A(MK_SA(1, 1), a1, 1);
            if constexpr (GA) { if (last && has_next) P.aoffs(nxt, wid, voC); }
            MK_WAIT_V(8); MK_WAIT_L(0); MK_BAR; MK_MMA(0, 0, At, B0); MK_MMA(0, 1, At, B1); MK_BAR; MK_SCHED;
            MK_LDA(At, 0, 1); MK_STAGE(MK_SB(0, 0), b2, voffB); MK_STAGE(MK_SB(0, 1), b2 + hstep, voffB); MK_STAGE_A(MK_SA(0, 0), a2, 0);
            MK_WAIT_V(8); MK_WAIT_L(0); MK_BAR; MK_MMA(1, 0, At, B0); MK_MMA(1, 1, At, B1); MK_BAR; MK_SCHED;
            MK_LDB(B0, 1, 0); MK_LDB(B1, 1, 1); MK_SCHED; MK_LDA(At, 1, 0); MK_STAGE_A(MK_SA(0, 1), a2, 1);
            MK_WAIT_V(8); MK_WAIT_L(0); MK_BAR; MK_MMA(0, 0, At, B0); MK_MMA(0, 1, At, B1); MK_BAR; MK_SCHED;
            MK_LDA(At, 1, 1); MK_STAGE(MK_SB(1, 0), b3, voffB); MK_STAGE(MK_SB(1, 1), b3 + hstep, voffB); MK_STAGE_A(MK_SA(1, 0), a3, 0);
            MK_WAIT_V(8); MK_WAIT_L(0); MK_BAR; MK_MMA(1, 0, At, B0); MK_MMA(1, 1, At, B1); MK_BAR; MK_SCHED;
        }
        if (wr == 0) MK_BAR;
        { const int l_ = lane_id_fresh(); P.epi(acc, cur, wr, wc, l_ & 15, l_ >> 4); }
#ifdef MK_EPI2
        if (Prog::ID == MK_EPI2) { const int l_ = lane_id_fresh(); P.epi(acc, cur, wr, wc, l_ & 15, l_ >> 4); }
#endif
        if (!has_next) break;
#pragma unroll
        for (int a = 0; a < 2; ++a)
#pragma unroll
            for (int b = 0; b < 2; ++b)
#pragma unroll
                for (int m = 0; m < 4; ++m)
#pragma unroll
                    for (int n = 0; n < 2; ++n) acc[a][b][m][n] = (f32x4){0.f, 0.f, 0.f, 0.f};
        cur = nxt; cA = nA; cB = nB; ++ui;
        if (wr == 1) MK_BAR;
    }
    MK_WAIT_V(0);
    MK_BAR;
#undef MK_SA
#undef MK_SB
#undef MK_STAGE
#undef MK_STAGE_A
#undef MK_LDA
#undef MK_LDB
#undef MK_MMA
#undef MK_CAT8
}
typedef f32x4 Acc[2][2][4][2];

#define XB_TMO      128
#define XB_XCNT(j)  (256  + 64 * (j))
#define XB_XSUB(j)  (1280 + 64 * (j))
#define XB_XGEN(j)  (2304 + 64 * (j))
#define XB_TOP      3328
#define XB_TOPGEN   3392
#define XCD_BAR_WORDS 3456
#define XB_SPIN_CAP (1u << 18)
__device__ __forceinline__ unsigned xb_ld(unsigned* p)              { return __hip_atomic_load(p, __ATOMIC_RELAXED, __HIP_MEMORY_SCOPE_AGENT); }
__device__ __forceinline__ unsigned xb_add(unsigned* p, unsigned v) { return __hip_atomic_fetch_add(p, v, __ATOMIC_RELAXED, __HIP_MEMORY_SCOPE_AGENT); }
__device__ __forceinline__ unsigned xb_xcc_id() { return (unsigned)__builtin_amdgcn_s_getreg((3 << 11) | 20) & 0xFu; }
#define XB_SPIN(cond, bar) do { unsigned _sp = 0; while (cond) { __builtin_amdgcn_s_sleep(1); \
    if ((++_sp & 255u) == 0u) { if (xb_ld(&(bar)[XB_TMO])) break; if (_sp > XB_SPIN_CAP) { atomicAdd(&(bar)[XB_TMO], 1u); break; } } } } while (0)
struct XcdBarrier { unsigned* bar; unsigned x; volatile LAS unsigned* st; };
__device__ __forceinline__ XcdBarrier xcd_barrier_post(unsigned* bar, volatile LAS unsigned* st) {
    XcdBarrier b; b.bar = bar; b.x = xb_xcc_id(); b.st = st;
    if (threadIdx.x == 0) (void)xb_add(&bar[XB_XCNT(b.x)], 1u);
    return b;
}
__device__ __forceinline__ void xcd_barrier_complete(unsigned* bar, unsigned x, unsigned& nloc, unsigned& nx) {
    const unsigned G = gridDim.x * gridDim.y * gridDim.z;
    unsigned sum, cnt, mine, sp = 0u;
    for (;;) {
        sum = 0u; cnt = 0u; mine = 0u;
#pragma unroll
        for (unsigned j = 0; j < 16; ++j) { const unsigned c = xb_ld(&bar[XB_XCNT(j)]); sum += c; cnt += (c > 0u) ? 1u : 0u; mine = (j == x) ? c : mine; }
        if (sum == G) break;
        __builtin_amdgcn_s_sleep(1);
        if ((++sp & 255u) == 0u) { if (xb_ld(&bar[XB_TMO])) break; if (sp > XB_SPIN_CAP) { atomicAdd(&bar[XB_TMO], 1u); break; } }
    }
    nloc = mine > 0u ? mine : 1u; nx = cnt > 0u ? cnt : 1u;
}
__device__ __forceinline__ void xcd_barrier(const XcdBarrier& b, int wave) {
    asm volatile("s_waitcnt vmcnt(0)" ::: "memory");
    __syncthreads();
    if (wave == 0 && lane_id() == 0) {
        unsigned* bar = b.bar;
        __builtin_amdgcn_s_waitcnt(0);
        unsigned nloc = b.st[0], nx = b.st[1];
        if (nloc == 0u) { xcd_barrier_complete(bar, b.x, nloc, nx); b.st[0] = nloc; b.st[1] = nx; }
        const unsigned old = xb_add(&bar[XB_XSUB(b.x)], 1u);
        const unsigned gen = old / nloc;
        if (old + 1u == (gen + 1u) * nloc) {
            __builtin_amdgcn_fence(__ATOMIC_RELEASE, "agent");
            asm volatile("s_waitcnt vmcnt(0)" ::: "memory");
            const unsigned og = xb_add(&bar[XB_TOP], 1u);
            const unsigned tg = og / nx;
            if (og + 1u == (tg + 1u) * nx) xb_add(&bar[XB_TOPGEN], 1u);
            else XB_SPIN(xb_ld(&bar[XB_TOPGEN]) == tg, bar);
            __builtin_amdgcn_fence(__ATOMIC_ACQUIRE, "agent");
            xb_add(&bar[XB_XGEN(b.x)], 1u);
            asm volatile("s_waitcnt vmcnt(0)" ::: "memory");
        } else {
            XB_SPIN(xb_ld(&bar[XB_XGEN(b.x)]) == gen, bar);
            __builtin_amdgcn_fence(__ATOMIC_ACQUIRE, "agent");
            asm volatile("s_waitcnt vmcnt(0)" ::: "memory");
        }
    }
    __syncthreads();
}

struct Args {
    const float* in[18]; float* out; unsigned char* ws; int ph_lo, ph_hi;
};
#define CAS __attribute__((address_space(4)))
struct Frame {
    LAS unsigned char* lds; int tid, lane, wave, vcu, G;
    const CAS Args* ka;
    __device__ __forceinline__ const float* inp(int k) const { return ka->in[k]; }
    __device__ __forceinline__ unsigned char* ws() const { return ka->ws; }
    __device__ __forceinline__ float* out() const { return ka->out; }
    __device__ __forceinline__ const float* x() const { return inp(0); }
    __device__ __forceinline__ const float* norm1_w() const { return inp(1); }
    __device__ __forceinline__ const float* w_in() const { return inp(2); }
    __device__ __forceinline__ const float* sgu_norm_w() const { return inp(3); }
    __device__ __forceinline__ const float* sgu_w() const { return inp(4); }
    __device__ __forceinline__ const float* sgu_b() const { return inp(5); }
    __device__ __forceinline__ const float* q_norm_w() const { return inp(6); }
    __device__ __forceinline__ const float* k_norm_w() const { return inp(7); }
    __device__ __forceinline__ const float* out_norm_a_w() const { return inp(8); }
    __device__ __forceinline__ const float* out_norm_b_w() const { return inp(9); }
    __device__ __forceinline__ const float* w_out() const { return inp(10); }
    __device__ __forceinline__ const float* norm2_w() const { return inp(11); }
    __device__ __forceinline__ const float* router_w() const { return inp(12); }
    __device__ __forceinline__ const float* router_b() const { return inp(13); }
    __device__ __forceinline__ const float* w_gate_up() const { return inp(14); }
    __device__ __forceinline__ const float* b_gate_up() const { return inp(15); }
    __device__ __forceinline__ const float* w_down() const { return inp(16); }
    __device__ __forceinline__ const float* b_down() const { return inp(17); }
    __device__ __forceinline__ bf16_t* XB() const { return (bf16_t*)(ws() + WS_XB); }
    __device__ __forceinline__ bf16_t* WIN() const { return (bf16_t*)(ws() + WS_WIN); }
    __device__ __forceinline__ bf16_t* WOUT() const { return (bf16_t*)(ws() + WS_WOUT); }
    __device__ __forceinline__ bf16_t* UV() const { return (bf16_t*)(ws() + WS_UV); }
    __device__ __forceinline__ bf16_t* Q() const { return (bf16_t*)(ws() + WS_Q); }
    __device__ __forceinline__ bf16_t* K() const { return (bf16_t*)(ws() + WS_K); }
    __device__ __forceinline__ bf16_t* VT() const { return (bf16_t*)(ws() + WS_VT); }
    __device__ __forceinline__ bf16_t* Y() const { return (bf16_t*)(ws() + WS_Y); }
    __device__ __forceinline__ unsigned char* YS() const { return ws() + WS_YS; }
    __device__ __forceinline__ bf16_t* RT() const { return (bf16_t*)(ws() + WS_RT); }
    __device__ __forceinline__ unsigned char* HB() const { return ws() + WS_HB; }
    __device__ __forceinline__ unsigned char* WGU() const { return ws() + WS_WGU; }
    __device__ __forceinline__ unsigned char* WD() const { return ws() + WS_WD; }
    __device__ __forceinline__ unsigned char* ACT() const { return ws() + WS_ACT; }
    __device__ __forceinline__ float* RSTD1() const { return (float*)(ws() + WS_RSTD1); }
    __device__ __forceinline__ float* SSPART() const { return (float*)(ws() + WS_SSPART); }
    __device__ __forceinline__ float* LISTGATE() const { return (float*)(ws() + WS_LISTGATE); }
    __device__ __forceinline__ int* LISTTOK() const { return (int*)(ws() + WS_LISTTOK); }
    __device__ __forceinline__ int* TOKINFO() const { return (int*)(ws() + WS_TOKINFO); }
    __device__ __forceinline__ unsigned* ctl() const { return (unsigned*)(ws() + WS_CTL); }
};

__device__ __forceinline__ void p0_transpose_item(const float* W, int K, int N, bf16_t* WT, int k0, int n0, int drow0, const float* kscale, LAS float* scr, int lane) {
#pragma unroll 8
    for (int i = 0; i < 32; ++i) { const int kk = 2 * i + (lane >> 5); float v = W[(size_t)(k0 + kk) * N + n0 + (lane & 31)]; if (kscale) v *= kscale[k0 + kk]; scr[kk * 33 + (lane & 31)] = v; }
    asm volatile("s_waitcnt lgkmcnt(0)" ::: "memory");
    const int c = lane & 7;
#pragma unroll
    for (int j = 0; j < 4; ++j) { const int n = (lane >> 3) + 8 * j; const LAS float* s = scr + (8 * c) * 33 + n;
        u32x4 o; o.x = cvt_pk_bf16(s[0 * 33], s[1 * 33]); o.y = cvt_pk_bf16(s[2 * 33], s[3 * 33]); o.z = cvt_pk_bf16(s[4 * 33], s[5 * 33]); o.w = cvt_pk_bf16(s[6 * 33], s[7 * 33]);
        *(u32x4*)(WT + (size_t)(drow0 + n) * K + k0 + 8 * c) = o; }
    asm volatile("s_waitcnt lgkmcnt(0)" ::: "memory");
}
__device__ __forceinline__ void p0_transpose_item_f8(const float* W, int K, int N, unsigned char* WT, int k0, int n0, LAS float* scr, int lane) {
#pragma unroll 8
    for (int i = 0; i < 32; ++i) { const int kk = 2 * i + (lane >> 5); scr[kk * 33 + (lane & 31)] = W[(size_t)(k0 + kk) * N + n0 + (lane & 31)] * WSCALE; }
    asm volatile("s_waitcnt lgkmcnt(0)" ::: "memory");
    const int c = lane & 7;
#pragma unroll
    for (int j = 0; j < 4; ++j) { const int n = (lane >> 3) + 8 * j; const LAS float* s = scr + (8 * c) * 33 + n;
        u32x2 o; o.x = pk4_fp8(s[0 * 33], s[1 * 33], s[2 * 33], s[3 * 33]); o.y = pk4_fp8(s[4 * 33], s[5 * 33], s[6 * 33], s[7 * 33]);
        *(u32x2*)(WT + (size_t)(n0 + n) * K + k0 + 8 * c) = o; }
    asm volatile("s_waitcnt lgkmcnt(0)" ::: "memory");
}
__device__ __forceinline__ int win_drow(int n0) {
    if (n0 < 1024 || n0 >= 2048) return n0;
    const int rel = n0 - 1024, isk = rel >> 9, head = (rel & 511) >> 6, dh = (rel & 63) >> 5;
    return 256 * (4 + 2 * isk + (head >> 2)) + 128 * dh + 32 * (head & 3);
}
constexpr int MOE_I_GU = 16 * 64, MOE_I_D = 16 * 32, MOE_ITEMS = NE * (MOE_I_GU + MOE_I_D);
struct ConvItem { const float* src; unsigned char* dst; int N; };
__device__ __forceinline__ ConvItem moe_conv_decode(const Frame& F, int it) {
    ConvItem c;
    if (it < NE * MOE_I_GU) { const int e = it / MOE_I_GU, q = it % MOE_I_GU, kb = q / 64, nb = q % 64; c.N = 2048;
        c.src = F.w_gate_up() + (size_t)e * KD * 2048 + (size_t)(64 * kb) * 2048 + 32 * nb; c.dst = F.WGU() + (size_t)e * 2048 * KD + (size_t)(32 * nb) * KD + 64 * kb; }
    else { const int r = it - NE * MOE_I_GU; const int e = r / MOE_I_D, q = r % MOE_I_D, kb = q / 32, nb = q % 32; c.N = 1024;
        c.src = F.w_down() + (size_t)e * KD * 1024 + (size_t)(64 * kb) * 1024 + 32 * nb; c.dst = F.WD() + (size_t)e * 1024 * KD + (size_t)(32 * nb) * KD + 64 * kb; }
    return c;
}
__device__ __forceinline__ void moe_conv_issue(const ConvItem& c, f32x4 (&v)[8], int lane) {
    const float* p = c.src + (size_t)(lane >> 3) * c.N + 4 * (lane & 7);
#pragma unroll
    for (int i = 0; i < 8; ++i) v[i] = *(const f32x4*)(p + (size_t)(8 * i) * c.N);
}
__device__ __forceinline__ void moe_conv_finish(const ConvItem& c, const f32x4 (&v)[8], LAS float* scr, int lane) {
    LAS float* w = scr + (lane >> 3) * 33 + 4 * (lane & 7);
#pragma unroll
    for (int i = 0; i < 8; ++i) { w[(8 * i) * 33 + 0] = v[i][0] * WSCALE; w[(8 * i) * 33 + 1] = v[i][1] * WSCALE; w[(8 * i) * 33 + 2] = v[i][2] * WSCALE; w[(8 * i) * 33 + 3] = v[i][3] * WSCALE; }
    asm volatile("s_waitcnt lgkmcnt(0)" ::: "memory");
    const int cc = lane & 7;
#pragma unroll
    for (int j = 0; j < 4; ++j) { const int n = (lane >> 3) + 8 * j; const LAS float* s = scr + (8 * cc) * 33 + n;
        u32x2 o; o.x = pk4_fp8(s[0 * 33], s[1 * 33], s[2 * 33], s[3 * 33]); o.y = pk4_fp8(s[4 * 33], s[5 * 33], s[6 * 33], s[7 * 33]);
        *(u32x2*)(c.dst + (size_t)n * KD + 8 * cc) = o; }
    asm volatile("s_waitcnt lgkmcnt(0)" ::: "memory");
}
constexpr int CONV_P4_PER_WAVE = 12, CONV_P4_ITEMS = CONV_P4_PER_WAVE * 1024;
constexpr int CONV_P2_ITEMS = MOE_ITEMS - CONV_P4_ITEMS, CONV_P2_PER_WAVE = CONV_P2_ITEMS / 2048;
static_assert(CONV_P2_ITEMS % 2048 == 0 && CONV_P4_PER_WAVE % 2 == 0, "conversion split");
__device__ __forceinline__ void p0_prologue(Frame& F) {
    LAS float* scr = (LAS float*)(F.lds + F.wave * 16384);
    const int gw = F.vcu * NWAVES + F.wave, NGW = F.G * NWAVES, lane = F.lane;
    for (int m = gw; m < NTOK; m += NGW) {
        const f32x4* xr = (const f32x4*)(F.x() + (size_t)m * DM) + lane; f32x4 v[4]; float s = 0.f;
#pragma unroll
        for (int j = 0; j < 4; ++j) { v[j] = xr[64 * j]; s += (v[j].x * v[j].x + v[j].y * v[j].y) + (v[j].z * v[j].z + v[j].w * v[j].w); }
        const float tot = wave_sum(s);
        if (lane == 0) F.RSTD1()[m] = 1.0f / sqrtf(tot * (1.0f / DM) + EPS);
        u32x2* o8 = (u32x2*)(F.XB() + (size_t)m * DM) + lane;
#pragma unroll
        for (int j = 0; j < 4; ++j) { u32x2 w; w.x = cvt_pk_bf16(v[j].x, v[j].y); w.y = cvt_pk_bf16(v[j].z, v[j].w); o8[64 * j] = w; }
    }
    constexpr int I_IN = 16 * 80, I_OUT = 16 * 32;
    for (int it = gw; it < I_IN + I_OUT; it += NGW) {
        int r = it;
        if (r < I_IN) { const int kb = r / 80, nb = r % 80; p0_transpose_item(F.w_in(), KD, 2560, F.WIN(), 64 * kb, 32 * nb, win_drow(32 * nb), F.norm1_w(), scr, lane); continue; } r -= I_IN;
        { const int kb = r / 32, nb = r % 32; p0_transpose_item(F.w_out(), KD, 1024, F.WOUT(), 64 * kb, 32 * nb, 32 * nb, nullptr, scr, lane); }
    }
    for (int idx = gw * 64 + lane; idx < NE * KD; idx += NGW * 64) {
        const int e = idx >> 10, k = idx & 1023; const float w = F.router_w()[(size_t)k * NE + e];
        const unsigned hi = cvt_pk_bf16(w, 0.f) & 0xffffu; const float rem = w - __uint_as_float(hi << 16);
        F.RT()[idx] = (bf16_t)hi; F.RT()[NE * KD + idx] = (bf16_t)(cvt_pk_bf16(rem, 0.f) & 0xffffu);
    }
}

struct ProgIn {
    static constexpr bool GATHER = false, FP8 = false; static constexpr int ID = 1;
    const Frame* F;
    __device__ __forceinline__ bool next(int i, Unit& u) const {
        const int v = F->vcu;
        if (i < 4) { const int uu = i * 256 + v, grp = uu >> 5, w = uu & 31; u.pm = grp * 4 + (w & 3); u.pn = w >> 2; u.kind = u.pn < 4 ? 0 : 1;
            u.A = (const char*)(F->XB() + (size_t)u.pm * 256 * KD); u.B = (const char*)(F->WIN() + (size_t)u.pn * 256 * KD); u.e = 0; u.r0 = 0; return true; }
        if (i == 4) { u.kind = 2; u.pm = v & 1; u.pn = v >> 1; u.A = (const char*)(F->WIN() + (size_t)(2048 + u.pm * 256) * KD); u.B = (const char*)(F->XB() + (size_t)u.pn * 256 * KD); u.e = 0; u.r0 = 0; return true; }
        return false;
    }
    __device__ __forceinline__ void epi(const Acc& acc, const Unit& u, int wr, int wc, int fr, int fq) const {
        asm volatile("" : "+v"(fr), "+v"(fq));
        if (u.kind == 2) {
            const int tk0 = u.pn * 256 + wc * 32 + 8 * fq;
            f32x4 rs[2][2];
#pragma unroll
            for (int bj = 0; bj < 2; ++bj)
#pragma unroll
                for (int n = 0; n < 2; ++n) rs[bj][n] = *(const f32x4*)(F->RSTD1() + tk0 + bj * 128 + 4 * n);
#pragma unroll
            for (int ai = 0; ai < 2; ++ai)
#pragma unroll
                for (int m = 0; m < 4; ++m) { const int cp = u.pm * 256 + ai * 128 + wr * 64 + m * 16 + fr; bf16_t* rowp = F->VT() + (size_t)cp * NTOK + tk0;
#pragma unroll
                    for (int bj = 0; bj < 2; ++bj) { const f32x4 v0 = acc[ai][bj][m][0] * rs[bj][0], v1 = acc[ai][bj][m][1] * rs[bj][1];
                        u32x4 w; w.x = cvt_pk_bf16(v0[0], v0[1]); w.y = cvt_pk_bf16(v0[2], v0[3]); w.z = cvt_pk_bf16(v1[0], v1[1]); w.w = cvt_pk_bf16(v1[2], v1[3]);
                        *(u32x4*)(rowp + bj * 128) = w; } }
            return;
        }
        float rsr[2][4];
#pragma unroll
        for (int ai = 0; ai < 2; ++ai)
#pragma unroll
            for (int m = 0; m < 4; ++m) rsr[ai][m] = F->RSTD1()[u.pm * 256 + ai * 128 + wr * 64 + m * 16 + fr];
        if (u.kind == 0) {
#pragma unroll
            for (int ai = 0; ai < 2; ++ai)
#pragma unroll
                for (int m = 0; m < 4; ++m) { const int r = u.pm * 256 + ai * 128 + wr * 64 + m * 16 + fr; bf16_t* rowp = F->UV() + (size_t)r * 1024 + u.pn * 256 + wc * 32 + 8 * fq; const float rs = rsr[ai][m];
#pragma unroll
                    for (int bj = 0; bj < 2; ++bj) { f32x4 v0 = acc[ai][bj][m][0] * rs, v1 = acc[ai][bj][m][1] * rs;
#pragma unroll
                        for (int j = 0; j < 4; ++j) { v0[j] = gelu_tanh_f(v0[j]); v1[j] = gelu_tanh_f(v1[j]); }
                        u32x4 w; w.x = cvt_pk_bf16(v0[0], v0[1]); w.y = cvt_pk_bf16(v0[2], v0[3]); w.z = cvt_pk_bf16(v1[0], v1[1]); w.w = cvt_pk_bf16(v1[2], v1[3]);
                        *(u32x4*)(rowp + bj * 128) = w; } }
            return;
        }
        {
            const int isk = (u.pn - 4) >> 1, head = 4 * (u.pn & 1) + wc; const float* nw = isk ? F->k_norm_w() : F->q_norm_w(); bf16_t* dst = isk ? F->K() : F->Q();
            const float osc = isk ? 1.0f : QSCALE;
            f32x4 nwv[2][2];
#pragma unroll
            for (int bj = 0; bj < 2; ++bj)
#pragma unroll
                for (int n = 0; n < 2; ++n) nwv[bj][n] = *(const f32x4*)(nw + 32 * bj + 8 * fq + 4 * n);
#pragma unroll
            for (int ai = 0; ai < 2; ++ai)
#pragma unroll
                for (int m = 0; m < 4; ++m) { const int r = u.pm * 256 + ai * 128 + wr * 64 + m * 16 + fr; const float rs = rsr[ai][m];
                    f32x4 t[2][2]; float ss = 0.f;
#pragma unroll
                    for (int bj = 0; bj < 2; ++bj)
#pragma unroll
                        for (int n = 0; n < 2; ++n) { t[bj][n] = acc[ai][bj][m][n] * rs; ss += (t[bj][n][0] * t[bj][n][0] + t[bj][n][1] * t[bj][n][1]) + (t[bj][n][2] * t[bj][n][2] + t[bj][n][3] * t[bj][n][3]); }
                    ss += __shfl_xor(ss, 16); ss += __shfl_xor(ss, 32);
                    const float rn = osc / sqrtf(ss * (1.0f / 64.0f) + EPS);
                    bf16_t* rowp = dst + (size_t)r * 512 + head * 64 + 8 * fq;
#pragma unroll
                    for (int bj = 0; bj < 2; ++bj) { const f32x4 v0 = t[bj][0] * nwv[bj][0] * rn, v1 = t[bj][1] * nwv[bj][1] * rn;
                        u32x4 w; w.x = cvt_pk_bf16(v0[0], v0[1]); w.y = cvt_pk_bf16(v0[2], v0[3]); w.z = cvt_pk_bf16(v1[0], v1[1]); w.w = cvt_pk_bf16(v1[2], v1[3]);
                        *(u32x4*)(rowp + bj * 32) = w; } }
        }
    }
};

constexpr int VN_PITCH = 136, YT_PITCH = 132, YT_OFF = 36864;
__device__ __forceinline__ void gmlp_unit(const Frame& F, int chunk, int g) {
    const int tid = F.tid, lane = F.lane, wid = F.wave;
    LAS bf16_t* vn = (LAS bf16_t*)F.lds; LAS float* yt = (LAS float*)(F.lds + YT_OFF);
    const size_t tok0 = (size_t)chunk * 128;
    {
        const int row = tid >> 2, qd = tid & 3; const bf16_t* src = F.UV() + (tok0 + row) * 1024 + 512 + g * 128 + qd * 32;
        u32x4 w[4]; float v[32]; float ss = 0.f;
#pragma unroll
        for (int i = 0; i < 4; ++i) w[i] = *(const u32x4*)(src + 8 * i);
#pragma unroll
        for (int i = 0; i < 4; ++i)
#pragma unroll
            for (int j = 0; j < 4; ++j) { v[8 * i + 2 * j] = bflo(w[i][j]); v[8 * i + 2 * j + 1] = bfhi(w[i][j]); }
#pragma unroll
        for (int i = 0; i < 32; ++i) ss += v[i] * v[i];
        ss += __shfl_xor(ss, 1); ss += __shfl_xor(ss, 2);
        const float rs = 1.0f / sqrtf(ss * (1.0f / 128.0f) + EPS);
        const float* nw = F.sgu_norm_w() + g * 128 + qd * 32;
#pragma unroll
        for (int i = 0; i < 4; ++i) { const f32x4 n0 = *(const f32x4*)(nw + 8 * i), n1 = *(const f32x4*)(nw + 8 * i + 4);
            u32x4 o; o.x = cvt_pk_bf16(v[8 * i] * rs * n0[0], v[8 * i + 1] * rs * n0[1]); o.y = cvt_pk_bf16(v[8 * i + 2] * rs * n0[2], v[8 * i + 3] * rs * n0[3]);
            o.z = cvt_pk_bf16(v[8 * i + 4] * rs * n1[0], v[8 * i + 5] * rs * n1[1]); o.w = cvt_pk_bf16(v[8 * i + 6] * rs * n1[2], v[8 * i + 7] * rs * n1[3]);
            *(LAS u32x4*)(vn + row * VN_PITCH + qd * 32 + 8 * i) = o; }
    }
    __syncthreads();
    {
        const int tb = wid >> 1, cb0 = 2 * (wid & 1), r32 = lane & 31, hh = lane >> 5;
        f32x16 a0 = {}, a1 = {};
        const int t = 32 * tb + r32; const float* wrow = F.sgu_w() + ((size_t)g * 128 + t) * 128;
        for (int ks = 0; ks < 2 * (tb + 1); ++ks) {
            const int s0 = 16 * ks + 8 * hh;
            const f32x4 w0 = *(const f32x4*)(wrow + s0), w1 = *(const f32x4*)(wrow + s0 + 4);
            float wv[8] = {w0[0], w0[1], w0[2], w0[3], w1[0], w1[1], w1[2], w1[3]};
#pragma unroll
            for (int j = 0; j < 8; ++j) if (s0 + j > t) wv[j] = 0.f;
            u32x4 aw; aw.x = cvt_pk_bf16(wv[0], wv[1]); aw.y = cvt_pk_bf16(wv[2], wv[3]); aw.z = cvt_pk_bf16(wv[4], wv[5]); aw.w = cvt_pk_bf16(wv[6], wv[7]);
            const bf16x8 af = __builtin_bit_cast(bf16x8, aw);
            bf16x8 b0, b1;
#pragma unroll
            for (int j = 0; j < 8; ++j) { b0[j] = (short)vn[(s0 + j) * VN_PITCH + 32 * cb0 + r32]; b1[j] = (short)vn[(s0 + j) * VN_PITCH + 32 * (cb0 + 1) + r32]; }
            a0 = __builtin_amdgcn_mfma_f32_32x32x16_bf16(af, b0, a0, 0, 0, 0);
            a1 = __builtin_amdgcn_mfma_f32_32x32x16_bf16(af, b1, a1, 0, 0, 0);
        }
#pragma unroll
        for (int reg = 0; reg < 16; ++reg) {
            const int tt = 32 * tb + (reg & 3) + 8 * (reg >> 2) + 4 * hh; const float bb = F.sgu_b()[g * 128 + tt];
            const bf16_t* up = F.UV() + (tok0 + tt) * 1024 + g * 128;
            const int c0 = 32 * cb0 + r32, c1 = c0 + 32;
            yt[tt * YT_PITCH + c0] = bf2f(up[c0]) * (a0[reg] + bb);
            yt[tt * YT_PITCH + c1] = bf2f(up[c1]) * (a1[reg] + bb);
        }
    }
    __syncthreads();
    {
        const int row = tid >> 2, qd = tid & 3; const LAS float* src = yt + row * YT_PITCH + qd * 32; f32x4 v[8]; float ss = 0.f;
#pragma unroll
        for (int i = 0; i < 8; ++i) { v[i] = *(const LAS f32x4*)(src + 4 * i); ss += (v[i][0] * v[i][0] + v[i][1] * v[i][1]) + (v[i][2] * v[i][2] + v[i][3] * v[i][3]); }
        ss += __shfl_xor(ss, 1); ss += __shfl_xor(ss, 2);
        const float rs = 1.0f / sqrtf(ss * (1.0f / 128.0f) + EPS);
        const float* nw = F.out_norm_a_w() + g * 128 + qd * 32; bf16_t* dst = F.Y() + (tok0 + row) * 1024 + g * 128 + qd * 32;
#pragma unroll
        for (int i = 0; i < 4; ++i) { const f32x4 n0 = *(const f32x4*)(nw + 8 * i), n1 = *(const f32x4*)(nw + 8 * i + 4); const f32x4 x0 = v[2 * i] * n0 * rs, x1 = v[2 * i + 1] * n1 * rs;
            u32x4 o; o.x = cvt_pk_bf16(x0[0], x0[1]); o.y = cvt_pk_bf16(x0[2], x0[3]); o.z = cvt_pk_bf16(x1[0], x1[1]); o.w = cvt_pk_bf16(x1[2], x1[3]);
            *(u32x4*)(dst + 8 * i) = o; }
    }
    __syncthreads();
}

__device__ __forceinline__ void attn_wave_unit(const Frame& F, int b, int h, int qblk, int& cit, int cend, LAS float* scr) {
    const int lane = F.lane, r32 = lane & 31, hi = lane >> 5;
    const size_t tokq = (size_t)b * SEQ + 32 * qblk + r32;
    bf16x8 qr[4];
#pragma unroll
    for (int d0 = 0; d0 < 4; ++d0) qr[d0] = *(const bf16x8*)(F.Q() + tokq * 512 + h * 64 + 16 * d0 + 8 * hi);
    f32x16 o0 = {}, o1 = {};
    float carry = 0.f;
    const bf16_t* Kb = F.K() + ((size_t)b * SEQ + r32) * 512 + h * 64 + 8 * hi;
    const bf16_t* V0 = F.VT() + (size_t)(h * 64 + r32) * NTOK + (size_t)b * SEQ + 4 * hi;
    bf16x8 kf[4]; s16x4 vf[2][2][2];
    auto load_tile = [&](int j, bf16x8 (&kk)[4], s16x4 (&vv)[2][2][2]) {
#pragma unroll
        for (int d0 = 0; d0 < 4; ++d0) kk[d0] = *(const bf16x8*)(Kb + (size_t)(32 * j) * 512 + 16 * d0);
#pragma unroll
        for (int dh = 0; dh < 2; ++dh)
#pragma unroll
            for (int ks = 0; ks < 2; ++ks) { const bf16_t* p = V0 + (size_t)dh * 32 * NTOK + 32 * j + 16 * ks; vv[dh][ks][0] = *(const s16x4*)p; vv[dh][ks][1] = *(const s16x4*)(p + 8); }
    };
    load_tile(qblk, kf, vf);
    for (int j = qblk; j >= 0; --j) {
        bf16x8 kn[4]; s16x4 vn2[2][2][2];
        const bool cv = cit < cend; ConvItem citem; f32x4 cvv[8];
        if (cv) { citem = moe_conv_decode(F, cit); moe_conv_issue(citem, cvv, lane); cit += 2048; }
        if (j > 0) load_tile(j - 1, kn, vn2);
        else {
#pragma unroll
            for (int d0 = 0; d0 < 4; ++d0) kn[d0] = kf[d0];
#pragma unroll
            for (int dh = 0; dh < 2; ++dh)
#pragma unroll
                for (int ks = 0; ks < 2; ++ks) { vn2[dh][ks][0] = vf[dh][ks][0]; vn2[dh][ks][1] = vf[dh][ks][1]; }
        }
        f32x16 s = {};
#pragma unroll
        for (int d0 = 0; d0 < 4; ++d0) s = __builtin_amdgcn_mfma_f32_32x32x16_bf16(kf[d0], qr[d0], s, 0, 0, 0);
        float sp[16];
        const bool diag = (j == qblk);
#pragma unroll
        for (int r = 0; r < 16; ++r) {
            const int kvl = (r & 3) + 8 * (r >> 2) + 4 * hi;
            const float z = s[r];
            float v = fmaxf(z, 0.f) + __builtin_amdgcn_logf(1.0f + __builtin_amdgcn_exp2f(-fabsf(z)));
            if (diag && kvl >= r32) v = 0.f;
            sp[r] = v;
        }
        float G[4], Gp[4];
#pragma unroll
        for (int k = 0; k < 4; ++k) { G[k] = (sp[4 * k] + sp[4 * k + 1]) + (sp[4 * k + 2] + sp[4 * k + 3]); Gp[k] = __shfl_xor(G[k], 32); }
        const float T3 = G[3] + Gp[3], T2 = G[2] + Gp[2], T1 = G[1] + Gp[1], T0 = G[0] + Gp[0];
        float off[4];
        off[3] = 0.f; off[2] = T3; off[1] = T3 + T2; off[0] = T3 + T2 + T1;
        const float tile_total = off[0] + T0;
#pragma unroll
        for (int k = 0; k < 4; ++k) off[k] += carry + (hi == 0 ? Gp[k] : 0.f);
        float a[16];
#pragma unroll
        for (int k = 0; k < 4; ++k) {
            float c = off[k];
#pragma unroll
            for (int i = 3; i >= 0; --i) { const int r = 4 * k + i; c += sp[r]; float av = __builtin_amdgcn_exp2f(s[r] - c);
                if (diag && ((r & 3) + 8 * (r >> 2) + 4 * hi) >= r32) av = 0.f;
                a[r] = av; }
        }
        carry += tile_total;
        u32x4 p0, p1;
        p0.x = cvt_pk_bf16(a[0], a[1]); p0.y = cvt_pk_bf16(a[2], a[3]); p0.z = cvt_pk_bf16(a[4], a[5]); p0.w = cvt_pk_bf16(a[6], a[7]);
        p1.x = cvt_pk_bf16(a[8], a[9]); p1.y = cvt_pk_bf16(a[10], a[11]); p1.z = cvt_pk_bf16(a[12], a[13]); p1.w = cvt_pk_bf16(a[14], a[15]);
        const bf16x8 pf0 = __builtin_bit_cast(bf16x8, p0), pf1 = __builtin_bit_cast(bf16x8, p1);
#define MK_VF(dh, ks) (bf16x8){vf[dh][ks][0][0], vf[dh][ks][0][1], vf[dh][ks][0][2], vf[dh][ks][0][3], vf[dh][ks][1][0], vf[dh][ks][1][1], vf[dh][ks][1][2], vf[dh][ks][1][3]}
        o0 = __builtin_amdgcn_mfma_f32_32x32x16_bf16(MK_VF(0, 0), pf0, o0, 0, 0, 0);
        o0 = __builtin_amdgcn_mfma_f32_32x32x16_bf16(MK_VF(0, 1), pf1, o0, 0, 0, 0);
        o1 = __builtin_amdgcn_mfma_f32_32x32x16_bf16(MK_VF(1, 0), pf0, o1, 0, 0, 0);
        o1 = __builtin_amdgcn_mfma_f32_32x32x16_bf16(MK_VF(1, 1), pf1, o1, 0, 0, 0);
#undef MK_VF
        if (cv) moe_conv_finish(citem, cvv, scr, lane);
        if (__all(carry > SB_THR)) break;
#pragma unroll
        for (int d0 = 0; d0 < 4; ++d0) kf[d0] = kn[d0];
#pragma unroll
        for (int dh = 0; dh < 2; ++dh)
#pragma unroll
            for (int ks = 0; ks < 2; ++ks) { vf[dh][ks][0] = vn2[dh][ks][0]; vf[dh][ks][1] = vn2[dh][ks][1]; }
    }
    float ss = 0.f;
#pragma unroll
    for (int r = 0; r < 16; ++r) ss += o0[r] * o0[r] + o1[r] * o1[r];
    ss += __shfl_xor(ss, 32);
    const float rs = 1.0f / sqrtf(ss * (1.0f / 64.0f) + EPS);
    const float* nw = F.out_norm_b_w() + h * 64 + 4 * hi; bf16_t* dst = F.Y() + tokq * 1024 + 512 + h * 64 + 4 * hi;
#pragma unroll
    for (int dh = 0; dh < 2; ++dh)
#pragma unroll
        for (int g = 0; g < 4; ++g) { const f32x4 w = *(const f32x4*)(nw + 32 * dh + 8 * g); const f32x16& o = dh ? o1 : o0;
            u32x2 pk; pk.x = cvt_pk_bf16(o[4 * g] * rs * w[0], o[4 * g + 1] * rs * w[1]); pk.y = cvt_pk_bf16(o[4 * g + 2] * rs * w[2], o[4 * g + 3] * rs * w[3]);
            *(u32x2*)(dst + 32 * dh + 8 * g) = pk; }
}
__device__ __forceinline__ void p2_mixers(Frame& F) {
    for (int i = 0; i < (MK_REP == 20 ? 8 : 4); ++i) { const int u = (i & 3) * 256 + F.vcu; gmlp_unit(F, u >> 2, u & 3); }
    const int gw = F.vcu * NWAVES + F.wave;
    LAS float* scr = (LAS float*)(F.lds + F.wave * 16384);
    int cit = CONV_P4_ITEMS + gw; const int cend = CONV_P4_ITEMS + CONV_P2_PER_WAVE * 2048;
    for (int i = 0; i < (MK_REP == 21 ? 8 : 4); ++i) { const int u = (i & 3) * 2048 + gw; const int qblk = u & 127, bh = u >> 7; attn_wave_unit(F, bh >> 3, bh & 7, qblk, cit, cend, scr); }
    for (; cit < cend; cit += 2048) { const ConvItem c = moe_conv_decode(F, cit); f32x4 v[8]; moe_conv_issue(c, v, F.lane); moe_conv_finish(c, v, scr, F.lane); }
}

struct ProgOut {
    static constexpr bool GATHER = false, FP8 = false; static constexpr int ID = 3;
    const Frame* F;
    __device__ __forceinline__ bool next(int i, Unit& u) const {
        if (i >= 2) return false;
        const int uu = i * 256 + F->vcu, grp = uu >> 5, w = uu & 31; u.pm = grp * 8 + (w & 7); u.pn = w >> 3; u.kind = 0; u.e = 0; u.r0 = 0;
        u.A = (const char*)(F->Y() + (size_t)u.pm * 256 * KD); u.B = (const char*)(F->WOUT() + (size_t)u.pn * 256 * KD); return true;
    }
    __device__ __forceinline__ void epi(const Acc& acc, const Unit& u, int wr, int wc, int fr, int fq) const {
        asm volatile("" : "+v"(fr), "+v"(fq));
        const size_t off0 = (size_t)(u.pm * 256 + wr * 64 + fr) * DM + u.pn * 256 + wc * 32 + 8 * fq;
        const float* xb = F->x() + off0; float* ob = F->out() + off0;
        f32x4 xv[2][2][2];
#define MK_LDX(g, slot) do { const size_t go_ = (size_t)(((g) >> 2) * 128 + ((g) & 3) * 16) * DM; _Pragma("unroll") for (int bj = 0; bj < 2; ++bj) _Pragma("unroll") for (int n = 0; n < 2; ++n) xv[slot][bj][n] = *(const f32x4*)(xb + go_ + bj * 128 + 4 * n); } while (0)
        MK_LDX(0, 0);
#pragma unroll
        for (int g = 0; g < 8; ++g) { const int ai = g >> 2, m = g & 3; const size_t go = (size_t)(ai * 128 + m * 16) * DM; float ss = 0.f;
            if (g + 1 < 8) MK_LDX(g + 1, (g + 1) & 1);
#pragma unroll
            for (int bj = 0; bj < 2; ++bj)
#pragma unroll
                for (int n = 0; n < 2; ++n) { const f32x4 o = xv[g & 1][bj][n] + acc[ai][bj][m][n];
                    ss += (o[0] * o[0] + o[1] * o[1]) + (o[2] * o[2] + o[3] * o[3]); *(f32x4*)(ob + go + bj * 128 + 4 * n) = o; }
            ss += __shfl_xor(ss, 16); ss += __shfl_xor(ss, 32);
            if (fq == 0) F->SSPART()[(size_t)(u.pm * 256 + ai * 128 + wr * 64 + m * 16 + fr) * 16 + u.pn * 4 + wc] = ss; }
#undef MK_LDX
    }
};

template <bool DRY> __device__ __forceinline__ void router_wave_unit(Frame& F, int unit) {
    const int lane = F.lane, r32 = lane & 31, hh = lane >> 5; const int tok = unit * 32 + r32;
    float ssum = 0.f;
    { const f32x4* sp = (const f32x4*)(F.SSPART() + (size_t)tok * 16);
#pragma unroll
      for (int i = 0; i < 4; ++i) { const f32x4 v = sp[i]; ssum += v[0]; ssum += v[1]; ssum += v[2]; ssum += v[3]; } }
    const float rs = 1.0f / sqrtf(ssum * (1.0f / DM) + EPS);
    f32x16 acc = {};
    const float* xrow = F.out() + (size_t)tok * DM + 8 * hh; const float* w2 = F.norm2_w() + 8 * hh; unsigned char* hrow = F.HB() + (size_t)tok * DM + 8 * hh;
    const bf16_t* rth = F.RT() + (size_t)r32 * KD + 8 * hh; const bf16_t* rtl = rth + NE * KD;
#pragma unroll 4
    for (int s = 0; s < 64; ++s) {
        const f32x4 x0 = *(const f32x4*)(xrow + 16 * s), x1 = *(const f32x4*)(xrow + 16 * s + 4);
        const f32x4 g0 = *(const f32x4*)(w2 + 16 * s), g1 = *(const f32x4*)(w2 + 16 * s + 4);
        const f32x4 h0 = x0 * g0 * rs, h1 = x1 * g1 * rs;
        u32x4 hw; hw.x = cvt_pk_bf16(h0[0], h0[1]); hw.y = cvt_pk_bf16(h0[2], h0[3]); hw.z = cvt_pk_bf16(h1[0], h1[1]); hw.w = cvt_pk_bf16(h1[2], h1[3]);
        { u32x2 h8; h8.x = pk4_fp8(h0[0], h0[1], h0[2], h0[3]); h8.y = pk4_fp8(h1[0], h1[1], h1[2], h1[3]); *(u32x2*)(hrow + 16 * s) = h8; }
        u32x4 lw; lw.x = cvt_pk_bf16(h0[0] - bflo(hw.x), h0[1] - bfhi(hw.x)); lw.y = cvt_pk_bf16(h0[2] - bflo(hw.y), h0[3] - bfhi(hw.y));
        lw.z = cvt_pk_bf16(h1[0] - bflo(hw.z), h1[1] - bfhi(hw.z)); lw.w = cvt_pk_bf16(h1[2] - bflo(hw.w), h1[3] - bfhi(hw.w));
        const bf16x8 bh = __builtin_bit_cast(bf16x8, hw), bl = __builtin_bit_cast(bf16x8, lw);
        const bf16x8 ah = *(const bf16x8*)(rth + 16 * s), al = *(const bf16x8*)(rtl + 16 * s);
        acc = __builtin_amdgcn_mfma_f32_32x32x16_bf16(ah, bh, acc, 0, 0, 0);
        acc = __builtin_amdgcn_mfma_f32_32x32x16_bf16(al, bh, acc, 0, 0, 0);
        acc = __builtin_amdgcn_mfma_f32_32x32x16_bf16(ah, bl, acc, 0, 0, 0);
    }
    float lv[16];
#pragma unroll
    for (int r = 0; r < 16; ++r) lv[r] = acc[r] + F.router_b()[(r & 3) + 8 * (r >> 2) + 4 * hh];
    float cv[8]; int ce[8];
#pragma unroll
    for (int k = 0; k < 4; ++k) { float bv = -INFINITY; int be = 0;
#pragma unroll
        for (int r = 0; r < 16; ++r) { const int e = (r & 3) + 8 * (r >> 2) + 4 * hh; if (lv[r] > bv) { bv = lv[r]; be = e; } }
#pragma unroll
        for (int r = 0; r < 16; ++r) { const int e = (r & 3) + 8 * (r >> 2) + 4 * hh; if (e == be) lv[r] = -INFINITY; }
        cv[k] = bv; ce[k] = be; }
#pragma unroll
    for (int k = 0; k < 4; ++k) { cv[4 + k] = __shfl_xor(cv[k], 32); ce[4 + k] = __shfl_xor(ce[k], 32); }
    float tv[4]; int te[4];
#pragma unroll
    for (int k = 0; k < 4; ++k) { float bv = -INFINITY; int be = 1 << 20;
#pragma unroll
        for (int c = 0; c < 8; ++c) if (cv[c] > bv || (cv[c] == bv && ce[c] < be)) { bv = cv[c]; be = ce[c]; }
#pragma unroll
        for (int c = 0; c < 8; ++c) if (ce[c] == be) cv[c] = -INFINITY;
        tv[k] = bv; te[k] = be; }
    float ex[4], den = 0.f;
#pragma unroll
    for (int k = 0; k < 4; ++k) { ex[k] = __builtin_amdgcn_exp2f((tv[k] - tv[0]) * LOG2E); den += ex[k]; }
    const float rden = 1.0f / den;
    const int e0 = hh ? te[2] : te[0], e1 = hh ? te[3] : te[1]; const float g0 = (hh ? ex[2] : ex[0]) * rden, g1 = (hh ? ex[3] : ex[1]) * rden;
    if (DRY) { asm volatile("" :: "v"(e0), "v"(e1), "v"(g0), "v"(g1)); return; }
    int myc = 0; int rank0 = 0, rank1 = 0;
    const unsigned long long ltmask = (1ull << lane) - 1ull;
    for (int e = 0; e < NE; ++e) {
        const unsigned long long m0 = __ballot(e0 == e), m1 = __ballot(e1 == e);
        const int c0 = __popcll(m0), c1 = __popcll(m1);
        if (lane == e) myc = c0 + c1;
        if (e0 == e) rank0 = __popcll(m0 & ltmask);
        if (e1 == e) rank1 = c0 + __popcll(m1 & ltmask);
    }
    int base = 0;
    if (lane < NE && myc > 0) base = (int)__hip_atomic_fetch_add(F.ctl() + CW_CNT + lane, (unsigned)myc, __ATOMIC_RELAXED, __HIP_MEMORY_SCOPE_AGENT);
    const int p0 = __shfl(base, e0) + rank0, p1 = __shfl(base, e1) + rank1;
    F.LISTTOK()[(size_t)e0 * NTOK + p0] = tok; F.LISTGATE()[(size_t)e0 * NTOK + p0] = g0;
    F.LISTTOK()[(size_t)e1 * NTOK + p1] = tok; F.LISTGATE()[(size_t)e1 * NTOK + p1] = g1;
    F.TOKINFO()[tok * 4 + 2 * hh] = (e0 << 16) | p0; F.TOKINFO()[tok * 4 + 2 * hh + 1] = (e1 << 16) | p1;
}

__device__ __forceinline__ void moe_build_table(Frame& F) {
    LAS int* tab = (LAS int*)(F.lds + TAB_OFF);
    if (F.tid < NE) tab[F.tid] = (int)__hip_atomic_load(F.ctl() + CW_CNT + F.tid, __ATOMIC_RELAXED, __HIP_MEMORY_SCOPE_AGENT);
    __syncthreads();
    if (F.tid == 0) { int acc = 0; for (int e = 0; e < NE; ++e) { tab[32 + e] = acc; acc += (tab[e] + 255) >> 8; } tab[64] = acc; }
    __syncthreads();
}
__device__ __forceinline__ int sgpr(int v) { return __builtin_amdgcn_readfirstlane(v); }
template <int WGM, int NN>
__device__ __forceinline__ bool moe_decode(const Frame* F, int T, int i, Unit& u) {
    const LAS int* tab = (const LAS int*)(F->lds + TAB_OFF);
    const int uu = i * 256 + F->vcu, grp = uu >> 5, w = uu & 31; const int mt = grp * WGM + (w % WGM); u.pn = w / WGM;
    if (mt >= T) return false;
    int e = 0;
    for (int k = 1; k < NE; ++k) if (sgpr(tab[32 + k]) <= mt) e = k;
    u.e = e; u.pm = mt; u.r0 = (mt - sgpr(tab[32 + e])) * 256; u.kind = sgpr(tab[e]); return true;
}
struct ProgMoe1 {
    static constexpr bool GATHER = true, FP8 = true; static constexpr int ID = 5;
    const Frame* F; int T;
    __device__ __forceinline__ bool next(int i, Unit& u) const {
        if (!moe_decode<4, 8>(F, T, i, u)) return false;
        u.A = (const char*)F->HB(); u.B = (const char*)(F->WGU() + ((size_t)u.e * 2048 + (size_t)u.pn * 256) * KD); return true;
    }
    __device__ __forceinline__ void aoffs(const Unit& u, int wid, unsigned (&vo)[2][2]) const {
        const int cnt = u.kind; const int tid = wid * 64 + lane_id_fresh();
#pragma unroll
        for (int i = 0; i < 2; ++i) { int R_, C_; stage_rc(tid * 16 + i * 8192, R_, C_);
#pragma unroll
            for (int h = 0; h < 2; ++h) { const int idx = u.r0 + h * 128 + R_; const int tok = idx < cnt ? F->LISTTOK()[(size_t)u.e * NTOK + idx] : 0; vo[h][i] = (unsigned)(tok * KD + C_ * 2); } }
    }
    __device__ __forceinline__ void epi(const Acc& acc, const Unit& u, int wr, int wc, int fr, int fq) const {
        asm volatile("" : "+v"(fr), "+v"(fq));
        const float* bp = F->b_gate_up() + (size_t)u.e * 2048 + u.pn * 256 + wc * 32 + 8 * fq;
        f32x4 bv[2][2];
#pragma unroll
        for (int bj = 0; bj < 2; ++bj)
#pragma unroll
            for (int n = 0; n < 2; ++n) bv[bj][n] = *(const f32x4*)(bp + bj * 128 + 4 * n);
#pragma unroll
        for (int ai = 0; ai < 2; ++ai)
#pragma unroll
            for (int m = 0; m < 4; ++m) { const size_t slot = (size_t)u.pm * 256 + ai * 128 + wr * 64 + m * 16 + fr; unsigned char* rowp = F->ACT() + slot * 1024 + u.pn * 128 + wc * 16 + 4 * fq;
#pragma unroll
                for (int bj = 0; bj < 2; ++bj) { const f32x4 v0 = acc[ai][bj][m][0] * WSCALE_INV + bv[bj][0], v1 = acc[ai][bj][m][1] * WSCALE_INV + bv[bj][1];
                    float r4[4];
#pragma unroll
                    for (int p = 0; p < 4; ++p) { float gt = (p < 2) ? v0[2 * p] : v1[2 * (p - 2)]; float up = (p < 2) ? v0[2 * p + 1] : v1[2 * (p - 2) + 1];
                        gt = fminf(gt, 7.0f); up = fminf(fmaxf(up, -7.0f), 7.0f);
                        const float glu = gt * __builtin_amdgcn_rcpf(1.0f + __builtin_amdgcn_exp2f(-1.702f * LOG2E * gt)); r4[p] = (up + 1.0f) * glu; }
                    *(unsigned*)(rowp + bj * 64) = pk4_fp8(r4[0], r4[1], r4[2], r4[3]); } }
    }
};
struct ProgMoe2 {
    static constexpr bool GATHER = false, FP8 = true; static constexpr int ID = 6;
    const Frame* F; int T;
    __device__ __forceinline__ bool next(int i, Unit& u) const {
        if (!moe_decode<8, 4>(F, T, i, u)) return false;
        u.A = (const char*)(F->ACT() + (size_t)u.pm * 256 * KD); u.B = (const char*)(F->WD() + ((size_t)u.e * 1024 + (size_t)u.pn * 256) * KD); return true;
    }
    __device__ __forceinline__ void epi(const Acc& acc, const Unit& u, int wr, int wc, int fr, int fq) const {
        asm volatile("" : "+v"(fr), "+v"(fq));
        const int cnt = u.kind;
        const float* bp = F->b_down() + (size_t)u.e * 1024 + u.pn * 256 + wc * 32 + 8 * fq;
        f32x4 bv[2][2];
#pragma unroll
        for (int bj = 0; bj < 2; ++bj)
#pragma unroll
            for (int n = 0; n < 2; ++n) bv[bj][n] = *(const f32x4*)(bp + bj * 128 + 4 * n);
#pragma unroll
        for (int ai = 0; ai < 2; ++ai) {
            float gt[4];
#pragma unroll
            for (int m = 0; m < 4; ++m) { const int idx = u.r0 + ai * 128 + wr * 64 + m * 16 + fr; gt[m] = idx < cnt ? F->LISTGATE()[(size_t)u.e * NTOK + idx] : 0.f; }
#pragma unroll
            for (int m = 0; m < 4; ++m) { const int rl = ai * 128 + wr * 64 + m * 16 + fr; const float gate = gt[m] * YSCALE;
                unsigned char* rowp = F->YS() + ((size_t)u.pm * 256 + rl) * 1024 + u.pn * 256 + wc * 32 + 8 * fq;
#pragma unroll
                for (int bj = 0; bj < 2; ++bj) { const f32x4 v0 = (acc[ai][bj][m][0] * WSCALE_INV + bv[bj][0]) * gate, v1 = (acc[ai][bj][m][1] * WSCALE_INV + bv[bj][1]) * gate;
                    u32x2 w; w.x = pk4_fp8(v0[0], v0[1], v0[2], v0[3]); w.y = pk4_fp8(v1[0], v1[1], v1[2], v1[3]);
                    *(u32x2*)(rowp + bj * 128) = w; } }
        }
    }
};

template <bool DRY> __device__ __forceinline__ void p7_combine(Frame& F) {
    const LAS int* tab = (const LAS int*)(F.lds + TAB_OFF);
    const int gw = F.vcu * NWAVES + F.wave, NGW = F.G * NWAVES, lane = F.lane;
    for (int tok = gw; tok < NTOK; tok += NGW) {
        f32x4* orow = (f32x4*)(F.out() + (size_t)tok * DM) + lane; f32x4 v[4];
#pragma unroll
        for (int j = 0; j < 4; ++j) v[j] = orow[64 * j];
#pragma unroll
        for (int k = 0; k < 4; ++k) { const int info = F.TOKINFO()[tok * 4 + k]; const int e = info >> 16, pos = info & 0xffff; const size_t slot = (size_t)tab[32 + e] * 256 + pos;
            const unsigned* yr = (const unsigned*)(F.YS() + slot * 1024) + lane;
#pragma unroll
            for (int j = 0; j < 4; ++j) { const unsigned w = yr[64 * j]; const f32x2 lo = __builtin_amdgcn_cvt_pk_f32_fp8((int)w, false), hi = __builtin_amdgcn_cvt_pk_f32_fp8((int)w, true);
                v[j][0] += lo[0] * YSCALE_INV; v[j][1] += lo[1] * YSCALE_INV; v[j][2] += hi[0] * YSCALE_INV; v[j][3] += hi[1] * YSCALE_INV; } }
        f32x4* wrow = DRY ? (f32x4*)((float*)(F.ws() + WS_EARLY) + (size_t)tok * DM) + lane : orow;
#pragma unroll
        for (int j = 0; j < 4; ++j) wrow[64 * j] = v[j];
    }
}

__global__ void __launch_bounds__(NWAVES * 64, 2) mk_fwd(Args args) {
    extern __shared__ __attribute__((aligned(16))) unsigned char lds_raw[];
    Frame F;
    F.lds = (LAS unsigned char*)lds_raw;
    F.tid = threadIdx.x; F.lane = F.tid & 63; F.wave = __builtin_amdgcn_readfirstlane(F.tid >> 6);
    F.G = gridDim.x; { const int bx = blockIdx.x; F.vcu = (bx % 8) * (F.G / 8) + bx / 8; }
    F.ka = (const CAS Args*)__builtin_amdgcn_kernarg_segment_ptr();
    for (int u = F.tid; u < (LDS_BYTES - LDSCTL_OFF) / 4; u += NWAVES * 64) ((LAS unsigned*)(F.lds + LDSCTL_OFF))[u] = 0u;
    __syncthreads();
    XcdBarrier bar = xcd_barrier_post(F.ctl() + CW_BAR, (volatile LAS unsigned*)(F.lds + MISC_OFF) + 8);
    const int lo = F.ka->ph_lo, hi = F.ka->ph_hi;
#define IN(k) (lo <= (k) && (k) < hi)
#define REFRESH() do { int l_ = lane_id(); asm volatile("" : "+v"(l_)); F.lane = l_; F.tid = F.wave * 64 + l_; } while (0)
#define SEAM(k) do { if (IN(k) && IN((k) + 1)) xcd_barrier(bar, F.wave); } while (0)
    if (IN(0)) { REFRESH(); p0_prologue(F); if (MK_REP == 0) p0_prologue(F); } SEAM(0);
    if (IN(1)) { { ProgIn P{&F}; gemm_phase(F.lds, P); } if (MK_REP == 1) { ProgIn P{&F}; gemm_phase(F.lds, P); } } SEAM(1);
    if (IN(2)) { REFRESH(); p2_mixers(F); if (MK_REP == 2) p2_mixers(F); } SEAM(2);
    if (IN(3)) { { ProgOut P{&F}; gemm_phase(F.lds, P); } if (MK_REP == 3) { ProgOut P{&F}; gemm_phase(F.lds, P); } } SEAM(3);
    if (IN(4)) { REFRESH(); if (F.wave < 4) { if (MK_REP == 4) router_wave_unit<true>(F, F.wave * 256 + F.vcu); router_wave_unit<false>(F, F.wave * 256 + F.vcu); }
                 else { LAS float* scr = (LAS float*)(F.lds + F.wave * 16384); const int cw = F.vcu * 4 + (F.wave - 4);
                        ConvItem ca = moe_conv_decode(F, cw); f32x4 va[8], vb[8]; moe_conv_issue(ca, va, F.lane);
                        for (int j = 0; j < CONV_P4_PER_WAVE; j += 2) {
                            const ConvItem cb = moe_conv_decode(F, (j + 1) * 1024 + cw); moe_conv_issue(cb, vb, F.lane);
                            moe_conv_finish(ca, va, scr, F.lane);
                            if (j + 2 < CONV_P4_PER_WAVE) { ca = moe_conv_decode(F, (j + 2) * 1024 + cw); moe_conv_issue(ca, va, F.lane); }
                            moe_conv_finish(cb, vb, scr, F.lane); } } } SEAM(4);
    if (lo <= 7 && hi > 5) { REFRESH(); moe_build_table(F); }
    if (IN(5)) { { ProgMoe1 P{&F, sgpr(((const LAS int*)(F.lds + TAB_OFF))[64])}; gemm_phase(F.lds, P); } if (MK_REP == 5) { ProgMoe1 P{&F, sgpr(((const LAS int*)(F.lds + TAB_OFF))[64])}; gemm_phase(F.lds, P); } } SEAM(5);
    if (IN(6)) { { ProgMoe2 P{&F, sgpr(((const LAS int*)(F.lds + TAB_OFF))[64])}; gemm_phase(F.lds, P); } if (MK_REP == 6) { ProgMoe2 P{&F, sgpr(((const LAS int*)(F.lds + TAB_OFF))[64])}; gemm_phase(F.lds, P); } } SEAM(6);
    if (IN(7)) { REFRESH(); if (MK_REP == 7) p7_combine<true>(F); p7_combine<false>(F); }
#undef IN
#undef SEAM
}
}
#ifndef MK_CUT
#define MK_CUT 8
#endif
extern "C" void kernel_launch(void* const* d_in, const int* in_sizes, int n_in, void* d_out, int out_size, void* d_ws, size_t ws_size, hipStream_t stream) {
    static int ready = 0;
    if (ready == 0) {
        if (n_in != 18 || out_size != mk::NTOK * mk::DM || ws_size < mk::WS_END) { fprintf(stderr, "kernel_launch: unexpected problem (n_in %d out %d ws %zu)\n", n_in, out_size, ws_size); ready = -1; return; }
        if (hipFuncSetAttribute((const void*)mk::mk_fwd, hipFuncAttributeMaxDynamicSharedMemorySize, mk::LDS_BYTES) != hipSuccess) { fprintf(stderr, "kernel_launch: hipFuncSetAttribute failed\n"); ready = -1; return; }
        ready = 1;
    }
    if (ready < 0) return;
    (void)hipMemsetAsync((char*)d_ws + mk::WS_CTL, 0, mk::CTL_ZERO_BYTES, stream);
    mk::Args a{};
    for (int i = 0; i < 18; ++i) a.in[i] = (const float*)d_in[i];
    a.out = (float*)d_out; a.ws = (unsigned char*)d_ws; a.ph_lo = 0; a.ph_hi = MK_CUT;
    hipLaunchKernelGGL(mk::mk_fwd, dim3(256), dim3(mk::NWAVES * 64), mk::LDS_BYTES, stream, a);
#if MK_CUT < 8
    {
        using namespace nv;
        const float* x = (const float*)d_in[0]; const float* w_out = (const float*)d_in[10]; const float* norm2_w = (const float*)d_in[11];
        const float* router_w = (const float*)d_in[12]; const float* router_b = (const float*)d_in[13]; const float* w_gate_up = (const float*)d_in[14];
        const float* b_gate_up = (const float*)d_in[15]; const float* w_down = (const float*)d_in[16]; const float* b_down = (const float*)d_in[17];
        float* out = (float*)d_out; char* ws = (char*)d_ws; const size_t MiB = 1u << 20;
        int* cnt = (int*)ws + mk::CW_CNT; int* list_tok = (int*)(ws + mk::WS_LISTTOK); float* list_gate = (float*)(ws + mk::WS_LISTGATE);
        float* hn = (float*)(ws + 16 * MiB); float* gu = (float*)(ws + 272 * MiB); float* act = (float*)(ws + (272 + 256) * MiB);
#if MK_CUT <= 3
        k_gemm<1, true><<<dim3(DM / 64, NTOK / 64), 256, 0, stream>>>((const void*)(ws + mk::WS_Y), nullptr, nullptr, nullptr, w_out, nullptr, x, nullptr, out, NTOK, DM, DM, DM, DM);
#endif
#if MK_CUT <= 4
        k_router<<<NTOK, 256, 0, stream>>>(out, norm2_w, router_w, router_b, hn, cnt, list_tok, list_gate);
#else
        k_bf2f<<<4096, 256, 0, stream>>>((const unsigned short*)(ws + mk::WS_HB), hn, (size_t)NTOK * DM);
#endif
        for (int e = 0; e < NE; ++e) {
            const int* lt = list_tok + (size_t)e * NTOK; const float* lgp = list_gate + (size_t)e * NTOK;
            k_gemm<0, false><<<dim3(2 * DFF / 64, NTOK / 64), 256, 0, stream>>>(hn, lt, nullptr, cnt + e, w_gate_up + (size_t)e * DM * 2 * DFF, b_gate_up + (size_t)e * 2 * DFF, nullptr, nullptr, gu, NTOK, 2 * DFF, DM, DM, 2 * DFF);
            k_swiglu<<<NTOK, 256, 0, stream>>>(gu, cnt + e, act);
            k_gemm<3, false><<<dim3(DM / 64, NTOK / 64), 256, 0, stream>>>(act, nullptr, lt, cnt + e, w_down + (size_t)e * DFF * DM, b_down + (size_t)e * DM, nullptr, lgp, out, NTOK, DM, DFF, DFF, DM);
        }
    }
#endif
}
```

```cpp
#include <hip/hip_runtime.h>
#include <cstdio>
#include <cstdint>
#ifndef MK_REP
#define MK_REP -1
#endif
namespace mk {
#define LAS __attribute__((address_space(3)))
#define GAS __attribute__((address_space(1)))
typedef unsigned short bf16_t;
typedef short bf16x8 __attribute__((ext_vector_type(8)));
typedef short s16x4 __attribute__((ext_vector_type(4)));
typedef float f32x4 __attribute__((ext_vector_type(4)));
typedef float f32x2 __attribute__((ext_vector_type(2)));
typedef float f32x16 __attribute__((ext_vector_type(16)));
typedef unsigned u32x4 __attribute__((ext_vector_type(4)));
typedef unsigned u32x2 __attribute__((ext_vector_type(2)));
typedef int i32x4 __attribute__((ext_vector_type(4)));
typedef int i32x8 __attribute__((ext_vector_type(8)));

constexpr int NTOK = 32768, DM = 1024, SEQ = 4096, NB = 8, NH = 8, HD = 64, NE = 32, DFF = 1024, KD = 1024;
constexpr float EPS = 1e-5f;
constexpr float LOG2E = 1.4426950408889634f;
constexpr float QSCALE = 0.125f * LOG2E;
constexpr float SB_THR = 64.0f;
constexpr int NWAVES = 8;
constexpr int SLOTS = NTOK * 4 + NE * 256;

constexpr size_t MiB = 1u << 20;
constexpr size_t WS_CTL = 0, CTL_ZERO_BYTES = 1 * MiB;
constexpr size_t WS_LISTTOK = 1 * MiB;
constexpr size_t WS_LISTGATE = 5 * MiB;
constexpr size_t WS_TOKINFO = 9 * MiB;
constexpr size_t WS_RSTD1 = 10 * MiB;
constexpr size_t WS_SSPART = 11 * MiB;
constexpr size_t WS_RT = 13 * MiB;
constexpr size_t WS_WGU = 16 * MiB;
constexpr size_t WS_WD = 80 * MiB;
constexpr size_t WS_HB = 112 * MiB;
constexpr size_t WS_YS = 144 * MiB;
constexpr size_t WS_EARLY = 416 * MiB;
constexpr size_t WS_XB = WS_EARLY;
constexpr size_t WS_WIN = WS_EARLY + 64 * MiB;
constexpr size_t WS_WOUT = WS_EARLY + 70 * MiB;
constexpr size_t WS_UV = WS_EARLY + 72 * MiB;
constexpr size_t WS_Q = WS_EARLY + 136 * MiB;
constexpr size_t WS_K = WS_EARLY + 168 * MiB;
constexpr size_t WS_VT = WS_EARLY + 200 * MiB;
constexpr size_t WS_Y = WS_EARLY + 232 * MiB;
constexpr size_t WS_ACT = WS_EARLY;
constexpr size_t WS_END = WS_EARLY + 296 * MiB;
constexpr float WSCALE = 32.0f, WSCALE_INV = 1.0f / 32.0f;
constexpr float YSCALE = 16.0f, YSCALE_INV = 1.0f / 16.0f;
constexpr int CW_CNT = 64;
constexpr int CW_BAR = 4096;

constexpr int RING_BYTES = 131072;
constexpr int LDSCTL_OFF = RING_BYTES, MISC_OFF = LDSCTL_OFF + 320, TAB_OFF = LDSCTL_OFF + 1024;
constexpr int LDS_BYTES = 147456;

__device__ __forceinline__ unsigned cvt_pk_bf16(float lo, float hi) { unsigned r; asm volatile("v_cvt_pk_bf16_f32 %0, %1, %2" : "=v"(r) : "v"(lo), "v"(hi)); return r; }
__device__ __forceinline__ unsigned pk4_fp8(float a, float b, float c, float d) { unsigned w = 0u; w = (unsigned)__builtin_amdgcn_cvt_pk_fp8_f32(a, b, (int)w, false); w = (unsigned)__builtin_amdgcn_cvt_pk_fp8_f32(c, d, (int)w, true); return w; }
__device__ __forceinline__ float bf2f(unsigned short h) { return __uint_as_float((unsigned)h << 16); }
__device__ __forceinline__ float bflo(unsigned w) { return __uint_as_float(w << 16); }
__device__ __forceinline__ float bfhi(unsigned w) { return __uint_as_float(w & 0xffff0000u); }
__device__ __forceinline__ int lane_id() { return (int)__builtin_amdgcn_mbcnt_hi(~0u, __builtin_amdgcn_mbcnt_lo(~0u, 0u)); }
__device__ __forceinline__ int lane_id_fresh() { int l; asm volatile("v_mbcnt_lo_u32_b32 %0, -1, 0\n\tv_mbcnt_hi_u32_b32 %0, -1, %0" : "=v"(l)); return l; }
__device__ __forceinline__ float wave_sum(float v) {
#pragma unroll
    for (int o = 1; o < 64; o <<= 1) v += __shfl_xor(v, o);
    return v;
}
__device__ __forceinline__ float gelu_tanh_f(float x) {
    const float u = 0.7978845608028654f * (x + 0.044715f * x * x * x);
    return x * __builtin_amdgcn_rcpf(1.0f + __builtin_amdgcn_exp2f(-2.0f * LOG2E * u));
}

constexpr int BM = 256, BK = 64, HALF = 128, HTB = HALF * BK * 2;
__device__ __forceinline__ int lds_byte(int r, int c) { const int st = (r >> 4) * 2 + (c >> 5), rr = r & 15, cc = c & 31, ob = rr * 64 + cc * 2; return st * 1024 + (ob ^ (((ob >> 9) & 1) << 5)); }
__device__ __forceinline__ void stage_rc(int b, int& R, int& C) { const int st = b / 1024, sb = b % 1024, swz = sb ^ (((sb >> 9) & 1) << 5); R = (st >> 1) * 16 + swz / 64; C = (st & 1) * 32 + (swz % 64) / 2; }
__device__ __forceinline__ int perm32(int rho) { const int n = rho >> 4, i = rho & 15; return 8 * (i >> 2) + 4 * n + (i & 3); }

struct Unit { const char* A; const char* B; int kind, pm, pn, e, r0; };

template <class Prog>
__device__ __forceinline__ void gemm_phase(LAS unsigned char* lds, const Prog& P) {
    const int wid = P.F->wave, lane = lane_id(), tid = wid * 64 + lane, wr = wid >> 2, wc = wid & 3;
    constexpr bool F8 = Prog::FP8;
    constexpr int K = KD, ESZ = F8 ? 1 : 2, nt = F8 ? K / 128 : K / BK;
    unsigned voffB[2];
#pragma unroll
    for (int i = 0; i < 2; ++i) { int R_, C_; stage_rc(tid * 16 + i * 8192, R_, C_); const int Rb = (R_ & ~31) + perm32(R_ & 31); voffB[i] = (unsigned)(Rb * K * ESZ + C_ * 2); }
    constexpr size_t kstep = (size_t)(BK * 2);
    constexpr size_t hstep = (size_t)HALF * K * ESZ;
    const unsigned ldsw = (unsigned)wid * 1024u;
    const int aoff = lds_byte(wr * 64 + (lane & 15), F8 ? (lane >> 4) * 16 : (lane >> 4) * 8), boff = lds_byte(wc * 32 + (lane & 15), F8 ? (lane >> 4) * 16 : (lane >> 4) * 8);
    constexpr int KOFF = F8 ? 16 : 1024;
#define MK_SA(b, h) (((b) * 2 + (h)) * HTB)
#define MK_SB(b, h) ((4 + (b) * 2 + (h)) * HTB)
#define MK_STAGE(bufoff, gbase, voff) do { _Pragma("unroll") for (int _i = 0; _i < 2; ++_i) { unsigned o_ = (voff)[_i]; asm volatile("" : "+v"(o_));     \
        __builtin_amdgcn_global_load_lds((const unsigned*)((const char*)(gbase) + o_), (LAS unsigned*)(lds + (bufoff) + ldsw + _i * 8192), 16, 0, 0); } } while (0)
#define MK_STAGE_A(bufoff, gbase, h) do { if constexpr (GA) MK_STAGE(bufoff, gbase, voC[h]); else MK_STAGE(bufoff, (gbase) + (h) * hstep, voC[0]); } while (0)
#define MK_LDA(dst, b, h) do { _Pragma("unroll") for (int m = 0; m < 4; ++m) _Pragma("unroll") for (int k = 0; k < 2; ++k) dst[m][k] = *(const LAS bf16x8*)(lds + MK_SA(b, h) + aoff + m * 2048 + k * KOFF); } while (0)
#define MK_LDB(dst, b, h) do { _Pragma("unroll") for (int n = 0; n < 2; ++n) _Pragma("unroll") for (int k = 0; k < 2; ++k) dst[n][k] = *(const LAS bf16x8*)(lds + MK_SB(b, h) + boff + n * 2048 + k * KOFF); } while (0)
#define MK_CAT8(x) __builtin_shufflevector(__builtin_bit_cast(i32x4, (x)[0]), __builtin_bit_cast(i32x4, (x)[1]), 0, 1, 2, 3, 4, 5, 6, 7)
#define MK_MMA(ai, bj, At, Bt) do { __builtin_amdgcn_s_setprio(1); \
        if constexpr (F8) { _Pragma("unroll") for (int m = 0; m < 4; ++m) _Pragma("unroll") for (int n = 0; n < 2; ++n) \
            acc[ai][bj][m][n] = __builtin_amdgcn_mfma_scale_f32_16x16x128_f8f6f4(MK_CAT8(Bt[n]), MK_CAT8(At[m]), acc[ai][bj][m][n], 0, 0, 0, 0, 0, 0); } \
        else { _Pragma("unroll") for (int m = 0; m < 4; ++m) _Pragma("unroll") for (int n = 0; n < 2; ++n) _Pragma("unroll") for (int k = 0; k < 2; ++k) \
            acc[ai][bj][m][n] = __builtin_amdgcn_mfma_f32_16x16x32_bf16(Bt[n][k], At[m][k], acc[ai][bj][m][n], 0, 0, 0); } \
        __builtin_amdgcn_s_setprio(0); } while (0)
#define MK_WAIT_V(n) asm volatile("s_waitcnt vmcnt(" #n ")" ::: "memory")
#define MK_WAIT_L(n) asm volatile("s_waitcnt lgkmcnt(" #n ")" ::: "memory")
#define MK_BAR __builtin_amdgcn_s_barrier()
#define MK_SCHED __builtin_amdgcn_sched_barrier(0)
    Unit cur, nxt; int ui = 0;
    if (!P.next(0, cur)) return;
    constexpr bool GA = Prog::GATHER;
    unsigned voC[2][2];
    if constexpr (GA) P.aoffs(cur, wid, voC);
    else {
#pragma unroll
        for (int i = 0; i < 2; ++i) { int R_, C_; stage_rc(tid * 16 + i * 8192, R_, C_); voC[0][i] = (unsigned)(R_ * K * ESZ + C_ * 2); voC[1][i] = 0u; }
    }
    f32x4 acc[2][2][4][2];
#pragma unroll
    for (int a = 0; a < 2; ++a)
#pragma unroll
        for (int b = 0; b < 2; ++b)
#pragma unroll
            for (int m = 0; m < 4; ++m)
#pragma unroll
                for (int n = 0; n < 2; ++n) acc[a][b][m][n] = (f32x4){0.f, 0.f, 0.f, 0.f};
    bf16x8 At[4][2], B0[2][2], B1[2][2];
    const char* cA = cur.A; const char* cB = cur.B;
    MK_STAGE(MK_SB(0, 0), cB, voffB); MK_STAGE(MK_SB(0, 1), cB + hstep, voffB); MK_STAGE_A(MK_SA(0, 0), cA, 0); MK_STAGE_A(MK_SA(0, 1), cA, 1);
    if (wr == 1) MK_BAR;
    MK_WAIT_V(2); MK_BAR;
    MK_STAGE(MK_SB(1, 0), cB + kstep, voffB); MK_STAGE_A(MK_SA(1, 0), cA + kstep, 0); MK_STAGE(MK_SB(1, 1), cB + hstep + kstep, voffB);
    MK_WAIT_V(6); MK_BAR;
    for (;;) {
        const bool has_next = P.next(ui + 1, nxt);
        if (!has_next) nxt = cur;
        const char* nA = nxt.A; const char* nB = nxt.B;
#pragma unroll 1
        for (int t = 0; t < nt; t += 2) {
            const bool last = (t == nt - 2);
            const char* a1 = cA + (size_t)(t + 1) * kstep;
            const char* a2 = last ? nA : cA + (size_t)(t + 2) * kstep; const char* b2 = last ? nB : cB + (size_t)(t + 2) * kstep;
            const char* a3 = a2 + kstep; const char* b3 = b2 + kstep;
            MK_LDB(B0, 0, 0); MK_LDB(B1, 0, 1); MK_SCHED; MK_LDA(At, 0, 0); MK_STAGE_A(MK_SA(1, 1), a1, 1);
            if constexpr (GA) { if (last && has_next) P.aoffs(nxt, wid, voC); }
            MK_WAIT_V(8); MK_WAIT_L(0); MK_BAR; MK_MMA(0, 0, At, B0); MK_MMA(0, 1, At, B1); MK_BAR; MK_SCHED;
            MK_LDA(At, 0, 1); MK_STAGE(MK_SB(0, 0), b2, voffB); MK_STAGE(MK_SB(0, 1), b2 + hstep, voffB); MK_STAGE_A(MK_SA(0, 0), a2, 0);
            MK_WAIT_V(8); MK_WAIT_L(0); MK_BAR; MK_MMA(1, 0, At, B0); MK_MMA(1, 1, At, B1); MK_BAR; MK_SCHED;
            MK_LDB(B0, 1, 0); MK_LDB(B1, 1, 1); MK_SCHED; MK_LDA(At, 1, 0); MK_STAGE_A(MK_SA(0, 1), a2, 1);
            MK_WAIT_V(8); MK_WAIT_L(0); MK_BAR; MK_MMA(0, 0, At, B0); MK_MMA(0, 1, At, B1); MK_BAR; MK_SCHED;
            MK_LDA(At, 1, 1); MK_STAGE(MK_SB(1, 0), b3, voffB); MK_STAGE(MK_SB(1, 1), b3 + hstep, voffB); MK_STAGE_A(MK_SA(1, 0), a3, 0);
            MK_WAIT_V(8); MK_WAIT_L(0); MK_BAR; MK_MMA(1, 0, At, B0); MK_MMA(1, 1, At, B1); MK_BAR; MK_SCHED;
        }
        if (wr == 0) MK_BAR;
        { const int l_ = lane_id_fresh(); P.epi(acc, cur, wr, wc, l_ & 15, l_ >> 4); }
#ifdef MK_EPI2
        if (Prog::ID == MK_EPI2) { const int l_ = lane_id_fresh(); P.epi(acc, cur, wr, wc, l_ & 15, l_ >> 4); }
#endif
        if (!has_next) break;
#pragma unroll
        for (int a = 0; a < 2; ++a)
#pragma unroll
            for (int b = 0; b < 2; ++b)
#pragma unroll
                for (int m = 0; m < 4; ++m)
#pragma unroll
                    for (int n = 0; n < 2; ++n) acc[a][b][m][n] = (f32x4){0.f, 0.f, 0.f, 0.f};
        cur = nxt; cA = nA; cB = nB; ++ui;
        if (wr == 1) MK_BAR;
    }
    MK_WAIT_V(0);
    MK_BAR;
#undef MK_SA
#undef MK_SB
#undef MK_STAGE
#undef MK_STAGE_A
#undef MK_LDA
#undef MK_LDB
#undef MK_MMA
#undef MK_CAT8
}
typedef f32x4 Acc[2][2][4][2];

#define XB_TMO      128
#define XB_XCNT(j)  (256  + 64 * (j))
#define XB_XSUB(j)  (1280 + 64 * (j))
#define XB_XGEN(j)  (2304 + 64 * (j))
#define XB_TOP      3328
#define XB_TOPGEN   3392
#define XCD_BAR_WORDS 3456
#define XB_SPIN_CAP (1u << 18)
__device__ __forceinline__ unsigned xb_ld(unsigned* p)              { return __hip_atomic_load(p, __ATOMIC_RELAXED, __HIP_MEMORY_SCOPE_AGENT); }
__device__ __forceinline__ unsigned xb_add(unsigned* p, unsigned v) { return __hip_atomic_fetch_add(p, v, __ATOMIC_RELAXED, __HIP_MEMORY_SCOPE_AGENT); }
__device__ __forceinline__ unsigned xb_xcc_id() { return (unsigned)__builtin_amdgcn_s_getreg((3 << 11) | 20) & 0xFu; }
#define XB_SPIN(cond, bar) do { unsigned _sp = 0; while (cond) { __builtin_amdgcn_s_sleep(1); \
    if ((++_sp & 255u) == 0u) { if (xb_ld(&(bar)[XB_TMO])) break; if (_sp > XB_SPIN_CAP) { atomicAdd(&(bar)[XB_TMO], 1u); break; } } } } while (0)
struct XcdBarrier { unsigned* bar; unsigned x; volatile LAS unsigned* st; };
__device__ __forceinline__ XcdBarrier xcd_barrier_post(unsigned* bar, volatile LAS unsigned* st) {
    XcdBarrier b; b.bar = bar; b.x = xb_xcc_id(); b.st = st;
    if (threadIdx.x == 0) (void)xb_add(&bar[XB_XCNT(b.x)], 1u);
    return b;
}
__device__ __forceinline__ void xcd_barrier_complete(unsigned* bar, unsigned x, unsigned& nloc, unsigned& nx) {
    const unsigned G = gridDim.x * gridDim.y * gridDim.z;
    unsigned sum, cnt, mine, sp = 0u;
    for (;;) {
        sum = 0u; cnt = 0u; mine = 0u;
#pragma unroll
        for (unsigned j = 0; j < 16; ++j) { const unsigned c = xb_ld(&bar[XB_XCNT(j)]); sum += c; cnt += (c > 0u) ? 1u : 0u; mine = (j == x) ? c : mine; }
        if (sum == G) break;
        __builtin_amdgcn_s_sleep(1);
        if ((++sp & 255u) == 0u) { if (xb_ld(&bar[XB_TMO])) break; if (sp > XB_SPIN_CAP) { atomicAdd(&bar[XB_TMO], 1u); break; } }
    }
    nloc = mine > 0u ? mine : 1u; nx = cnt > 0u ? cnt : 1u;
}
__device__ __forceinline__ void xcd_barrier(const XcdBarrier& b, int wave) {
    asm volatile("s_waitcnt vmcnt(0)" ::: "memory");
    __syncthreads();
    if (wave == 0 && lane_id() == 0) {
        unsigned* bar = b.bar;
        __builtin_amdgcn_s_waitcnt(0);
        unsigned nloc = b.st[0], nx = b.st[1];
        if (nloc == 0u) { xcd_barrier_complete(bar, b.x, nloc, nx); b.st[0] = nloc; b.st[1] = nx; }
        const unsigned old = xb_add(&bar[XB_XSUB(b.x)], 1u);
        const unsigned gen = old / nloc;
        if (old + 1u == (gen + 1u) * nloc) {
            __builtin_amdgcn_fence(__ATOMIC_RELEASE, "agent");
            asm volatile("s_waitcnt vmcnt(0)" ::: "memory");
            const unsigned og = xb_add(&bar[XB_TOP], 1u);
            const unsigned tg = og / nx;
            if (og + 1u == (tg + 1u) * nx) xb_add(&bar[XB_TOPGEN], 1u);
            else XB_SPIN(xb_ld(&bar[XB_TOPGEN]) == tg, bar);
            __builtin_amdgcn_fence(__ATOMIC_ACQUIRE, "agent");
            xb_add(&bar[XB_XGEN(b.x)], 1u);
            asm volatile("s_waitcnt vmcnt(0)" ::: "memory");
        } else {
            XB_SPIN(xb_ld(&bar[XB_XGEN(b.x)]) == gen, bar);
            __builtin_amdgcn_fence(__ATOMIC_ACQUIRE, "agent");
            asm volatile("s_waitcnt vmcnt(0)" ::: "memory");
        }
    }
    __syncthreads();
}

struct Args {
    const float* in[18]; float* out; unsigned char* ws; int ph_lo, ph_hi;
};
#define CAS __attribute__((address_space(4)))
struct Frame {
    LAS unsigned char* lds; int tid, lane, wave, vcu, G;
    const CAS Args* ka;
    __device__ __forceinline__ const float* inp(int k) const { return ka->in[k]; }
    __device__ __forceinline__ unsigned char* ws() const { return ka->ws; }
    __device__ __forceinline__ float* out() const { return ka->out; }
    __device__ __forceinline__ const float* x() const { return inp(0); }
    __device__ __forceinline__ const float* norm1_w() const { return inp(1); }
    __device__ __forceinline__ const float* w_in() const { return inp(2); }
    __device__ __forceinline__ const float* sgu_norm_w() const { return inp(3); }
    __device__ __forceinline__ const float* sgu_w() const { return inp(4); }
    __device__ __forceinline__ const float* sgu_b() const { return inp(5); }
    __device__ __forceinline__ const float* q_norm_w() const { return inp(6); }
    __device__ __forceinline__ const float* k_norm_w() const { return inp(7); }
    __device__ __forceinline__ const float* out_norm_a_w() const { return inp(8); }
    __device__ __forceinline__ const float* out_norm_b_w() const { return inp(9); }
    __device__ __forceinline__ const float* w_out() const { return inp(10); }
    __device__ __forceinline__ const float* norm2_w() const { return inp(11); }
    __device__ __forceinline__ const float* router_w() const { return inp(12); }
    __device__ __forceinline__ const float* router_b() const { return inp(13); }
    __device__ __forceinline__ const float* w_gate_up() const { return inp(14); }
    __device__ __forceinline__ const float* b_gate_up() const { return inp(15); }
    __device__ __forceinline__ const float* w_down() const { return inp(16); }
    __device__ __forceinline__ const float* b_down() const { return inp(17); }
    __device__ __forceinline__ bf16_t* XB() const { return (bf16_t*)(ws() + WS_XB); }
    __device__ __forceinline__ bf16_t* WIN() const { return (bf16_t*)(ws() + WS_WIN); }
    __device__ __forceinline__ bf16_t* WOUT() const { return (bf16_t*)(ws() + WS_WOUT); }
    __device__ __forceinline__ bf16_t* UV() const { return (bf16_t*)(ws() + WS_UV); }
    __device__ __forceinline__ bf16_t* Q() const { return (bf16_t*)(ws() + WS_Q); }
    __device__ __forceinline__ bf16_t* K() const { return (bf16_t*)(ws() + WS_K); }
    __device__ __forceinline__ bf16_t* VT() const { return (bf16_t*)(ws() + WS_VT); }
    __device__ __forceinline__ bf16_t* Y() const { return (bf16_t*)(ws() + WS_Y); }
    __device__ __forceinline__ unsigned char* YS() const { return ws() + WS_YS; }
    __device__ __forceinline__ bf16_t* RT() const { return (bf16_t*)(ws() + WS_RT); }
    __device__ __forceinline__ unsigned char* HB() const { return ws() + WS_HB; }
    __device__ __forceinline__ unsigned char* WGU() const { return ws() + WS_WGU; }
    __device__ __forceinline__ unsigned char* WD() const { return ws() + WS_WD; }
    __device__ __forceinline__ unsigned char* ACT() const { return ws() + WS_ACT; }
    __device__ __forceinline__ float* RSTD1() const { return (float*)(ws() + WS_RSTD1); }
    __device__ __forceinline__ float* SSPART() const { return (float*)(ws() + WS_SSPART); }
    __device__ __forceinline__ float* LISTGATE() const { return (float*)(ws() + WS_LISTGATE); }
    __device__ __forceinline__ int* LISTTOK() const { return (int*)(ws() + WS_LISTTOK); }
    __device__ __forceinline__ int* TOKINFO() const { return (int*)(ws() + WS_TOKINFO); }
    __device__ __forceinline__ unsigned* ctl() const { return (unsigned*)(ws() + WS_CTL); }
};

__device__ __forceinline__ void p0_transpose_item(const float* W, int K, int N, bf16_t* WT, int k0, int n0, int drow0, const float* kscale, LAS float* scr, int lane) {
#pragma unroll 8
    for (int i = 0; i < 32; ++i) { const int kk = 2 * i + (lane >> 5); float v = W[(size_t)(k0 + kk) * N + n0 + (lane & 31)]; if (kscale) v *= kscale[k0 + kk]; scr[kk * 33 + (lane & 31)] = v; }
    asm volatile("s_waitcnt lgkmcnt(0)" ::: "memory");
    const int c = lane & 7;
#pragma unroll
    for (int j = 0; j < 4; ++j) { const int n = (lane >> 3) + 8 * j; const LAS float* s = scr + (8 * c) * 33 + n;
        u32x4 o; o.x = cvt_pk_bf16(s[0 * 33], s[1 * 33]); o.y = cvt_pk_bf16(s[2 * 33], s[3 * 33]); o.z = cvt_pk_bf16(s[4 * 33], s[5 * 33]); o.w = cvt_pk_bf16(s[6 * 33], s[7 * 33]);
        *(u32x4*)(WT + (size_t)(drow0 + n) * K + k0 + 8 * c) = o; }
    asm volatile("s_waitcnt lgkmcnt(0)" ::: "memory");
}
__device__ __forceinline__ void p0_transpose_item_f8(const float* W, int K, int N, unsigned char* WT, int k0, int n0, LAS float* scr, int lane) {
#pragma unroll 8
    for (int i = 0; i < 32; ++i) { const int kk = 2 * i + (lane >> 5); scr[kk * 33 + (lane & 31)] = W[(size_t)(k0 + kk) * N + n0 + (lane & 31)] * WSCALE; }
    asm volatile("s_waitcnt lgkmcnt(0)" ::: "memory");
    const int c = lane & 7;
#pragma unroll
    for (int j = 0; j < 4; ++j) { const int n = (lane >> 3) + 8 * j; const LAS float* s = scr + (8 * c) * 33 + n;
        u32x2 o; o.x = pk4_fp8(s[0 * 33], s[1 * 33], s[2 * 33], s[3 * 33]); o.y = pk4_fp8(s[4 * 33], s[5 * 33], s[6 * 33], s[7 * 33]);
        *(u32x2*)(WT + (size_t)(n0 + n) * K + k0 + 8 * c) = o; }
    asm volatile("s_waitcnt lgkmcnt(0)" ::: "memory");
}
__device__ __forceinline__ int win_drow(int n0) {
    if (n0 < 1024 || n0 >= 2048) return n0;
    const int rel = n0 - 1024, isk = rel >> 9, head = (rel & 511) >> 6, dh = (rel & 63) >> 5;
    return 256 * (4 + 2 * isk + (head >> 2)) + 128 * dh + 32 * (head & 3);
}
constexpr int MOE_I_GU = 16 * 64, MOE_I_D = 16 * 32, MOE_ITEMS = NE * (MOE_I_GU + MOE_I_D);
struct ConvItem { const float* src; unsigned char* dst; int N; };
__device__ __forceinline__ ConvItem moe_conv_decode(const Frame& F, int it) {
    ConvItem c;
    if (it < NE * MOE_I_GU) { const int e = it / MOE_I_GU, q = it % MOE_I_GU, kb = q / 64, nb = q % 64; c.N = 2048;
        c.src = F.w_gate_up() + (size_t)e * KD * 2048 + (size_t)(64 * kb) * 2048 + 32 * nb; c.dst = F.WGU() + (size_t)e * 2048 * KD + (size_t)(32 * nb) * KD + 64 * kb; }
    else { const int r = it - NE * MOE_I_GU; const int e = r / MOE_I_D, q = r % MOE_I_D, kb = q / 32, nb = q % 32; c.N = 1024;
        c.src = F.w_down() + (size_t)e * KD * 1024 + (size_t)(64 * kb) * 1024 + 32 * nb; c.dst = F.WD() + (size_t)e * 1024 * KD + (size_t)(32 * nb) * KD + 64 * kb; }
    return c;
}
__device__ __forceinline__ void moe_conv_issue(const ConvItem& c, f32x4 (&v)[8], int lane) {
    const float* p = c.src + (size_t)(lane >> 3) * c.N + 4 * (lane & 7);
#pragma unroll
    for (int i = 0; i < 8; ++i) v[i] = *(const f32x4*)(p + (size_t)(8 * i) * c.N);
}
__device__ __forceinline__ void moe_conv_finish(const ConvItem& c, const f32x4 (&v)[8], LAS float* scr, int lane) {
    LAS float* w = scr + (lane >> 3) * 33 + 4 * (lane & 7);
#pragma unroll
    for (int i = 0; i < 8; ++i) { w[(8 * i) * 33 + 0] = v[i][0] * WSCALE; w[(8 * i) * 33 + 1] = v[i][1] * WSCALE; w[(8 * i) * 33 + 2] = v[i][2] * WSCALE; w[(8 * i) * 33 + 3] = v[i][3] * WSCALE; }
    asm volatile("s_waitcnt lgkmcnt(0)" ::: "memory");
    const int cc = lane & 7;
#pragma unroll
    for (int j = 0; j < 4; ++j) { const int n = (lane >> 3) + 8 * j; const LAS float* s = scr + (8 * cc) * 33 + n;
        u32x2 o; o.x = pk4_fp8(s[0 * 33], s[1 * 33], s[2 * 33], s[3 * 33]); o.y = pk4_fp8(s[4 * 33], s[5 * 33], s[6 * 33], s[7 * 33]);
        *(u32x2*)(c.dst + (size_t)n * KD + 8 * cc) = o; }
    asm volatile("s_waitcnt lgkmcnt(0)" ::: "memory");
}
constexpr int CONV_P4_PER_WAVE = 20, CONV_P4_ITEMS = CONV_P4_PER_WAVE * 1024;
constexpr int CONV_P2_ITEMS = MOE_ITEMS - CONV_P4_ITEMS, CONV_P2_PER_WAVE = CONV_P2_ITEMS / 2048;
static_assert(CONV_P2_ITEMS % 2048 == 0 && CONV_P4_PER_WAVE % 2 == 0, "conversion split");
__device__ __forceinline__ void p0_prologue(Frame& F) {
    LAS float* scr = (LAS float*)(F.lds + F.wave * 16384);
    const int gw = F.vcu * NWAVES + F.wave, NGW = F.G * NWAVES, lane = F.lane;
    for (int m = gw; m < NTOK; m += NGW) {
        const f32x4* xr = (const f32x4*)(F.x() + (size_t)m * DM) + lane; f32x4 v[4]; float s = 0.f;
#pragma unroll
        for (int j = 0; j < 4; ++j) { v[j] = xr[64 * j]; s += (v[j].x * v[j].x + v[j].y * v[j].y) + (v[j].z * v[j].z + v[j].w * v[j].w); }
        const float tot = wave_sum(s);
        if (lane == 0) F.RSTD1()[m] = 1.0f / sqrtf(tot * (1.0f / DM) + EPS);
        u32x2* o8 = (u32x2*)(F.XB() + (size_t)m * DM) + lane;
#pragma unroll
        for (int j = 0; j < 4; ++j) { u32x2 w; w.x = cvt_pk_bf16(v[j].x, v[j].y); w.y = cvt_pk_bf16(v[j].z, v[j].w); o8[64 * j] = w; }
    }
    constexpr int I_IN = 16 * 80, I_OUT = 16 * 32;
    for (int it = gw; it < I_IN + I_OUT; it += NGW) {
        int r = it;
        if (r < I_IN) { const int kb = r / 80, nb = r % 80; p0_transpose_item(F.w_in(), KD, 2560, F.WIN(), 64 * kb, 32 * nb, win_drow(32 * nb), F.norm1_w(), scr, lane); continue; } r -= I_IN;
        { const int kb = r / 32, nb = r % 32; p0_transpose_item(F.w_out(), KD, 1024, F.WOUT(), 64 * kb, 32 * nb, 32 * nb, nullptr, scr, lane); }
    }
    for (int idx = gw * 64 + lane; idx < NE * KD; idx += NGW * 64) {
        const int e = idx >> 10, k = idx & 1023; const float w = F.router_w()[(size_t)k * NE + e];
        const unsigned hi = cvt_pk_bf16(w, 0.f) & 0xffffu; const float rem = w - __uint_as_float(hi << 16);
        F.RT()[idx] = (bf16_t)hi; F.RT()[NE * KD + idx] = (bf16_t)(cvt_pk_bf16(rem, 0.f) & 0xffffu);
    }
}

struct ProgIn {
    static constexpr bool GATHER = false, FP8 = false; static constexpr int ID = 1;
    const Frame* F;
    __device__ __forceinline__ bool next(int i, Unit& u) const {
        const int v = F->vcu;
        if (i < 4) { const int uu = i * 256 + v, grp = uu >> 5, w = uu & 31; u.pm = grp * 4 + (w & 3); u.pn = w >> 2; u.kind = u.pn < 4 ? 0 : 1;
            u.A = (const char*)(F->XB() + (size_t)u.pm * 256 * KD); u.B = (const char*)(F->WIN() + (size_t)u.pn * 256 * KD); u.e = 0; u.r0 = 0; return true; }
        if (i == 4) { u.kind = 2; u.pm = v & 1; u.pn = v >> 1; u.A = (const char*)(F->WIN() + (size_t)(2048 + u.pm * 256) * KD); u.B = (const char*)(F->XB() + (size_t)u.pn * 256 * KD); u.e = 0; u.r0 = 0; return true; }
        return false;
    }
    __device__ __forceinline__ void epi(const Acc& acc, const Unit& u, int wr, int wc, int fr, int fq) const {
        asm volatile("" : "+v"(fr), "+v"(fq));
        if (u.kind == 2) {
            const int tk0 = u.pn * 256 + wc * 32 + 8 * fq;
            f32x4 rs[2][2];
#pragma unroll
            for (int bj = 0; bj < 2; ++bj)
#pragma unroll
                for (int n = 0; n < 2; ++n) rs[bj][n] = *(const f32x4*)(F->RSTD1() + tk0 + bj * 128 + 4 * n);
#pragma unroll
            for (int ai = 0; ai < 2; ++ai)
#pragma unroll
                for (int m = 0; m < 4; ++m) { const int cp = u.pm * 256 + ai * 128 + wr * 64 + m * 16 + fr; bf16_t* rowp = F->VT() + (size_t)cp * NTOK + tk0;
#pragma unroll
                    for (int bj = 0; bj < 2; ++bj) { const f32x4 v0 = acc[ai][bj][m][0] * rs[bj][0], v1 = acc[ai][bj][m][1] * rs[bj][1];
                        u32x4 w; w.x = cvt_pk_bf16(v0[0], v0[1]); w.y = cvt_pk_bf16(v0[2], v0[3]); w.z = cvt_pk_bf16(v1[0], v1[1]); w.w = cvt_pk_bf16(v1[2], v1[3]);
                        *(u32x4*)(rowp + bj * 128) = w; } }
            return;
        }
        float rsr[2][4];
#pragma unroll
        for (int ai = 0; ai < 2; ++ai)
#pragma unroll
            for (int m = 0; m < 4; ++m) rsr[ai][m] = F->RSTD1()[u.pm * 256 + ai * 128 + wr * 64 + m * 16 + fr];
        if (u.kind == 0) {
#pragma unroll
            for (int ai = 0; ai < 2; ++ai)
#pragma unroll
                for (int m = 0; m < 4; ++m) { const int r = u.pm * 256 + ai * 128 + wr * 64 + m * 16 + fr; bf16_t* rowp = F->UV() + (size_t)r * 1024 + u.pn * 256 + wc * 32 + 8 * fq; const float rs = rsr[ai][m];
#pragma unroll
                    for (int bj = 0; bj < 2; ++bj) { f32x4 v0 = acc[ai][bj][m][0] * rs, v1 = acc[ai][bj][m][1] * rs;
#pragma unroll
                        for (int j = 0; j < 4; ++j) { v0[j] = gelu_tanh_f(v0[j]); v1[j] = gelu_tanh_f(v1[j]); }
                        u32x4 w; w.x = cvt_pk_bf16(v0[0], v0[1]); w.y = cvt_pk_bf16(v0[2], v0[3]); w.z = cvt_pk_bf16(v1[0], v1[1]); w.w = cvt_pk_bf16(v1[2], v1[3]);
                        *(u32x4*)(rowp + bj * 128) = w; } }
            return;
        }
        {
            const int isk = (u.pn - 4) >> 1, head = 4 * (u.pn & 1) + wc; const float* nw = isk ? F->k_norm_w() : F->q_norm_w(); bf16_t* dst = isk ? F->K() : F->Q();
            const float osc = isk ? 1.0f : QSCALE;
            f32x4 nwv[2][2];
#pragma unroll
            for (int bj = 0; bj < 2; ++bj)
#pragma unroll
                for (int n = 0; n < 2; ++n) nwv[bj][n] = *(const f32x4*)(nw + 32 * bj + 8 * fq + 4 * n);
#pragma unroll
            for (int ai = 0; ai < 2; ++ai)
#pragma unroll
                for (int m = 0; m < 4; ++m) { const int r = u.pm * 256 + ai * 128 + wr * 64 + m * 16 + fr; const float rs = rsr[ai][m];
                    f32x4 t[2][2]; float ss = 0.f;
#pragma unroll
                    for (int bj = 0; bj < 2; ++bj)
#pragma unroll
                        for (int n = 0; n < 2; ++n) { t[bj][n] = acc[ai][bj][m][n] * rs; ss += (t[bj][n][0] * t[bj][n][0] + t[bj][n][1] * t[bj][n][1]) + (t[bj][n][2] * t[bj][n][2] + t[bj][n][3] * t[bj][n][3]); }
                    ss += __shfl_xor(ss, 16); ss += __shfl_xor(ss, 32);
                    const float rn = osc / sqrtf(ss * (1.0f / 64.0f) + EPS);
                    bf16_t* rowp = dst + (size_t)r * 512 + head * 64 + 8 * fq;
#pragma unroll
                    for (int bj = 0; bj < 2; ++bj) { const f32x4 v0 = t[bj][0] * nwv[bj][0] * rn, v1 = t[bj][1] * nwv[bj][1] * rn;
                        u32x4 w; w.x = cvt_pk_bf16(v0[0], v0[1]); w.y = cvt_pk_bf16(v0[2], v0[3]); w.z = cvt_pk_bf16(v1[0], v1[1]); w.w = cvt_pk_bf16(v1[2], v1[3]);
                        *(u32x4*)(rowp + bj * 32) = w; } }
        }
    }
};

constexpr int VN_PITCH = 136, YT_PITCH = 132, YT_OFF = 36864;
__device__ __forceinline__ void gmlp_unit(const Frame& F, int chunk, int g) {
    const int tid = F.tid, lane = F.lane, wid = F.wave;
    LAS bf16_t* vn = (LAS bf16_t*)F.lds; LAS float* yt = (LAS float*)(F.lds + YT_OFF);
    const size_t tok0 = (size_t)chunk * 128;
    {
        const int row = tid >> 2, qd = tid & 3; const bf16_t* src = F.UV() + (tok0 + row) * 1024 + 512 + g * 128 + qd * 32;
        u32x4 w[4]; float v[32]; float ss = 0.f;
#pragma unroll
        for (int i = 0; i < 4; ++i) w[i] = *(const u32x4*)(src + 8 * i);
#pragma unroll
        for (int i = 0; i < 4; ++i)
#pragma unroll
            for (int j = 0; j < 4; ++j) { v[8 * i + 2 * j] = bflo(w[i][j]); v[8 * i + 2 * j + 1] = bfhi(w[i][j]); }
#pragma unroll
        for (int i = 0; i < 32; ++i) ss += v[i] * v[i];
        ss += __shfl_xor(ss, 1); ss += __shfl_xor(ss, 2);
        const float rs = 1.0f / sqrtf(ss * (1.0f / 128.0f) + EPS);
        const float* nw = F.sgu_norm_w() + g * 128 + qd * 32;
#pragma unroll
        for (int i = 0; i < 4; ++i) { const f32x4 n0 = *(const f32x4*)(nw + 8 * i), n1 = *(const f32x4*)(nw + 8 * i + 4);
            u32x4 o; o.x = cvt_pk_bf16(v[8 * i] * rs * n0[0], v[8 * i + 1] * rs * n0[1]); o.y = cvt_pk_bf16(v[8 * i + 2] * rs * n0[2], v[8 * i + 3] * rs * n0[3]);
            o.z = cvt_pk_bf16(v[8 * i + 4] * rs * n1[0], v[8 * i + 5] * rs * n1[1]); o.w = cvt_pk_bf16(v[8 * i + 6] * rs * n1[2], v[8 * i + 7] * rs * n1[3]);
            *(LAS u32x4*)(vn + row * VN_PITCH + qd * 32 + 8 * i) = o; }
    }
    __syncthreads();
    {
        const int tb = wid >> 1, cb0 = 2 * (wid & 1), r32 = lane & 31, hh = lane >> 5;
        f32x16 a0 = {}, a1 = {};
        const int t = 32 * tb + r32; const float* wrow = F.sgu_w() + ((size_t)g * 128 + t) * 128;
        for (int ks = 0; ks < 2 * (tb + 1); ++ks) {
            const int s0 = 16 * ks + 8 * hh;
            const f32x4 w0 = *(const f32x4*)(wrow + s0), w1 = *(const f32x4*)(wrow + s0 + 4);
            float wv[8] = {w0[0], w0[1], w0[2], w0[3], w1[0], w1[1], w1[2], w1[3]};
#pragma unroll
            for (int j = 0; j < 8; ++j) if (s0 + j > t) wv[j] = 0.f;
            u32x4 aw; aw.x = cvt_pk_bf16(wv[0], wv[1]); aw.y = cvt_pk_bf16(wv[2], wv[3]); aw.z = cvt_pk_bf16(wv[4], wv[5]); aw.w = cvt_pk_bf16(wv[6], wv[7]);
            const bf16x8 af = __builtin_bit_cast(bf16x8, aw);
            bf16x8 b0, b1;
#pragma unroll
            for (int j = 0; j < 8; ++j) { b0[j] = (short)vn[(s0 + j) * VN_PITCH + 32 * cb0 + r32]; b1[j] = (short)vn[(s0 + j) * VN_PITCH + 32 * (cb0 + 1) + r32]; }
            a0 = __builtin_amdgcn_mfma_f32_32x32x16_bf16(af, b0, a0, 0, 0, 0);
            a1 = __builtin_amdgcn_mfma_f32_32x32x16_bf16(af, b1, a1, 0, 0, 0);
        }
#pragma unroll
        for (int reg = 0; reg < 16; ++reg) {
            const int tt = 32 * tb + (reg & 3) + 8 * (reg >> 2) + 4 * hh; const float bb = F.sgu_b()[g * 128 + tt];
            const bf16_t* up = F.UV() + (tok0 + tt) * 1024 + g * 128;
            const int c0 = 32 * cb0 + r32, c1 = c0 + 32;
            yt[tt * YT_PITCH + c0] = bf2f(up[c0]) * (a0[reg] + bb);
            yt[tt * YT_PITCH + c1] = bf2f(up[c1]) * (a1[reg] + bb);
        }
    }
    __syncthreads();
    {
        const int row = tid >> 2, qd = tid & 3; const LAS float* src = yt + row * YT_PITCH + qd * 32; f32x4 v[8]; float ss = 0.f;
#pragma unroll
        for (int i = 0; i < 8; ++i) { v[i] = *(const LAS f32x4*)(src + 4 * i); ss += (v[i][0] * v[i][0] + v[i][1] * v[i][1]) + (v[i][2] * v[i][2] + v[i][3] * v[i][3]); }
        ss += __shfl_xor(ss, 1); ss += __shfl_xor(ss, 2);
        const float rs = 1.0f / sqrtf(ss * (1.0f / 128.0f) + EPS);
        const float* nw = F.out_norm_a_w() + g * 128 + qd * 32; bf16_t* dst = F.Y() + (tok0 + row) * 1024 + g * 128 + qd * 32;
#pragma unroll
        for (int i = 0; i < 4; ++i) { const f32x4 n0 = *(const f32x4*)(nw + 8 * i), n1 = *(const f32x4*)(nw + 8 * i + 4); const f32x4 x0 = v[2 * i] * n0 * rs, x1 = v[2 * i + 1] * n1 * rs;
            u32x4 o; o.x = cvt_pk_bf16(x0[0], x0[1]); o.y = cvt_pk_bf16(x0[2], x0[3]); o.z = cvt_pk_bf16(x1[0], x1[1]); o.w = cvt_pk_bf16(x1[2], x1[3]);
            *(u32x4*)(dst + 8 * i) = o; }
    }
    __syncthreads();
}

__device__ __forceinline__ void attn_wave_unit(const Frame& F, int b, int h, int qblk, int& cit, int cend, LAS float* scr) {
    const int lane = F.lane, r32 = lane & 31, hi = lane >> 5;
    const size_t tokq = (size_t)b * SEQ + 32 * qblk + r32;
    bf16x8 qr[4];
#pragma unroll
    for (int d0 = 0; d0 < 4; ++d0) qr[d0] = *(const bf16x8*)(F.Q() + tokq * 512 + h * 64 + 16 * d0 + 8 * hi);
    f32x16 o0 = {}, o1 = {};
    float carry = 0.f;
    const bf16_t* Kb = F.K() + ((size_t)b * SEQ + r32) * 512 + h * 64 + 8 * hi;
    const bf16_t* V0 = F.VT() + (size_t)(h * 64 + r32) * NTOK + (size_t)b * SEQ + 4 * hi;
    bf16x8 kf[4]; s16x4 vf[2][2][2];
    auto load_tile = [&](int j, bf16x8 (&kk)[4], s16x4 (&vv)[2][2][2]) {
#pragma unroll
        for (int d0 = 0; d0 < 4; ++d0) kk[d0] = *(const bf16x8*)(Kb + (size_t)(32 * j) * 512 + 16 * d0);
#pragma unroll
        for (int dh = 0; dh < 2; ++dh)
#pragma unroll
            for (int ks = 0; ks < 2; ++ks) { const bf16_t* p = V0 + (size_t)dh * 32 * NTOK + 32 * j + 16 * ks; vv[dh][ks][0] = *(const s16x4*)p; vv[dh][ks][1] = *(const s16x4*)(p + 8); }
    };
    load_tile(qblk, kf, vf);
    for (int j = qblk; j >= 0; --j) {
        bf16x8 kn[4]; s16x4 vn2[2][2][2];
        const bool cv = cit < cend; ConvItem citem; f32x4 cvv[8];
        if (cv) { citem = moe_conv_decode(F, cit); moe_conv_issue(citem, cvv, lane); cit += 2048; }
        if (j > 0) load_tile(j - 1, kn, vn2);
        else {
#pragma unroll
            for (int d0 = 0; d0 < 4; ++d0) kn[d0] = kf[d0];
#pragma unroll
            for (int dh = 0; dh < 2; ++dh)
#pragma unroll
                for (int ks = 0; ks < 2; ++ks) { vn2[dh][ks][0] = vf[dh][ks][0]; vn2[dh][ks][1] = vf[dh][ks][1]; }
        }
        f32x16 s = {};
#pragma unroll
        for (int d0 = 0; d0 < 4; ++d0) s = __builtin_amdgcn_mfma_f32_32x32x16_bf16(kf[d0], qr[d0], s, 0, 0, 0);
        float sp[16];
        const bool diag = (j == qblk);
#pragma unroll
        for (int r = 0; r < 16; ++r) {
            const int kvl = (r & 3) + 8 * (r >> 2) + 4 * hi;
            const float z = s[r];
            float v = fmaxf(z, 0.f) + __builtin_amdgcn_logf(1.0f + __builtin_amdgcn_exp2f(-fabsf(z)));
            if (diag && kvl >= r32) v = 0.f;
            sp[r] = v;
        }
        float G[4], Gp[4];
#pragma unroll
        for (int k = 0; k < 4; ++k) { G[k] = (sp[4 * k] + sp[4 * k + 1]) + (sp[4 * k + 2] + sp[4 * k + 3]); Gp[k] = __shfl_xor(G[k], 32); }
        const float T3 = G[3] + Gp[3], T2 = G[2] + Gp[2], T1 = G[1] + Gp[1], T0 = G[0] + Gp[0];
        float off[4];
        off[3] = 0.f; off[2] = T3; off[1] = T3 + T2; off[0] = T3 + T2 + T1;
        const float tile_total = off[0] + T0;
#pragma unroll
        for (int k = 0; k < 4; ++k) off[k] += carry + (hi == 0 ? Gp[k] : 0.f);
        float a[16];
#pragma unroll
        for (int k = 0; k < 4; ++k) {
            float c = off[k];
#pragma unroll
            for (int i = 3; i >= 0; --i) { const int r = 4 * k + i; c += sp[r]; float av = __builtin_amdgcn_exp2f(s[r] - c);
                if (diag && ((r & 3) + 8 * (r >> 2) + 4 * hi) >= r32) av = 0.f;
                a[r] = av; }
        }
        carry += tile_total;
        u32x4 p0, p1;
        p0.x = cvt_pk_bf16(a[0], a[1]); p0.y = cvt_pk_bf16(a[2], a[3]); p0.z = cvt_pk_bf16(a[4], a[5]); p0.w = cvt_pk_bf16(a[6], a[7]);
        p1.x = cvt_pk_bf16(a[8], a[9]); p1.y = cvt_pk_bf16(a[10], a[11]); p1.z = cvt_pk_bf16(a[12], a[13]); p1.w = cvt_pk_bf16(a[14], a[15]);
        const bf16x8 pf0 = __builtin_bit_cast(bf16x8, p0), pf1 = __builtin_bit_cast(bf16x8, p1);
#define MK_VF(dh, ks) (bf16x8){vf[dh][ks][0][0], vf[dh][ks][0][1], vf[dh][ks][0][2], vf[dh][ks][0][3], vf[dh][ks][1][0], vf[dh][ks][1][1], vf[dh][ks][1][2], vf[dh][ks][1][3]}
        o0 = __builtin_amdgcn_mfma_f32_32x32x16_bf16(MK_VF(0, 0), pf0, o0, 0, 0, 0);
        o0 = __builtin_amdgcn_mfma_f32_32x32x16_bf16(MK_VF(0, 1), pf1, o0, 0, 0, 0);
        o1 = __builtin_amdgcn_mfma_f32_32x32x16_bf16(MK_VF(1, 0), pf0, o1, 0, 0, 0);
        o1 = __builtin_amdgcn_mfma_f32_32x32x16_bf16(MK_VF(1, 1), pf1, o1, 0, 0, 0);
#undef MK_VF
        if (cv) moe_conv_finish(citem, cvv, scr, lane);
        if (__all(carry > SB_THR)) break;
#pragma unroll
        for (int d0 = 0; d0 < 4; ++d0) kf[d0] = kn[d0];
#pragma unroll
        for (int dh = 0; dh < 2; ++dh)
#pragma unroll
            for (int ks = 0; ks < 2; ++ks) { vf[dh][ks][0] = vn2[dh][ks][0]; vf[dh][ks][1] = vn2[dh][ks][1]; }
    }
    float ss = 0.f;
#pragma unroll
    for (int r = 0; r < 16; ++r) ss += o0[r] * o0[r] + o1[r] * o1[r];
    ss += __shfl_xor(ss, 32);
    const float rs = 1.0f / sqrtf(ss * (1.0f / 64.0f) + EPS);
    const float* nw = F.out_norm_b_w() + h * 64 + 4 * hi; bf16_t* dst = F.Y() + tokq * 1024 + 512 + h * 64 + 4 * hi;
#pragma unroll
    for (int dh = 0; dh < 2; ++dh)
#pragma unroll
        for (int g = 0; g < 4; ++g) { const f32x4 w = *(const f32x4*)(nw + 32 * dh + 8 * g); const f32x16& o = dh ? o1 : o0;
            u32x2 pk; pk.x = cvt_pk_bf16(o[4 * g] * rs * w[0], o[4 * g + 1] * rs * w[1]); pk.y = cvt_pk_bf16(o[4 * g + 2] * rs * w[2], o[4 * g + 3] * rs * w[3]);
            *(u32x2*)(dst + 32 * dh + 8 * g) = pk; }
}
__device__ __forceinline__ void p2_mixers(Frame& F) {
    for (int i = 0; i < (MK_REP == 20 ? 8 : 4); ++i) { const int u = (i & 3) * 256 + F.vcu; gmlp_unit(F, u >> 2, u & 3); }
    const int gw = F.vcu * NWAVES + F.wave;
    LAS float* scr = (LAS float*)(F.lds + F.wave * 16384);
    int cit = CONV_P4_ITEMS + gw; const int cend = CONV_P4_ITEMS + CONV_P2_PER_WAVE * 2048;
    for (int i = 0; i < ((MK_REP == 21 || MK_REP == 22) ? 8 : 4); ++i) { if (MK_REP == 22 && i == 4) cit = CONV_P4_ITEMS + gw; const int u = (i & 3) * 2048 + gw; const int qblk = u & 127, bh = u >> 7; attn_wave_unit(F, bh >> 3, bh & 7, qblk, cit, cend, scr); }
    for (; cit < cend; cit += 2048) { const ConvItem c = moe_conv_decode(F, cit); f32x4 v[8]; moe_conv_issue(c, v, F.lane); moe_conv_finish(c, v, scr, F.lane); }
}

struct ProgOut {
    static constexpr bool GATHER = false, FP8 = false; static constexpr int ID = 3;
    const Frame* F;
    __device__ __forceinline__ bool next(int i, Unit& u) const {
        if (i >= 2) return false;
        const int uu = i * 256 + F->vcu, grp = uu >> 5, w = uu & 31; u.pm = grp * 8 + (w & 7); u.pn = w >> 3; u.kind = 0; u.e = 0; u.r0 = 0;
        u.A = (const char*)(F->Y() + (size_t)u.pm * 256 * KD); u.B = (const char*)(F->WOUT() + (size_t)u.pn * 256 * KD); return true;
    }
    __device__ __forceinline__ void epi(const Acc& acc, const Unit& u, int wr, int wc, int fr, int fq) const {
        asm volatile("" : "+v"(fr), "+v"(fq));
        const size_t off0 = (size_t)(u.pm * 256 + wr * 64 + fr) * DM + u.pn * 256 + wc * 32 + 8 * fq;
        const float* xb = F->x() + off0; float* ob = F->out() + off0;
        f32x4 xv[2][2][2];
#define MK_LDX(g, slot) do { const size_t go_ = (size_t)(((g) >> 2) * 128 + ((g) & 3) * 16) * DM; _Pragma("unroll") for (int bj = 0; bj < 2; ++bj) _Pragma("unroll") for (int n = 0; n < 2; ++n) xv[slot][bj][n] = *(const f32x4*)(xb + go_ + bj * 128 + 4 * n); } while (0)
        MK_LDX(0, 0);
#pragma unroll
        for (int g = 0; g < 8; ++g) { const int ai = g >> 2, m = g & 3; const size_t go = (size_t)(ai * 128 + m * 16) * DM; float ss = 0.f;
            if (g + 1 < 8) MK_LDX(g + 1, (g + 1) & 1);
#pragma unroll
            for (int bj = 0; bj < 2; ++bj)
#pragma unroll
                for (int n = 0; n < 2; ++n) { const f32x4 o = xv[g & 1][bj][n] + acc[ai][bj][m][n];
                    ss += (o[0] * o[0] + o[1] * o[1]) + (o[2] * o[2] + o[3] * o[3]); *(f32x4*)(ob + go + bj * 128 + 4 * n) = o; }
            ss += __shfl_xor(ss, 16); ss += __shfl_xor(ss, 32);
            if (fq == 0) F->SSPART()[(size_t)(u.pm * 256 + ai * 128 + wr * 64 + m * 16 + fr) * 16 + u.pn * 4 + wc] = ss; }
#undef MK_LDX
    }
};

template <bool DRY> __device__ __forceinline__ void router_wave_unit(Frame& F, int unit) {
    const int lane = F.lane, r32 = lane & 31, hh = lane >> 5; const int tok = unit * 32 + r32;
    float ssum = 0.f;
    { const f32x4* sp = (const f32x4*)(F.SSPART() + (size_t)tok * 16);
#pragma unroll
      for (int i = 0; i < 4; ++i) { const f32x4 v = sp[i]; ssum += v[0]; ssum += v[1]; ssum += v[2]; ssum += v[3]; } }
    const float rs = 1.0f / sqrtf(ssum * (1.0f / DM) + EPS);
    f32x16 acc = {};
    const float* xrow = F.out() + (size_t)tok * DM + 8 * hh; const float* w2 = F.norm2_w() + 8 * hh; unsigned char* hrow = F.HB() + (size_t)tok * DM + 8 * hh;
    const bf16_t* rth = F.RT() + (size_t)r32 * KD + 8 * hh; const bf16_t* rtl = rth + NE * KD;
#pragma unroll 4
    for (int s = 0; s < 64; ++s) {
        const f32x4 x0 = *(const f32x4*)(xrow + 16 * s), x1 = *(const f32x4*)(xrow + 16 * s + 4);
        const f32x4 g0 = *(const f32x4*)(w2 + 16 * s), g1 = *(const f32x4*)(w2 + 16 * s + 4);
        const f32x4 h0 = x0 * g0 * rs, h1 = x1 * g1 * rs;
        u32x4 hw; hw.x = cvt_pk_bf16(h0[0], h0[1]); hw.y = cvt_pk_bf16(h0[2], h0[3]); hw.z = cvt_pk_bf16(h1[0], h1[1]); hw.w = cvt_pk_bf16(h1[2], h1[3]);
        { u32x2 h8; h8.x = pk4_fp8(h0[0], h0[1], h0[2], h0[3]); h8.y = pk4_fp8(h1[0], h1[1], h1[2], h1[3]); *(u32x2*)(hrow + 16 * s) = h8; }
        u32x4 lw; lw.x = cvt_pk_bf16(h0[0] - bflo(hw.x), h0[1] - bfhi(hw.x)); lw.y = cvt_pk_bf16(h0[2] - bflo(hw.y), h0[3] - bfhi(hw.y));
        lw.z = cvt_pk_bf16(h1[0] - bflo(hw.z), h1[1] - bfhi(hw.z)); lw.w = cvt_pk_bf16(h1[2] - bflo(hw.w), h1[3] - bfhi(hw.w));
        const bf16x8 bh = __builtin_bit_cast(bf16x8, hw), bl = __builtin_bit_cast(bf16x8, lw);
        const bf16x8 ah = *(const bf16x8*)(rth + 16 * s), al = *(const bf16x8*)(rtl + 16 * s);
        acc = __builtin_amdgcn_mfma_f32_32x32x16_bf16(ah, bh, acc, 0, 0, 0);
        acc = __builtin_amdgcn_mfma_f32_32x32x16_bf16(al, bh, acc, 0, 0, 0);
        acc = __builtin_amdgcn_mfma_f32_32x32x16_bf16(ah, bl, acc, 0, 0, 0);
    }
    float lv[16];
#pragma unroll
    for (int r = 0; r < 16; ++r) lv[r] = acc[r] + F.router_b()[(r & 3) + 8 * (r >> 2) + 4 * hh];
    float cv[8]; int ce[8];
#pragma unroll
    for (int k = 0; k < 4; ++k) { float bv = -INFINITY; int be = 0;
#pragma unroll
        for (int r = 0; r < 16; ++r) { const int e = (r & 3) + 8 * (r >> 2) + 4 * hh; if (lv[r] > bv) { bv = lv[r]; be = e; } }
#pragma unroll
        for (int r = 0; r < 16; ++r) { const int e = (r & 3) + 8 * (r >> 2) + 4 * hh; if (e == be) lv[r] = -INFINITY; }
        cv[k] = bv; ce[k] = be; }
#pragma unroll
    for (int k = 0; k < 4; ++k) { cv[4 + k] = __shfl_xor(cv[k], 32); ce[4 + k] = __shfl_xor(ce[k], 32); }
    float tv[4]; int te[4];
#pragma unroll
    for (int k = 0; k < 4; ++k) { float bv = -INFINITY; int be = 1 << 20;
#pragma unroll
        for (int c = 0; c < 8; ++c) if (cv[c] > bv || (cv[c] == bv && ce[c] < be)) { bv = cv[c]; be = ce[c]; }
#pragma unroll
        for (int c = 0; c < 8; ++c) if (ce[c] == be) cv[c] = -INFINITY;
        tv[k] = bv; te[k] = be; }
    float ex[4], den = 0.f;
#pragma unroll
    for (int k = 0; k < 4; ++k) { ex[k] = __builtin_amdgcn_exp2f((tv[k] - tv[0]) * LOG2E); den += ex[k]; }
    const float rden = 1.0f / den;
    const int e0 = hh ? te[2] : te[0], e1 = hh ? te[3] : te[1]; const float g0 = (hh ? ex[2] : ex[0]) * rden, g1 = (hh ? ex[3] : ex[1]) * rden;
    if (DRY) { asm volatile("" :: "v"(e0), "v"(e1), "v"(g0), "v"(g1)); return; }
    int myc = 0; int rank0 = 0, rank1 = 0;
    const unsigned long long ltmask = (1ull << lane) - 1ull;
    for (int e = 0; e < NE; ++e) {
        const unsigned long long m0 = __ballot(e0 == e), m1 = __ballot(e1 == e);
        const int c0 = __popcll(m0), c1 = __popcll(m1);
        if (lane == e) myc = c0 + c1;
        if (e0 == e) rank0 = __popcll(m0 & ltmask);
        if (e1 == e) rank1 = c0 + __popcll(m1 & ltmask);
    }
    int base = 0;
    if (lane < NE && myc > 0) base = (int)__hip_atomic_fetch_add(F.ctl() + CW_CNT + lane, (unsigned)myc, __ATOMIC_RELAXED, __HIP_MEMORY_SCOPE_AGENT);
    const int p0 = __shfl(base, e0) + rank0, p1 = __shfl(base, e1) + rank1;
    F.LISTTOK()[(size_t)e0 * NTOK + p0] = tok; F.LISTGATE()[(size_t)e0 * NTOK + p0] = g0;
    F.LISTTOK()[(size_t)e1 * NTOK + p1] = tok; F.LISTGATE()[(size_t)e1 * NTOK + p1] = g1;
    F.TOKINFO()[tok * 4 + 2 * hh] = (e0 << 16) | p0; F.TOKINFO()[tok * 4 + 2 * hh + 1] = (e1 << 16) | p1;
}

__device__ __forceinline__ void moe_build_table(Frame& F) {
    LAS int* tab = (LAS int*)(F.lds + TAB_OFF);
    if (F.tid < NE) tab[F.tid] = (int)__hip_atomic_load(F.ctl() + CW_CNT + F.tid, __ATOMIC_RELAXED, __HIP_MEMORY_SCOPE_AGENT);
    __syncthreads();
    if (F.tid == 0) { int acc = 0; for (int e = 0; e < NE; ++e) { tab[32 + e] = acc; acc += (tab[e] + 255) >> 8; } tab[64] = acc; }
    __syncthreads();
}
__device__ __forceinline__ int sgpr(int v) { return __builtin_amdgcn_readfirstlane(v); }
template <int WGM, int NN>
__device__ __forceinline__ bool moe_decode(const Frame* F, int T, int i, Unit& u) {
    const LAS int* tab = (const LAS int*)(F->lds + TAB_OFF);
    const int uu = i * 256 + F->vcu, grp = uu >> 5, w = uu & 31; const int mt = grp * WGM + (w % WGM); u.pn = w / WGM;
    if (mt >= T) return false;
    int e = 0;
    for (int k = 1; k < NE; ++k) if (sgpr(tab[32 + k]) <= mt) e = k;
    u.e = e; u.pm = mt; u.r0 = (mt - sgpr(tab[32 + e])) * 256; u.kind = sgpr(tab[e]); return true;
}
struct ProgMoe1 {
    static constexpr bool GATHER = true, FP8 = true; static constexpr int ID = 5;
    const Frame* F; int T;
    __device__ __forceinline__ bool next(int i, Unit& u) const {
        if (!moe_decode<4, 8>(F, T, i, u)) return false;
        u.A = (const char*)F->HB(); u.B = (const char*)(F->WGU() + ((size_t)u.e * 2048 + (size_t)u.pn * 256) * KD); return true;
    }
    __device__ __forceinline__ void aoffs(const Unit& u, int wid, unsigned (&vo)[2][2]) const {
        const int cnt = u.kind; const int tid = wid * 64 + lane_id_fresh();
#pragma unroll
        for (int i = 0; i < 2; ++i) { int R_, C_; stage_rc(tid * 16 + i * 8192, R_, C_);
#pragma unroll
            for (int h = 0; h < 2; ++h) { const int idx = u.r0 + h * 128 + R_; const int tok = idx < cnt ? F->LISTTOK()[(size_t)u.e * NTOK + idx] : 0; vo[h][i] = (unsigned)(tok * KD + C_ * 2); } }
    }
    __device__ __forceinline__ void epi(const Acc& acc, const Unit& u, int wr, int wc, int fr, int fq) const {
        asm volatile("" : "+v"(fr), "+v"(fq));
        const float* bp = F->b_gate_up() + (size_t)u.e * 2048 + u.pn * 256 + wc * 32 + 8 * fq;
        f32x4 bv[2][2];
#pragma unroll
        for (int bj = 0; bj < 2; ++bj)
#pragma unroll
            for (int n = 0; n < 2; ++n) bv[bj][n] = *(const f32x4*)(bp + bj * 128 + 4 * n);
#pragma unroll
        for (int ai = 0; ai < 2; ++ai)
#pragma unroll
            for (int m = 0; m < 4; ++m) { const size_t slot = (size_t)u.pm * 256 + ai * 128 + wr * 64 + m * 16 + fr; unsigned char* rowp = F->ACT() + slot * 1024 + u.pn * 128 + wc * 16 + 4 * fq;
#pragma unroll
                for (int bj = 0; bj < 2; ++bj) { const f32x4 v0 = acc[ai][bj][m][0] * WSCALE_INV + bv[bj][0], v1 = acc[ai][bj][m][1] * WSCALE_INV + bv[bj][1];
                    f32x2 ga = {fminf(v0[0], 7.0f), fminf(v0[2], 7.0f)}, gb = {fminf(v1[0], 7.0f), fminf(v1[2], 7.0f)};
                    f32x2 ua = {__builtin_amdgcn_fmed3f(v0[1], -7.0f, 7.0f), __builtin_amdgcn_fmed3f(v0[3], -7.0f, 7.0f)}, ub = {__builtin_amdgcn_fmed3f(v1[1], -7.0f, 7.0f), __builtin_amdgcn_fmed3f(v1[3], -7.0f, 7.0f)};
                    const f32x2 xa = ga * (-1.702f * LOG2E), xb = gb * (-1.702f * LOG2E);
                    f32x2 ea = {__builtin_amdgcn_exp2f(xa[0]), __builtin_amdgcn_exp2f(xa[1])}, eb = {__builtin_amdgcn_exp2f(xb[0]), __builtin_amdgcn_exp2f(xb[1])};
                    ea = ea + 1.0f; eb = eb + 1.0f;
                    const f32x2 ra = {__builtin_amdgcn_rcpf(ea[0]), __builtin_amdgcn_rcpf(ea[1])}, rb = {__builtin_amdgcn_rcpf(eb[0]), __builtin_amdgcn_rcpf(eb[1])};
                    const f32x2 gla = ga * ra, glb = gb * rb;
                    const f32x2 oa = ua * gla + gla, ob = ub * glb + glb;
                    float r4[4] = {oa[0], oa[1], ob[0], ob[1]};
                    *(unsigned*)(rowp + bj * 64) = pk4_fp8(r4[0], r4[1], r4[2], r4[3]); } }
    }
};
struct ProgMoe2 {
    static constexpr bool GATHER = false, FP8 = true; static constexpr int ID = 6;
    const Frame* F; int T;
    __device__ __forceinline__ bool next(int i, Unit& u) const {
        if (!moe_decode<8, 4>(F, T, i, u)) return false;
        u.A = (const char*)(F->ACT() + (size_t)u.pm * 256 * KD); u.B = (const char*)(F->WD() + ((size_t)u.e * 1024 + (size_t)u.pn * 256) * KD); return true;
    }
    __device__ __forceinline__ void epi(const Acc& acc, const Unit& u, int wr, int wc, int fr, int fq) const {
        asm volatile("" : "+v"(fr), "+v"(fq));
        const int cnt = u.kind;
        const float* bp = F->b_down() + (size_t)u.e * 1024 + u.pn * 256 + wc * 32 + 8 * fq;
        f32x4 bv[2][2];
#pragma unroll
        for (int bj = 0; bj < 2; ++bj)
#pragma unroll
            for (int n = 0; n < 2; ++n) bv[bj][n] = *(const f32x4*)(bp + bj * 128 + 4 * n);
#pragma unroll
        for (int ai = 0; ai < 2; ++ai) {
            float gt[4];
#pragma unroll
            for (int m = 0; m < 4; ++m) { const int idx = u.r0 + ai * 128 + wr * 64 + m * 16 + fr; gt[m] = idx < cnt ? F->LISTGATE()[(size_t)u.e * NTOK + idx] : 0.f; }
#pragma unroll
            for (int m = 0; m < 4; ++m) { const int rl = ai * 128 + wr * 64 + m * 16 + fr; const float gate = gt[m] * YSCALE;
                unsigned char* rowp = F->YS() + ((size_t)u.pm * 256 + rl) * 1024 + u.pn * 256 + wc * 32 + 8 * fq;
#pragma unroll
                for (int bj = 0; bj < 2; ++bj) { const f32x4 v0 = (acc[ai][bj][m][0] * WSCALE_INV + bv[bj][0]) * gate, v1 = (acc[ai][bj][m][1] * WSCALE_INV + bv[bj][1]) * gate;
                    u32x2 w; w.x = pk4_fp8(v0[0], v0[1], v0[2], v0[3]); w.y = pk4_fp8(v1[0], v1[1], v1[2], v1[3]);
                    *(u32x2*)(rowp + bj * 128) = w; } }
        }
    }
};

template <bool DRY> __device__ __forceinline__ void p7_combine(Frame& F) {
    const LAS int* tab = (const LAS int*)(F.lds + TAB_OFF);
    const int gw = F.vcu * NWAVES + F.wave, NGW = F.G * NWAVES, lane = F.lane;
    for (int tok = gw; tok < NTOK; tok += NGW) {
        f32x4* orow = (f32x4*)(F.out() + (size_t)tok * DM) + lane; f32x4 v[4];
#pragma unroll
        for (int j = 0; j < 4; ++j) v[j] = orow[64 * j];
#pragma unroll
        for (int k = 0; k < 4; ++k) { const int info = F.TOKINFO()[tok * 4 + k]; const int e = info >> 16, pos = info & 0xffff; const size_t slot = (size_t)tab[32 + e] * 256 + pos;
            const unsigned* yr = (const unsigned*)(F.YS() + slot * 1024) + lane;
#pragma unroll
            for (int j = 0; j < 4; ++j) { const unsigned w = yr[64 * j]; const f32x2 lo = __builtin_amdgcn_cvt_pk_f32_fp8((int)w, false), hi = __builtin_amdgcn_cvt_pk_f32_fp8((int)w, true);
                v[j][0] += lo[0] * YSCALE_INV; v[j][1] += lo[1] * YSCALE_INV; v[j][2] += hi[0] * YSCALE_INV; v[j][3] += hi[1] * YSCALE_INV; } }
        f32x4* wrow = DRY ? (f32x4*)((float*)(F.ws() + WS_EARLY) + (size_t)tok * DM) + lane : orow;
#pragma unroll
        for (int j = 0; j < 4; ++j) wrow[64 * j] = v[j];
    }
}

__global__ void __launch_bounds__(NWAVES * 64, 2) mk_fwd(Args args) {
    extern __shared__ __attribute__((aligned(16))) unsigned char lds_raw[];
    Frame F;
    F.lds = (LAS unsigned char*)lds_raw;
    F.tid = threadIdx.x; F.lane = F.tid & 63; F.wave = __builtin_amdgcn_readfirstlane(F.tid >> 6);
    F.G = gridDim.x; { const int bx = blockIdx.x; F.vcu = (bx % 8) * (F.G / 8) + bx / 8; }
    F.ka = (const CAS Args*)__builtin_amdgcn_kernarg_segment_ptr();
    for (int u = F.tid; u < (LDS_BYTES - LDSCTL_OFF) / 4; u += NWAVES * 64) ((LAS unsigned*)(F.lds + LDSCTL_OFF))[u] = 0u;
    __syncthreads();
    XcdBarrier bar = xcd_barrier_post(F.ctl() + CW_BAR, (volatile LAS unsigned*)(F.lds + MISC_OFF) + 8);
    const int lo = F.ka->ph_lo, hi = F.ka->ph_hi;
#define IN(k) (lo <= (k) && (k) < hi)
#define REFRESH() do { int l_ = lane_id(); asm volatile("" : "+v"(l_)); F.lane = l_; F.tid = F.wave * 64 + l_; } while (0)
#define SEAM(k) do { if (IN(k) && IN((k) + 1)) { xcd_barrier(bar, F.wave); if (MK_REP == 100 + (k)) { xcd_barrier(bar, F.wave); xcd_barrier(bar, F.wave); xcd_barrier(bar, F.wave); xcd_barrier(bar, F.wave); } } } while (0)
    if (IN(0)) { REFRESH(); p0_prologue(F); if (MK_REP == 0) p0_prologue(F); } SEAM(0);
    if (IN(1)) { { ProgIn P{&F}; gemm_phase(F.lds, P); } if (MK_REP == 1) { ProgIn P{&F}; gemm_phase(F.lds, P); } } SEAM(1);
    if (IN(2)) { REFRESH(); p2_mixers(F); if (MK_REP == 2) p2_mixers(F); } SEAM(2);
    if (IN(3)) { { ProgOut P{&F}; gemm_phase(F.lds, P); } if (MK_REP == 3) { ProgOut P{&F}; gemm_phase(F.lds, P); } } SEAM(3);
    if (IN(4)) { REFRESH(); if (F.wave < 4) { if (MK_REP == 4) router_wave_unit<true>(F, F.wave * 256 + F.vcu); router_wave_unit<false>(F, F.wave * 256 + F.vcu); }
                 else { LAS float* scr = (LAS float*)(F.lds + F.wave * 16384); const int cw = F.vcu * 4 + (F.wave - 4);
                        for (int rep_ = 0; rep_ < (MK_REP == 41 ? 2 : 1); ++rep_) {
                        ConvItem ca = moe_conv_decode(F, cw); f32x4 va[8], vb[8]; moe_conv_issue(ca, va, F.lane);
                        for (int j = 0; j < CONV_P4_PER_WAVE; j += 2) {
                            const ConvItem cb = moe_conv_decode(F, (j + 1) * 1024 + cw); moe_conv_issue(cb, vb, F.lane);
                            moe_conv_finish(ca, va, scr, F.lane);
                            if (j + 2 < CONV_P4_PER_WAVE) { ca = moe_conv_decode(F, (j + 2) * 1024 + cw); moe_conv_issue(ca, va, F.lane); }
                            moe_conv_finish(cb, vb, scr, F.lane); } } } } SEAM(4);
    if (lo <= 7 && hi > 5) { REFRESH(); moe_build_table(F); }
    if (IN(5)) { { ProgMoe1 P{&F, sgpr(((const LAS int*)(F.lds + TAB_OFF))[64])}; gemm_phase(F.lds, P); } if (MK_REP == 5) { ProgMoe1 P{&F, sgpr(((const LAS int*)(F.lds + TAB_OFF))[64])}; gemm_phase(F.lds, P); } } SEAM(5);
    if (IN(6)) { { ProgMoe2 P{&F, sgpr(((const LAS int*)(F.lds + TAB_OFF))[64])}; gemm_phase(F.lds, P); } if (MK_REP == 6) { ProgMoe2 P{&F, sgpr(((const LAS int*)(F.lds + TAB_OFF))[64])}; gemm_phase(F.lds, P); } } SEAM(6);
    if (IN(7)) { REFRESH(); if (MK_REP == 7) p7_combine<true>(F); p7_combine<false>(F); }
#undef IN
#undef SEAM
}
}
#ifndef MK_CUT
#define MK_CUT 8
#endif
extern "C" void kernel_launch(void* const* d_in, const int* in_sizes, int n_in, void* d_out, int out_size, void* d_ws, size_t ws_size, hipStream_t stream) {
    static int ready = 0;
    if (ready == 0) {
        if (n_in != 18 || out_size != mk::NTOK * mk::DM || ws_size < mk::WS_END) { fprintf(stderr, "kernel_launch: unexpected problem (n_in %d out %d ws %zu)\n", n_in, out_size, ws_size); ready = -1; return; }
        if (hipFuncSetAttribute((const void*)mk::mk_fwd, hipFuncAttributeMaxDynamicSharedMemorySize, mk::LDS_BYTES) != hipSuccess) { fprintf(stderr, "kernel_launch: hipFuncSetAttribute failed\n"); ready = -1; return; }
        ready = 1;
    }
    if (ready < 0) return;
    (void)hipMemsetAsync((char*)d_ws + mk::WS_CTL, 0, mk::CTL_ZERO_BYTES, stream);
    mk::Args a{};
    for (int i = 0; i < 18; ++i) a.in[i] = (const float*)d_in[i];
    a.out = (float*)d_out; a.ws = (unsigned char*)d_ws; a.ph_lo = 0; a.ph_hi = MK_CUT;
    hipLaunchKernelGGL(mk::mk_fwd, dim3(256), dim3(mk::NWAVES * 64), mk::LDS_BYTES, stream, a);
#if MK_CUT < 8
    {
        using namespace nv;
        const float* x = (const float*)d_in[0]; const float* w_out = (const float*)d_in[10]; const float* norm2_w = (const float*)d_in[11];
        const float* router_w = (const float*)d_in[12]; const float* router_b = (const float*)d_in[13]; const float* w_gate_up = (const float*)d_in[14];
        const float* b_gate_up = (const float*)d_in[15]; const float* w_down = (const float*)d_in[16]; const float* b_down = (const float*)d_in[17];
        float* out = (float*)d_out; char* ws = (char*)d_ws; const size_t MiB = 1u << 20;
        int* cnt = (int*)ws + mk::CW_CNT; int* list_tok = (int*)(ws + mk::WS_LISTTOK); float* list_gate = (float*)(ws + mk::WS_LISTGATE);
        float* hn = (float*)(ws + 16 * MiB); float* gu = (float*)(ws + 272 * MiB); float* act = (float*)(ws + (272 + 256) * MiB);
#if MK_CUT <= 3
        k_gemm<1, true><<<dim3(DM / 64, NTOK / 64), 256, 0, stream>>>((const void*)(ws + mk::WS_Y), nullptr, nullptr, nullptr, w_out, nullptr, x, nullptr, out, NTOK, DM, DM, DM, DM);
#endif
#if MK_CUT <= 4
        k_router<<<NTOK, 256, 0, stream>>>(out, norm2_w, router_w, router_b, hn, cnt, list_tok, list_gate);
#else
        k_bf2f<<<4096, 256, 0, stream>>>((const unsigned short*)(ws + mk::WS_HB), hn, (size_t)NTOK * DM);
#endif
        for (int e = 0; e < NE; ++e) {
            const int* lt = list_tok + (size_t)e * NTOK; const float* lgp = list_gate + (size_t)e * NTOK;
            k_gemm<0, false><<<dim3(2 * DFF / 64, NTOK / 64), 256, 0, stream>>>(hn, lt, nullptr, cnt + e, w_gate_up + (size_t)e * DM * 2 * DFF, b_gate_up + (size_t)e * 2 * DFF, nullptr, nullptr, gu, NTOK, 2 * DFF, DM, DM, 2 * DFF);
            k_swiglu<<<NTOK, 256, 0, stream>>>(gu, cnt + e, act);
            k_gemm<3, false><<<dim3(DM / 64, NTOK / 64), 256, 0, stream>>>(act, nullptr, lt, cnt + e, w_down + (size_t)e * DFF * DM, b_down + (size_t)e * DM, nullptr, lgp, out, NTOK, DM, DFF, DFF, DM);
        }
    }
#endif
}
```

```cpp
#include <hip/hip_runtime.h>
#include <cstdio>
#include <cstdint>
#ifndef MK_REP
#define MK_REP -1
#endif
namespace mk {
#define LAS __attribute__((address_space(3)))
#define GAS __attribute__((address_space(1)))
typedef unsigned short bf16_t;
typedef short bf16x8 __attribute__((ext_vector_type(8)));
typedef short s16x4 __attribute__((ext_vector_type(4)));
typedef float f32x4 __attribute__((ext_vector_type(4)));
typedef float f32x2 __attribute__((ext_vector_type(2)));
typedef float f32x16 __attribute__((ext_vector_type(16)));
typedef unsigned u32x4 __attribute__((ext_vector_type(4)));
typedef unsigned u32x2 __attribute__((ext_vector_type(2)));
typedef int i32x4 __attribute__((ext_vector_type(4)));
typedef int i32x8 __attribute__((ext_vector_type(8)));

constexpr int NTOK = 32768, DM = 1024, SEQ = 4096, NB = 8, NH = 8, HD = 64, NE = 32, DFF = 1024, KD = 1024;
constexpr float EPS = 1e-5f;
constexpr float LOG2E = 1.4426950408889634f;
constexpr float QSCALE = 0.125f * LOG2E;
constexpr float SB_THR = 64.0f;
constexpr int NWAVES = 8;
constexpr int SLOTS = NTOK * 4 + NE * 256;

constexpr size_t MiB = 1u << 20;
constexpr size_t WS_CTL = 0, CTL_ZERO_BYTES = 1 * MiB;
constexpr size_t WS_LISTTOK = 1 * MiB;
constexpr size_t WS_LISTGATE = 5 * MiB;
constexpr size_t WS_TOKINFO = 9 * MiB;
constexpr size_t WS_RSTD1 = 10 * MiB;
constexpr size_t WS_SSPART = 11 * MiB;
constexpr size_t WS_RT = 13 * MiB;
constexpr size_t WS_WGU = 16 * MiB;
constexpr size_t WS_WD = 80 * MiB;
constexpr size_t WS_HB = 112 * MiB;
constexpr size_t WS_YS = 144 * MiB;
constexpr size_t WS_EARLY = 416 * MiB;
constexpr size_t WS_XB = WS_EARLY;
constexpr size_t WS_WIN = WS_EARLY + 64 * MiB;
constexpr size_t WS_WOUT = WS_EARLY + 70 * MiB;
constexpr size_t WS_UV = WS_EARLY + 72 * MiB;
constexpr size_t WS_Q = WS_EARLY + 136 * MiB;
constexpr size_t WS_K = WS_EARLY + 168 * MiB;
constexpr size_t WS_VT = WS_EARLY + 200 * MiB;
constexpr size_t WS_Y = WS_EARLY + 232 * MiB;
constexpr size_t WS_ACT = WS_EARLY;
constexpr size_t WS_END = WS_EARLY + 296 * MiB;
constexpr float WSCALE = 32.0f, WSCALE_INV = 1.0f / 32.0f;
constexpr float YSCALE = 16.0f, YSCALE_INV = 1.0f / 16.0f;
constexpr int CW_CNT = 64;
constexpr int CW_BAR = 4096;

constexpr int RING_BYTES = 131072;
constexpr int LDSCTL_OFF = RING_BYTES, MISC_OFF = LDSCTL_OFF + 320, TAB_OFF = LDSCTL_OFF + 1024;
constexpr int LDS_BYTES = 147456;

__device__ __forceinline__ unsigned cvt_pk_bf16(float lo, float hi) { unsigned r; asm volatile("v_cvt_pk_bf16_f32 %0, %1, %2" : "=v"(r) : "v"(lo), "v"(hi)); return r; }
__device__ __forceinline__ unsigned pk4_fp8(float a, float b, float c, float d) { unsigned w = 0u; w = (unsigned)__builtin_amdgcn_cvt_pk_fp8_f32(a, b, (int)w, false); w = (unsigned)__builtin_amdgcn_cvt_pk_fp8_f32(c, d, (int)w, true); return w; }
__device__ __forceinline__ float bf2f(unsigned short h) { return __uint_as_float((unsigned)h << 16); }
__device__ __forceinline__ float bflo(unsigned w) { return __uint_as_float(w << 16); }
__device__ __forceinline__ float bfhi(unsigned w) { return __uint_as_float(w & 0xffff0000u); }
__device__ __forceinline__ int lane_id() { return (int)__builtin_amdgcn_mbcnt_hi(~0u, __builtin_amdgcn_mbcnt_lo(~0u, 0u)); }
__device__ __forceinline__ int lane_id_fresh() { int l; asm volatile("v_mbcnt_lo_u32_b32 %0, -1, 0\n\tv_mbcnt_hi_u32_b32 %0, -1, %0" : "=v"(l)); return l; }
__device__ __forceinline__ float wave_sum(float v) {
#pragma unroll
    for (int o = 1; o < 64; o <<= 1) v += __shfl_xor(v, o);
    return v;
}
__device__ __forceinline__ float gelu_tanh_f(float x) {
    const float u = 0.7978845608028654f * (x + 0.044715f * x * x * x);
    return x * __builtin_amdgcn_rcpf(1.0f + __builtin_amdgcn_exp2f(-2.0f * LOG2E * u));
}

constexpr int BM = 256, BK = 64, HALF = 128, HTB = HALF * BK * 2;
__device__ __forceinline__ int lds_byte(int r, int c) { const int st = (r >> 4) * 2 + (c >> 5), rr = r & 15, cc = c & 31, ob = rr * 64 + cc * 2; return st * 1024 + (ob ^ (((ob >> 9) & 1) << 5)); }
__device__ __forceinline__ void stage_rc(int b, int& R, int& C) { const int st = b / 1024, sb = b % 1024, swz = sb ^ (((sb >> 9) & 1) << 5); R = (st >> 1) * 16 + swz / 64; C = (st & 1) * 32 + (swz % 64) / 2; }
__device__ __forceinline__ int perm32(int rho) { const int n = rho >> 4, i = rho & 15; return 8 * (i >> 2) + 4 * n + (i & 3); }

struct Unit { const char* A; const char* B; int kind, pm, pn, e, r0; };

template <class Prog>
__device__ __forceinline__ void gemm_phase(LAS unsigned char* lds, const Prog& P) {
    const int wid = P.F->wave, lane = lane_id(), tid = wid * 64 + lane, wr = wid >> 2, wc = wid & 3;
    constexpr bool F8 = Prog::FP8;
    constexpr int K = KD, ESZ = F8 ? 1 : 2, nt = F8 ? K / 128 : K / BK;
    unsigned voffB[2];
#pragma unroll
    for (int i = 0; i < 2; ++i) { int R_, C_; stage_rc(tid * 16 + i * 8192, R_, C_); const int Rb = (R_ & ~31) + perm32(R_ & 31); voffB[i] = (unsigned)(Rb * K * ESZ + C_ * 2); }
    constexpr size_t kstep = (size_t)(BK * 2);
    constexpr size_t hstep = (size_t)HALF * K * ESZ;
    const unsigned ldsw = (unsigned)wid * 1024u;
    const int aoff = lds_byte(wr * 64 + (lane & 15), F8 ? (lane >> 4) * 16 : (lane >> 4) * 8), boff = lds_byte(wc * 32 + (lane & 15), F8 ? (lane >> 4) * 16 : (lane >> 4) * 8);
    constexpr int KOFF = F8 ? 16 : 1024;
#define MK_SA(b, h) (((b) * 2 + (h)) * HTB)
#define MK_SB(b, h) ((4 + (b) * 2 + (h)) * HTB)
#define MK_STAGE(bufoff, gbase, voff) do { _Pragma("unroll") for (int _i = 0; _i < 2; ++_i) { unsigned o_ = (voff)[_i]; asm volatile("" : "+v"(o_));     \
        __builtin_amdgcn_global_load_lds((const unsigned*)((const char*)(gbase) + o_), (LAS unsigned*)(lds + (bufoff) + ldsw + _i * 8192), 16, 0, 0); } } while (0)
#define MK_STAGE_A(bufoff, gbase, h) do { if constexpr (GA) MK_STAGE(bufoff, gbase, voC[h]); else MK_STAGE(bufoff, (gbase) + (h) * hstep, voC[0]); } while (0)
#define MK_LDA(dst, b, h) do { _Pragma("unroll") for (int m = 0; m < 4; ++m) _Pragma("unroll") for (int k = 0; k < 2; ++k) dst[m][k] = *(const LAS bf16x8*)(lds + MK_SA(b, h) + aoff + m * 2048 + k * KOFF); } while (0)
#define MK_LDB(dst, b, h) do { _Pragma("unroll") for (int n = 0; n < 2; ++n) _Pragma("unroll") for (int k = 0; k < 2; ++k) dst[n][k] = *(const LAS bf16x8*)(lds + MK_SB(b, h) + boff + n * 2048 + k * KOFF); } while (0)
#define MK_CAT8(x) __builtin_shufflevector(__builtin_bit_cast(i32x4, (x)[0]), __builtin_bit_cast(i32x4, (x)[1]), 0, 1, 2, 3, 4, 5, 6, 7)
#define MK_MMA(ai, bj, At, Bt) do { __builtin_amdgcn_s_setprio(1); \
        if constexpr (F8) { _Pragma("unroll") for (int m = 0; m < 4; ++m) _Pragma("unroll") for (int n = 0; n < 2; ++n) \
            acc[ai][bj][m][n] = __builtin_amdgcn_mfma_scale_f32_16x16x128_f8f6f4(MK_CAT8(Bt[n]), MK_CAT8(At[m]), acc[ai][bj][m][n], 0, 0, 0, 0, 0, 0); } \
        else { _Pragma("unroll") for (int m = 0; m < 4; ++m) _Pragma("unroll") for (int n = 0; n < 2; ++n) _Pragma("unroll") for (int k = 0; k < 2; ++k) \
            acc[ai][bj][m][n] = __builtin_amdgcn_mfma_f32_16x16x32_bf16(Bt[n][k], At[m][k], acc[ai][bj][m][n], 0, 0, 0); } \
        __builtin_amdgcn_s_setprio(0); } while (0)
#define MK_WAIT_V(n) asm volatile("s_waitcnt vmcnt(" #n ")" ::: "memory")
#define MK_WAIT_L(n) asm volatile("s_waitcnt lgkmcnt(" #n ")" ::: "memory")
#define MK_BAR __builtin_amdgcn_s_barrier()
#define MK_SCHED __builtin_amdgcn_sched_barrier(0)
    Unit cur, nxt; int ui = 0;
    if (!P.next(0, cur)) return;
    constexpr bool GA = Prog::GATHER;
    unsigned voC[2][2];
    if constexpr (GA) P.aoffs(cur, wid, voC);
    else {
#pragma unroll
        for (int i = 0; i < 2; ++i) { int R_, C_; stage_rc(tid * 16 + i * 8192, R_, C_); voC[0][i] = (unsigned)(R_ * K * ESZ + C_ * 2); voC[1][i] = 0u; }
    }
    f32x4 acc[2][2][4][2];
#pragma unroll
    for (int a = 0; a < 2; ++a)
#pragma unroll
        for (int b = 0; b < 2; ++b)
#pragma unroll
            for (int m = 0; m < 4; ++m)
#pragma unroll
                for (int n = 0; n < 2; ++n) acc[a][b][m][n] = (f32x4){0.f, 0.f, 0.f, 0.f};
    bf16x8 At[4][2], B0[2][2], B1[2][2];
    const char* cA = cur.A; const char* cB = cur.B;
    MK_STAGE(MK_SB(0, 0), cB, voffB); MK_STAGE(MK_SB(0, 1), cB + hstep, voffB); MK_STAGE_A(MK_SA(0, 0), cA, 0); MK_STAGE_A(MK_SA(0, 1), cA, 1);
    if (wr == 1) MK_BAR;
    MK_WAIT_V(2); MK_BAR;
    MK_STAGE(MK_SB(1, 0), cB + kstep, voffB); MK_STAGE_A(MK_SA(1, 0), cA + kstep, 0); MK_STAGE(MK_SB(1, 1), cB + hstep + kstep, voffB);
    MK_WAIT_V(6); MK_BAR;
    for (;;) {
        const bool has_next = P.next(ui + 1, nxt);
        if (!has_next) nxt = cur;
        const char* nA = nxt.A; const char* nB = nxt.B;
#pragma unroll 1
        for (int t = 0; t < nt; t += 2) {
            const bool last = (t == nt - 2);
            const char* a1 = cA + (size_t)(t + 1) * kstep;
            const char* a2 = last ? nA : cA + (size_t)(t + 2) * kstep; const char* b2 = last ? nB : cB + (size_t)(t + 2) * kstep;
            const char* a3 = a2 + kstep; const char* b3 = b2 + kstep;
            MK_LDB(B0, 0, 0); MK_LDB(B1, 0, 1); MK_SCHED; MK_LDA(At, 0, 0); MK_STAGE_A(MK_SA(1, 1), a1, 1);
            if constexpr (GA) { if (last && has_next) P.aoffs(nxt, wid, voC); }
            MK_WAIT_V(8); MK_WAIT_L(0); MK_BAR; MK_MMA(0, 0, At, B0); MK_MMA(0, 1, At, B1); MK_BAR; MK_SCHED;
            MK_LDA(At, 0, 1); MK_STAGE(MK_SB(0, 0), b2, voffB); MK_STAGE(MK_SB(0, 1), b2 + hstep, voffB); MK_STAGE_A(MK_SA(0, 0), a2, 0);
            MK_WAIT_V(8); MK_WAIT_L(0); MK_BAR; MK_MMA(1, 0, At, B0); MK_MMA(1, 1, At, B1); MK_BAR; MK_SCHED;
            MK_LDB(B0, 1, 0); MK_LDB(B1, 1, 1); MK_SCHED; MK_LDA(At, 1, 0); MK_STAGE_A(MK_SA(0, 1), a2, 1);
            MK_WAIT_V(8); MK_WAIT_L(0); MK_BAR; MK_MMA(0, 0, At, B0); MK_MMA(0, 1, At, B1); MK_BAR; MK_SCHED;
            MK_LDA(At, 1, 1); MK_STAGE(MK_SB(1, 0), b3, voffB); MK_STAGE(MK_SB(1, 1), b3 + hstep, voffB); MK_STAGE_A(MK_SA(1, 0), a3, 0);
            MK_WAIT_V(8); MK_WAIT_L(0); MK_BAR; MK_MMA(1, 0, At, B0); MK_MMA(1, 1, At, B1); MK_BAR; MK_SCHED;
        }
        if (wr == 0) MK_BAR;
        { const int l_ = lane_id_fresh(); P.epi(acc, cur, wr, wc, l_ & 15, l_ >> 4); }
#ifdef MK_EPI2
        if (Prog::ID == MK_EPI2) { const int l_ = lane_id_fresh(); P.epi(acc, cur, wr, wc, l_ & 15, l_ >> 4); }
#endif
        if (!has_next) break;
#pragma unroll
        for (int a = 0; a < 2; ++a)
#pragma unroll
            for (int b = 0; b < 2; ++b)
#pragma unroll
                for (int m = 0; m < 4; ++m)
#pragma unroll
                    for (int n = 0; n < 2; ++n) acc[a][b][m][n] = (f32x4){0.f, 0.f, 0.f, 0.f};
        cur = nxt; cA = nA; cB = nB; ++ui;
        if (wr == 1) MK_BAR;
    }
    MK_WAIT_V(0);
    MK_BAR;
#undef MK_SA
#undef MK_SB
#undef MK_STAGE
#undef MK_STAGE_A
#undef MK_LDA
#undef MK_LDB
#undef MK_MMA
#undef MK_CAT8
}
typedef f32x4 Acc[2][2][4][2];

#define XB_TMO      128
#define XB_XCNT(j)  (256  + 64 * (j))
#define XB_XSUB(j)  (1280 + 64 * (j))
#define XB_XGEN(j)  (2304 + 64 * (j))
#define XB_TOP      3328
#define XB_TOPGEN   3392
#define XCD_BAR_WORDS 3456
#define XB_SPIN_CAP (1u << 18)
__device__ __forceinline__ unsigned xb_ld(unsigned* p)              { return __hip_atomic_load(p, __ATOMIC_RELAXED, __HIP_MEMORY_SCOPE_AGENT); }
__device__ __forceinline__ unsigned xb_add(unsigned* p, unsigned v) { return __hip_atomic_fetch_add(p, v, __ATOMIC_RELAXED, __HIP_MEMORY_SCOPE_AGENT); }
__device__ __forceinline__ unsigned xb_xcc_id() { return (unsigned)__builtin_amdgcn_s_getreg((3 << 11) | 20) & 0xFu; }
#define XB_SPIN(cond, bar) do { unsigned _sp = 0; while (cond) { __builtin_amdgcn_s_sleep(1); \
    if ((++_sp & 255u) == 0u) { if (xb_ld(&(bar)[XB_TMO])) break; if (_sp > XB_SPIN_CAP) { atomicAdd(&(bar)[XB_TMO], 1u); break; } } } } while (0)
struct XcdBarrier { unsigned* bar; unsigned x; volatile LAS unsigned* st; };
__device__ __forceinline__ XcdBarrier xcd_barrier_post(unsigned* bar, volatile LAS unsigned* st) {
    XcdBarrier b; b.bar = bar; b.x = xb_xcc_id(); b.st = st;
    if (threadIdx.x == 0) (void)xb_add(&bar[XB_XCNT(b.x)], 1u);
    return b;
}
__device__ __forceinline__ void xcd_barrier_complete(unsigned* bar, unsigned x, unsigned& nloc, unsigned& nx) {
    const unsigned G = gridDim.x * gridDim.y * gridDim.z;
    unsigned sum, cnt, mine, sp = 0u;
    for (;;) {
        sum = 0u; cnt = 0u; mine = 0u;
#pragma unroll
        for (unsigned j = 0; j < 16; ++j) { const unsigned c = xb_ld(&bar[XB_XCNT(j)]); sum += c; cnt += (c > 0u) ? 1u : 0u; mine = (j == x) ? c : mine; }
        if (sum == G) break;
        __builtin_amdgcn_s_sleep(1);
        if ((++sp & 255u) == 0u) { if (xb_ld(&bar[XB_TMO])) break; if (sp > XB_SPIN_CAP) { atomicAdd(&bar[XB_TMO], 1u); break; } }
    }
    nloc = mine > 0u ? mine : 1u; nx = cnt > 0u ? cnt : 1u;
}
__device__ __forceinline__ void xcd_barrier(const XcdBarrier& b, int wave) {
    asm volatile("s_waitcnt vmcnt(0)" ::: "memory");
    __syncthreads();
    if (wave == 0 && lane_id() == 0) {
        unsigned* bar = b.bar;
        __builtin_amdgcn_s_waitcnt(0);
        unsigned nloc = b.st[0], nx = b.st[1];
        if (nloc == 0u) { xcd_barrier_complete(bar, b.x, nloc, nx); b.st[0] = nloc; b.st[1] = nx; }
        const unsigned old = xb_add(&bar[XB_XSUB(b.x)], 1u);
        const unsigned gen = old / nloc;
        if (old + 1u == (gen + 1u) * nloc) {
            __builtin_amdgcn_fence(__ATOMIC_RELEASE, "agent");
            asm volatile("s_waitcnt vmcnt(0)" ::: "memory");
            const unsigned og = xb_add(&bar[XB_TOP], 1u);
            const unsigned tg = og / nx;
            if (og + 1u == (tg + 1u) * nx) xb_add(&bar[XB_TOPGEN], 1u);
            else XB_SPIN(xb_ld(&bar[XB_TOPGEN]) == tg, bar);
            __builtin_amdgcn_fence(__ATOMIC_ACQUIRE, "agent");
            xb_add(&bar[XB_XGEN(b.x)], 1u);
            asm volatile("s_waitcnt vmcnt(0)" ::: "memory");
        } else {
            XB_SPIN(xb_ld(&bar[XB_XGEN(b.x)]) == gen, bar);
            __builtin_amdgcn_fence(__ATOMIC_ACQUIRE, "agent");
            asm volatile("s_waitcnt vmcnt(0)" ::: "memory");
        }
    }
    __syncthreads();
}

struct Args {
    const float* in[18]; float* out; unsigned char* ws; int ph_lo, ph_hi;
};
#define CAS __attribute__((address_space(4)))
struct Frame {
    LAS unsigned char* lds; int tid, lane, wave, vcu, G;
    const CAS Args* ka;
    __device__ __forceinline__ const float* inp(int k) const { return ka->in[k]; }
    __device__ __forceinline__ unsigned char* ws() const { return ka->ws; }
    __device__ __forceinline__ float* out() const { return ka->out; }
    __device__ __forceinline__ const float* x() const { return inp(0); }
    __device__ __forceinline__ const float* norm1_w() const { return inp(1); }
    __device__ __forceinline__ const float* w_in() const { return inp(2); }
    __device__ __forceinline__ const float* sgu_norm_w() const { return inp(3); }
    __device__ __forceinline__ const float* sgu_w() const { return inp(4); }
    __device__ __forceinline__ const float* sgu_b() const { return inp(5); }
    __device__ __forceinline__ const float* q_norm_w() const { return inp(6); }
    __device__ __forceinline__ const float* k_norm_w() const { return inp(7); }
    __device__ __forceinline__ const float* out_norm_a_w() const { return inp(8); }
    __device__ __forceinline__ const float* out_norm_b_w() const { return inp(9); }
    __device__ __forceinline__ const float* w_out() const { return inp(10); }
    __device__ __forceinline__ const float* norm2_w() const { return inp(11); }
    __device__ __forceinline__ const float* router_w() const { return inp(12); }
    __device__ __forceinline__ const float* router_b() const { return inp(13); }
    __device__ __forceinline__ const float* w_gate_up() const { return inp(14); }
    __device__ __forceinline__ const float* b_gate_up() const { return inp(15); }
    __device__ __forceinline__ const float* w_down() const { return inp(16); }
    __device__ __forceinline__ const float* b_down() const { return inp(17); }
    __device__ __forceinline__ bf16_t* XB() const { return (bf16_t*)(ws() + WS_XB); }
    __device__ __forceinline__ bf16_t* WIN() const { return (bf16_t*)(ws() + WS_WIN); }
    __device__ __forceinline__ bf16_t* WOUT() const { return (bf16_t*)(ws() + WS_WOUT); }
    __device__ __forceinline__ bf16_t* UV() const { return (bf16_t*)(ws() + WS_UV); }
    __device__ __forceinline__ bf16_t* Q() const { return (bf16_t*)(ws() + WS_Q); }
    __device__ __forceinline__ bf16_t* K() const { return (bf16_t*)(ws() + WS_K); }
    __device__ __forceinline__ bf16_t* VT() const { return (bf16_t*)(ws() + WS_VT); }
    __device__ __forceinline__ bf16_t* Y() const { return (bf16_t*)(ws() + WS_Y); }
    __device__ __forceinline__ unsigned char* YS() const { return ws() + WS_YS; }
    __device__ __forceinline__ bf16_t* RT() const { return (bf16_t*)(ws() + WS_RT); }
    __device__ __forceinline__ unsigned char* HB() const { return ws() + WS_HB; }
    __device__ __forceinline__ unsigned char* WGU() const { return ws() + WS_WGU; }
    __device__ __forceinline__ unsigned char* WD() const { return ws() + WS_WD; }
    __device__ __forceinline__ unsigned char* ACT() const { return ws() + WS_ACT; }
    __device__ __forceinline__ float* RSTD1() const { return (float*)(ws() + WS_RSTD1); }
    __device__ __forceinline__ float* SSPART() const { return (float*)(ws() + WS_SSPART); }
    __device__ __forceinline__ float* LISTGATE() const { return (float*)(ws() + WS_LISTGATE); }
    __device__ __forceinline__ int* LISTTOK() const { return (int*)(ws() + WS_LISTTOK); }
    __device__ __forceinline__ int* TOKINFO() const { return (int*)(ws() + WS_TOKINFO); }
    __device__ __forceinline__ unsigned* ctl() const { return (unsigned*)(ws() + WS_CTL); }
};

__device__ __forceinline__ void p0_transpose_item(const float* W, int K, int N, bf16_t* WT, int k0, int n0, int drow0, const float* kscale, LAS float* scr, int lane) {
#pragma unroll 8
    for (int i = 0; i < 32; ++i) { const int kk = 2 * i + (lane >> 5); float v = W[(size_t)(k0 + kk) * N + n0 + (lane & 31)]; if (kscale) v *= kscale[k0 + kk]; scr[kk * 33 + (lane & 31)] = v; }
    asm volatile("s_waitcnt lgkmcnt(0)" ::: "memory");
    const int c = lane & 7;
#pragma unroll
    for (int j = 0; j < 4; ++j) { const int n = (lane >> 3) + 8 * j; const LAS float* s = scr + (8 * c) * 33 + n;
        u32x4 o; o.x = cvt_pk_bf16(s[0 * 33], s[1 * 33]); o.y = cvt_pk_bf16(s[2 * 33], s[3 * 33]); o.z = cvt_pk_bf16(s[4 * 33], s[5 * 33]); o.w = cvt_pk_bf16(s[6 * 33], s[7 * 33]);
        *(u32x4*)(WT + (size_t)(drow0 + n) * K + k0 + 8 * c) = o; }
    asm volatile("s_waitcnt lgkmcnt(0)" ::: "memory");
}
__device__ __forceinline__ void p0_transpose_item_f8(const float* W, int K, int N, unsigned char* WT, int k0, int n0, LAS float* scr, int lane) {
#pragma unroll 8
    for (int i = 0; i < 32; ++i) { const int kk = 2 * i + (lane >> 5); scr[kk * 33 + (lane & 31)] = W[(size_t)(k0 + kk) * N + n0 + (lane & 31)] * WSCALE; }
    asm volatile("s_waitcnt lgkmcnt(0)" ::: "memory");
    const int c = lane & 7;
#pragma unroll
    for (int j = 0; j < 4; ++j) { const int n = (lane >> 3) + 8 * j; const LAS float* s = scr + (8 * c) * 33 + n;
        u32x2 o; o.x = pk4_fp8(s[0 * 33], s[1 * 33], s[2 * 33], s[3 * 33]); o.y = pk4_fp8(s[4 * 33], s[5 * 33], s[6 * 33], s[7 * 33]);
        *(u32x2*)(WT + (size_t)(n0 + n) * K + k0 + 8 * c) = o; }
    asm volatile("s_waitcnt lgkmcnt(0)" ::: "memory");
}
__device__ __forceinline__ int win_drow(int n0) {
    if (n0 < 1024 || n0 >= 2048) return n0;
    const int rel = n0 - 1024, isk = rel >> 9, head = (rel & 511) >> 6, dh = (rel & 63) >> 5;
    return 256 * (4 + 2 * isk + (head >> 2)) + 128 * dh + 32 * (head & 3);
}
constexpr int MOE_I_GU = 16 * 64, MOE_I_D = 16 * 32, MOE_ITEMS = NE * (MOE_I_GU + MOE_I_D);
struct ConvItem { const float* src; unsigned char* dst; int N; };
__device__ __forceinline__ ConvItem moe_conv_decode(const Frame& F, int it) {
    ConvItem c;
    if (it < NE * MOE_I_GU) { const int e = it / MOE_I_GU, q = it % MOE_I_GU, kb = q / 64, nb = q % 64; c.N = 2048;
        c.src = F.w_gate_up() + (size_t)e * KD * 2048 + (size_t)(64 * kb) * 2048 + 32 * nb; c.dst = F.WGU() + (size_t)e * 2048 * KD + (size_t)(32 * nb) * KD + 64 * kb; }
    else { const int r = it - NE * MOE_I_GU; const int e = r / MOE_I_D, q = r % MOE_I_D, kb = q / 32, nb = q % 32; c.N = 1024;
        c.src = F.w_down() + (size_t)e * KD * 1024 + (size_t)(64 * kb) * 1024 + 32 * nb; c.dst = F.WD() + (size_t)e * 1024 * KD + (size_t)(32 * nb) * KD + 64 * kb; }
    return c;
}
__device__ __forceinline__ void moe_conv_issue(const ConvItem& c, f32x4 (&v)[8], int lane) {
    const float* p = c.src + (size_t)(lane >> 3) * c.N + 4 * (lane & 7);
#pragma unroll
    for (int i = 0; i < 8; ++i) v[i] = *(const f32x4*)(p + (size_t)(8 * i) * c.N);
}
__device__ __forceinline__ void moe_conv_finish(const ConvItem& c, const f32x4 (&v)[8], LAS float* scr, int lane) {
    LAS float* w = scr + (lane >> 3) * 33 + 4 * (lane & 7);
#pragma unroll
    for (int i = 0; i < 8; ++i) { w[(8 * i) * 33 + 0] = v[i][0] * WSCALE; w[(8 * i) * 33 + 1] = v[i][1] * WSCALE; w[(8 * i) * 33 + 2] = v[i][2] * WSCALE; w[(8 * i) * 33 + 3] = v[i][3] * WSCALE; }
    asm volatile("s_waitcnt lgkmcnt(0)" ::: "memory");
    const int cc = lane & 7;
#pragma unroll
    for (int j = 0; j < 4; ++j) { const int n = (lane >> 3) + 8 * j; const LAS float* s = scr + (8 * cc) * 33 + n;
        u32x2 o; o.x = pk4_fp8(s[0 * 33], s[1 * 33], s[2 * 33], s[3 * 33]); o.y = pk4_fp8(s[4 * 33], s[5 * 33], s[6 * 33], s[7 * 33]);
        *(u32x2*)(c.dst + (size_t)n * KD + 8 * cc) = o; }
    asm volatile("s_waitcnt lgkmcnt(0)" ::: "memory");
}
constexpr int CONV_P4_PER_WAVE = 20, CONV_P4_ITEMS = CONV_P4_PER_WAVE * 1024;
constexpr int CONV_P2_ITEMS = MOE_ITEMS - CONV_P4_ITEMS, CONV_P2_PER_WAVE = CONV_P2_ITEMS / 2048;
static_assert(CONV_P2_ITEMS % 2048 == 0 && CONV_P4_PER_WAVE % 2 == 0, "conversion split");
__device__ __forceinline__ void p0_prologue(Frame& F) {
    LAS float* scr = (LAS float*)(F.lds + F.wave * 16384);
    const int gw = F.vcu * NWAVES + F.wave, NGW = F.G * NWAVES, lane = F.lane;
    for (int m = gw; m < NTOK; m += 2 * NGW) {
        const int m2 = m + NGW;
        const f32x4* xr = (const f32x4*)(F.x() + (size_t)m * DM) + lane; const f32x4* xr2 = (const f32x4*)(F.x() + (size_t)m2 * DM) + lane; f32x4 v[4], w[4]; float s = 0.f, s2 = 0.f;
#pragma unroll
        for (int j = 0; j < 4; ++j) v[j] = __builtin_nontemporal_load(xr + 64 * j);
#pragma unroll
        for (int j = 0; j < 4; ++j) w[j] = __builtin_nontemporal_load(xr2 + 64 * j);
#pragma unroll
        for (int j = 0; j < 4; ++j) { s += (v[j].x * v[j].x + v[j].y * v[j].y) + (v[j].z * v[j].z + v[j].w * v[j].w); s2 += (w[j].x * w[j].x + w[j].y * w[j].y) + (w[j].z * w[j].z + w[j].w * w[j].w); }
        const float tot = wave_sum(s), tot2 = wave_sum(s2);
        if (lane == 0) { F.RSTD1()[m] = 1.0f / sqrtf(tot * (1.0f / DM) + EPS); F.RSTD1()[m2] = 1.0f / sqrtf(tot2 * (1.0f / DM) + EPS); }
        u32x2* o8 = (u32x2*)(F.XB() + (size_t)m * DM) + lane; u32x2* o82 = (u32x2*)(F.XB() + (size_t)m2 * DM) + lane;
#pragma unroll
        for (int j = 0; j < 4; ++j) { u32x2 a; a.x = cvt_pk_bf16(v[j].x, v[j].y); a.y = cvt_pk_bf16(v[j].z, v[j].w); o8[64 * j] = a; u32x2 b; b.x = cvt_pk_bf16(w[j].x, w[j].y); b.y = cvt_pk_bf16(w[j].z, w[j].w); o82[64 * j] = b; }
    }
    constexpr int I_IN = 16 * 80, I_OUT = 16 * 32;
    for (int it = gw; it < I_IN + I_OUT; it += NGW) {
        int r = it;
        if (r < I_IN) { const int kb = r / 80, nb = r % 80; p0_transpose_item(F.w_in(), KD, 2560, F.WIN(), 64 * kb, 32 * nb, win_drow(32 * nb), F.norm1_w(), scr, lane); continue; } r -= I_IN;
        { const int kb = r / 32, nb = r % 32; p0_transpose_item(F.w_out(), KD, 1024, F.WOUT(), 64 * kb, 32 * nb, 32 * nb, nullptr, scr, lane); }
    }
    for (int idx = gw * 64 + lane; idx < NE * KD; idx += NGW * 64) {
        const int e = idx >> 10, k = idx & 1023; const float w = F.router_w()[(size_t)k * NE + e];
        const unsigned hi = cvt_pk_bf16(w, 0.f) & 0xffffu; const float rem = w - __uint_as_float(hi << 16);
        F.RT()[idx] = (bf16_t)hi; F.RT()[NE * KD + idx] = (bf16_t)(cvt_pk_bf16(rem, 0.f) & 0xffffu);
    }
}

struct ProgIn {
    static constexpr bool GATHER = false, FP8 = false; static constexpr int ID = 1;
    const Frame* F;
    __device__ __forceinline__ bool next(int i, Unit& u) const {
        const int v = F->vcu;
        if (i < 4) { const int uu = i * 256 + v, grp = uu >> 5, w = uu & 31; u.pm = grp * 4 + (w & 3); u.pn = w >> 2; u.kind = u.pn < 4 ? 0 : 1;
            u.A = (const char*)(F->XB() + (size_t)u.pm * 256 * KD); u.B = (const char*)(F->WIN() + (size_t)u.pn * 256 * KD); u.e = 0; u.r0 = 0; return true; }
        if (i == 4) { u.kind = 2; u.pm = v & 1; u.pn = v >> 1; u.A = (const char*)(F->WIN() + (size_t)(2048 + u.pm * 256) * KD); u.B = (const char*)(F->XB() + (size_t)u.pn * 256 * KD); u.e = 0; u.r0 = 0; return true; }
        return false;
    }
    __device__ __forceinline__ void epi(const Acc& acc, const Unit& u, int wr, int wc, int fr, int fq) const {
        asm volatile("" : "+v"(fr), "+v"(fq));
        if (u.kind == 2) {
            const int tk0 = u.pn * 256 + wc * 32 + 8 * fq;
            f32x4 rs[2][2];
#pragma unroll
            for (int bj = 0; bj < 2; ++bj)
#pragma unroll
                for (int n = 0; n < 2; ++n) rs[bj][n] = *(const f32x4*)(F->RSTD1() + tk0 + bj * 128 + 4 * n);
#pragma unroll
            for (int ai = 0; ai < 2; ++ai)
#pragma unroll
                for (int m = 0; m < 4; ++m) { const int cp = u.pm * 256 + ai * 128 + wr * 64 + m * 16 + fr; bf16_t* rowp = F->VT() + (size_t)cp * NTOK + tk0;
#pragma unroll
                    for (int bj = 0; bj < 2; ++bj) { const f32x4 v0 = acc[ai][bj][m][0] * rs[bj][0], v1 = acc[ai][bj][m][1] * rs[bj][1];
                        u32x4 w; w.x = cvt_pk_bf16(v0[0], v0[1]); w.y = cvt_pk_bf16(v0[2], v0[3]); w.z = cvt_pk_bf16(v1[0], v1[1]); w.w = cvt_pk_bf16(v1[2], v1[3]);
                        *(u32x4*)(rowp + bj * 128) = w; } }
            return;
        }
        float rsr[2][4];
#pragma unroll
        for (int ai = 0; ai < 2; ++ai)
#pragma unroll
            for (int m = 0; m < 4; ++m) rsr[ai][m] = F->RSTD1()[u.pm * 256 + ai * 128 + wr * 64 + m * 16 + fr];
        if (u.kind == 0) {
#pragma unroll
            for (int ai = 0; ai < 2; ++ai)
#pragma unroll
                for (int m = 0; m < 4; ++m) { const int r = u.pm * 256 + ai * 128 + wr * 64 + m * 16 + fr; bf16_t* rowp = F->UV() + (size_t)r * 1024 + u.pn * 256 + wc * 32 + 8 * fq; const float rs = rsr[ai][m];
#pragma unroll
                    for (int bj = 0; bj < 2; ++bj) { f32x4 v0 = acc[ai][bj][m][0] * rs, v1 = acc[ai][bj][m][1] * rs;
#pragma unroll
                        for (int j = 0; j < 4; ++j) { v0[j] = gelu_tanh_f(v0[j]); v1[j] = gelu_tanh_f(v1[j]); }
                        u32x4 w; w.x = cvt_pk_bf16(v0[0], v0[1]); w.y = cvt_pk_bf16(v0[2], v0[3]); w.z = cvt_pk_bf16(v1[0], v1[1]); w.w = cvt_pk_bf16(v1[2], v1[3]);
                        *(u32x4*)(rowp + bj * 128) = w; } }
            return;
        }
        {
            const int isk = (u.pn - 4) >> 1, head = 4 * (u.pn & 1) + wc; const float* nw = isk ? F->k_norm_w() : F->q_norm_w(); bf16_t* dst = isk ? F->K() : F->Q();
            const float osc = isk ? 1.0f : QSCALE;
            f32x4 nwv[2][2];
#pragma unroll
            for (int bj = 0; bj < 2; ++bj)
#pragma unroll
                for (int n = 0; n < 2; ++n) nwv[bj][n] = *(const f32x4*)(nw + 32 * bj + 8 * fq + 4 * n);
#pragma unroll
            for (int ai = 0; ai < 2; ++ai)
#pragma unroll
                for (int m = 0; m < 4; ++m) { const int r = u.pm * 256 + ai * 128 + wr * 64 + m * 16 + fr; const float rs = rsr[ai][m];
                    f32x4 t[2][2]; float ss = 0.f;
#pragma unroll
                    for (int bj = 0; bj < 2; ++bj)
#pragma unroll
                        for (int n = 0; n < 2; ++n) { t[bj][n] = acc[ai][bj][m][n] * rs; ss += (t[bj][n][0] * t[bj][n][0] + t[bj][n][1] * t[bj][n][1]) + (t[bj][n][2] * t[bj][n][2] + t[bj][n][3] * t[bj][n][3]); }
                    ss += __shfl_xor(ss, 16); ss += __shfl_xor(ss, 32);
                    const float rn = osc / sqrtf(ss * (1.0f / 64.0f) + EPS);
                    bf16_t* rowp = dst + (size_t)r * 512 + head * 64 + 8 * fq;
#pragma unroll
                    for (int bj = 0; bj < 2; ++bj) { const f32x4 v0 = t[bj][0] * nwv[bj][0] * rn, v1 = t[bj][1] * nwv[bj][1] * rn;
                        u32x4 w; w.x = cvt_pk_bf16(v0[0], v0[1]); w.y = cvt_pk_bf16(v0[2], v0[3]); w.z = cvt_pk_bf16(v1[0], v1[1]); w.w = cvt_pk_bf16(v1[2], v1[3]);
                        *(u32x4*)(rowp + bj * 32) = w; } }
        }
    }
};

constexpr int VN_PITCH = 136, YT_PITCH = 132, YT_OFF = 36864;
__device__ __forceinline__ void gmlp_unit(const Frame& F, int chunk, int g) {
    const int tid = F.tid, lane = F.lane, wid = F.wave;
    LAS bf16_t* vn = (LAS bf16_t*)F.lds; LAS float* yt = (LAS float*)(F.lds + YT_OFF);
    const size_t tok0 = (size_t)chunk * 128;
    {
        const int row = tid >> 2, qd = tid & 3; const bf16_t* src = F.UV() + (tok0 + row) * 1024 + 512 + g * 128 + qd * 32;
        u32x4 w[4]; float v[32]; float ss = 0.f;
#pragma unroll
        for (int i = 0; i < 4; ++i) w[i] = *(const u32x4*)(src + 8 * i);
#pragma unroll
        for (int i = 0; i < 4; ++i)
#pragma unroll
            for (int j = 0; j < 4; ++j) { v[8 * i + 2 * j] = bflo(w[i][j]); v[8 * i + 2 * j + 1] = bfhi(w[i][j]); }
#pragma unroll
        for (int i = 0; i < 32; ++i) ss += v[i] * v[i];
        ss += __shfl_xor(ss, 1); ss += __shfl_xor(ss, 2);
        const float rs = 1.0f / sqrtf(ss * (1.0f / 128.0f) + EPS);
        const float* nw = F.sgu_norm_w() + g * 128 + qd * 32;
#pragma unroll
        for (int i = 0; i < 4; ++i) { const f32x4 n0 = *(const f32x4*)(nw + 8 * i), n1 = *(const f32x4*)(nw + 8 * i + 4);
            u32x4 o; o.x = cvt_pk_bf16(v[8 * i] * rs * n0[0], v[8 * i + 1] * rs * n0[1]); o.y = cvt_pk_bf16(v[8 * i + 2] * rs * n0[2], v[8 * i + 3] * rs * n0[3]);
            o.z = cvt_pk_bf16(v[8 * i + 4] * rs * n1[0], v[8 * i + 5] * rs * n1[1]); o.w = cvt_pk_bf16(v[8 * i + 6] * rs * n1[2], v[8 * i + 7] * rs * n1[3]);
            *(LAS u32x4*)(vn + row * VN_PITCH + qd * 32 + 8 * i) = o; }
    }
    __syncthreads();
    {
        const int tb = wid >> 1, cb0 = 2 * (wid & 1), r32 = lane & 31, hh = lane >> 5;
        f32x16 a0 = {}, a1 = {};
        const int t = 32 * tb + r32; const float* wrow = F.sgu_w() + ((size_t)g * 128 + t) * 128;
        for (int ks = 0; ks < 2 * (tb + 1); ++ks) {
            const int s0 = 16 * ks + 8 * hh;
            const f32x4 w0 = *(const f32x4*)(wrow + s0), w1 = *(const f32x4*)(wrow + s0 + 4);
            float wv[8] = {w0[0], w0[1], w0[2], w0[3], w1[0], w1[1], w1[2], w1[3]};
#pragma unroll
            for (int j = 0; j < 8; ++j) if (s0 + j > t) wv[j] = 0.f;
            u32x4 aw; aw.x = cvt_pk_bf16(wv[0], wv[1]); aw.y = cvt_pk_bf16(wv[2], wv[3]); aw.z = cvt_pk_bf16(wv[4], wv[5]); aw.w = cvt_pk_bf16(wv[6], wv[7]);
            const bf16x8 af = __builtin_bit_cast(bf16x8, aw);
            bf16x8 b0, b1;
#pragma unroll
            for (int j = 0; j < 8; ++j) { b0[j] = (short)vn[(s0 + j) * VN_PITCH + 32 * cb0 + r32]; b1[j] = (short)vn[(s0 + j) * VN_PITCH + 32 * (cb0 + 1) + r32]; }
            a0 = __builtin_amdgcn_mfma_f32_32x32x16_bf16(af, b0, a0, 0, 0, 0);
            a1 = __builtin_amdgcn_mfma_f32_32x32x16_bf16(af, b1, a1, 0, 0, 0);
        }
#pragma unroll
        for (int reg = 0; reg < 16; ++reg) {
            const int tt = 32 * tb + (reg & 3) + 8 * (reg >> 2) + 4 * hh; const float bb = F.sgu_b()[g * 128 + tt];
            const bf16_t* up = F.UV() + (tok0 + tt) * 1024 + g * 128;
            const int c0 = 32 * cb0 + r32, c1 = c0 + 32;
            yt[tt * YT_PITCH + c0] = bf2f(up[c0]) * (a0[reg] + bb);
            yt[tt * YT_PITCH + c1] = bf2f(up[c1]) * (a1[reg] + bb);
        }
    }
    __syncthreads();
    {
        const int row = tid >> 2, qd = tid & 3; const LAS float* src = yt + row * YT_PITCH + qd * 32; f32x4 v[8]; float ss = 0.f;
#pragma unroll
        for (int i = 0; i < 8; ++i) { v[i] = *(const LAS f32x4*)(src + 4 * i); ss += (v[i][0] * v[i][0] + v[i][1] * v[i][1]) + (v[i][2] * v[i][2] + v[i][3] * v[i][3]); }
        ss += __shfl_xor(ss, 1); ss += __shfl_xor(ss, 2);
        const float rs = 1.0f / sqrtf(ss * (1.0f / 128.0f) + EPS);
        const float* nw = F.out_norm_a_w() + g * 128 + qd * 32; bf16_t* dst = F.Y() + (tok0 + row) * 1024 + g * 128 + qd * 32;
#pragma unroll
        for (int i = 0; i < 4; ++i) { const f32x4 n0 = *(const f32x4*)(nw + 8 * i), n1 = *(const f32x4*)(nw + 8 * i + 4); const f32x4 x0 = v[2 * i] * n0 * rs, x1 = v[2 * i + 1] * n1 * rs;
            u32x4 o; o.x = cvt_pk_bf16(x0[0], x0[1]); o.y = cvt_pk_bf16(x0[2], x0[3]); o.z = cvt_pk_bf16(x1[0], x1[1]); o.w = cvt_pk_bf16(x1[2], x1[3]);
            *(u32x4*)(dst + 8 * i) = o; }
    }
    __syncthreads();
}

__device__ __forceinline__ void attn_wave_unit(const Frame& F, int b, int h, int qblk, int& cit, int cend, LAS float* scr) {
    const int lane = F.lane, r32 = lane & 31, hi = lane >> 5;
    const size_t tokq = (size_t)b * SEQ + 32 * qblk + r32;
    bf16x8 qr[4];
#pragma unroll
    for (int d0 = 0; d0 < 4; ++d0) qr[d0] = *(const bf16x8*)(F.Q() + tokq * 512 + h * 64 + 16 * d0 + 8 * hi);
    f32x16 o0 = {}, o1 = {};
    float carry = 0.f;
    const bf16_t* Kb = F.K() + ((size_t)b * SEQ + r32) * 512 + h * 64 + 8 * hi;
    const bf16_t* V0 = F.VT() + (size_t)(h * 64 + r32) * NTOK + (size_t)b * SEQ + 4 * hi;
    bf16x8 kf[4]; s16x4 vf[2][2][2];
    auto load_tile = [&](int j, bf16x8 (&kk)[4], s16x4 (&vv)[2][2][2]) {
#pragma unroll
        for (int d0 = 0; d0 < 4; ++d0) kk[d0] = *(const bf16x8*)(Kb + (size_t)(32 * j) * 512 + 16 * d0);
#pragma unroll
        for (int dh = 0; dh < 2; ++dh)
#pragma unroll
            for (int ks = 0; ks < 2; ++ks) { const bf16_t* p = V0 + (size_t)dh * 32 * NTOK + 32 * j + 16 * ks; vv[dh][ks][0] = *(const s16x4*)p; vv[dh][ks][1] = *(const s16x4*)(p + 8); }
    };
    load_tile(qblk, kf, vf);
    for (int j = qblk; j >= 0; --j) {
        bf16x8 kn[4]; s16x4 vn2[2][2][2];
        const bool cv = cit < cend; ConvItem citem; f32x4 cvv[8];
        if (cv) { citem = moe_conv_decode(F, cit); moe_conv_issue(citem, cvv, lane); cit += 2048; }
        if (j > 0) load_tile(j - 1, kn, vn2);
        else {
#pragma unroll
            for (int d0 = 0; d0 < 4; ++d0) kn[d0] = kf[d0];
#pragma unroll
            for (int dh = 0; dh < 2; ++dh)
#pragma unroll
                for (int ks = 0; ks < 2; ++ks) { vn2[dh][ks][0] = vf[dh][ks][0]; vn2[dh][ks][1] = vf[dh][ks][1]; }
        }
        f32x16 s = {};
#pragma unroll
        for (int d0 = 0; d0 < 4; ++d0) s = __builtin_amdgcn_mfma_f32_32x32x16_bf16(kf[d0], qr[d0], s, 0, 0, 0);
        float sp[16];
        const bool diag = (j == qblk);
#pragma unroll
        for (int r = 0; r < 16; ++r) {
            const int kvl = (r & 3) + 8 * (r >> 2) + 4 * hi;
            const float z = s[r];
            float v = fmaxf(z, 0.f) + __builtin_amdgcn_logf(1.0f + __builtin_amdgcn_exp2f(-fabsf(z)));
            if (diag && kvl >= r32) v = 0.f;
            sp[r] = v;
        }
        float G[4], Gp[4];
#pragma unroll
        for (int k = 0; k < 4; ++k) { G[k] = (sp[4 * k] + sp[4 * k + 1]) + (sp[4 * k + 2] + sp[4 * k + 3]); Gp[k] = __shfl_xor(G[k], 32); }
        const float T3 = G[3] + Gp[3], T2 = G[2] + Gp[2], T1 = G[1] + Gp[1], T0 = G[0] + Gp[0];
        float off[4];
        off[3] = 0.f; off[2] = T3; off[1] = T3 + T2; off[0] = T3 + T2 + T1;
        const float tile_total = off[0] + T0;
#pragma unroll
        for (int k = 0; k < 4; ++k) off[k] += carry + (hi == 0 ? Gp[k] : 0.f);
        float a[16];
#pragma unroll
        for (int k = 0; k < 4; ++k) {
            float c = off[k];
#pragma unroll
            for (int i = 3; i >= 0; --i) { const int r = 4 * k + i; c += sp[r]; float av = __builtin_amdgcn_exp2f(s[r] - c);
                if (diag && ((r & 3) + 8 * (r >> 2) + 4 * hi) >= r32) av = 0.f;
                a[r] = av; }
        }
        carry += tile_total;
        u32x4 p0, p1;
        p0.x = cvt_pk_bf16(a[0], a[1]); p0.y = cvt_pk_bf16(a[2], a[3]); p0.z = cvt_pk_bf16(a[4], a[5]); p0.w = cvt_pk_bf16(a[6], a[7]);
        p1.x = cvt_pk_bf16(a[8], a[9]); p1.y = cvt_pk_bf16(a[10], a[11]); p1.z = cvt_pk_bf16(a[12], a[13]); p1.w = cvt_pk_bf16(a[14], a[15]);
        const bf16x8 pf0 = __builtin_bit_cast(bf16x8, p0), pf1 = __builtin_bit_cast(bf16x8, p1);
#define MK_VF(dh, ks) (bf16x8){vf[dh][ks][0][0], vf[dh][ks][0][1], vf[dh][ks][0][2], vf[dh][ks][0][3], vf[dh][ks][1][0], vf[dh][ks][1][1], vf[dh][ks][1][2], vf[dh][ks][1][3]}
        o0 = __builtin_amdgcn_mfma_f32_32x32x16_bf16(MK_VF(0, 0), pf0, o0, 0, 0, 0);
        o0 = __builtin_amdgcn_mfma_f32_32x32x16_bf16(MK_VF(0, 1), pf1, o0, 0, 0, 0);
        o1 = __builtin_amdgcn_mfma_f32_32x32x16_bf16(MK_VF(1, 0), pf0, o1, 0, 0, 0);
        o1 = __builtin_amdgcn_mfma_f32_32x32x16_bf16(MK_VF(1, 1), pf1, o1, 0, 0, 0);
#undef MK_VF
        if (cv) moe_conv_finish(citem, cvv, scr, lane);
        if (__all(carry > SB_THR)) break;
#pragma unroll
        for (int d0 = 0; d0 < 4; ++d0) kf[d0] = kn[d0];
#pragma unroll
        for (int dh = 0; dh < 2; ++dh)
#pragma unroll
            for (int ks = 0; ks < 2; ++ks) { vf[dh][ks][0] = vn2[dh][ks][0]; vf[dh][ks][1] = vn2[dh][ks][1]; }
    }
    float ss = 0.f;
#pragma unroll
    for (int r = 0; r < 16; ++r) ss += o0[r] * o0[r] + o1[r] * o1[r];
    ss += __shfl_xor(ss, 32);
    const float rs = 1.0f / sqrtf(ss * (1.0f / 64.0f) + EPS);
    const float* nw = F.out_norm_b_w() + h * 64 + 4 * hi; bf16_t* dst = F.Y() + tokq * 1024 + 512 + h * 64 + 4 * hi;
#pragma unroll
    for (int dh = 0; dh < 2; ++dh)
#pragma unroll
        for (int g = 0; g < 4; ++g) { const f32x4 w = *(const f32x4*)(nw + 32 * dh + 8 * g); const f32x16& o = dh ? o1 : o0;
            u32x2 pk; pk.x = cvt_pk_bf16(o[4 * g] * rs * w[0], o[4 * g + 1] * rs * w[1]); pk.y = cvt_pk_bf16(o[4 * g + 2] * rs * w[2], o[4 * g + 3] * rs * w[3]);
            *(u32x2*)(dst + 32 * dh + 8 * g) = pk; }
}
__device__ __forceinline__ void p2_mixers(Frame& F) {
    for (int i = 0; i < (MK_REP == 20 ? 8 : 4); ++i) { const int u = (i & 3) * 256 + F.vcu; gmlp_unit(F, u >> 2, u & 3); }
    const int gw = F.vcu * NWAVES + F.wave;
    LAS float* scr = (LAS float*)(F.lds + F.wave * 16384);
    int cit = CONV_P4_ITEMS + gw; const int cend = CONV_P4_ITEMS + CONV_P2_PER_WAVE * 2048;
    for (int i = 0; i < ((MK_REP == 21 || MK_REP == 22) ? 8 : 4); ++i) { if (MK_REP == 22 && i == 4) cit = CONV_P4_ITEMS + gw; const int u = (i & 3) * 2048 + gw; const int qblk = u & 127, bh = u >> 7; attn_wave_unit(F, bh >> 3, bh & 7, qblk, cit, cend, scr); }
    for (; cit < cend; cit += 2048) { const ConvItem c = moe_conv_decode(F, cit); f32x4 v[8]; moe_conv_issue(c, v, F.lane); moe_conv_finish(c, v, scr, F.lane); }
}

struct ProgOut {
    static constexpr bool GATHER = false, FP8 = false; static constexpr int ID = 3;
    const Frame* F;
    __device__ __forceinline__ bool next(int i, Unit& u) const {
        if (i >= 2) return false;
        const int uu = i * 256 + F->vcu, grp = uu >> 5, w = uu & 31; u.pm = grp * 8 + (w & 7); u.pn = w >> 3; u.kind = 0; u.e = 0; u.r0 = 0;
        u.A = (const char*)(F->Y() + (size_t)u.pm * 256 * KD); u.B = (const char*)(F->WOUT() + (size_t)u.pn * 256 * KD); return true;
    }
    __device__ __forceinline__ void epi(const Acc& acc, const Unit& u, int wr, int wc, int fr, int fq) const {
        asm volatile("" : "+v"(fr), "+v"(fq));
        const size_t off0 = (size_t)(u.pm * 256 + wr * 64 + fr) * DM + u.pn * 256 + wc * 32 + 8 * fq;
        const float* xb = F->x() + off0; float* ob = F->out() + off0;
        f32x4 xv[2][2][2];
#define MK_LDX(g, slot) do { const size_t go_ = (size_t)(((g) >> 2) * 128 + ((g) & 3) * 16) * DM; _Pragma("unroll") for (int bj = 0; bj < 2; ++bj) _Pragma("unroll") for (int n = 0; n < 2; ++n) xv[slot][bj][n] = *(const f32x4*)(xb + go_ + bj * 128 + 4 * n); } while (0)
        MK_LDX(0, 0);
#pragma unroll
        for (int g = 0; g < 8; ++g) { const int ai = g >> 2, m = g & 3; const size_t go = (size_t)(ai * 128 + m * 16) * DM; float ss = 0.f;
            if (g + 1 < 8) MK_LDX(g + 1, (g + 1) & 1);
#pragma unroll
            for (int bj = 0; bj < 2; ++bj)
#pragma unroll
                for (int n = 0; n < 2; ++n) { const f32x4 o = xv[g & 1][bj][n] + acc[ai][bj][m][n];
                    ss += (o[0] * o[0] + o[1] * o[1]) + (o[2] * o[2] + o[3] * o[3]); *(f32x4*)(ob + go + bj * 128 + 4 * n) = o; }
            ss += __shfl_xor(ss, 16); ss += __shfl_xor(ss, 32);
            if (fq == 0) F->SSPART()[(size_t)(u.pm * 256 + ai * 128 + wr * 64 + m * 16 + fr) * 16 + u.pn * 4 + wc] = ss; }
#undef MK_LDX
    }
};

template <bool DRY> __device__ __forceinline__ void router_wave_unit(Frame& F, int unit) {
    const int lane = F.lane, r32 = lane & 31, hh = lane >> 5; const int tok = unit * 32 + r32;
    float ssum = 0.f;
    { const f32x4* sp = (const f32x4*)(F.SSPART() + (size_t)tok * 16);
#pragma unroll
      for (int i = 0; i < 4; ++i) { const f32x4 v = sp[i]; ssum += v[0]; ssum += v[1]; ssum += v[2]; ssum += v[3]; } }
    const float rs = 1.0f / sqrtf(ssum * (1.0f / DM) + EPS);
    f32x16 acc = {};
    const float* xrow = F.out() + (size_t)tok * DM + 8 * hh; const float* w2 = F.norm2_w() + 8 * hh; unsigned char* hrow = F.HB() + (size_t)tok * DM + 8 * hh;
    const bf16_t* rth = F.RT() + (size_t)r32 * KD + 8 * hh; const bf16_t* rtl = rth + NE * KD;
#pragma unroll 4
    for (int s = 0; s < 64; ++s) {
        const f32x4 x0 = *(const f32x4*)(xrow + 16 * s), x1 = *(const f32x4*)(xrow + 16 * s + 4);
        const f32x4 g0 = *(const f32x4*)(w2 + 16 * s), g1 = *(const f32x4*)(w2 + 16 * s + 4);
        const f32x4 h0 = x0 * g0 * rs, h1 = x1 * g1 * rs;
        u32x4 hw; hw.x = cvt_pk_bf16(h0[0], h0[1]); hw.y = cvt_pk_bf16(h0[2], h0[3]); hw.z = cvt_pk_bf16(h1[0], h1[1]); hw.w = cvt_pk_bf16(h1[2], h1[3]);
        { u32x2 h8; h8.x = pk4_fp8(h0[0], h0[1], h0[2], h0[3]); h8.y = pk4_fp8(h1[0], h1[1], h1[2], h1[3]); *(u32x2*)(hrow + 16 * s) = h8; }
        u32x4 lw; lw.x = cvt_pk_bf16(h0[0] - bflo(hw.x), h0[1] - bfhi(hw.x)); lw.y = cvt_pk_bf16(h0[2] - bflo(hw.y), h0[3] - bfhi(hw.y));
        lw.z = cvt_pk_bf16(h1[0] - bflo(hw.z), h1[1] - bfhi(hw.z)); lw.w = cvt_pk_bf16(h1[2] - bflo(hw.w), h1[3] - bfhi(hw.w));
        const bf16x8 bh = __builtin_bit_cast(bf16x8, hw), bl = __builtin_bit_cast(bf16x8, lw);
        const bf16x8 ah = *(const bf16x8*)(rth + 16 * s), al = *(const bf16x8*)(rtl + 16 * s);
        acc = __builtin_amdgcn_mfma_f32_32x32x16_bf16(ah, bh, acc, 0, 0, 0);
        acc = __builtin_amdgcn_mfma_f32_32x32x16_bf16(al, bh, acc, 0, 0, 0);
        acc = __builtin_amdgcn_mfma_f32_32x32x16_bf16(ah, bl, acc, 0, 0, 0);
    }
    float lv[16];
#pragma unroll
    for (int r = 0; r < 16; ++r) lv[r] = acc[r] + F.router_b()[(r & 3) + 8 * (r >> 2) + 4 * hh];
    float cv[8]; int ce[8];
#pragma unroll
    for (int k = 0; k < 4; ++k) { float bv = -INFINITY; int be = 0;
#pragma unroll
        for (int r = 0; r < 16; ++r) { const int e = (r & 3) + 8 * (r >> 2) + 4 * hh; if (lv[r] > bv) { bv = lv[r]; be = e; } }
#pragma unroll
        for (int r = 0; r < 16; ++r) { const int e = (r & 3) + 8 * (r >> 2) + 4 * hh; if (e == be) lv[r] = -INFINITY; }
        cv[k] = bv; ce[k] = be; }
#pragma unroll
    for (int k = 0; k < 4; ++k) { cv[4 + k] = __shfl_xor(cv[k], 32); ce[4 + k] = __shfl_xor(ce[k], 32); }
    float tv[4]; int te[4];
#pragma unroll
    for (int k = 0; k < 4; ++k) { float bv = -INFINITY; int be = 1 << 20;
#pragma unroll
        for (int c = 0; c < 8; ++c) if (cv[c] > bv || (cv[c] == bv && ce[c] < be)) { bv = cv[c]; be = ce[c]; }
#pragma unroll
        for (int c = 0; c < 8; ++c) if (ce[c] == be) cv[c] = -INFINITY;
        tv[k] = bv; te[k] = be; }
    float ex[4], den = 0.f;
#pragma unroll
    for (int k = 0; k < 4; ++k) { ex[k] = __builtin_amdgcn_exp2f((tv[k] - tv[0]) * LOG2E); den += ex[k]; }
    const float rden = 1.0f / den;
    const int e0 = hh ? te[2] : te[0], e1 = hh ? te[3] : te[1]; const float g0 = (hh ? ex[2] : ex[0]) * rden, g1 = (hh ? ex[3] : ex[1]) * rden;
    if (DRY) { asm volatile("" :: "v"(e0), "v"(e1), "v"(g0), "v"(g1)); return; }
    int myc = 0; int rank0 = 0, rank1 = 0;
    const unsigned long long ltmask = (1ull << lane) - 1ull;
    for (int e = 0; e < NE; ++e) {
        const unsigned long long m0 = __ballot(e0 == e), m1 = __ballot(e1 == e);
        const int c0 = __popcll(m0), c1 = __popcll(m1);
        if (lane == e) myc = c0 + c1;
        if (e0 == e) rank0 = __popcll(m0 & ltmask);
        if (e1 == e) rank1 = c0 + __popcll(m1 & ltmask);
    }
    int base = 0;
    if (lane < NE && myc > 0) base = (int)__hip_atomic_fetch_add(F.ctl() + CW_CNT + lane, (unsigned)myc, __ATOMIC_RELAXED, __HIP_MEMORY_SCOPE_AGENT);
    const int p0 = __shfl(base, e0) + rank0, p1 = __shfl(base, e1) + rank1;
    F.LISTTOK()[(size_t)e0 * NTOK + p0] = tok; F.LISTGATE()[(size_t)e0 * NTOK + p0] = g0;
    F.LISTTOK()[(size_t)e1 * NTOK + p1] = tok; F.LISTGATE()[(size_t)e1 * NTOK + p1] = g1;
    F.TOKINFO()[tok * 4 + 2 * hh] = (e0 << 16) | p0; F.TOKINFO()[tok * 4 + 2 * hh + 1] = (e1 << 16) | p1;
}

__device__ __forceinline__ void moe_build_table(Frame& F) {
    LAS int* tab = (LAS int*)(F.lds + TAB_OFF);
    if (F.tid < NE) tab[F.tid] = (int)__hip_atomic_load(F.ctl() + CW_CNT + F.tid, __ATOMIC_RELAXED, __HIP_MEMORY_SCOPE_AGENT);
    __syncthreads();
    if (F.tid == 0) { int acc = 0; for (int e = 0; e < NE; ++e) { tab[32 + e] = acc; acc += (tab[e] + 255) >> 8; } tab[64] = acc; }
    __syncthreads();
}
__device__ __forceinline__ int sgpr(int v) { return __builtin_amdgcn_readfirstlane(v); }
template <int WGM, int NN>
__device__ __forceinline__ bool moe_decode(const Frame* F, int T, int i, Unit& u) {
    const LAS int* tab = (const LAS int*)(F->lds + TAB_OFF);
    const int uu = i * 256 + F->vcu, grp = uu >> 5, w = uu & 31; const int mt = grp * WGM + (w % WGM); u.pn = w / WGM;
    if (mt >= T) return false;
    int e = 0;
    for (int k = 1; k < NE; ++k) if (sgpr(tab[32 + k]) <= mt) e = k;
    u.e = e; u.pm = mt; u.r0 = (mt - sgpr(tab[32 + e])) * 256; u.kind = sgpr(tab[e]); return true;
}
struct ProgMoe1 {
    static constexpr bool GATHER = true, FP8 = true; static constexpr int ID = 5;
    const Frame* F; int T;
    __device__ __forceinline__ bool next(int i, Unit& u) const {
        if (!moe_decode<4, 8>(F, T, i, u)) return false;
        u.A = (const char*)F->HB(); u.B = (const char*)(F->WGU() + ((size_t)u.e * 2048 + (size_t)u.pn * 256) * KD); return true;
    }
    __device__ __forceinline__ void aoffs(const Unit& u, int wid, unsigned (&vo)[2][2]) const {
        const int cnt = u.kind; const int tid = wid * 64 + lane_id_fresh();
#pragma unroll
        for (int i = 0; i < 2; ++i) { int R_, C_; stage_rc(tid * 16 + i * 8192, R_, C_);
#pragma unroll
            for (int h = 0; h < 2; ++h) { const int idx = u.r0 + h * 128 + R_; const int tok = idx < cnt ? F->LISTTOK()[(size_t)u.e * NTOK + idx] : 0; vo[h][i] = (unsigned)(tok * KD + C_ * 2); } }
    }
    __device__ __forceinline__ void epi(const Acc& acc, const Unit& u, int wr, int wc, int fr, int fq) const {
        asm volatile("" : "+v"(fr), "+v"(fq));
        const float* bp = F->b_gate_up() + (size_t)u.e * 2048 + u.pn * 256 + wc * 32 + 8 * fq;
        f32x4 bv[2][2];
#pragma unroll
        for (int bj = 0; bj < 2; ++bj)
#pragma unroll
            for (int n = 0; n < 2; ++n) bv[bj][n] = *(const f32x4*)(bp + bj * 128 + 4 * n);
#pragma unroll
        for (int ai = 0; ai < 2; ++ai)
#pragma unroll
            for (int m = 0; m < 4; ++m) { const size_t slot = (size_t)u.pm * 256 + ai * 128 + wr * 64 + m * 16 + fr; unsigned char* rowp = F->ACT() + slot * 1024 + u.pn * 128 + wc * 16 + 4 * fq;
#pragma unroll
                for (int bj = 0; bj < 2; ++bj) { const f32x4 v0 = acc[ai][bj][m][0] * WSCALE_INV + bv[bj][0], v1 = acc[ai][bj][m][1] * WSCALE_INV + bv[bj][1];
                    f32x2 ga = {fminf(v0[0], 7.0f), fminf(v0[2], 7.0f)}, gb = {fminf(v1[0], 7.0f), fminf(v1[2], 7.0f)};
                    f32x2 ua = {__builtin_amdgcn_fmed3f(v0[1], -7.0f, 7.0f), __builtin_amdgcn_fmed3f(v0[3], -7.0f, 7.0f)}, ub = {__builtin_amdgcn_fmed3f(v1[1], -7.0f, 7.0f), __builtin_amdgcn_fmed3f(v1[3], -7.0f, 7.0f)};
                    const f32x2 xa = ga * (-1.702f * LOG2E), xb = gb * (-1.702f * LOG2E);
                    f32x2 ea = {__builtin_amdgcn_exp2f(xa[0]), __builtin_amdgcn_exp2f(xa[1])}, eb = {__builtin_amdgcn_exp2f(xb[0]), __builtin_amdgcn_exp2f(xb[1])};
                    ea = ea + 1.0f; eb = eb + 1.0f;
                    const f32x2 ra = {__builtin_amdgcn_rcpf(ea[0]), __builtin_amdgcn_rcpf(ea[1])}, rb = {__builtin_amdgcn_rcpf(eb[0]), __builtin_amdgcn_rcpf(eb[1])};
                    const f32x2 gla = ga * ra, glb = gb * rb;
                    const f32x2 oa = ua * gla + gla, ob = ub * glb + glb;
                    float r4[4] = {oa[0], oa[1], ob[0], ob[1]};
                    *(unsigned*)(rowp + bj * 64) = pk4_fp8(r4[0], r4[1], r4[2], r4[3]); } }
    }
};
struct ProgMoe2 {
    static constexpr bool GATHER = false, FP8 = true; static constexpr int ID = 6;
    const Frame* F; int T;
    __device__ __forceinline__ bool next(int i, Unit& u) const {
        if (!moe_decode<8, 4>(F, T, i, u)) return false;
        u.A = (const char*)(F->ACT() + (size_t)u.pm * 256 * KD); u.B = (const char*)(F->WD() + ((size_t)u.e * 1024 + (size_t)u.pn * 256) * KD); return true;
    }
    __device__ __forceinline__ void epi(const Acc& acc, const Unit& u, int wr, int wc, int fr, int fq) const {
        asm volatile("" : "+v"(fr), "+v"(fq));
        const int cnt = u.kind;
        const float* bp = F->b_down() + (size_t)u.e * 1024 + u.pn * 256 + wc * 32 + 8 * fq;
        f32x4 bv[2][2];
#pragma unroll
        for (int bj = 0; bj < 2; ++bj)
#pragma unroll
            for (int n = 0; n < 2; ++n) bv[bj][n] = *(const f32x4*)(bp + bj * 128 + 4 * n);
#pragma unroll
        for (int ai = 0; ai < 2; ++ai) {
            float gt[4];
#pragma unroll
            for (int m = 0; m < 4; ++m) { const int idx = u.r0 + ai * 128 + wr * 64 + m * 16 + fr; gt[m] = idx < cnt ? F->LISTGATE()[(size_t)u.e * NTOK + idx] : 0.f; }
#pragma unroll
            for (int m = 0; m < 4; ++m) { const int rl = ai * 128 + wr * 64 + m * 16 + fr; const float gate = gt[m] * YSCALE;
                unsigned char* rowp = F->YS() + ((size_t)u.pm * 256 + rl) * 1024 + u.pn * 256 + wc * 32 + 8 * fq;
#pragma unroll
                for (int bj = 0; bj < 2; ++bj) { const f32x4 v0 = (acc[ai][bj][m][0] * WSCALE_INV + bv[bj][0]) * gate, v1 = (acc[ai][bj][m][1] * WSCALE_INV + bv[bj][1]) * gate;
                    u32x2 w; w.x = pk4_fp8(v0[0], v0[1], v0[2], v0[3]); w.y = pk4_fp8(v1[0], v1[1], v1[2], v1[3]);
                    *(u32x2*)(rowp + bj * 128) = w; } }
        }
    }
};

template <bool DRY> __device__ __forceinline__ void p7_combine(Frame& F) {
    const LAS int* tab = (const LAS int*)(F.lds + TAB_OFF);
    const int gw = F.vcu * NWAVES + F.wave, NGW = F.G * NWAVES, lane = F.lane;
    for (int tok = gw; tok < NTOK; tok += NGW) {
        f32x4* orow = (f32x4*)(F.out() + (size_t)tok * DM) + lane; f32x4 v[4];
#pragma unroll
        for (int j = 0; j < 4; ++j) v[j] = orow[64 * j];
#pragma unroll
        for (int k = 0; k < 4; ++k) { const int info = F.TOKINFO()[tok * 4 + k]; const int e = info >> 16, pos = info & 0xffff; const size_t slot = (size_t)tab[32 + e] * 256 + pos;
            const unsigned* yr = (const unsigned*)(F.YS() + slot * 1024) + lane;
#pragma unroll
            for (int j = 0; j < 4; ++j) { const unsigned w = yr[64 * j]; const f32x2 lo = __builtin_amdgcn_cvt_pk_f32_fp8((int)w, false), hi = __builtin_amdgcn_cvt_pk_f32_fp8((int)w, true);
                v[j][0] += lo[0] * YSCALE_INV; v[j][1] += lo[1] * YSCALE_INV; v[j][2] += hi[0] * YSCALE_INV; v[j][3] += hi[1] * YSCALE_INV; } }
        f32x4* wrow = DRY ? (f32x4*)((float*)(F.ws() + WS_EARLY) + (size_t)tok * DM) + lane : orow;
#pragma unroll
        for (int j = 0; j < 4; ++j) wrow[64 * j] = v[j];
    }
}

__global__ void __launch_bounds__(NWAVES * 64, 2) mk_fwd(Args args) {
    extern __shared__ __attribute__((aligned(16))) unsigned char lds_raw[];
    Frame F;
    F.lds = (LAS unsigned char*)lds_raw;
    F.tid = threadIdx.x; F.lane = F.tid & 63; F.wave = __builtin_amdgcn_readfirstlane(F.tid >> 6);
    F.G = gridDim.x; { const int bx = blockIdx.x; F.vcu = (bx % 8) * (F.G / 8) + bx / 8; }
    F.ka = (const CAS Args*)__builtin_amdgcn_kernarg_segment_ptr();
    for (int u = F.tid; u < (LDS_BYTES - LDSCTL_OFF) / 4; u += NWAVES * 64) ((LAS unsigned*)(F.lds + LDSCTL_OFF))[u] = 0u;
    __syncthreads();
    XcdBarrier bar = xcd_barrier_post(F.ctl() + CW_BAR, (volatile LAS unsigned*)(F.lds + MISC_OFF) + 8);
    const int lo = F.ka->ph_lo, hi = F.ka->ph_hi;
#define IN(k) (lo <= (k) && (k) < hi)
#define REFRESH() do { int l_ = lane_id(); asm volatile("" : "+v"(l_)); F.lane = l_; F.tid = F.wave * 64 + l_; } while (0)
#define SEAM(k) do { if (IN(k) && IN((k) + 1)) { xcd_barrier(bar, F.wave); if (MK_REP == 100 + (k)) { xcd_barrier(bar, F.wave); xcd_barrier(bar, F.wave); xcd_barrier(bar, F.wave); xcd_barrier(bar, F.wave); } } } while (0)
    if (IN(0)) { REFRESH(); p0_prologue(F); if (MK_REP == 0) p0_prologue(F); } SEAM(0);
    if (IN(1)) { { ProgIn P{&F}; gemm_phase(F.lds, P); } if (MK_REP == 1) { ProgIn P{&F}; gemm_phase(F.lds, P); } } SEAM(1);
    if (IN(2)) { REFRESH(); p2_mixers(F); if (MK_REP == 2) p2_mixers(F); } SEAM(2);
    if (IN(3)) { { ProgOut P{&F}; gemm_phase(F.lds, P); } if (MK_REP == 3) { ProgOut P{&F}; gemm_phase(F.lds, P); } } SEAM(3);
    if (IN(4)) { REFRESH(); if (F.wave < 4) { if (MK_REP == 4) router_wave_unit<true>(F, F.wave * 256 + F.vcu); router_wave_unit<false>(F, F.wave * 256 + F.vcu); }
                 else { LAS float* scr = (LAS float*)(F.lds + F.wave * 16384); const int cw = F.vcu * 4 + (F.wave - 4);
                        for (int rep_ = 0; rep_ < (MK_REP == 41 ? 2 : 1); ++rep_) {
                        ConvItem ca = moe_conv_decode(F, cw); f32x4 va[8], vb[8]; moe_conv_issue(ca, va, F.lane);
                        for (int j = 0; j < CONV_P4_PER_WAVE; j += 2) {
                            const ConvItem cb = moe_conv_decode(F, (j + 1) * 1024 + cw); moe_conv_issue(cb, vb, F.lane);
                            moe_conv_finish(ca, va, scr, F.lane);
                            if (j + 2 < CONV_P4_PER_WAVE) { ca = moe_conv_decode(F, (j + 2) * 1024 + cw); moe_conv_issue(ca, va, F.lane); }
                            moe_conv_finish(cb, vb, scr, F.lane); } } } } SEAM(4);
    if (lo <= 7 && hi > 5) { REFRESH(); moe_build_table(F); }
    if (IN(5)) { { ProgMoe1 P{&F, sgpr(((const LAS int*)(F.lds + TAB_OFF))[64])}; gemm_phase(F.lds, P); } if (MK_REP == 5) { ProgMoe1 P{&F, sgpr(((const LAS int*)(F.lds + TAB_OFF))[64])}; gemm_phase(F.lds, P); } } SEAM(5);
    if (IN(6)) { { ProgMoe2 P{&F, sgpr(((const LAS int*)(F.lds + TAB_OFF))[64])}; gemm_phase(F.lds, P); } if (MK_REP == 6) { ProgMoe2 P{&F, sgpr(((const LAS int*)(F.lds + TAB_OFF))[64])}; gemm_phase(F.lds, P); } } SEAM(6);
    if (IN(7)) { REFRESH(); if (MK_REP == 7) p7_combine<true>(F); p7_combine<false>(F); }
#undef IN
#undef SEAM
}
}
#ifndef MK_CUT
#define MK_CUT 8
#endif
extern "C" void kernel_launch(void* const* d_in, const int* in_sizes, int n_in, void* d_out, int out_size, void* d_ws, size_t ws_size, hipStream_t stream) {
    static int ready = 0;
    if (ready == 0) {
        if (n_in != 18 || out_size != mk::NTOK * mk::DM || ws_size < mk::WS_END) { fprintf(stderr, "kernel_launch: unexpected problem (n_in %d out %d ws %zu)\n", n_in, out_size, ws_size); ready = -1; return; }
        if (hipFuncSetAttribute((const void*)mk::mk_fwd, hipFuncAttributeMaxDynamicSharedMemorySize, mk::LDS_BYTES) != hipSuccess) { fprintf(stderr, "kernel_launch: hipFuncSetAttribute failed\n"); ready = -1; return; }
        ready = 1;
    }
    if (ready < 0) return;
    (void)hipMemsetAsync((char*)d_ws + mk::WS_CTL, 0, mk::CTL_ZERO_BYTES, stream);
    mk::Args a{};
    for (int i = 0; i < 18; ++i) a.in[i] = (const float*)d_in[i];
    a.out = (float*)d_out; a.ws = (unsigned char*)d_ws; a.ph_lo = 0; a.ph_hi = MK_CUT;
    hipLaunchKernelGGL(mk::mk_fwd, dim3(256), dim3(mk::NWAVES * 64), mk::LDS_BYTES, stream, a);
#if MK_CUT < 8
    {
        using namespace nv;
        const float* x = (const float*)d_in[0]; const float* w_out = (const float*)d_in[10]; const float* norm2_w = (const float*)d_in[11];
        const float* router_w = (const float*)d_in[12]; const float* router_b = (const float*)d_in[13]; const float* w_gate_up = (const float*)d_in[14];
        const float* b_gate_up = (const float*)d_in[15]; const float* w_down = (const float*)d_in[16]; const float* b_down = (const float*)d_in[17];
        float* out = (float*)d_out; char* ws = (char*)d_ws; const size_t MiB = 1u << 20;
        int* cnt = (int*)ws + mk::CW_CNT; int* list_tok = (int*)(ws + mk::WS_LISTTOK); float* list_gate = (float*)(ws + mk::WS_LISTGATE);
        float* hn = (float*)(ws + 16 * MiB); float* gu = (float*)(ws + 272 * MiB); float* act = (float*)(ws + (272 + 256) * MiB);
#if MK_CUT <= 3
        k_gemm<1, true><<<dim3(DM / 64, NTOK / 64), 256, 0, stream>>>((const void*)(ws + mk::WS_Y), nullptr, nullptr, nullptr, w_out, nullptr, x, nullptr, out, NTOK, DM, DM, DM, DM);
#endif
#if MK_CUT <= 4
        k_router<<<NTOK, 256, 0, stream>>>(out, norm2_w, router_w, router_b, hn, cnt, list_tok, list_gate);
#else
        k_bf2f<<<4096, 256, 0, stream>>>((const unsigned short*)(ws + mk::WS_HB), hn, (size_t)NTOK * DM);
#endif
        for (int e = 0; e < NE; ++e) {
            const int* lt = list_tok + (size_t)e * NTOK; const float* lgp = list_gate + (size_t)e * NTOK;
            k_gemm<0, false><<<dim3(2 * DFF / 64, NTOK / 64), 256, 0, stream>>>(hn, lt, nullptr, cnt + e, w_gate_up + (size_t)e * DM * 2 * DFF, b_gate_up + (size_t)e * 2 * DFF, nullptr, nullptr, gu, NTOK, 2 * DFF, DM, DM, 2 * DFF);
            k_swiglu<<<NTOK, 256, 0, stream>>>(gu, cnt + e, act);
            k_gemm<3, false><<<dim3(DM / 64, NTOK / 64), 256, 0, stream>>>(act, nullptr, lt, cnt + e, w_down + (size_t)e * DFF * DM, b_down + (size_t)e * DM, nullptr, lgp, out, NTOK, DM, DFF, DFF, DM);
        }
    }
#endif
}
```

```cpp
#include <hip/hip_runtime.h>
#include <cstdio>
#include <cstdint>
#ifndef MK_REP
#define MK_REP -1
#endif
namespace mk {
#define LAS __attribute__((address_space(3)))
#define GAS __attribute__((address_space(1)))
typedef unsigned short bf16_t;
typedef short bf16x8 __attribute__((ext_vector_type(8)));
typedef short s16x4 __attribute__((ext_vector_type(4)));
typedef float f32x4 __attribute__((ext_vector_type(4)));
typedef float f32x2 __attribute__((ext_vector_type(2)));
typedef float f32x16 __attribute__((ext_vector_type(16)));
typedef unsigned u32x4 __attribute__((ext_vector_type(4)));
typedef unsigned u32x2 __attribute__((ext_vector_type(2)));
typedef int i32x4 __attribute__((ext_vector_type(4)));
typedef int i32x8 __attribute__((ext_vector_type(8)));

constexpr int NTOK = 32768, DM = 1024, SEQ = 4096, NB = 8, NH = 8, HD = 64, NE = 32, DFF = 1024, KD = 1024;
constexpr float EPS = 1e-5f;
constexpr float LOG2E = 1.4426950408889634f;
constexpr float QSCALE = 0.125f * LOG2E;
constexpr float SB_THR = 64.0f;
constexpr int NWAVES = 8;
constexpr int SLOTS = NTOK * 4 + NE * 256;

constexpr size_t MiB = 1u << 20;
constexpr size_t WS_CTL = 0, CTL_ZERO_BYTES = 1 * MiB;
constexpr size_t WS_LISTTOK = 1 * MiB;
constexpr size_t WS_LISTGATE = 5 * MiB;
constexpr size_t WS_TOKINFO = 9 * MiB;
constexpr size_t WS_RSTD1 = 10 * MiB;
constexpr size_t WS_SSPART = 11 * MiB;
constexpr size_t WS_RT = 13 * MiB;
constexpr size_t WS_WGU = 16 * MiB;
constexpr size_t WS_WD = 80 * MiB;
constexpr size_t WS_HB = 112 * MiB;
constexpr size_t WS_YS = 144 * MiB;
constexpr size_t WS_EARLY = 416 * MiB;
constexpr size_t WS_XB = WS_EARLY;
constexpr size_t WS_WIN = WS_EARLY + 64 * MiB;
constexpr size_t WS_WOUT = WS_EARLY + 70 * MiB;
constexpr size_t WS_UV = WS_EARLY + 72 * MiB;
constexpr size_t WS_Q = WS_EARLY + 136 * MiB;
constexpr size_t WS_K = WS_EARLY + 168 * MiB;
constexpr size_t WS_VT = WS_EARLY + 200 * MiB;
constexpr size_t WS_Y = WS_EARLY + 232 * MiB;
constexpr size_t WS_ACT = WS_EARLY;
constexpr size_t WS_END = WS_EARLY + 296 * MiB;
constexpr float WSCALE = 32.0f, WSCALE_INV = 1.0f / 32.0f;
constexpr float YSCALE = 16.0f, YSCALE_INV = 1.0f / 16.0f;
constexpr int CW_CNT = 64;
constexpr int CW_BAR = 4096;

constexpr int RING_BYTES = 131072;
constexpr int LDSCTL_OFF = RING_BYTES, MISC_OFF = LDSCTL_OFF + 320, TAB_OFF = LDSCTL_OFF + 1024;
constexpr int LDS_BYTES = 147456;

__device__ __forceinline__ unsigned cvt_pk_bf16(float lo, float hi) { unsigned r; asm volatile("v_cvt_pk_bf16_f32 %0, %1, %2" : "=v"(r) : "v"(lo), "v"(hi)); return r; }
__device__ __forceinline__ unsigned pk4_fp8(float a, float b, float c, float d) { unsigned w = 0u; w = (unsigned)__builtin_amdgcn_cvt_pk_fp8_f32(a, b, (int)w, false); w = (unsigned)__builtin_amdgcn_cvt_pk_fp8_f32(c, d, (int)w, true); return w; }
__device__ __forceinline__ float bf2f(unsigned short h) { return __uint_as_float((unsigned)h << 16); }
__device__ __forceinline__ float bflo(unsigned w) { return __uint_as_float(w << 16); }
__device__ __forceinline__ float bfhi(unsigned w) { return __uint_as_float(w & 0xffff0000u); }
__device__ __forceinline__ int lane_id() { return (int)__builtin_amdgcn_mbcnt_hi(~0u, __builtin_amdgcn_mbcnt_lo(~0u, 0u)); }
__device__ __forceinline__ int lane_id_fresh() { int l; asm volatile("v_mbcnt_lo_u32_b32 %0, -1, 0\n\tv_mbcnt_hi_u32_b32 %0, -1, %0" : "=v"(l)); return l; }
__device__ __forceinline__ float wave_sum(float v) {
#pragma unroll
    for (int o = 1; o < 64; o <<= 1) v += __shfl_xor(v, o);
    return v;
}
__device__ __forceinline__ float gelu_tanh_f(float x) {
    const float u = 0.7978845608028654f * (x + 0.044715f * x * x * x);
    return x * __builtin_amdgcn_rcpf(1.0f + __builtin_amdgcn_exp2f(-2.0f * LOG2E * u));
}

constexpr int BM = 256, BK = 64, HALF = 128, HTB = HALF * BK * 2;
__device__ __forceinline__ int lds_byte(int r, int c) { const int st = (r >> 4) * 2 + (c >> 5), rr = r & 15, cc = c & 31, ob = rr * 64 + cc * 2; return st * 1024 + (ob ^ (((ob >> 9) & 1) << 5)); }
__device__ __forceinline__ void stage_rc(int b, int& R, int& C) { const int st = b / 1024, sb = b % 1024, swz = sb ^ (((sb >> 9) & 1) << 5); R = (st >> 1) * 16 + swz / 64; C = (st & 1) * 32 + (swz % 64) / 2; }
__device__ __forceinline__ int perm32(int rho) { const int n = rho >> 4, i = rho & 15; return 8 * (i >> 2) + 4 * n + (i & 3); }

struct Unit { const char* A; const char* B; int kind, pm, pn, e, r0; };

template <class Prog>
__device__ __forceinline__ void gemm_phase(LAS unsigned char* lds, const Prog& P) {
    const int wid = P.F->wave, lane = lane_id(), tid = wid * 64 + lane, wr = wid >> 2, wc = wid & 3;
    constexpr bool F8 = Prog::FP8;
    constexpr int K = KD, ESZ = F8 ? 1 : 2, nt = F8 ? K / 128 : K / BK;
    unsigned voffB[2];
#pragma unroll
    for (int i = 0; i < 2; ++i) {
        if constexpr (F8) { const int b_ = tid * 16 + i * 8192, k16_ = b_ >> 11, sl_ = (b_ & 2047) >> 4; voffB[i] = (unsigned)((k16_ * Prog::BN + (sl_ & ~31) + perm32(sl_ & 31)) * 16); }
        else { int R_, C_; stage_rc(tid * 16 + i * 8192, R_, C_); const int Rb = (R_ & ~31) + perm32(R_ & 31); voffB[i] = (unsigned)(Rb * K * ESZ + C_ * 2); } }
    constexpr size_t kstep = (size_t)(BK * 2);
    constexpr size_t hstep = (size_t)HALF * K * ESZ;
    constexpr size_t kstepB = F8 ? (size_t)8 * Prog::BN * 16 : kstep;
    constexpr size_t hstepB = F8 ? (size_t)HALF * 16 : hstep;
    const unsigned ldsw = (unsigned)wid * 1024u;
    const int aoff = lds_byte(wr * 64 + (lane & 15), F8 ? (lane >> 4) * 16 : (lane >> 4) * 8), boff = F8 ? (2 * (lane >> 4)) * 2048 + (wc * 32 + (lane & 15)) * 16 : lds_byte(wc * 32 + (lane & 15), (lane >> 4) * 8);
    constexpr int BNS = F8 ? 256 : 2048, BKS = F8 ? 2048 : 1024;
    constexpr int KOFF = F8 ? 16 : 1024;
#define MK_SA(b, h) (((b) * 2 + (h)) * HTB)
#define MK_SB(b, h) ((4 + (b) * 2 + (h)) * HTB)
#define MK_STAGE(bufoff, gbase, voff) do { _Pragma("unroll") for (int _i = 0; _i < 2; ++_i) { unsigned o_ = (voff)[_i]; asm volatile("" : "+v"(o_));     \
        __builtin_amdgcn_global_load_lds((const unsigned*)((const char*)(gbase) + o_), (LAS unsigned*)(lds + (bufoff) + ldsw + _i * 8192), 16, 0, 0); } } while (0)
#define MK_STAGE_A(bufoff, gbase, h) do { if constexpr (GA) MK_STAGE(bufoff, gbase, voC[h]); else MK_STAGE(bufoff, (gbase) + (h) * hstep, voC[0]); } while (0)
#define MK_LDA(dst, b, h) do { _Pragma("unroll") for (int m = 0; m < 4; ++m) _Pragma("unroll") for (int k = 0; k < 2; ++k) dst[m][k] = *(const LAS bf16x8*)(lds + MK_SA(b, h) + aoff + m * 2048 + k * KOFF); } while (0)
#define MK_LDB(dst, b, h) do { _Pragma("unroll") for (int n = 0; n < 2; ++n) _Pragma("unroll") for (int k = 0; k < 2; ++k) dst[n][k] = *(const LAS bf16x8*)(lds + MK_SB(b, h) + boff + n * BNS + k * BKS); } while (0)
#define MK_CAT8(x) __builtin_shufflevector(__builtin_bit_cast(i32x4, (x)[0]), __builtin_bit_cast(i32x4, (x)[1]), 0, 1, 2, 3, 4, 5, 6, 7)
#define MK_MMA(ai, bj, At, Bt) do { __builtin_amdgcn_s_setprio(1); \
        if constexpr (F8) { _Pragma("unroll") for (int m = 0; m < 4; ++m) _Pragma("unroll") for (int n = 0; n < 2; ++n) \
            acc[ai][bj][m][n] = __builtin_amdgcn_mfma_scale_f32_16x16x128_f8f6f4(MK_CAT8(Bt[n]), MK_CAT8(At[m]), acc[ai][bj][m][n], 0, 0, 0, 0, 0, 0); } \
        else { _Pragma("unroll") for (int m = 0; m < 4; ++m) _Pragma("unroll") for (int n = 0; n < 2; ++n) _Pragma("unroll") for (int k = 0; k < 2; ++k) \
            acc[ai][bj][m][n] = __builtin_amdgcn_mfma_f32_16x16x32_bf16(Bt[n][k], At[m][k], acc[ai][bj][m][n], 0, 0, 0); } \
        __builtin_amdgcn_s_setprio(0); } while (0)
#define MK_WAIT_V(n) asm volatile("s_waitcnt vmcnt(" #n ")" ::: "memory")
#define MK_WAIT_L(n) asm volatile("s_waitcnt lgkmcnt(" #n ")" ::: "memory")
#define MK_BAR __builtin_amdgcn_s_barrier()
#define MK_SCHED __builtin_amdgcn_sched_barrier(0)
    Unit cur, nxt; int ui = 0;
    if (!P.next(0, cur)) return;
    constexpr bool GA = Prog::GATHER;
    unsigned voC[2][2];
    if constexpr (GA) P.aoffs(cur, wid, voC);
    else {
#pragma unroll
        for (int i = 0; i < 2; ++i) { int R_, C_; stage_rc(tid * 16 + i * 8192, R_, C_); voC[0][i] = (unsigned)(R_ * K * ESZ + C_ * 2); voC[1][i] = 0u; }
    }
    f32x4 acc[2][2][4][2];
#pragma unroll
    for (int a = 0; a < 2; ++a)
#pragma unroll
        for (int b = 0; b < 2; ++b)
#pragma unroll
            for (int m = 0; m < 4; ++m)
#pragma unroll
                for (int n = 0; n < 2; ++n) acc[a][b][m][n] = (f32x4){0.f, 0.f, 0.f, 0.f};
    bf16x8 At[4][2], B0[2][2], B1[2][2];
    const char* cA = cur.A; const char* cB = cur.B;
    MK_STAGE(MK_SB(0, 0), cB, voffB); MK_STAGE(MK_SB(0, 1), cB + hstepB, voffB); MK_STAGE_A(MK_SA(0, 0), cA, 0); MK_STAGE_A(MK_SA(0, 1), cA, 1);
    if (wr == 1) MK_BAR;
    MK_WAIT_V(2); MK_BAR;
    MK_STAGE(MK_SB(1, 0), cB + kstepB, voffB); MK_STAGE_A(MK_SA(1, 0), cA + kstep, 0); MK_STAGE(MK_SB(1, 1), cB + hstepB + kstepB, voffB);
    MK_WAIT_V(6); MK_BAR;
    for (;;) {
        const bool has_next = P.next(ui + 1, nxt);
        if (!has_next) nxt = cur;
        const char* nA = nxt.A; const char* nB = nxt.B;
#pragma unroll 1
        for (int t = 0; t < nt; t += 2) {
            const bool last = (t == nt - 2);
            const char* a1 = cA + (size_t)(t + 1) * kstep;
            const char* a2 = last ? nA : cA + (size_t)(t + 2) * kstep; const char* b2 = last ? nB : cB + (size_t)(t + 2) * kstepB;
            const char* a3 = a2 + kstep; const char* b3 = b2 + kstepB;
            MK_LDB(B0, 0, 0); MK_LDB(B1, 0, 1); MK_SCHED; MK_LDA(At, 0, 0); MK_STAGE_A(MK_SA(1, 1), a1, 1);
            if constexpr (GA) { if (last && has_next) P.aoffs(nxt, wid, voC); }
            MK_WAIT_V(8); MK_WAIT_L(0); MK_BAR; MK_MMA(0, 0, At, B0); MK_MMA(0, 1, At, B1); MK_BAR; MK_SCHED;
            MK_LDA(At, 0, 1); MK_STAGE(MK_SB(0, 0), b2, voffB); MK_STAGE(MK_SB(0, 1), b2 + hstepB, voffB); MK_STAGE_A(MK_SA(0, 0), a2, 0);
            MK_WAIT_V(8); MK_WAIT_L(0); MK_BAR; MK_MMA(1, 0, At, B0); MK_MMA(1, 1, At, B1); MK_BAR; MK_SCHED;
            MK_LDB(B0, 1, 0); MK_LDB(B1, 1, 1); MK_SCHED; MK_LDA(At, 1, 0); MK_STAGE_A(MK_SA(0, 1), a2, 1);
            MK_WAIT_V(8); MK_WAIT_L(0); MK_BAR; MK_MMA(0, 0, At, B0); MK_MMA(0, 1, At, B1); MK_BAR; MK_SCHED;
            MK_LDA(At, 1, 1); MK_STAGE(MK_SB(1, 0), b3, voffB); MK_STAGE(MK_SB(1, 1), b3 + hstepB, voffB); MK_STAGE_A(MK_SA(1, 0), a3, 0);
            MK_WAIT_V(8); MK_WAIT_L(0); MK_BAR; MK_MMA(1, 0, At, B0); MK_MMA(1, 1, At, B1); MK_BAR; MK_SCHED;
        }
        if (wr == 0) MK_BAR;
        { const int l_ = lane_id_fresh(); P.epi(acc, cur, wr, wc, l_ & 15, l_ >> 4); }
#ifdef MK_EPI2
        if (Prog::ID == MK_EPI2) { const int l_ = lane_id_fresh(); P.epi(acc, cur, wr, wc, l_ & 15, l_ >> 4); }
#endif
        if (!has_next) break;
#pragma unroll
        for (int a = 0; a < 2; ++a)
#pragma unroll
            for (int b = 0; b < 2; ++b)
#pragma unroll
                for (int m = 0; m < 4; ++m)
#pragma unroll
                    for (int n = 0; n < 2; ++n) acc[a][b][m][n] = (f32x4){0.f, 0.f, 0.f, 0.f};
        cur = nxt; cA = nA; cB = nB; ++ui;
        if (wr == 1) MK_BAR;
    }
    MK_WAIT_V(0);
    MK_BAR;
#undef MK_SA
#undef MK_SB
#undef MK_STAGE
#undef MK_STAGE_A
#undef MK_LDA
#undef MK_LDB
#undef MK_MMA
#undef MK_CAT8
}
typedef f32x4 Acc[2][2][4][2];

#define XB_TMO      128
#define XB_XCNT(j)  (256  + 64 * (j))
#define XB_XSUB(j)  (1280 + 64 * (j))
#define XB_XGEN(j)  (2304 + 64 * (j))
#define XB_TOP      3328
#define XB_TOPGEN   3392
#define XCD_BAR_WORDS 3456
#define XB_SPIN_CAP (1u << 18)
__device__ __forceinline__ unsigned xb_ld(unsigned* p)              { return __hip_atomic_load(p, __ATOMIC_RELAXED, __HIP_MEMORY_SCOPE_AGENT); }
__device__ __forceinline__ unsigned xb_add(unsigned* p, unsigned v) { return __hip_atomic_fetch_add(p, v, __ATOMIC_RELAXED, __HIP_MEMORY_SCOPE_AGENT); }
__device__ __forceinline__ unsigned xb_xcc_id() { return (unsigned)__builtin_amdgcn_s_getreg((3 << 11) | 20) & 0xFu; }
#define XB_SPIN(cond, bar) do { unsigned _sp = 0; while (cond) { __builtin_amdgcn_s_sleep(1); \
    if ((++_sp & 255u) == 0u) { if (xb_ld(&(bar)[XB_TMO])) break; if (_sp > XB_SPIN_CAP) { atomicAdd(&(bar)[XB_TMO], 1u); break; } } } } while (0)
struct XcdBarrier { unsigned* bar; unsigned x; volatile LAS unsigned* st; };
__device__ __forceinline__ XcdBarrier xcd_barrier_post(unsigned* bar, volatile LAS unsigned* st) {
    XcdBarrier b; b.bar = bar; b.x = xb_xcc_id(); b.st = st;
    if (threadIdx.x == 0) (void)xb_add(&bar[XB_XCNT(b.x)], 1u);
    return b;
}
__device__ __forceinline__ void xcd_barrier_complete(unsigned* bar, unsigned x, unsigned& nloc, unsigned& nx) {
    const unsigned G = gridDim.x * gridDim.y * gridDim.z;
    unsigned sum, cnt, mine, sp = 0u;
    for (;;) {
        sum = 0u; cnt = 0u; mine = 0u;
#pragma unroll
        for (unsigned j = 0; j < 16; ++j) { const unsigned c = xb_ld(&bar[XB_XCNT(j)]); sum += c; cnt += (c > 0u) ? 1u : 0u; mine = (j == x) ? c : mine; }
        if (sum == G) break;
        __builtin_amdgcn_s_sleep(1);
        if ((++sp & 255u) == 0u) { if (xb_ld(&bar[XB_TMO])) break; if (sp > XB_SPIN_CAP) { atomicAdd(&bar[XB_TMO], 1u); break; } }
    }
    nloc = mine > 0u ? mine : 1u; nx = cnt > 0u ? cnt : 1u;
}
__device__ __forceinline__ void xcd_barrier(const XcdBarrier& b, int wave) {
    asm volatile("s_waitcnt vmcnt(0)" ::: "memory");
    __syncthreads();
    if (wave == 0 && lane_id() == 0) {
        unsigned* bar = b.bar;
        __builtin_amdgcn_s_waitcnt(0);
        unsigned nloc = b.st[0], nx = b.st[1];
        if (nloc == 0u) { xcd_barrier_complete(bar, b.x, nloc, nx); b.st[0] = nloc; b.st[1] = nx; }
        const unsigned old = xb_add(&bar[XB_XSUB(b.x)], 1u);
        const unsigned gen = old / nloc;
        if (old + 1u == (gen + 1u) * nloc) {
            __builtin_amdgcn_fence(__ATOMIC_RELEASE, "agent");
            asm volatile("s_waitcnt vmcnt(0)" ::: "memory");
            const unsigned og = xb_add(&bar[XB_TOP], 1u);
            const unsigned tg = og / nx;
            if (og + 1u == (tg + 1u) * nx) xb_add(&bar[XB_TOPGEN], 1u);
            else XB_SPIN(xb_ld(&bar[XB_TOPGEN]) == tg, bar);
            __builtin_amdgcn_fence(__ATOMIC_ACQUIRE, "agent");
            xb_add(&bar[XB_XGEN(b.x)], 1u);
            asm volatile("s_waitcnt vmcnt(0)" ::: "memory");
        } else {
            XB_SPIN(xb_ld(&bar[XB_XGEN(b.x)]) == gen, bar);
            __builtin_amdgcn_fence(__ATOMIC_ACQUIRE, "agent");
            asm volatile("s_waitcnt vmcnt(0)" ::: "memory");
        }
    }
    __syncthreads();
}

struct Args {
    const float* in[18]; float* out; unsigned char* ws; int ph_lo, ph_hi;
};
#define CAS __attribute__((address_space(4)))
struct Frame {
    LAS unsigned char* lds; int tid, lane, wave, vcu, G;
    const CAS Args* ka;
    __device__ __forceinline__ const float* inp(int k) const { return ka->in[k]; }
    __device__ __forceinline__ unsigned char* ws() const { return ka->ws; }
    __device__ __forceinline__ float* out() const { return ka->out; }
    __device__ __forceinline__ const float* x() const { return inp(0); }
    __device__ __forceinline__ const float* norm1_w() const { return inp(1); }
    __device__ __forceinline__ const float* w_in() const { return inp(2); }
    __device__ __forceinline__ const float* sgu_norm_w() const { return inp(3); }
    __device__ __forceinline__ const float* sgu_w() const { return inp(4); }
    __device__ __forceinline__ const float* sgu_b() const { return inp(5); }
    __device__ __forceinline__ const float* q_norm_w() const { return inp(6); }
    __device__ __forceinline__ const float* k_norm_w() const { return inp(7); }
    __device__ __forceinline__ const float* out_norm_a_w() const { return inp(8); }
    __device__ __forceinline__ const float* out_norm_b_w() const { return inp(9); }
    __device__ __forceinline__ const float* w_out() const { return inp(10); }
    __device__ __forceinline__ const float* norm2_w() const { return inp(11); }
    __device__ __forceinline__ const float* router_w() const { return inp(12); }
    __device__ __forceinline__ const float* router_b() const { return inp(13); }
    __device__ __forceinline__ const float* w_gate_up() const { return inp(14); }
    __device__ __forceinline__ const float* b_gate_up() const { return inp(15); }
    __device__ __forceinline__ const float* w_down() const { return inp(16); }
    __device__ __forceinline__ const float* b_down() const { return inp(17); }
    __device__ __forceinline__ bf16_t* XB() const { return (bf16_t*)(ws() + WS_XB); }
    __device__ __forceinline__ bf16_t* WIN() const { return (bf16_t*)(ws() + WS_WIN); }
    __device__ __forceinline__ bf16_t* WOUT() const { return (bf16_t*)(ws() + WS_WOUT); }
    __device__ __forceinline__ bf16_t* UV() const { return (bf16_t*)(ws() + WS_UV); }
    __device__ __forceinline__ bf16_t* Q() const { return (bf16_t*)(ws() + WS_Q); }
    __device__ __forceinline__ bf16_t* K() const { return (bf16_t*)(ws() + WS_K); }
    __device__ __forceinline__ bf16_t* VT() const { return (bf16_t*)(ws() + WS_VT); }
    __device__ __forceinline__ bf16_t* Y() const { return (bf16_t*)(ws() + WS_Y); }
    __device__ __forceinline__ unsigned char* YS() const { return ws() + WS_YS; }
    __device__ __forceinline__ bf16_t* RT() const { return (bf16_t*)(ws() + WS_RT); }
    __device__ __forceinline__ unsigned char* HB() const { return ws() + WS_HB; }
    __device__ __forceinline__ unsigned char* WGU() const { return ws() + WS_WGU; }
    __device__ __forceinline__ unsigned char* WD() const { return ws() + WS_WD; }
    __device__ __forceinline__ unsigned char* ACT() const { return ws() + WS_ACT; }
    __device__ __forceinline__ float* RSTD1() const { return (float*)(ws() + WS_RSTD1); }
    __device__ __forceinline__ float* SSPART() const { return (float*)(ws() + WS_SSPART); }
    __device__ __forceinline__ float* LISTGATE() const { return (float*)(ws() + WS_LISTGATE); }
    __device__ __forceinline__ int* LISTTOK() const { return (int*)(ws() + WS_LISTTOK); }
    __device__ __forceinline__ int* TOKINFO() const { return (int*)(ws() + WS_TOKINFO); }
    __device__ __forceinline__ unsigned* ctl() const { return (unsigned*)(ws() + WS_CTL); }
};

__device__ __forceinline__ void p0_transpose_item(const float* W, int K, int N, bf16_t* WT, int k0, int n0, int drow0, const float* kscale, LAS float* scr, int lane) {
#pragma unroll 8
    for (int i = 0; i < 32; ++i) { const int kk = 2 * i + (lane >> 5); float v = W[(size_t)(k0 + kk) * N + n0 + (lane & 31)]; if (kscale) v *= kscale[k0 + kk]; scr[kk * 33 + (lane & 31)] = v; }
    asm volatile("s_waitcnt lgkmcnt(0)" ::: "memory");
    const int c = lane & 7;
#pragma unroll
    for (int j = 0; j < 4; ++j) { const int n = (lane >> 3) + 8 * j; const LAS float* s = scr + (8 * c) * 33 + n;
        u32x4 o; o.x = cvt_pk_bf16(s[0 * 33], s[1 * 33]); o.y = cvt_pk_bf16(s[2 * 33], s[3 * 33]); o.z = cvt_pk_bf16(s[4 * 33], s[5 * 33]); o.w = cvt_pk_bf16(s[6 * 33], s[7 * 33]);
        *(u32x4*)(WT + (size_t)(drow0 + n) * K + k0 + 8 * c) = o; }
    asm volatile("s_waitcnt lgkmcnt(0)" ::: "memory");
}
__device__ __forceinline__ void p0_transpose_item_f8(const float* W, int K, int N, unsigned char* WT, int k0, int n0, LAS float* scr, int lane) {
#pragma unroll 8
    for (int i = 0; i < 32; ++i) { const int kk = 2 * i + (lane >> 5); scr[kk * 33 + (lane & 31)] = W[(size_t)(k0 + kk) * N + n0 + (lane & 31)] * WSCALE; }
    asm volatile("s_waitcnt lgkmcnt(0)" ::: "memory");
    const int c = lane & 7;
#pragma unroll
    for (int j = 0; j < 4; ++j) { const int n = (lane >> 3) + 8 * j; const LAS float* s = scr + (8 * c) * 33 + n;
        u32x2 o; o.x = pk4_fp8(s[0 * 33], s[1 * 33], s[2 * 33], s[3 * 33]); o.y = pk4_fp8(s[4 * 33], s[5 * 33], s[6 * 33], s[7 * 33]);
        *(u32x2*)(WT + (size_t)(n0 + n) * K + k0 + 8 * c) = o; }
    asm volatile("s_waitcnt lgkmcnt(0)" ::: "memory");
}
__device__ __forceinline__ int win_drow(int n0) {
    if (n0 < 1024 || n0 >= 2048) return n0;
    const int rel = n0 - 1024, isk = rel >> 9, head = (rel & 511) >> 6, dh = (rel & 63) >> 5;
    return 256 * (4 + 2 * isk + (head >> 2)) + 128 * dh + 32 * (head & 3);
}
constexpr int MOE_I_GU = 64 * 32, MOE_I_D = 64 * 16, MOE_ITEMS = NE * (MOE_I_GU + MOE_I_D);
struct ConvItem { const float* src; unsigned char* dst; int N; };
__device__ __forceinline__ ConvItem moe_conv_decode(const Frame& F, int it) {
    ConvItem c;
    if (it < NE * MOE_I_GU) { const int e = it / MOE_I_GU, q = it % MOE_I_GU, k16 = q >> 5, n64 = q & 31; c.N = 2048;
        c.src = F.w_gate_up() + (size_t)e * KD * 2048 + (size_t)(16 * k16) * 2048 + 64 * n64; c.dst = F.WGU() + (size_t)e * 2048 * KD + ((size_t)k16 * 2048 + 64 * n64) * 16; }
    else { const int r = it - NE * MOE_I_GU; const int e = r / MOE_I_D, q = r % MOE_I_D, k16 = q >> 4, n64 = q & 15; c.N = 1024;
        c.src = F.w_down() + (size_t)e * KD * 1024 + (size_t)(16 * k16) * 1024 + 64 * n64; c.dst = F.WD() + (size_t)e * 1024 * KD + ((size_t)k16 * 1024 + 64 * n64) * 16; }
    return c;
}
__device__ __forceinline__ void moe_conv_issue(const ConvItem& c, float (&v)[16], int lane) {
    const float* p = c.src + lane;
#pragma unroll
    for (int i = 0; i < 16; ++i) v[i] = __builtin_nontemporal_load(p + (size_t)i * c.N);
}
__device__ __forceinline__ void moe_conv_finish(const ConvItem& c, const float (&v)[16], LAS float*, int lane) {
    u32x4 o;
    o.x = pk4_fp8(v[0] * WSCALE, v[1] * WSCALE, v[2] * WSCALE, v[3] * WSCALE); o.y = pk4_fp8(v[4] * WSCALE, v[5] * WSCALE, v[6] * WSCALE, v[7] * WSCALE);
    o.z = pk4_fp8(v[8] * WSCALE, v[9] * WSCALE, v[10] * WSCALE, v[11] * WSCALE); o.w = pk4_fp8(v[12] * WSCALE, v[13] * WSCALE, v[14] * WSCALE, v[15] * WSCALE);
    *(u32x4*)(c.dst + (size_t)lane * 16) = o;
}
constexpr int CONV_P4_PER_WAVE = 56, CONV_P4_ITEMS = CONV_P4_PER_WAVE * 1024;
constexpr int CONV_G_PER_UNIT = 3, CONV_G_ITEMS = CONV_G_PER_UNIT * 4 * 2048;
constexpr int CONV_P2_ITEMS = MOE_ITEMS - CONV_P4_ITEMS - CONV_G_ITEMS, CONV_P2_PER_WAVE = CONV_P2_ITEMS / 2048;
static_assert(CONV_P2_ITEMS % 2048 == 0 && CONV_P4_PER_WAVE % 2 == 0, "conversion split");
__device__ __forceinline__ void p0_prologue(Frame& F) {
    LAS float* scr = (LAS float*)(F.lds + F.wave * 16384);
    const int gw = F.vcu * NWAVES + F.wave, NGW = F.G * NWAVES, lane = F.lane;
    for (int m = gw; m < NTOK; m += 2 * NGW) {
        const int m2 = m + NGW;
        const f32x4* xr = (const f32x4*)(F.x() + (size_t)m * DM) + lane; const f32x4* xr2 = (const f32x4*)(F.x() + (size_t)m2 * DM) + lane; f32x4 v[4], w[4]; float s = 0.f, s2 = 0.f;
#pragma unroll
        for (int j = 0; j < 4; ++j) v[j] = __builtin_nontemporal_load(xr + 64 * j);
#pragma unroll
        for (int j = 0; j < 4; ++j) w[j] = __builtin_nontemporal_load(xr2 + 64 * j);
#pragma unroll
        for (int j = 0; j < 4; ++j) { s += (v[j].x * v[j].x + v[j].y * v[j].y) + (v[j].z * v[j].z + v[j].w * v[j].w); s2 += (w[j].x * w[j].x + w[j].y * w[j].y) + (w[j].z * w[j].z + w[j].w * w[j].w); }
        const float tot = wave_sum(s), tot2 = wave_sum(s2);
        if (lane == 0) { F.RSTD1()[m] = 1.0f / sqrtf(tot * (1.0f / DM) + EPS); F.RSTD1()[m2] = 1.0f / sqrtf(tot2 * (1.0f / DM) + EPS); }
        u32x2* o8 = (u32x2*)(F.XB() + (size_t)m * DM) + lane; u32x2* o82 = (u32x2*)(F.XB() + (size_t)m2 * DM) + lane;
#pragma unroll
        for (int j = 0; j < 4; ++j) { u32x2 a; a.x = cvt_pk_bf16(v[j].x, v[j].y); a.y = cvt_pk_bf16(v[j].z, v[j].w); o8[64 * j] = a; u32x2 b; b.x = cvt_pk_bf16(w[j].x, w[j].y); b.y = cvt_pk_bf16(w[j].z, w[j].w); o82[64 * j] = b; }
    }
    constexpr int I_IN = 16 * 80, I_OUT = 16 * 32;
    for (int it = gw; it < I_IN + I_OUT; it += NGW) {
        int r = it;
        if (r < I_IN) { const int kb = r / 80, nb = r % 80; p0_transpose_item(F.w_in(), KD, 2560, F.WIN(), 64 * kb, 32 * nb, win_drow(32 * nb), F.norm1_w(), scr, lane); continue; } r -= I_IN;
        { const int kb = r / 32, nb = r % 32; p0_transpose_item(F.w_out(), KD, 1024, F.WOUT(), 64 * kb, 32 * nb, 32 * nb, nullptr, scr, lane); }
    }
    for (int idx = gw * 64 + lane; idx < NE * KD; idx += NGW * 64) {
        const int e = idx >> 10, k = idx & 1023; const float w = F.router_w()[(size_t)k * NE + e];
        const unsigned hi = cvt_pk_bf16(w, 0.f) & 0xffffu; const float rem = w - __uint_as_float(hi << 16);
        F.RT()[idx] = (bf16_t)hi; F.RT()[NE * KD + idx] = (bf16_t)(cvt_pk_bf16(rem, 0.f) & 0xffffu);
    }
}

struct ProgIn {
    static constexpr bool GATHER = false, FP8 = false; static constexpr int ID = 1, BN = 0;
    const Frame* F;
    __device__ __forceinline__ bool next(int i, Unit& u) const {
        const int v = F->vcu;
        if (i < 4) { const int uu = i * 256 + v, grp = uu >> 5, w = uu & 31; u.pm = grp * 4 + (w & 3); u.pn = w >> 2; u.kind = u.pn < 4 ? 0 : 1;
            u.A = (const char*)(F->XB() + (size_t)u.pm * 256 * KD); u.B = (const char*)(F->WIN() + (size_t)u.pn * 256 * KD); u.e = 0; u.r0 = 0; return true; }
        if (i == 4) { u.kind = 2; u.pm = v & 1; u.pn = v >> 1; u.A = (const char*)(F->WIN() + (size_t)(2048 + u.pm * 256) * KD); u.B = (const char*)(F->XB() + (size_t)u.pn * 256 * KD); u.e = 0; u.r0 = 0; return true; }
        return false;
    }
    __device__ __forceinline__ void epi(const Acc& acc, const Unit& u, int wr, int wc, int fr, int fq) const {
        asm volatile("" : "+v"(fr), "+v"(fq));
        if (u.kind == 2) {
            const int tk0 = u.pn * 256 + wc * 32 + 8 * fq;
            f32x4 rs[2][2];
#pragma unroll
            for (int bj = 0; bj < 2; ++bj)
#pragma unroll
                for (int n = 0; n < 2; ++n) rs[bj][n] = *(const f32x4*)(F->RSTD1() + tk0 + bj * 128 + 4 * n);
#pragma unroll
            for (int ai = 0; ai < 2; ++ai)
#pragma unroll
                for (int m = 0; m < 4; ++m) { const int cp = u.pm * 256 + ai * 128 + wr * 64 + m * 16 + fr; bf16_t* rowp = F->VT() + (size_t)cp * NTOK + tk0;
#pragma unroll
                    for (int bj = 0; bj < 2; ++bj) { const f32x4 v0 = acc[ai][bj][m][0] * rs[bj][0], v1 = acc[ai][bj][m][1] * rs[bj][1];
                        u32x4 w; w.x = cvt_pk_bf16(v0[0], v0[1]); w.y = cvt_pk_bf16(v0[2], v0[3]); w.z = cvt_pk_bf16(v1[0], v1[1]); w.w = cvt_pk_bf16(v1[2], v1[3]);
                        *(u32x4*)(rowp + bj * 128) = w; } }
            return;
        }
        float rsr[2][4];
#pragma unroll
        for (int ai = 0; ai < 2; ++ai)
#pragma unroll
            for (int m = 0; m < 4; ++m) rsr[ai][m] = F->RSTD1()[u.pm * 256 + ai * 128 + wr * 64 + m * 16 + fr];
        if (u.kind == 0) {
#pragma unroll
            for (int ai = 0; ai < 2; ++ai)
#pragma unroll
                for (int m = 0; m < 4; ++m) { const int r = u.pm * 256 + ai * 128 + wr * 64 + m * 16 + fr; bf16_t* rowp = F->UV() + (size_t)r * 1024 + u.pn * 256 + wc * 32 + 8 * fq; const float rs = rsr[ai][m];
#pragma unroll
                    for (int bj = 0; bj < 2; ++bj) { f32x4 v0 = acc[ai][bj][m][0] * rs, v1 = acc[ai][bj][m][1] * rs;
#pragma unroll
                        for (int j = 0; j < 4; ++j) { v0[j] = gelu_tanh_f(v0[j]); v1[j] = gelu_tanh_f(v1[j]); }
                        u32x4 w; w.x = cvt_pk_bf16(v0[0], v0[1]); w.y = cvt_pk_bf16(v0[2], v0[3]); w.z = cvt_pk_bf16(v1[0], v1[1]); w.w = cvt_pk_bf16(v1[2], v1[3]);
                        *(u32x4*)(rowp + bj * 128) = w; } }
            return;
        }
        {
            const int isk = (u.pn - 4) >> 1, head = 4 * (u.pn & 1) + wc; const float* nw = isk ? F->k_norm_w() : F->q_norm_w(); bf16_t* dst = isk ? F->K() : F->Q();
            const float osc = isk ? 1.0f : QSCALE;
            f32x4 nwv[2][2];
#pragma unroll
            for (int bj = 0; bj < 2; ++bj)
#pragma unroll
                for (int n = 0; n < 2; ++n) nwv[bj][n] = *(const f32x4*)(nw + 32 * bj + 8 * fq + 4 * n);
#pragma unroll
            for (int ai = 0; ai < 2; ++ai)
#pragma unroll
                for (int m = 0; m < 4; ++m) { const int r = u.pm * 256 + ai * 128 + wr * 64 + m * 16 + fr; const float rs = rsr[ai][m];
                    f32x4 t[2][2]; float ss = 0.f;
#pragma unroll
                    for (int bj = 0; bj < 2; ++bj)
#pragma unroll
                        for (int n = 0; n < 2; ++n) { t[bj][n] = acc[ai][bj][m][n] * rs; ss += (t[bj][n][0] * t[bj][n][0] + t[bj][n][1] * t[bj][n][1]) + (t[bj][n][2] * t[bj][n][2] + t[bj][n][3] * t[bj][n][3]); }
                    ss += __shfl_xor(ss, 16); ss += __shfl_xor(ss, 32);
                    const float rn = osc / sqrtf(ss * (1.0f / 64.0f) + EPS);
                    bf16_t* rowp = dst + (size_t)r * 512 + head * 64 + 8 * fq;
#pragma unroll
                    for (int bj = 0; bj < 2; ++bj) { const f32x4 v0 = t[bj][0] * nwv[bj][0] * rn, v1 = t[bj][1] * nwv[bj][1] * rn;
                        u32x4 w; w.x = cvt_pk_bf16(v0[0], v0[1]); w.y = cvt_pk_bf16(v0[2], v0[3]); w.z = cvt_pk_bf16(v1[0], v1[1]); w.w = cvt_pk_bf16(v1[2], v1[3]);
                        *(u32x4*)(rowp + bj * 32) = w; } }
        }
    }
};

constexpr int VN_PITCH = 136, YT_PITCH = 132, YT_OFF = 36864;
__device__ __forceinline__ void gmlp_unit(const Frame& F, int chunk, int g, int cbase) {
    const int tid = F.tid, lane = F.lane, wid = F.wave;
    ConvItem gci[CONV_G_PER_UNIT]; float gcv[CONV_G_PER_UNIT][16];
#pragma unroll
    for (int q = 0; q < CONV_G_PER_UNIT; ++q) { gci[q] = moe_conv_decode(F, cbase + q * 2048); moe_conv_issue(gci[q], gcv[q], lane); }
    LAS bf16_t* vn = (LAS bf16_t*)F.lds; LAS float* yt = (LAS float*)(F.lds + YT_OFF);
    const size_t tok0 = (size_t)chunk * 128;
    {
        const int row = tid >> 2, qd = tid & 3; const bf16_t* src = F.UV() + (tok0 + row) * 1024 + 512 + g * 128 + qd * 32;
        u32x4 w[4]; float v[32]; float ss = 0.f;
#pragma unroll
        for (int i = 0; i < 4; ++i) w[i] = *(const u32x4*)(src + 8 * i);
#pragma unroll
        for (int i = 0; i < 4; ++i)
#pragma unroll
            for (int j = 0; j < 4; ++j) { v[8 * i + 2 * j] = bflo(w[i][j]); v[8 * i + 2 * j + 1] = bfhi(w[i][j]); }
#pragma unroll
        for (int i = 0; i < 32; ++i) ss += v[i] * v[i];
        ss += __shfl_xor(ss, 1); ss += __shfl_xor(ss, 2);
        const float rs = 1.0f / sqrtf(ss * (1.0f / 128.0f) + EPS);
        const float* nw = F.sgu_norm_w() + g * 128 + qd * 32;
#pragma unroll
        for (int i = 0; i < 4; ++i) { const f32x4 n0 = *(const f32x4*)(nw + 8 * i), n1 = *(const f32x4*)(nw + 8 * i + 4);
            u32x4 o; o.x = cvt_pk_bf16(v[8 * i] * rs * n0[0], v[8 * i + 1] * rs * n0[1]); o.y = cvt_pk_bf16(v[8 * i + 2] * rs * n0[2], v[8 * i + 3] * rs * n0[3]);
            o.z = cvt_pk_bf16(v[8 * i + 4] * rs * n1[0], v[8 * i + 5] * rs * n1[1]); o.w = cvt_pk_bf16(v[8 * i + 6] * rs * n1[2], v[8 * i + 7] * rs * n1[3]);
            *(LAS u32x4*)(vn + row * VN_PITCH + qd * 32 + 8 * i) = o; }
    }
    __syncthreads();
    {
        const int tb = wid >> 1, cb0 = 2 * (wid & 1), r32 = lane & 31, hh = lane >> 5;
        f32x16 a0 = {}, a1 = {};
        const int t = 32 * tb + r32; const float* wrow = F.sgu_w() + ((size_t)g * 128 + t) * 128;
        for (int ks = 0; ks < 2 * (tb + 1); ++ks) {
            const int s0 = 16 * ks + 8 * hh;
            const f32x4 w0 = *(const f32x4*)(wrow + s0), w1 = *(const f32x4*)(wrow + s0 + 4);
            float wv[8] = {w0[0], w0[1], w0[2], w0[3], w1[0], w1[1], w1[2], w1[3]};
#pragma unroll
            for (int j = 0; j < 8; ++j) if (s0 + j > t) wv[j] = 0.f;
            u32x4 aw; aw.x = cvt_pk_bf16(wv[0], wv[1]); aw.y = cvt_pk_bf16(wv[2], wv[3]); aw.z = cvt_pk_bf16(wv[4], wv[5]); aw.w = cvt_pk_bf16(wv[6], wv[7]);
            const bf16x8 af = __builtin_bit_cast(bf16x8, aw);
            bf16x8 b0, b1;
#pragma unroll
            for (int j = 0; j < 8; ++j) { b0[j] = (short)vn[(s0 + j) * VN_PITCH + 32 * cb0 + r32]; b1[j] = (short)vn[(s0 + j) * VN_PITCH + 32 * (cb0 + 1) + r32]; }
            a0 = __builtin_amdgcn_mfma_f32_32x32x16_bf16(af, b0, a0, 0, 0, 0);
            a1 = __builtin_amdgcn_mfma_f32_32x32x16_bf16(af, b1, a1, 0, 0, 0);
        }
#pragma unroll
        for (int reg = 0; reg < 16; ++reg) {
            const int tt = 32 * tb + (reg & 3) + 8 * (reg >> 2) + 4 * hh; const float bb = F.sgu_b()[g * 128 + tt];
            const bf16_t* up = F.UV() + (tok0 + tt) * 1024 + g * 128;
            const int c0 = 32 * cb0 + r32, c1 = c0 + 32;
            yt[tt * YT_PITCH + c0] = bf2f(up[c0]) * (a0[reg] + bb);
            yt[tt * YT_PITCH + c1] = bf2f(up[c1]) * (a1[reg] + bb);
        }
    }
    __syncthreads();
    {
        const int row = tid >> 2, qd = tid & 3; const LAS float* src = yt + row * YT_PITCH + qd * 32; f32x4 v[8]; float ss = 0.f;
#pragma unroll
        for (int i = 0; i < 8; ++i) { v[i] = *(const LAS f32x4*)(src + 4 * i); ss += (v[i][0] * v[i][0] + v[i][1] * v[i][1]) + (v[i][2] * v[i][2] + v[i][3] * v[i][3]); }
        ss += __shfl_xor(ss, 1); ss += __shfl_xor(ss, 2);
        const float rs = 1.0f / sqrtf(ss * (1.0f / 128.0f) + EPS);
        const float* nw = F.out_norm_a_w() + g * 128 + qd * 32; bf16_t* dst = F.Y() + (tok0 + row) * 1024 + g * 128 + qd * 32;
#pragma unroll
        for (int i = 0; i < 4; ++i) { const f32x4 n0 = *(const f32x4*)(nw + 8 * i), n1 = *(const f32x4*)(nw + 8 * i + 4); const f32x4 x0 = v[2 * i] * n0 * rs, x1 = v[2 * i + 1] * n1 * rs;
            u32x4 o; o.x = cvt_pk_bf16(x0[0], x0[1]); o.y = cvt_pk_bf16(x0[2], x0[3]); o.z = cvt_pk_bf16(x1[0], x1[1]); o.w = cvt_pk_bf16(x1[2], x1[3]);
            *(u32x4*)(dst + 8 * i) = o; }
    }
#pragma unroll
    for (int q = 0; q < CONV_G_PER_UNIT; ++q) moe_conv_finish(gci[q], gcv[q], nullptr, lane);
    __syncthreads();
}

__device__ __forceinline__ void attn_wave_unit(const Frame& F, int b, int h, int qblk, int& cit, int cend, LAS float* scr) {
    const int lane = F.lane, r32 = lane & 31, hi = lane >> 5;
    const size_t tokq = (size_t)b * SEQ + 32 * qblk + r32;
    bf16x8 qr[4];
#pragma unroll
    for (int d0 = 0; d0 < 4; ++d0) qr[d0] = *(const bf16x8*)(F.Q() + tokq * 512 + h * 64 + 16 * d0 + 8 * hi);
    f32x16 o0 = {}, o1 = {};
    float carry = 0.f;
    const bf16_t* Kb = F.K() + ((size_t)b * SEQ + r32) * 512 + h * 64 + 8 * hi;
    const bf16_t* V0 = F.VT() + (size_t)(h * 64 + r32) * NTOK + (size_t)b * SEQ + 4 * hi;
    bf16x8 kf[4]; s16x4 vf[2][2][2];
    auto load_tile = [&](int j, bf16x8 (&kk)[4], s16x4 (&vv)[2][2][2]) {
#pragma unroll
        for (int d0 = 0; d0 < 4; ++d0) kk[d0] = *(const bf16x8*)(Kb + (size_t)(32 * j) * 512 + 16 * d0);
#pragma unroll
        for (int dh = 0; dh < 2; ++dh)
#pragma unroll
            for (int ks = 0; ks < 2; ++ks) { const bf16_t* p = V0 + (size_t)dh * 32 * NTOK + 32 * j + 16 * ks; vv[dh][ks][0] = *(const s16x4*)p; vv[dh][ks][1] = *(const s16x4*)(p + 8); }
    };
    load_tile(qblk, kf, vf);
    for (int j = qblk; j >= 0; --j) {
        bf16x8 kn[4]; s16x4 vn2[2][2][2];
        const bool cv = cit < cend; ConvItem citem; float cvv[16];
        if (cv) { citem = moe_conv_decode(F, cit); moe_conv_issue(citem, cvv, lane); cit += 2048; }
        const bool cv2 = cit < cend; ConvItem citem2; float cvw[16];
        if (cv2) { citem2 = moe_conv_decode(F, cit); moe_conv_issue(citem2, cvw, lane); cit += 2048; }
        if (j > 0) load_tile(j - 1, kn, vn2);
        else {
#pragma unroll
            for (int d0 = 0; d0 < 4; ++d0) kn[d0] = kf[d0];
#pragma unroll
            for (int dh = 0; dh < 2; ++dh)
#pragma unroll
                for (int ks = 0; ks < 2; ++ks) { vn2[dh][ks][0] = vf[dh][ks][0]; vn2[dh][ks][1] = vf[dh][ks][1]; }
        }
        f32x16 s = {};
#pragma unroll
        for (int d0 = 0; d0 < 4; ++d0) s = __builtin_amdgcn_mfma_f32_32x32x16_bf16(kf[d0], qr[d0], s, 0, 0, 0);
        float sp[16];
        const bool diag = (j == qblk);
#pragma unroll
        for (int r = 0; r < 16; ++r) {
            const int kvl = (r & 3) + 8 * (r >> 2) + 4 * hi;
            const float z = s[r];
            float v = fmaxf(z, 0.f) + __builtin_amdgcn_logf(1.0f + __builtin_amdgcn_exp2f(-fabsf(z)));
            if (diag && kvl >= r32) v = 0.f;
            sp[r] = v;
        }
        float G[4], Gp[4];
#pragma unroll
        for (int k = 0; k < 4; ++k) { G[k] = (sp[4 * k] + sp[4 * k + 1]) + (sp[4 * k + 2] + sp[4 * k + 3]); Gp[k] = __shfl_xor(G[k], 32); }
        const float T3 = G[3] + Gp[3], T2 = G[2] + Gp[2], T1 = G[1] + Gp[1], T0 = G[0] + Gp[0];
        float off[4];
        off[3] = 0.f; off[2] = T3; off[1] = T3 + T2; off[0] = T3 + T2 + T1;
        const float tile_total = off[0] + T0;
#pragma unroll
        for (int k = 0; k < 4; ++k) off[k] += carry + (hi == 0 ? Gp[k] : 0.f);
        float a[16];
#pragma unroll
        for (int k = 0; k < 4; ++k) {
            float c = off[k];
#pragma unroll
            for (int i = 3; i >= 0; --i) { const int r = 4 * k + i; c += sp[r]; float av = __builtin_amdgcn_exp2f(s[r] - c);
                if (diag && ((r & 3) + 8 * (r >> 2) + 4 * hi) >= r32) av = 0.f;
                a[r] = av; }
        }
        carry += tile_total;
        u32x4 p0, p1;
        p0.x = cvt_pk_bf16(a[0], a[1]); p0.y = cvt_pk_bf16(a[2], a[3]); p0.z = cvt_pk_bf16(a[4], a[5]); p0.w = cvt_pk_bf16(a[6], a[7]);
        p1.x = cvt_pk_bf16(a[8], a[9]); p1.y = cvt_pk_bf16(a[10], a[11]); p1.z = cvt_pk_bf16(a[12], a[13]); p1.w = cvt_pk_bf16(a[14], a[15]);
        const bf16x8 pf0 = __builtin_bit_cast(bf16x8, p0), pf1 = __builtin_bit_cast(bf16x8, p1);
#define MK_VF(dh, ks) (bf16x8){vf[dh][ks][0][0], vf[dh][ks][0][1], vf[dh][ks][0][2], vf[dh][ks][0][3], vf[dh][ks][1][0], vf[dh][ks][1][1], vf[dh][ks][1][2], vf[dh][ks][1][3]}
        o0 = __builtin_amdgcn_mfma_f32_32x32x16_bf16(MK_VF(0, 0), pf0, o0, 0, 0, 0);
        o0 = __builtin_amdgcn_mfma_f32_32x32x16_bf16(MK_VF(0, 1), pf1, o0, 0, 0, 0);
        o1 = __builtin_amdgcn_mfma_f32_32x32x16_bf16(MK_VF(1, 0), pf0, o1, 0, 0, 0);
        o1 = __builtin_amdgcn_mfma_f32_32x32x16_bf16(MK_VF(1, 1), pf1, o1, 0, 0, 0);
#undef MK_VF
        if (cv) moe_conv_finish(citem, cvv, scr, lane);
        if (cv2) moe_conv_finish(citem2, cvw, scr, lane);
        if (__all(carry > SB_THR)) break;
#pragma unroll
        for (int d0 = 0; d0 < 4; ++d0) kf[d0] = kn[d0];
#pragma unroll
        for (int dh = 0; dh < 2; ++dh)
#pragma unroll
            for (int ks = 0; ks < 2; ++ks) { vf[dh][ks][0] = vn2[dh][ks][0]; vf[dh][ks][1] = vn2[dh][ks][1]; }
    }
    float ss = 0.f;
#pragma unroll
    for (int r = 0; r < 16; ++r) ss += o0[r] * o0[r] + o1[r] * o1[r];
    ss += __shfl_xor(ss, 32);
    const float rs = 1.0f / sqrtf(ss * (1.0f / 64.0f) + EPS);
    const float* nw = F.out_norm_b_w() + h * 64 + 4 * hi; bf16_t* dst = F.Y() + tokq * 1024 + 512 + h * 64 + 4 * hi;
#pragma unroll
    for (int dh = 0; dh < 2; ++dh)
#pragma unroll
        for (int g = 0; g < 4; ++g) { const f32x4 w = *(const f32x4*)(nw + 32 * dh + 8 * g); const f32x16& o = dh ? o1 : o0;
            u32x2 pk; pk.x = cvt_pk_bf16(o[4 * g] * rs * w[0], o[4 * g + 1] * rs * w[1]); pk.y = cvt_pk_bf16(o[4 * g + 2] * rs * w[2], o[4 * g + 3] * rs * w[3]);
            *(u32x2*)(dst + 32 * dh + 8 * g) = pk; }
}
__device__ __forceinline__ void p2_mixers(Frame& F) {
    for (int i = 0; i < 4; ++i) { const int u = i * 256 + F.vcu; gmlp_unit(F, u >> 2, u & 3, CONV_P4_ITEMS + i * CONV_G_PER_UNIT * 2048 + F.vcu * NWAVES + F.wave); }
    const int gw = F.vcu * NWAVES + F.wave;
    LAS float* scr = (LAS float*)(F.lds + F.wave * 16384);
    int cit = CONV_P4_ITEMS + CONV_G_ITEMS + gw; const int cend = MOE_ITEMS;
    for (int i = 0; i < ((MK_REP == 21 || MK_REP == 22) ? 8 : 4); ++i) { if (MK_REP == 22 && i == 4) cit = CONV_P4_ITEMS + gw; const int u = (i & 3) * 2048 + gw; const int qblk = u & 127, bh = u >> 7; attn_wave_unit(F, bh >> 3, bh & 7, qblk, cit, cend, scr); }
    for (; cit < cend; cit += 2048) { const ConvItem c = moe_conv_decode(F, cit); float v[16]; moe_conv_issue(c, v, F.lane); moe_conv_finish(c, v, scr, F.lane); }
}

struct ProgOut {
    static constexpr bool GATHER = false, FP8 = false; static constexpr int ID = 3, BN = 0;
    const Frame* F;
    __device__ __forceinline__ bool next(int i, Unit& u) const {
        if (i >= 2) return false;
        const int uu = i * 256 + F->vcu, grp = uu >> 5, w = uu & 31; u.pm = grp * 8 + (w & 7); u.pn = w >> 3; u.kind = 0; u.e = 0; u.r0 = 0;
        u.A = (const char*)(F->Y() + (size_t)u.pm * 256 * KD); u.B = (const char*)(F->WOUT() + (size_t)u.pn * 256 * KD); return true;
    }
    __device__ __forceinline__ void epi(const Acc& acc, const Unit& u, int wr, int wc, int fr, int fq) const {
        asm volatile("" : "+v"(fr), "+v"(fq));
        const size_t off0 = (size_t)(u.pm * 256 + wr * 64 + fr) * DM + u.pn * 256 + wc * 32 + 8 * fq;
        const float* xb = F->x() + off0; float* ob = F->out() + off0;
        f32x4 xv[2][2][2];
#define MK_LDX(g, slot) do { const size_t go_ = (size_t)(((g) >> 2) * 128 + ((g) & 3) * 16) * DM; _Pragma("unroll") for (int bj = 0; bj < 2; ++bj) _Pragma("unroll") for (int n = 0; n < 2; ++n) xv[slot][bj][n] = *(const f32x4*)(xb + go_ + bj * 128 + 4 * n); } while (0)
        MK_LDX(0, 0);
#pragma unroll
        for (int g = 0; g < 8; ++g) { const int ai = g >> 2, m = g & 3; const size_t go = (size_t)(ai * 128 + m * 16) * DM; float ss = 0.f;
            if (g + 1 < 8) MK_LDX(g + 1, (g + 1) & 1);
#pragma unroll
            for (int bj = 0; bj < 2; ++bj)
#pragma unroll
                for (int n = 0; n < 2; ++n) { const f32x4 o = xv[g & 1][bj][n] + acc[ai][bj][m][n];
                    ss += (o[0] * o[0] + o[1] * o[1]) + (o[2] * o[2] + o[3] * o[3]); *(f32x4*)(ob + go + bj * 128 + 4 * n) = o; }
            ss += __shfl_xor(ss, 16); ss += __shfl_xor(ss, 32);
            if (fq == 0) F->SSPART()[(size_t)(u.pm * 256 + ai * 128 + wr * 64 + m * 16 + fr) * 16 + u.pn * 4 + wc] = ss; }
#undef MK_LDX
    }
};

template <bool DRY> __device__ __forceinline__ void router_wave_unit(Frame& F, int unit) {
    const int lane = F.lane, r32 = lane & 31, hh = lane >> 5; const int tok = unit * 32 + r32;
    float ssum = 0.f;
    { const f32x4* sp = (const f32x4*)(F.SSPART() + (size_t)tok * 16);
#pragma unroll
      for (int i = 0; i < 4; ++i) { const f32x4 v = sp[i]; ssum += v[0]; ssum += v[1]; ssum += v[2]; ssum += v[3]; } }
    const float rs = 1.0f / sqrtf(ssum * (1.0f / DM) + EPS);
    f32x16 acc = {};
    const float* xrow = F.out() + (size_t)tok * DM + 8 * hh; const float* w2 = F.norm2_w() + 8 * hh; unsigned char* hrow = F.HB() + (size_t)tok * DM + 8 * hh;
    const bf16_t* rth = F.RT() + (size_t)r32 * KD + 8 * hh; const bf16_t* rtl = rth + NE * KD;
#pragma unroll 4
    for (int s = 0; s < 64; ++s) {
        const f32x4 x0 = *(const f32x4*)(xrow + 16 * s), x1 = *(const f32x4*)(xrow + 16 * s + 4);
        const f32x4 g0 = *(const f32x4*)(w2 + 16 * s), g1 = *(const f32x4*)(w2 + 16 * s + 4);
        const f32x4 h0 = x0 * g0 * rs, h1 = x1 * g1 * rs;
        u32x4 hw; hw.x = cvt_pk_bf16(h0[0], h0[1]); hw.y = cvt_pk_bf16(h0[2], h0[3]); hw.z = cvt_pk_bf16(h1[0], h1[1]); hw.w = cvt_pk_bf16(h1[2], h1[3]);
        { u32x2 h8; h8.x = pk4_fp8(h0[0], h0[1], h0[2], h0[3]); h8.y = pk4_fp8(h1[0], h1[1], h1[2], h1[3]); *(u32x2*)(hrow + 16 * s) = h8; }
        u32x4 lw; lw.x = cvt_pk_bf16(h0[0] - bflo(hw.x), h0[1] - bfhi(hw.x)); lw.y = cvt_pk_bf16(h0[2] - bflo(hw.y), h0[3] - bfhi(hw.y));
        lw.z = cvt_pk_bf16(h1[0] - bflo(hw.z), h1[1] - bfhi(hw.z)); lw.w = cvt_pk_bf16(h1[2] - bflo(hw.w), h1[3] - bfhi(hw.w));
        const bf16x8 bh = __builtin_bit_cast(bf16x8, hw), bl = __builtin_bit_cast(bf16x8, lw);
        const bf16x8 ah = *(const bf16x8*)(rth + 16 * s), al = *(const bf16x8*)(rtl + 16 * s);
        acc = __builtin_amdgcn_mfma_f32_32x32x16_bf16(ah, bh, acc, 0, 0, 0);
        acc = __builtin_amdgcn_mfma_f32_32x32x16_bf16(al, bh, acc, 0, 0, 0);
        acc = __builtin_amdgcn_mfma_f32_32x32x16_bf16(ah, bl, acc, 0, 0, 0);
    }
    float lv[16];
#pragma unroll
    for (int r = 0; r < 16; ++r) lv[r] = acc[r] + F.router_b()[(r & 3) + 8 * (r >> 2) + 4 * hh];
    float cv[8]; int ce[8];
#pragma unroll
    for (int k = 0; k < 4; ++k) { float bv = -INFINITY; int be = 0;
#pragma unroll
        for (int r = 0; r < 16; ++r) { const int e = (r & 3) + 8 * (r >> 2) + 4 * hh; if (lv[r] > bv) { bv = lv[r]; be = e; } }
#pragma unroll
        for (int r = 0; r < 16; ++r) { const int e = (r & 3) + 8 * (r >> 2) + 4 * hh; if (e == be) lv[r] = -INFINITY; }
        cv[k] = bv; ce[k] = be; }
#pragma unroll
    for (int k = 0; k < 4; ++k) { cv[4 + k] = __shfl_xor(cv[k], 32); ce[4 + k] = __shfl_xor(ce[k], 32); }
    float tv[4]; int te[4];
#pragma unroll
    for (int k = 0; k < 4; ++k) { float bv = -INFINITY; int be = 1 << 20;
#pragma unroll
        for (int c = 0; c < 8; ++c) if (cv[c] > bv || (cv[c] == bv && ce[c] < be)) { bv = cv[c]; be = ce[c]; }
#pragma unroll
        for (int c = 0; c < 8; ++c) if (ce[c] == be) cv[c] = -INFINITY;
        tv[k] = bv; te[k] = be; }
    float ex[4], den = 0.f;
#pragma unroll
    for (int k = 0; k < 4; ++k) { ex[k] = __builtin_amdgcn_exp2f((tv[k] - tv[0]) * LOG2E); den += ex[k]; }
    const float rden = 1.0f / den;
    const int e0 = hh ? te[2] : te[0], e1 = hh ? te[3] : te[1]; const float g0 = (hh ? ex[2] : ex[0]) * rden, g1 = (hh ? ex[3] : ex[1]) * rden;
    if (DRY) { asm volatile("" :: "v"(e0), "v"(e1), "v"(g0), "v"(g1)); return; }
    int myc = 0; int rank0 = 0, rank1 = 0;
    const unsigned long long ltmask = (1ull << lane) - 1ull;
    for (int e = 0; e < NE; ++e) {
        const unsigned long long m0 = __ballot(e0 == e), m1 = __ballot(e1 == e);
        const int c0 = __popcll(m0), c1 = __popcll(m1);
        if (lane == e) myc = c0 + c1;
        if (e0 == e) rank0 = __popcll(m0 & ltmask);
        if (e1 == e) rank1 = c0 + __popcll(m1 & ltmask);
    }
    int base = 0;
    if (lane < NE && myc > 0) base = (int)__hip_atomic_fetch_add(F.ctl() + CW_CNT + lane, (unsigned)myc, __ATOMIC_RELAXED, __HIP_MEMORY_SCOPE_AGENT);
    const int p0 = __shfl(base, e0) + rank0, p1 = __shfl(base, e1) + rank1;
    F.LISTTOK()[(size_t)e0 * NTOK + p0] = tok; F.LISTGATE()[(size_t)e0 * NTOK + p0] = g0;
    F.LISTTOK()[(size_t)e1 * NTOK + p1] = tok; F.LISTGATE()[(size_t)e1 * NTOK + p1] = g1;
    F.TOKINFO()[tok * 4 + 2 * hh] = (e0 << 16) | p0; F.TOKINFO()[tok * 4 + 2 * hh + 1] = (e1 << 16) | p1;
}

__device__ __forceinline__ void moe_build_table(Frame& F) {
    LAS int* tab = (LAS int*)(F.lds + TAB_OFF);
    if (F.tid < NE) tab[F.tid] = (int)__hip_atomic_load(F.ctl() + CW_CNT + F.tid, __ATOMIC_RELAXED, __HIP_MEMORY_SCOPE_AGENT);
    __syncthreads();
    if (F.tid == 0) { int acc = 0; for (int e = 0; e < NE; ++e) { tab[32 + e] = acc; acc += (tab[e] + 255) >> 8; } tab[64] = acc; }
    __syncthreads();
}
__device__ __forceinline__ int sgpr(int v) { return __builtin_amdgcn_readfirstlane(v); }
template <int WGM, int NN>
__device__ __forceinline__ bool moe_decode(const Frame* F, int T, int i, Unit& u) {
    const LAS int* tab = (const LAS int*)(F->lds + TAB_OFF);
    const int uu = i * 256 + F->vcu, grp = uu >> 5, w = uu & 31; const int mt = grp * WGM + (w % WGM); u.pn = w / WGM;
    if (mt >= T) return false;
    int e = 0;
    for (int k = 1; k < NE; ++k) if (sgpr(tab[32 + k]) <= mt) e = k;
    u.e = e; u.pm = mt; u.r0 = (mt - sgpr(tab[32 + e])) * 256; u.kind = sgpr(tab[e]); return true;
}
struct ProgMoe1 {
    static constexpr bool GATHER = true, FP8 = true; static constexpr int ID = 5, BN = 2048;
    const Frame* F; int T;
    __device__ __forceinline__ bool next(int i, Unit& u) const {
        if (!moe_decode<4, 8>(F, T, i, u)) return false;
        u.A = (const char*)F->HB(); u.B = (const char*)(F->WGU() + (size_t)u.e * 2048 * KD + (size_t)u.pn * 256 * 16); return true;
    }
    __device__ __forceinline__ void aoffs(const Unit& u, int wid, unsigned (&vo)[2][2]) const {
        const int cnt = u.kind; const int tid = wid * 64 + lane_id_fresh();
#pragma unroll
        for (int i = 0; i < 2; ++i) { int R_, C_; stage_rc(tid * 16 + i * 8192, R_, C_);
#pragma unroll
            for (int h = 0; h < 2; ++h) { const int idx = u.r0 + h * 128 + R_; const int tok = idx < cnt ? F->LISTTOK()[(size_t)u.e * NTOK + idx] : 0; vo[h][i] = (unsigned)(tok * KD + C_ * 2); } }
    }
    __device__ __forceinline__ void epi(const Acc& acc, const Unit& u, int wr, int wc, int fr, int fq) const {
        asm volatile("" : "+v"(fr), "+v"(fq));
        const float* bp = F->b_gate_up() + (size_t)u.e * 2048 + u.pn * 256 + wc * 32 + 8 * fq;
        f32x4 bv[2][2];
#pragma unroll
        for (int bj = 0; bj < 2; ++bj)
#pragma unroll
            for (int n = 0; n < 2; ++n) bv[bj][n] = *(const f32x4*)(bp + bj * 128 + 4 * n);
#pragma unroll
        for (int ai = 0; ai < 2; ++ai)
#pragma unroll
            for (int m = 0; m < 4; ++m) { const size_t slot = (size_t)u.pm * 256 + ai * 128 + wr * 64 + m * 16 + fr; unsigned char* rowp = F->ACT() + slot * 1024 + u.pn * 128 + wc * 16 + 4 * fq;
#pragma unroll
                for (int bj = 0; bj < 2; ++bj) { const f32x4 v0 = acc[ai][bj][m][0] * WSCALE_INV + bv[bj][0], v1 = acc[ai][bj][m][1] * WSCALE_INV + bv[bj][1];
                    f32x2 ga = {fminf(v0[0], 7.0f), fminf(v0[2], 7.0f)}, gb = {fminf(v1[0], 7.0f), fminf(v1[2], 7.0f)};
                    f32x2 ua = {__builtin_amdgcn_fmed3f(v0[1], -7.0f, 7.0f), __builtin_amdgcn_fmed3f(v0[3], -7.0f, 7.0f)}, ub = {__builtin_amdgcn_fmed3f(v1[1], -7.0f, 7.0f), __builtin_amdgcn_fmed3f(v1[3], -7.0f, 7.0f)};
                    const f32x2 xa = ga * (-1.702f * LOG2E), xb = gb * (-1.702f * LOG2E);
                    f32x2 ea = {__builtin_amdgcn_exp2f(xa[0]), __builtin_amdgcn_exp2f(xa[1])}, eb = {__builtin_amdgcn_exp2f(xb[0]), __builtin_amdgcn_exp2f(xb[1])};
                    ea = ea + 1.0f; eb = eb + 1.0f;
                    const f32x2 ra = {__builtin_amdgcn_rcpf(ea[0]), __builtin_amdgcn_rcpf(ea[1])}, rb = {__builtin_amdgcn_rcpf(eb[0]), __builtin_amdgcn_rcpf(eb[1])};
                    const f32x2 gla = ga * ra, glb = gb * rb;
                    const f32x2 oa = ua * gla + gla, ob = ub * glb + glb;
                    float r4[4] = {oa[0], oa[1], ob[0], ob[1]};
                    *(unsigned*)(rowp + bj * 64) = pk4_fp8(r4[0], r4[1], r4[2], r4[3]); } }
    }
};
struct ProgMoe2 {
    static constexpr bool GATHER = false, FP8 = true; static constexpr int ID = 6, BN = 1024;
    const Frame* F; int T;
    __device__ __forceinline__ bool next(int i, Unit& u) const {
        if (!moe_decode<8, 4>(F, T, i, u)) return false;
        u.A = (const char*)(F->ACT() + (size_t)u.pm * 256 * KD); u.B = (const char*)(F->WD() + (size_t)u.e * 1024 * KD + (size_t)u.pn * 256 * 16); return true;
    }
    __device__ __forceinline__ void epi(const Acc& acc, const Unit& u, int wr, int wc, int fr, int fq) const {
        asm volatile("" : "+v"(fr), "+v"(fq));
        const int cnt = u.kind;
        const float* bp = F->b_down() + (size_t)u.e * 1024 + u.pn * 256 + wc * 32 + 8 * fq;
        f32x4 bv[2][2];
#pragma unroll
        for (int bj = 0; bj < 2; ++bj)
#pragma unroll
            for (int n = 0; n < 2; ++n) bv[bj][n] = *(const f32x4*)(bp + bj * 128 + 4 * n);
#pragma unroll
        for (int ai = 0; ai < 2; ++ai) {
            float gt[4];
#pragma unroll
            for (int m = 0; m < 4; ++m) { const int idx = u.r0 + ai * 128 + wr * 64 + m * 16 + fr; gt[m] = idx < cnt ? F->LISTGATE()[(size_t)u.e * NTOK + idx] : 0.f; }
#pragma unroll
            for (int m = 0; m < 4; ++m) { const int rl = ai * 128 + wr * 64 + m * 16 + fr; const float gate = gt[m] * YSCALE;
                unsigned char* rowp = F->YS() + ((size_t)u.pm * 256 + rl) * 1024 + u.pn * 256 + wc * 32 + 8 * fq;
#pragma unroll
                for (int bj = 0; bj < 2; ++bj) { const f32x4 v0 = (acc[ai][bj][m][0] * WSCALE_INV + bv[bj][0]) * gate, v1 = (acc[ai][bj][m][1] * WSCALE_INV + bv[bj][1]) * gate;
                    u32x2 w; w.x = pk4_fp8(v0[0], v0[1], v0[2], v0[3]); w.y = pk4_fp8(v1[0], v1[1], v1[2], v1[3]);
                    *(u32x2*)(rowp + bj * 128) = w; } }
        }
    }
};

template <bool DRY> __device__ __forceinline__ void p7_combine(Frame& F) {
    const LAS int* tab = (const LAS int*)(F.lds + TAB_OFF);
    const int gw = F.vcu * NWAVES + F.wave, NGW = F.G * NWAVES, lane = F.lane;
    for (int tok = gw; tok < NTOK; tok += NGW) {
        f32x4* orow = (f32x4*)(F.out() + (size_t)tok * DM) + lane; f32x4 v[4];
#pragma unroll
        for (int j = 0; j < 4; ++j) v[j] = orow[64 * j];
#pragma unroll
        for (int k = 0; k < 4; ++k) { const int info = F.TOKINFO()[tok * 4 + k]; const int e = info >> 16, pos = info & 0xffff; const size_t slot = (size_t)tab[32 + e] * 256 + pos;
            const unsigned* yr = (const unsigned*)(F.YS() + slot * 1024) + lane;
#pragma unroll
            for (int j = 0; j < 4; ++j) { const unsigned w = yr[64 * j]; const f32x2 lo = __builtin_amdgcn_cvt_pk_f32_fp8((int)w, false), hi = __builtin_amdgcn_cvt_pk_f32_fp8((int)w, true);
                v[j][0] += lo[0] * YSCALE_INV; v[j][1] += lo[1] * YSCALE_INV; v[j][2] += hi[0] * YSCALE_INV; v[j][3] += hi[1] * YSCALE_INV; } }
        f32x4* wrow = DRY ? (f32x4*)((float*)(F.ws() + WS_EARLY) + (size_t)tok * DM) + lane : orow;
#pragma unroll
        for (int j = 0; j < 4; ++j) wrow[64 * j] = v[j];
    }
}

__global__ void __launch_bounds__(NWAVES * 64, 2) mk_fwd(Args args) {
    extern __shared__ __attribute__((aligned(16))) unsigned char lds_raw[];
    Frame F;
    F.lds = (LAS unsigned char*)lds_raw;
    F.tid = threadIdx.x; F.lane = F.tid & 63; F.wave = __builtin_amdgcn_readfirstlane(F.tid >> 6);
    F.G = gridDim.x; { const int bx = blockIdx.x; F.vcu = (bx % 8) * (F.G / 8) + bx / 8; }
    F.ka = (const CAS Args*)__builtin_amdgcn_kernarg_segment_ptr();
    for (int u = F.tid; u < (LDS_BYTES - LDSCTL_OFF) / 4; u += NWAVES * 64) ((LAS unsigned*)(F.lds + LDSCTL_OFF))[u] = 0u;
    __syncthreads();
    XcdBarrier bar = xcd_barrier_post(F.ctl() + CW_BAR, (volatile LAS unsigned*)(F.lds + MISC_OFF) + 8);
    const int lo = F.ka->ph_lo, hi = F.ka->ph_hi;
#define IN(k) (lo <= (k) && (k) < hi)
#define REFRESH() do { int l_ = lane_id(); asm volatile("" : "+v"(l_)); F.lane = l_; F.tid = F.wave * 64 + l_; } while (0)
#define SEAM(k) do { if (IN(k) && IN((k) + 1)) { xcd_barrier(bar, F.wave); if (MK_REP == 100 + (k)) { xcd_barrier(bar, F.wave); xcd_barrier(bar, F.wave); xcd_barrier(bar, F.wave); xcd_barrier(bar, F.wave); } } } while (0)
    if (IN(0)) { REFRESH(); p0_prologue(F); if (MK_REP == 0) p0_prologue(F); } SEAM(0);
    if (IN(1)) { { ProgIn P{&F}; gemm_phase(F.lds, P); } if (MK_REP == 1) { ProgIn P{&F}; gemm_phase(F.lds, P); } } SEAM(1);
    if (IN(2)) { REFRESH(); p2_mixers(F); if (MK_REP == 2) p2_mixers(F); } SEAM(2);
    if (IN(3)) { { ProgOut P{&F}; gemm_phase(F.lds, P); } if (MK_REP == 3) { ProgOut P{&F}; gemm_phase(F.lds, P); } } SEAM(3);
    if (IN(4)) { REFRESH(); if (F.wave < 4) { if (MK_REP == 4) router_wave_unit<true>(F, F.wave * 256 + F.vcu); router_wave_unit<false>(F, F.wave * 256 + F.vcu); }
                 else { LAS float* scr = (LAS float*)(F.lds + F.wave * 16384); const int cw = F.vcu * 4 + (F.wave - 4);
                        for (int rep_ = 0; rep_ < (MK_REP == 41 ? 2 : 1); ++rep_) {
                        ConvItem ca = moe_conv_decode(F, cw); float va[16], vb[16]; moe_conv_issue(ca, va, F.lane);
                        for (int j = 0; j < CONV_P4_PER_WAVE; j += 2) {
                            const ConvItem cb = moe_conv_decode(F, (j + 1) * 1024 + cw); moe_conv_issue(cb, vb, F.lane);
                            moe_conv_finish(ca, va, scr, F.lane);
                            if (j + 2 < CONV_P4_PER_WAVE) { ca = moe_conv_decode(F, (j + 2) * 1024 + cw); moe_conv_issue(ca, va, F.lane); }
                            moe_conv_finish(cb, vb, scr, F.lane); } } } } SEAM(4);
    if (lo <= 7 && hi > 5) { REFRESH(); moe_build_table(F); }
    if (IN(5)) { { ProgMoe1 P{&F, sgpr(((const LAS int*)(F.lds + TAB_OFF))[64])}; gemm_phase(F.lds, P); } if (MK_REP == 5) { ProgMoe1 P{&F, sgpr(((const LAS int*)(F.lds + TAB_OFF))[64])}; gemm_phase(F.lds, P); } } SEAM(5);
    if (IN(6)) { { ProgMoe2 P{&F, sgpr(((const LAS int*)(F.lds + TAB_OFF))[64])}; gemm_phase(F.lds, P); } if (MK_REP == 6) { ProgMoe2 P{&F, sgpr(((const LAS int*)(F.lds + TAB_OFF))[64])}; gemm_phase(F.lds, P); } } SEAM(6);
    if (IN(7)) { REFRESH(); if (MK_REP == 7) p7_combine<true>(F); p7_combine<false>(F); }
#undef IN
#undef SEAM
}
}
#ifndef MK_CUT
#define MK_CUT 8
#endif
extern "C" void kernel_launch(void* const* d_in, const int* in_sizes, int n_in, void* d_out, int out_size, void* d_ws, size_t ws_size, hipStream_t stream) {
    static int ready = 0;
    if (ready == 0) {
        if (n_in != 18 || out_size != mk::NTOK * mk::DM || ws_size < mk::WS_END) { fprintf(stderr, "kernel_launch: unexpected problem (n_in %d out %d ws %zu)\n", n_in, out_size, ws_size); ready = -1; return; }
        if (hipFuncSetAttribute((const void*)mk::mk_fwd, hipFuncAttributeMaxDynamicSharedMemorySize, mk::LDS_BYTES) != hipSuccess) { fprintf(stderr, "kernel_launch: hipFuncSetAttribute failed\n"); ready = -1; return; }
        ready = 1;
    }
    if (ready < 0) return;
    (void)hipMemsetAsync((char*)d_ws + mk::WS_CTL, 0, mk::CTL_ZERO_BYTES, stream);
    mk::Args a{};
    for (int i = 0; i < 18; ++i) a.in[i] = (const float*)d_in[i];
    a.out = (float*)d_out; a.ws = (unsigned char*)d_ws; a.ph_lo = 0; a.ph_hi = MK_CUT;
    hipLaunchKernelGGL(mk::mk_fwd, dim3(256), dim3(mk::NWAVES * 64), mk::LDS_BYTES, stream, a);
#if MK_CUT < 8
    {
        using namespace nv;
        const float* x = (const float*)d_in[0]; const float* w_out = (const float*)d_in[10]; const float* norm2_w = (const float*)d_in[11];
        const float* router_w = (const float*)d_in[12]; const float* router_b = (const float*)d_in[13]; const float* w_gate_up = (const float*)d_in[14];
        const float* b_gate_up = (const float*)d_in[15]; const float* w_down = (const float*)d_in[16]; const float* b_down = (const float*)d_in[17];
        float* out = (float*)d_out; char* ws = (char*)d_ws; const size_t MiB = 1u << 20;
        int* cnt = (int*)ws + mk::CW_CNT; int* list_tok = (int*)(ws + mk::WS_LISTTOK); float* list_gate = (float*)(ws + mk::WS_LISTGATE);
        float* hn = (float*)(ws + 16 * MiB); float* gu = (float*)(ws + 272 * MiB); float* act = (float*)(ws + (272 + 256) * MiB);
#if MK_CUT <= 3
        k_gemm<1, true><<<dim3(DM / 64, NTOK / 64), 256, 0, stream>>>((const void*)(ws + mk::WS_Y), nullptr, nullptr, nullptr, w_out, nullptr, x, nullptr, out, NTOK, DM, DM, DM, DM);
#endif
#if MK_CUT <= 4
        k_router<<<NTOK, 256, 0, stream>>>(out, norm2_w, router_w, router_b, hn, cnt, list_tok, list_gate);
#else
        k_bf2f<<<4096, 256, 0, stream>>>((const unsigned short*)(ws + mk::WS_HB), hn, (size_t)NTOK * DM);
#endif
        for (int e = 0; e < NE; ++e) {
            const int* lt = list_tok + (size_t)e * NTOK; const float* lgp = list_gate + (size_t)e * NTOK;
            k_gemm<0, false><<<dim3(2 * DFF / 64, NTOK / 64), 256, 0, stream>>>(hn, lt, nullptr, cnt + e, w_gate_up + (size_t)e * DM * 2 * DFF, b_gate_up + (size_t)e * 2 * DFF, nullptr, nullptr, gu, NTOK, 2 * DFF, DM, DM, 2 * DFF);
            k_swiglu<<<NTOK, 256, 0, stream>>>(gu, cnt + e, act);
            k_gemm<3, false><<<dim3(DM / 64, NTOK / 64), 256, 0, stream>>>(act, nullptr, lt, cnt + e, w_down + (size_t)e * DFF * DM, b_down + (size_t)e * DM, nullptr, lgp, out, NTOK, DM, DFF, DFF, DM);
        }
    }
#endif
}
```

```cpp
#include <hip/hip_runtime.h>
#include <cstdio>
#include <cstdint>
#ifndef MK_REP
#define MK_REP -1
#endif
namespace mk {
#define LAS __attribute__((address_space(3)))
#define GAS __attribute__((address_space(1)))
typedef unsigned short bf16_t;
typedef short bf16x8 __attribute__((ext_vector_type(8)));
typedef short s16x4 __attribute__((ext_vector_type(4)));
typedef float f32x4 __attribute__((ext_vector_type(4)));
typedef float f32x2 __attribute__((ext_vector_type(2)));
typedef float f32x16 __attribute__((ext_vector_type(16)));
typedef unsigned u32x4 __attribute__((ext_vector_type(4)));
typedef unsigned u32x2 __attribute__((ext_vector_type(2)));
typedef int i32x4 __attribute__((ext_vector_type(4)));
typedef int i32x8 __attribute__((ext_vector_type(8)));

constexpr int NTOK = 32768, DM = 1024, SEQ = 4096, NB = 8, NH = 8, HD = 64, NE = 32, DFF = 1024, KD = 1024;
constexpr float EPS = 1e-5f;
constexpr float LOG2E = 1.4426950408889634f;
constexpr float QSCALE = 0.125f * LOG2E;
constexpr float SB_THR = 64.0f;
constexpr int NWAVES = 8;
constexpr int SLOTS = NTOK * 4 + NE * 256;

constexpr size_t MiB = 1u << 20;
constexpr size_t WS_CTL = 0, CTL_ZERO_BYTES = 1 * MiB;
constexpr size_t WS_LISTTOK = 1 * MiB;
constexpr size_t WS_LISTGATE = 5 * MiB;
constexpr size_t WS_TOKINFO = 9 * MiB;
constexpr size_t WS_RSTD1 = 10 * MiB;
constexpr size_t WS_SSPART = 11 * MiB;
constexpr size_t WS_RT = 13 * MiB;
constexpr size_t WS_WGU = 16 * MiB;
constexpr size_t WS_WD = 80 * MiB;
constexpr size_t WS_HB = 112 * MiB;
constexpr size_t WS_YS = 144 * MiB;
constexpr size_t WS_EARLY = 416 * MiB;
constexpr size_t WS_XB = WS_EARLY;
constexpr size_t WS_WIN = WS_EARLY + 64 * MiB;
constexpr size_t WS_WOUT = WS_EARLY + 70 * MiB;
constexpr size_t WS_UV = WS_EARLY + 72 * MiB;
constexpr size_t WS_Q = WS_EARLY + 136 * MiB;
constexpr size_t WS_K = WS_EARLY + 168 * MiB;
constexpr size_t WS_VT = WS_EARLY + 200 * MiB;
constexpr size_t WS_Y = WS_EARLY + 232 * MiB;
constexpr size_t WS_ACT = WS_EARLY;
constexpr size_t WS_END = WS_EARLY + 296 * MiB;
constexpr float WSCALE = 32.0f, WSCALE_INV = 1.0f / 32.0f;
constexpr float YSCALE = 16.0f, YSCALE_INV = 1.0f / 16.0f;
constexpr int CW_CNT = 64;
constexpr int CW_BAR = 4096;

constexpr int RING_BYTES = 131072;
constexpr int LDSCTL_OFF = RING_BYTES, MISC_OFF = LDSCTL_OFF + 320, TAB_OFF = LDSCTL_OFF + 1024;
constexpr int LDS_BYTES = 147456;

__device__ __forceinline__ unsigned cvt_pk_bf16(float lo, float hi) { unsigned r; asm volatile("v_cvt_pk_bf16_f32 %0, %1, %2" : "=v"(r) : "v"(lo), "v"(hi)); return r; }
__device__ __forceinline__ unsigned pk4_fp8(float a, float b, float c, float d) { unsigned w = 0u; w = (unsigned)__builtin_amdgcn_cvt_pk_fp8_f32(a, b, (int)w, false); w = (unsigned)__builtin_amdgcn_cvt_pk_fp8_f32(c, d, (int)w, true); return w; }
__device__ __forceinline__ float bf2f(unsigned short h) { return __uint_as_float((unsigned)h << 16); }
__device__ __forceinline__ float bflo(unsigned w) { return __uint_as_float(w << 16); }
__device__ __forceinline__ float bfhi(unsigned w) { return __uint_as_float(w & 0xffff0000u); }
__device__ __forceinline__ int lane_id() { return (int)__builtin_amdgcn_mbcnt_hi(~0u, __builtin_amdgcn_mbcnt_lo(~0u, 0u)); }
__device__ __forceinline__ int lane_id_fresh() { int l; asm volatile("v_mbcnt_lo_u32_b32 %0, -1, 0\n\tv_mbcnt_hi_u32_b32 %0, -1, %0" : "=v"(l)); return l; }
__device__ __forceinline__ float wave_sum(float v) {
#pragma unroll
    for (int o = 1; o < 64; o <<= 1) v += __shfl_xor(v, o);
    return v;
}
__device__ __forceinline__ float gelu_tanh_f(float x) {
    const float u = 0.7978845608028654f * (x + 0.044715f * x * x * x);
    return x * __builtin_amdgcn_rcpf(1.0f + __builtin_amdgcn_exp2f(-2.0f * LOG2E * u));
}

constexpr int BM = 256, BK = 64, HALF = 128, HTB = HALF * BK * 2;
__device__ __forceinline__ int lds_byte(int r, int c) { const int st = (r >> 4) * 2 + (c >> 5), rr = r & 15, cc = c & 31, ob = rr * 64 + cc * 2; return st * 1024 + (ob ^ (((ob >> 9) & 1) << 5)); }
__device__ __forceinline__ void stage_rc(int b, int& R, int& C) { const int st = b / 1024, sb = b % 1024, swz = sb ^ (((sb >> 9) & 1) << 5); R = (st >> 1) * 16 + swz / 64; C = (st & 1) * 32 + (swz % 64) / 2; }
__device__ __forceinline__ int perm32(int rho) { const int n = rho >> 4, i = rho & 15; return 8 * (i >> 2) + 4 * n + (i & 3); }

struct Unit { const char* A; const char* B; int kind, pm, pn, e, r0; };

template <class Prog>
__device__ __forceinline__ void gemm_phase(LAS unsigned char* lds, const Prog& P) {
    const int wid = P.F->wave, lane = lane_id(), tid = wid * 64 + lane, wr = wid >> 2, wc = wid & 3;
    constexpr bool F8 = Prog::FP8;
    constexpr int K = KD, ESZ = F8 ? 1 : 2, nt = F8 ? K / 128 : K / BK;
    unsigned voffB[2];
#pragma unroll
    for (int i = 0; i < 2; ++i) {
        if constexpr (F8) { const int b_ = tid * 16 + i * 8192, k16_ = b_ >> 11, sl_ = (b_ & 2047) >> 4; voffB[i] = (unsigned)((k16_ * Prog::BN + (sl_ & ~31) + perm32(sl_ & 31)) * 16); }
        else { int R_, C_; stage_rc(tid * 16 + i * 8192, R_, C_); const int Rb = (R_ & ~31) + perm32(R_ & 31); voffB[i] = (unsigned)(Rb * K * ESZ + C_ * 2); } }
    constexpr size_t kstep = (size_t)(BK * 2);
    constexpr size_t hstep = (size_t)HALF * K * ESZ;
    constexpr bool AK16 = F8 && !Prog::GATHER;
    constexpr size_t kstepA = AK16 ? (size_t)8 * Prog::AR * 16 : kstep;
    constexpr size_t hstepA = AK16 ? (size_t)HALF * 16 : hstep;
    constexpr size_t kstepB = F8 ? (size_t)8 * Prog::BN * 16 : kstep;
    constexpr size_t hstepB = F8 ? (size_t)HALF * 16 : hstep;
    const unsigned ldsw = (unsigned)wid * 1024u;
    const int aoff = AK16 ? (2 * (lane >> 4)) * 2048 + (wr * 64 + (lane & 15)) * 16 : lds_byte(wr * 64 + (lane & 15), F8 ? (lane >> 4) * 16 : (lane >> 4) * 8), boff = F8 ? (2 * (lane >> 4)) * 2048 + (wc * 32 + (lane & 15)) * 16 : lds_byte(wc * 32 + (lane & 15), (lane >> 4) * 8);
    constexpr int ANS = AK16 ? 256 : 2048, AKS = AK16 ? 2048 : (F8 ? 16 : 1024);
    constexpr int BNS = F8 ? 256 : 2048, BKS = F8 ? 2048 : 1024;
    constexpr int KOFF = F8 ? 16 : 1024;
#define MK_SA(b, h) (((b) * 2 + (h)) * HTB)
#define MK_SB(b, h) ((4 + (b) * 2 + (h)) * HTB)
#define MK_STAGE(bufoff, gbase, voff) do { _Pragma("unroll") for (int _i = 0; _i < 2; ++_i) { unsigned o_ = (voff)[_i]; asm volatile("" : "+v"(o_));     \
        __builtin_amdgcn_global_load_lds((const unsigned*)((const char*)(gbase) + o_), (LAS unsigned*)(lds + (bufoff) + ldsw + _i * 8192), 16, 0, 0); } } while (0)
#define MK_STAGE_A(bufoff, gbase, h) do { if constexpr (GA) MK_STAGE(bufoff, gbase, voC[h]); else MK_STAGE(bufoff, (gbase) + (h) * hstepA, voC[0]); } while (0)
#define MK_LDA(dst, b, h) do { _Pragma("unroll") for (int m = 0; m < 4; ++m) _Pragma("unroll") for (int k = 0; k < 2; ++k) dst[m][k] = *(const LAS bf16x8*)(lds + MK_SA(b, h) + aoff + m * ANS + k * AKS); } while (0)
#define MK_LDB(dst, b, h) do { _Pragma("unroll") for (int n = 0; n < 2; ++n) _Pragma("unroll") for (int k = 0; k < 2; ++k) dst[n][k] = *(const LAS bf16x8*)(lds + MK_SB(b, h) + boff + n * BNS + k * BKS); } while (0)
#define MK_CAT8(x) __builtin_shufflevector(__builtin_bit_cast(i32x4, (x)[0]), __builtin_bit_cast(i32x4, (x)[1]), 0, 1, 2, 3, 4, 5, 6, 7)
#define MK_MMA(ai, bj, At, Bt) do { __builtin_amdgcn_s_setprio(1); \
        if constexpr (F8) { _Pragma("unroll") for (int m = 0; m < 4; ++m) _Pragma("unroll") for (int n = 0; n < 2; ++n) \
            acc[ai][bj][m][n] = __builtin_amdgcn_mfma_scale_f32_16x16x128_f8f6f4(MK_CAT8(Bt[n]), MK_CAT8(At[m]), acc[ai][bj][m][n], 0, 0, 0, 0, 0, 0); } \
        else { _Pragma("unroll") for (int m = 0; m < 4; ++m) _Pragma("unroll") for (int n = 0; n < 2; ++n) _Pragma("unroll") for (int k = 0; k < 2; ++k) \
            acc[ai][bj][m][n] = __builtin_amdgcn_mfma_f32_16x16x32_bf16(Bt[n][k], At[m][k], acc[ai][bj][m][n], 0, 0, 0); } \
        __builtin_amdgcn_s_setprio(0); } while (0)
#define MK_WAIT_V(n) asm volatile("s_waitcnt vmcnt(" #n ")" ::: "memory")
#define MK_WAIT_L(n) asm volatile("s_waitcnt lgkmcnt(" #n ")" ::: "memory")
#define MK_BAR __builtin_amdgcn_s_barrier()
#define MK_SCHED __builtin_amdgcn_sched_barrier(0)
    Unit cur, nxt; int ui = 0;
    if (!P.next(0, cur)) return;
    constexpr bool GA = Prog::GATHER;
    unsigned voC[2][2];
    if constexpr (GA) P.aoffs(cur, wid, voC);
    else {
#pragma unroll
        for (int i = 0; i < 2; ++i) { if constexpr (AK16) { const int b_ = tid * 16 + i * 8192; voC[0][i] = (unsigned)(((b_ >> 11) * Prog::AR + ((b_ & 2047) >> 4)) * 16); } else { int R_, C_; stage_rc(tid * 16 + i * 8192, R_, C_); voC[0][i] = (unsigned)(R_ * K * ESZ + C_ * 2); } voC[1][i] = 0u; }
    }
    f32x4 acc[2][2][4][2];
#pragma unroll
    for (int a = 0; a < 2; ++a)
#pragma unroll
        for (int b = 0; b < 2; ++b)
#pragma unroll
            for (int m = 0; m < 4; ++m)
#pragma unroll
                for (int n = 0; n < 2; ++n) acc[a][b][m][n] = (f32x4){0.f, 0.f, 0.f, 0.f};
    bf16x8 At[4][2], B0[2][2], B1[2][2];
    const char* cA = cur.A; const char* cB = cur.B;
    MK_STAGE(MK_SB(0, 0), cB, voffB); MK_STAGE(MK_SB(0, 1), cB + hstepB, voffB); MK_STAGE_A(MK_SA(0, 0), cA, 0); MK_STAGE_A(MK_SA(0, 1), cA, 1);
    if (wr == 1) MK_BAR;
    MK_WAIT_V(2); MK_BAR;
    MK_STAGE(MK_SB(1, 0), cB + kstepB, voffB); MK_STAGE_A(MK_SA(1, 0), cA + kstepA, 0); MK_STAGE(MK_SB(1, 1), cB + hstepB + kstepB, voffB);
    MK_WAIT_V(6); MK_BAR;
    for (;;) {
        const bool has_next = P.next(ui + 1, nxt);
        if (!has_next) nxt = cur;
        const char* nA = nxt.A; const char* nB = nxt.B;
#pragma unroll 1
        for (int t = 0; t < nt; t += 2) {
            const bool last = (t == nt - 2);
            const char* a1 = cA + (size_t)(t + 1) * kstepA;
            const char* a2 = last ? nA : cA + (size_t)(t + 2) * kstepA; const char* b2 = last ? nB : cB + (size_t)(t + 2) * kstepB;
            const char* a3 = a2 + kstepA; const char* b3 = b2 + kstepB;
            MK_LDB(B0, 0, 0); MK_LDB(B1, 0, 1); MK_SCHED; MK_LDA(At, 0, 0); MK_STAGE_A(MK_SA(1, 1), a1, 1);
            if constexpr (GA) { if (last && has_next) P.aoffs(nxt, wid, voC); }
            MK_WAIT_V(8); MK_WAIT_L(0); MK_BAR; MK_MMA(0, 0, At, B0); MK_MMA(0, 1, At, B1); MK_BAR; MK_SCHED;
            MK_LDA(At, 0, 1); MK_STAGE(MK_SB(0, 0), b2, voffB); MK_STAGE(MK_SB(0, 1), b2 + hstepB, voffB); MK_STAGE_A(MK_SA(0, 0), a2, 0);
            MK_WAIT_V(8); MK_WAIT_L(0); MK_BAR; MK_MMA(1, 0, At, B0); MK_MMA(1, 1, At, B1); MK_BAR; MK_SCHED;
            MK_LDB(B0, 1, 0); MK_LDB(B1, 1, 1); MK_SCHED; MK_LDA(At, 1, 0); MK_STAGE_A(MK_SA(0, 1), a2, 1);
            MK_WAIT_V(8); MK_WAIT_L(0); MK_BAR; MK_MMA(0, 0, At, B0); MK_MMA(0, 1, At, B1); MK_BAR; MK_SCHED;
            MK_LDA(At, 1, 1); MK_STAGE(MK_SB(1, 0), b3, voffB); MK_STAGE(MK_SB(1, 1), b3 + hstepB, voffB); MK_STAGE_A(MK_SA(1, 0), a3, 0);
            MK_WAIT_V(8); MK_WAIT_L(0); MK_BAR; MK_MMA(1, 0, At, B0); MK_MMA(1, 1, At, B1); MK_BAR; MK_SCHED;
        }
        if (wr == 0) MK_BAR;
        { const int l_ = lane_id_fresh(); P.epi(acc, cur, wr, wc, l_ & 15, l_ >> 4); }
#ifdef MK_EPI2
        if (Prog::ID == MK_EPI2) { const int l_ = lane_id_fresh(); P.epi(acc, cur, wr, wc, l_ & 15, l_ >> 4); }
#endif
        if (!has_next) break;
#pragma unroll
        for (int a = 0; a < 2; ++a)
#pragma unroll
            for (int b = 0; b < 2; ++b)
#pragma unroll
                for (int m = 0; m < 4; ++m)
#pragma unroll
                    for (int n = 0; n < 2; ++n) acc[a][b][m][n] = (f32x4){0.f, 0.f, 0.f, 0.f};
        cur = nxt; cA = nA; cB = nB; ++ui;
        if (wr == 1) MK_BAR;
    }
    MK_WAIT_V(0);
    MK_BAR;
#undef MK_SA
#undef MK_SB
#undef MK_STAGE
#undef MK_STAGE_A
#undef MK_LDA
#undef MK_LDB
#undef MK_MMA
#undef MK_CAT8
}
typedef f32x4 Acc[2][2][4][2];

#define XB_TMO      128
#define XB_XCNT(j)  (256  + 64 * (j))
#define XB_XSUB(j)  (1280 + 64 * (j))
#define XB_XGEN(j)  (2304 + 64 * (j))
#define XB_TOP      3328
#define XB_TOPGEN   3392
#define XCD_BAR_WORDS 3456
#define XB_SPIN_CAP (1u << 18)
__device__ __forceinline__ unsigned xb_ld(unsigned* p)              { return __hip_atomic_load(p, __ATOMIC_RELAXED, __HIP_MEMORY_SCOPE_AGENT); }
__device__ __forceinline__ unsigned xb_add(unsigned* p, unsigned v) { return __hip_atomic_fetch_add(p, v, __ATOMIC_RELAXED, __HIP_MEMORY_SCOPE_AGENT); }
__device__ __forceinline__ unsigned xb_xcc_id() { return (unsigned)__builtin_amdgcn_s_getreg((3 << 11) | 20) & 0xFu; }
#define XB_SPIN(cond, bar) do { unsigned _sp = 0; while (cond) { __builtin_amdgcn_s_sleep(1); \
    if ((++_sp & 255u) == 0u) { if (xb_ld(&(bar)[XB_TMO])) break; if (_sp > XB_SPIN_CAP) { atomicAdd(&(bar)[XB_TMO], 1u); break; } } } } while (0)
struct XcdBarrier { unsigned* bar; unsigned x; volatile LAS unsigned* st; };
__device__ __forceinline__ XcdBarrier xcd_barrier_post(unsigned* bar, volatile LAS unsigned* st) {
    XcdBarrier b; b.bar = bar; b.x = xb_xcc_id(); b.st = st;
    if (threadIdx.x == 0) (void)xb_add(&bar[XB_XCNT(b.x)], 1u);
    return b;
}
__device__ __forceinline__ void xcd_barrier_complete(unsigned* bar, unsigned x, unsigned& nloc, unsigned& nx) {
    const unsigned G = gridDim.x * gridDim.y * gridDim.z;
    unsigned sum, cnt, mine, sp = 0u;
    for (;;) {
        sum = 0u; cnt = 0u; mine = 0u;
#pragma unroll
        for (unsigned j = 0; j < 16; ++j) { const unsigned c = xb_ld(&bar[XB_XCNT(j)]); sum += c; cnt += (c > 0u) ? 1u : 0u; mine = (j == x) ? c : mine; }
        if (sum == G) break;
        __builtin_amdgcn_s_sleep(1);
        if ((++sp & 255u) == 0u) { if (xb_ld(&bar[XB_TMO])) break; if (sp > XB_SPIN_CAP) { atomicAdd(&bar[XB_TMO], 1u); break; } }
    }
    nloc = mine > 0u ? mine : 1u; nx = cnt > 0u ? cnt : 1u;
}
__device__ __forceinline__ void xcd_barrier(const XcdBarrier& b, int wave) {
    asm volatile("s_waitcnt vmcnt(0)" ::: "memory");
    __syncthreads();
    if (wave == 0 && lane_id() == 0) {
        unsigned* bar = b.bar;
        __builtin_amdgcn_s_waitcnt(0);
        unsigned nloc = b.st[0], nx = b.st[1];
        if (nloc == 0u) { xcd_barrier_complete(bar, b.x, nloc, nx); b.st[0] = nloc; b.st[1] = nx; }
        const unsigned old = xb_add(&bar[XB_XSUB(b.x)], 1u);
        const unsigned gen = old / nloc;
        if (old + 1u == (gen + 1u) * nloc) {
            __builtin_amdgcn_fence(__ATOMIC_RELEASE, "agent");
            asm volatile("s_waitcnt vmcnt(0)" ::: "memory");
            const unsigned og = xb_add(&bar[XB_TOP], 1u);
            const unsigned tg = og / nx;
            if (og + 1u == (tg + 1u) * nx) xb_add(&bar[XB_TOPGEN], 1u);
            else XB_SPIN(xb_ld(&bar[XB_TOPGEN]) == tg, bar);
            __builtin_amdgcn_fence(__ATOMIC_ACQUIRE, "agent");
            xb_add(&bar[XB_XGEN(b.x)], 1u);
            asm volatile("s_waitcnt vmcnt(0)" ::: "memory");
        } else {
            XB_SPIN(xb_ld(&bar[XB_XGEN(b.x)]) == gen, bar);
            __builtin_amdgcn_fence(__ATOMIC_ACQUIRE, "agent");
            asm volatile("s_waitcnt vmcnt(0)" ::: "memory");
        }
    }
    __syncthreads();
}

struct Args {
    const float* in[18]; float* out; unsigned char* ws; int ph_lo, ph_hi;
};
#define CAS __attribute__((address_space(4)))
struct Frame {
    LAS unsigned char* lds; int tid, lane, wave, vcu, G;
    const CAS Args* ka;
    __device__ __forceinline__ const float* inp(int k) const { return ka->in[k]; }
    __device__ __forceinline__ unsigned char* ws() const { return ka->ws; }
    __device__ __forceinline__ float* out() const { return ka->out; }
    __device__ __forceinline__ const float* x() const { return inp(0); }
    __device__ __forceinline__ const float* norm1_w() const { return inp(1); }
    __device__ __forceinline__ const float* w_in() const { return inp(2); }
    __device__ __forceinline__ const float* sgu_norm_w() const { return inp(3); }
    __device__ __forceinline__ const float* sgu_w() const { return inp(4); }
    __device__ __forceinline__ const float* sgu_b() const { return inp(5); }
    __device__ __forceinline__ const float* q_norm_w() const { return inp(6); }
    __device__ __forceinline__ const float* k_norm_w() const { return inp(7); }
    __device__ __forceinline__ const float* out_norm_a_w() const { return inp(8); }
    __device__ __forceinline__ const float* out_norm_b_w() const { return inp(9); }
    __device__ __forceinline__ const float* w_out() const { return inp(10); }
    __device__ __forceinline__ const float* norm2_w() const { return inp(11); }
    __device__ __forceinline__ const float* router_w() const { return inp(12); }
    __device__ __forceinline__ const float* router_b() const { return inp(13); }
    __device__ __forceinline__ const float* w_gate_up() const { return inp(14); }
    __device__ __forceinline__ const float* b_gate_up() const { return inp(15); }
    __device__ __forceinline__ const float* w_down() const { return inp(16); }
    __device__ __forceinline__ const float* b_down() const { return inp(17); }
    __device__ __forceinline__ bf16_t* XB() const { return (bf16_t*)(ws() + WS_XB); }
    __device__ __forceinline__ bf16_t* WIN() const { return (bf16_t*)(ws() + WS_WIN); }
    __device__ __forceinline__ bf16_t* WOUT() const { return (bf16_t*)(ws() + WS_WOUT); }
    __device__ __forceinline__ bf16_t* UV() const { return (bf16_t*)(ws() + WS_UV); }
    __device__ __forceinline__ bf16_t* Q() const { return (bf16_t*)(ws() + WS_Q); }
    __device__ __forceinline__ bf16_t* K() const { return (bf16_t*)(ws() + WS_K); }
    __device__ __forceinline__ bf16_t* VT() const { return (bf16_t*)(ws() + WS_VT); }
    __device__ __forceinline__ bf16_t* Y() const { return (bf16_t*)(ws() + WS_Y); }
    __device__ __forceinline__ unsigned char* YS() const { return ws() + WS_YS; }
    __device__ __forceinline__ bf16_t* RT() const { return (bf16_t*)(ws() + WS_RT); }
    __device__ __forceinline__ unsigned char* HB() const { return ws() + WS_HB; }
    __device__ __forceinline__ unsigned char* WGU() const { return ws() + WS_WGU; }
    __device__ __forceinline__ unsigned char* WD() const { return ws() + WS_WD; }
    __device__ __forceinline__ unsigned char* ACT() const { return ws() + WS_ACT; }
    __device__ __forceinline__ float* RSTD1() const { return (float*)(ws() + WS_RSTD1); }
    __device__ __forceinline__ float* SSPART() const { return (float*)(ws() + WS_SSPART); }
    __device__ __forceinline__ float* LISTGATE() const { return (float*)(ws() + WS_LISTGATE); }
    __device__ __forceinline__ int* LISTTOK() const { return (int*)(ws() + WS_LISTTOK); }
    __device__ __forceinline__ int* TOKINFO() const { return (int*)(ws() + WS_TOKINFO); }
    __device__ __forceinline__ unsigned* ctl() const { return (unsigned*)(ws() + WS_CTL); }
};

__device__ __forceinline__ void p0_transpose_item(const float* W, int K, int N, bf16_t* WT, int k0, int n0, int drow0, const float* kscale, LAS float* scr, int lane) {
#pragma unroll 8
    for (int i = 0; i < 32; ++i) { const int kk = 2 * i + (lane >> 5); float v = W[(size_t)(k0 + kk) * N + n0 + (lane & 31)]; if (kscale) v *= kscale[k0 + kk]; scr[kk * 33 + (lane & 31)] = v; }
    asm volatile("s_waitcnt lgkmcnt(0)" ::: "memory");
    const int c = lane & 7;
#pragma unroll
    for (int j = 0; j < 4; ++j) { const int n = (lane >> 3) + 8 * j; const LAS float* s = scr + (8 * c) * 33 + n;
        u32x4 o; o.x = cvt_pk_bf16(s[0 * 33], s[1 * 33]); o.y = cvt_pk_bf16(s[2 * 33], s[3 * 33]); o.z = cvt_pk_bf16(s[4 * 33], s[5 * 33]); o.w = cvt_pk_bf16(s[6 * 33], s[7 * 33]);
        *(u32x4*)(WT + (size_t)(drow0 + n) * K + k0 + 8 * c) = o; }
    asm volatile("s_waitcnt lgkmcnt(0)" ::: "memory");
}
__device__ __forceinline__ void p0_transpose_item_f8(const float* W, int K, int N, unsigned char* WT, int k0, int n0, LAS float* scr, int lane) {
#pragma unroll 8
    for (int i = 0; i < 32; ++i) { const int kk = 2 * i + (lane >> 5); scr[kk * 33 + (lane & 31)] = W[(size_t)(k0 + kk) * N + n0 + (lane & 31)] * WSCALE; }
    asm volatile("s_waitcnt lgkmcnt(0)" ::: "memory");
    const int c = lane & 7;
#pragma unroll
    for (int j = 0; j < 4; ++j) { const int n = (lane >> 3) + 8 * j; const LAS float* s = scr + (8 * c) * 33 + n;
        u32x2 o; o.x = pk4_fp8(s[0 * 33], s[1 * 33], s[2 * 33], s[3 * 33]); o.y = pk4_fp8(s[4 * 33], s[5 * 33], s[6 * 33], s[7 * 33]);
        *(u32x2*)(WT + (size_t)(n0 + n) * K + k0 + 8 * c) = o; }
    asm volatile("s_waitcnt lgkmcnt(0)" ::: "memory");
}
__device__ __forceinline__ int win_drow(int n0) {
    if (n0 < 1024 || n0 >= 2048) return n0;
    const int rel = n0 - 1024, isk = rel >> 9, head = (rel & 511) >> 6, dh = (rel & 63) >> 5;
    return 256 * (4 + 2 * isk + (head >> 2)) + 128 * dh + 32 * (head & 3);
}
constexpr int MOE_I_GU = 64 * 32, MOE_I_D = 64 * 16, MOE_ITEMS = NE * (MOE_I_GU + MOE_I_D);
struct ConvItem { const float* src; unsigned char* dst; int N; };
__device__ __forceinline__ ConvItem moe_conv_decode(const Frame& F, int it) {
    ConvItem c;
    if (it < NE * MOE_I_GU) { const int e = it / MOE_I_GU, q = it % MOE_I_GU, k16 = q >> 5, n64 = q & 31; c.N = 2048;
        c.src = F.w_gate_up() + (size_t)e * KD * 2048 + (size_t)(16 * k16) * 2048 + 64 * n64; c.dst = F.WGU() + (size_t)e * 2048 * KD + ((size_t)k16 * 2048 + 64 * n64) * 16; }
    else { const int r = it - NE * MOE_I_GU; const int e = r / MOE_I_D, q = r % MOE_I_D, k16 = q >> 4, n64 = q & 15; c.N = 1024;
        c.src = F.w_down() + (size_t)e * KD * 1024 + (size_t)(16 * k16) * 1024 + 64 * n64; c.dst = F.WD() + (size_t)e * 1024 * KD + ((size_t)k16 * 1024 + 64 * n64) * 16; }
    return c;
}
__device__ __forceinline__ void moe_conv_issue(const ConvItem& c, float (&v)[16], int lane) {
    const float* p = c.src + lane;
#pragma unroll
    for (int i = 0; i < 16; ++i) v[i] = __builtin_nontemporal_load(p + (size_t)i * c.N);
}
__device__ __forceinline__ void moe_conv_finish(const ConvItem& c, const float (&v)[16], LAS float*, int lane) {
    u32x4 o;
    o.x = pk4_fp8(v[0] * WSCALE, v[1] * WSCALE, v[2] * WSCALE, v[3] * WSCALE); o.y = pk4_fp8(v[4] * WSCALE, v[5] * WSCALE, v[6] * WSCALE, v[7] * WSCALE);
    o.z = pk4_fp8(v[8] * WSCALE, v[9] * WSCALE, v[10] * WSCALE, v[11] * WSCALE); o.w = pk4_fp8(v[12] * WSCALE, v[13] * WSCALE, v[14] * WSCALE, v[15] * WSCALE);
    *(u32x4*)(c.dst + (size_t)lane * 16) = o;
}
constexpr int CONV_P4_PER_WAVE = 56, CONV_P4_ITEMS = CONV_P4_PER_WAVE * 1024;
constexpr int CONV_G_PER_UNIT = 3, CONV_G_ITEMS = CONV_G_PER_UNIT * 4 * 2048;
constexpr int CONV_P2_ITEMS = MOE_ITEMS - CONV_P4_ITEMS - CONV_G_ITEMS, CONV_P2_PER_WAVE = CONV_P2_ITEMS / 2048;
static_assert(CONV_P2_ITEMS % 2048 == 0 && CONV_P4_PER_WAVE % 2 == 0, "conversion split");
__device__ __forceinline__ void p0_prologue(Frame& F) {
    LAS float* scr = (LAS float*)(F.lds + F.wave * 16384);
    const int gw = F.vcu * NWAVES + F.wave, NGW = F.G * NWAVES, lane = F.lane;
    for (int m = gw; m < NTOK; m += 2 * NGW) {
        const int m2 = m + NGW;
        const f32x4* xr = (const f32x4*)(F.x() + (size_t)m * DM) + lane; const f32x4* xr2 = (const f32x4*)(F.x() + (size_t)m2 * DM) + lane; f32x4 v[4], w[4]; float s = 0.f, s2 = 0.f;
#pragma unroll
        for (int j = 0; j < 4; ++j) v[j] = __builtin_nontemporal_load(xr + 64 * j);
#pragma unroll
        for (int j = 0; j < 4; ++j) w[j] = __builtin_nontemporal_load(xr2 + 64 * j);
#pragma unroll
        for (int j = 0; j < 4; ++j) { s += (v[j].x * v[j].x + v[j].y * v[j].y) + (v[j].z * v[j].z + v[j].w * v[j].w); s2 += (w[j].x * w[j].x + w[j].y * w[j].y) + (w[j].z * w[j].z + w[j].w * w[j].w); }
        const float tot = wave_sum(s), tot2 = wave_sum(s2);
        if (lane == 0) { F.RSTD1()[m] = 1.0f / sqrtf(tot * (1.0f / DM) + EPS); F.RSTD1()[m2] = 1.0f / sqrtf(tot2 * (1.0f / DM) + EPS); }
        u32x2* o8 = (u32x2*)(F.XB() + (size_t)m * DM) + lane; u32x2* o82 = (u32x2*)(F.XB() + (size_t)m2 * DM) + lane;
#pragma unroll
        for (int j = 0; j < 4; ++j) { u32x2 a; a.x = cvt_pk_bf16(v[j].x, v[j].y); a.y = cvt_pk_bf16(v[j].z, v[j].w); o8[64 * j] = a; u32x2 b; b.x = cvt_pk_bf16(w[j].x, w[j].y); b.y = cvt_pk_bf16(w[j].z, w[j].w); o82[64 * j] = b; }
    }
    constexpr int I_IN = 16 * 80, I_OUT = 16 * 32;
    for (int it = gw; it < I_IN + I_OUT; it += NGW) {
        int r = it;
        if (r < I_IN) { const int kb = r / 80, nb = r % 80; p0_transpose_item(F.w_in(), KD, 2560, F.WIN(), 64 * kb, 32 * nb, win_drow(32 * nb), F.norm1_w(), scr, lane); continue; } r -= I_IN;
        { const int kb = r / 32, nb = r % 32; p0_transpose_item(F.w_out(), KD, 1024, F.WOUT(), 64 * kb, 32 * nb, 32 * nb, nullptr, scr, lane); }
    }
    for (int idx = gw * 64 + lane; idx < NE * KD; idx += NGW * 64) {
        const int e = idx >> 10, k = idx & 1023; const float w = F.router_w()[(size_t)k * NE + e];
        const unsigned hi = cvt_pk_bf16(w, 0.f) & 0xffffu; const float rem = w - __uint_as_float(hi << 16);
        F.RT()[idx] = (bf16_t)hi; F.RT()[NE * KD + idx] = (bf16_t)(cvt_pk_bf16(rem, 0.f) & 0xffffu);
    }
}

struct ProgIn {
    static constexpr bool GATHER = false, FP8 = false; static constexpr int ID = 1, BN = 0, AR = 0;
    const Frame* F;
    __device__ __forceinline__ bool next(int i, Unit& u) const {
        const int v = F->vcu;
        if (i < 4) { const int uu = i * 256 + v, grp = uu >> 5, w = uu & 31; u.pm = grp * 4 + (w & 3); u.pn = w >> 2; u.kind = u.pn < 4 ? 0 : 1;
            u.A = (const char*)(F->XB() + (size_t)u.pm * 256 * KD); u.B = (const char*)(F->WIN() + (size_t)u.pn * 256 * KD); u.e = 0; u.r0 = 0; return true; }
        if (i == 4) { u.kind = 2; u.pm = v & 1; u.pn = v >> 1; u.A = (const char*)(F->WIN() + (size_t)(2048 + u.pm * 256) * KD); u.B = (const char*)(F->XB() + (size_t)u.pn * 256 * KD); u.e = 0; u.r0 = 0; return true; }
        return false;
    }
    __device__ __forceinline__ void epi(const Acc& acc, const Unit& u, int wr, int wc, int fr, int fq) const {
        asm volatile("" : "+v"(fr), "+v"(fq));
        if (u.kind == 2) {
            const int tk0 = u.pn * 256 + wc * 32 + 8 * fq;
            f32x4 rs[2][2];
#pragma unroll
            for (int bj = 0; bj < 2; ++bj)
#pragma unroll
                for (int n = 0; n < 2; ++n) rs[bj][n] = *(const f32x4*)(F->RSTD1() + tk0 + bj * 128 + 4 * n);
#pragma unroll
            for (int ai = 0; ai < 2; ++ai)
#pragma unroll
                for (int m = 0; m < 4; ++m) { const int cp = u.pm * 256 + ai * 128 + wr * 64 + m * 16 + fr; bf16_t* rowp = F->VT() + (size_t)cp * NTOK + tk0;
#pragma unroll
                    for (int bj = 0; bj < 2; ++bj) { const f32x4 v0 = acc[ai][bj][m][0] * rs[bj][0], v1 = acc[ai][bj][m][1] * rs[bj][1];
                        u32x4 w; w.x = cvt_pk_bf16(v0[0], v0[1]); w.y = cvt_pk_bf16(v0[2], v0[3]); w.z = cvt_pk_bf16(v1[0], v1[1]); w.w = cvt_pk_bf16(v1[2], v1[3]);
                        *(u32x4*)(rowp + bj * 128) = w; } }
            return;
        }
        float rsr[2][4];
#pragma unroll
        for (int ai = 0; ai < 2; ++ai)
#pragma unroll
            for (int m = 0; m < 4; ++m) rsr[ai][m] = F->RSTD1()[u.pm * 256 + ai * 128 + wr * 64 + m * 16 + fr];
        if (u.kind == 0) {
#pragma unroll
            for (int ai = 0; ai < 2; ++ai)
#pragma unroll
                for (int m = 0; m < 4; ++m) { const int r = u.pm * 256 + ai * 128 + wr * 64 + m * 16 + fr; bf16_t* rowp = F->UV() + (size_t)r * 1024 + u.pn * 256 + wc * 32 + 8 * fq; const float rs = rsr[ai][m];
#pragma unroll
                    for (int bj = 0; bj < 2; ++bj) { f32x4 v0 = acc[ai][bj][m][0] * rs, v1 = acc[ai][bj][m][1] * rs;
#pragma unroll
                        for (int j = 0; j < 4; ++j) { v0[j] = gelu_tanh_f(v0[j]); v1[j] = gelu_tanh_f(v1[j]); }
                        u32x4 w; w.x = cvt_pk_bf16(v0[0], v0[1]); w.y = cvt_pk_bf16(v0[2], v0[3]); w.z = cvt_pk_bf16(v1[0], v1[1]); w.w = cvt_pk_bf16(v1[2], v1[3]);
                        *(u32x4*)(rowp + bj * 128) = w; } }
            return;
        }
        {
            const int isk = (u.pn - 4) >> 1, head = 4 * (u.pn & 1) + wc; const float* nw = isk ? F->k_norm_w() : F->q_norm_w(); bf16_t* dst = isk ? F->K() : F->Q();
            const float osc = isk ? 1.0f : QSCALE;
            f32x4 nwv[2][2];
#pragma unroll
            for (int bj = 0; bj < 2; ++bj)
#pragma unroll
                for (int n = 0; n < 2; ++n) nwv[bj][n] = *(const f32x4*)(nw + 32 * bj + 8 * fq + 4 * n);
#pragma unroll
            for (int ai = 0; ai < 2; ++ai)
#pragma unroll
                for (int m = 0; m < 4; ++m) { const int r = u.pm * 256 + ai * 128 + wr * 64 + m * 16 + fr; const float rs = rsr[ai][m];
                    f32x4 t[2][2]; float ss = 0.f;
#pragma unroll
                    for (int bj = 0; bj < 2; ++bj)
#pragma unroll
                        for (int n = 0; n < 2; ++n) { t[bj][n] = acc[ai][bj][m][n] * rs; ss += (t[bj][n][0] * t[bj][n][0] + t[bj][n][1] * t[bj][n][1]) + (t[bj][n][2] * t[bj][n][2] + t[bj][n][3] * t[bj][n][3]); }
                    ss += __shfl_xor(ss, 16); ss += __shfl_xor(ss, 32);
                    const float rn = osc / sqrtf(ss * (1.0f / 64.0f) + EPS);
                    bf16_t* rowp = dst + (size_t)r * 512 + head * 64 + 8 * fq;
#pragma unroll
                    for (int bj = 0; bj < 2; ++bj) { const f32x4 v0 = t[bj][0] * nwv[bj][0] * rn, v1 = t[bj][1] * nwv[bj][1] * rn;
                        u32x4 w; w.x = cvt_pk_bf16(v0[0], v0[1]); w.y = cvt_pk_bf16(v0[2], v0[3]); w.z = cvt_pk_bf16(v1[0], v1[1]); w.w = cvt_pk_bf16(v1[2], v1[3]);
                        *(u32x4*)(rowp + bj * 32) = w; } }
        }
    }
};

constexpr int VN_PITCH = 136, YT_PITCH = 132, YT_OFF = 36864;
__device__ __forceinline__ void gmlp_unit(const Frame& F, int chunk, int g, int cbase) {
    const int tid = F.tid, lane = F.lane, wid = F.wave;
    ConvItem gci[CONV_G_PER_UNIT]; float gcv[CONV_G_PER_UNIT][16];
#pragma unroll
    for (int q = 0; q < CONV_G_PER_UNIT; ++q) { gci[q] = moe_conv_decode(F, cbase + q * 2048); moe_conv_issue(gci[q], gcv[q], lane); }
    LAS bf16_t* vn = (LAS bf16_t*)F.lds; LAS float* yt = (LAS float*)(F.lds + YT_OFF);
    const size_t tok0 = (size_t)chunk * 128;
    {
        const int row = tid >> 2, qd = tid & 3; const bf16_t* src = F.UV() + (tok0 + row) * 1024 + 512 + g * 128 + qd * 32;
        u32x4 w[4]; float v[32]; float ss = 0.f;
#pragma unroll
        for (int i = 0; i < 4; ++i) w[i] = *(const u32x4*)(src + 8 * i);
#pragma unroll
        for (int i = 0; i < 4; ++i)
#pragma unroll
            for (int j = 0; j < 4; ++j) { v[8 * i + 2 * j] = bflo(w[i][j]); v[8 * i + 2 * j + 1] = bfhi(w[i][j]); }
#pragma unroll
        for (int i = 0; i < 32; ++i) ss += v[i] * v[i];
        ss += __shfl_xor(ss, 1); ss += __shfl_xor(ss, 2);
        const float rs = 1.0f / sqrtf(ss * (1.0f / 128.0f) + EPS);
        const float* nw = F.sgu_norm_w() + g * 128 + qd * 32;
#pragma unroll
        for (int i = 0; i < 4; ++i) { const f32x4 n0 = *(const f32x4*)(nw + 8 * i), n1 = *(const f32x4*)(nw + 8 * i + 4);
            u32x4 o; o.x = cvt_pk_bf16(v[8 * i] * rs * n0[0], v[8 * i + 1] * rs * n0[1]); o.y = cvt_pk_bf16(v[8 * i + 2] * rs * n0[2], v[8 * i + 3] * rs * n0[3]);
            o.z = cvt_pk_bf16(v[8 * i + 4] * rs * n1[0], v[8 * i + 5] * rs * n1[1]); o.w = cvt_pk_bf16(v[8 * i + 6] * rs * n1[2], v[8 * i + 7] * rs * n1[3]);
            *(LAS u32x4*)(vn + row * VN_PITCH + qd * 32 + 8 * i) = o; }
    }
    __syncthreads();
    {
        const int tb = wid >> 1, cb0 = 2 * (wid & 1), r32 = lane & 31, hh = lane >> 5;
        f32x16 a0 = {}, a1 = {};
        const int t = 32 * tb + r32; const float* wrow = F.sgu_w() + ((size_t)g * 128 + t) * 128;
        for (int ks = 0; ks < 2 * (tb + 1); ++ks) {
            const int s0 = 16 * ks + 8 * hh;
            const f32x4 w0 = *(const f32x4*)(wrow + s0), w1 = *(const f32x4*)(wrow + s0 + 4);
            float wv[8] = {w0[0], w0[1], w0[2], w0[3], w1[0], w1[1], w1[2], w1[3]};
#pragma unroll
            for (int j = 0; j < 8; ++j) if (s0 + j > t) wv[j] = 0.f;
            u32x4 aw; aw.x = cvt_pk_bf16(wv[0], wv[1]); aw.y = cvt_pk_bf16(wv[2], wv[3]); aw.z = cvt_pk_bf16(wv[4], wv[5]); aw.w = cvt_pk_bf16(wv[6], wv[7]);
            const bf16x8 af = __builtin_bit_cast(bf16x8, aw);
            bf16x8 b0, b1;
#pragma unroll
            for (int j = 0; j < 8; ++j) { b0[j] = (short)vn[(s0 + j) * VN_PITCH + 32 * cb0 + r32]; b1[j] = (short)vn[(s0 + j) * VN_PITCH + 32 * (cb0 + 1) + r32]; }
            a0 = __builtin_amdgcn_mfma_f32_32x32x16_bf16(af, b0, a0, 0, 0, 0);
            a1 = __builtin_amdgcn_mfma_f32_32x32x16_bf16(af, b1, a1, 0, 0, 0);
        }
#pragma unroll
        for (int reg = 0; reg < 16; ++reg) {
            const int tt = 32 * tb + (reg & 3) + 8 * (reg >> 2) + 4 * hh; const float bb = F.sgu_b()[g * 128 + tt];
            const bf16_t* up = F.UV() + (tok0 + tt) * 1024 + g * 128;
            const int c0 = 32 * cb0 + r32, c1 = c0 + 32;
            yt[tt * YT_PITCH + c0] = bf2f(up[c0]) * (a0[reg] + bb);
            yt[tt * YT_PITCH + c1] = bf2f(up[c1]) * (a1[reg] + bb);
        }
    }
    __syncthreads();
    {
        const int row = tid >> 2, qd = tid & 3; const LAS float* src = yt + row * YT_PITCH + qd * 32; f32x4 v[8]; float ss = 0.f;
#pragma unroll
        for (int i = 0; i < 8; ++i) { v[i] = *(const LAS f32x4*)(src + 4 * i); ss += (v[i][0] * v[i][0] + v[i][1] * v[i][1]) + (v[i][2] * v[i][2] + v[i][3] * v[i][3]); }
        ss += __shfl_xor(ss, 1); ss += __shfl_xor(ss, 2);
        const float rs = 1.0f / sqrtf(ss * (1.0f / 128.0f) + EPS);
        const float* nw = F.out_norm_a_w() + g * 128 + qd * 32; bf16_t* dst = F.Y() + (tok0 + row) * 1024 + g * 128 + qd * 32;
#pragma unroll
        for (int i = 0; i < 4; ++i) { const f32x4 n0 = *(const f32x4*)(nw + 8 * i), n1 = *(const f32x4*)(nw + 8 * i + 4); const f32x4 x0 = v[2 * i] * n0 * rs, x1 = v[2 * i + 1] * n1 * rs;
            u32x4 o; o.x = cvt_pk_bf16(x0[0], x0[1]); o.y = cvt_pk_bf16(x0[2], x0[3]); o.z = cvt_pk_bf16(x1[0], x1[1]); o.w = cvt_pk_bf16(x1[2], x1[3]);
            *(u32x4*)(dst + 8 * i) = o; }
    }
#pragma unroll
    for (int q = 0; q < CONV_G_PER_UNIT; ++q) moe_conv_finish(gci[q], gcv[q], nullptr, lane);
    __syncthreads();
}

__device__ __forceinline__ void attn_wave_unit(const Frame& F, int b, int h, int qblk, int& cit, int cend, LAS float* scr) {
    const int lane = F.lane, r32 = lane & 31, hi = lane >> 5;
    const size_t tokq = (size_t)b * SEQ + 32 * qblk + r32;
    bf16x8 qr[4];
#pragma unroll
    for (int d0 = 0; d0 < 4; ++d0) qr[d0] = *(const bf16x8*)(F.Q() + tokq * 512 + h * 64 + 16 * d0 + 8 * hi);
    f32x16 o0 = {}, o1 = {};
    float carry = 0.f;
    const bf16_t* Kb = F.K() + ((size_t)b * SEQ + r32) * 512 + h * 64 + 8 * hi;
    const bf16_t* V0 = F.VT() + (size_t)(h * 64 + r32) * NTOK + (size_t)b * SEQ + 4 * hi;
    bf16x8 kf[4]; s16x4 vf[2][2][2];
    auto load_tile = [&](int j, bf16x8 (&kk)[4], s16x4 (&vv)[2][2][2]) {
#pragma unroll
        for (int d0 = 0; d0 < 4; ++d0) kk[d0] = *(const bf16x8*)(Kb + (size_t)(32 * j) * 512 + 16 * d0);
#pragma unroll
        for (int dh = 0; dh < 2; ++dh)
#pragma unroll
            for (int ks = 0; ks < 2; ++ks) { const bf16_t* p = V0 + (size_t)dh * 32 * NTOK + 32 * j + 16 * ks; vv[dh][ks][0] = *(const s16x4*)p; vv[dh][ks][1] = *(const s16x4*)(p + 8); }
    };
    load_tile(qblk, kf, vf);
    for (int j = qblk; j >= 0; --j) {
        bf16x8 kn[4]; s16x4 vn2[2][2][2];
        const bool cv = cit < cend; ConvItem citem; float cvv[16];
        if (cv) { citem = moe_conv_decode(F, cit); moe_conv_issue(citem, cvv, lane); cit += 2048; }
        const bool cv2 = cit < cend; ConvItem citem2; float cvw[16];
        if (cv2) { citem2 = moe_conv_decode(F, cit); moe_conv_issue(citem2, cvw, lane); cit += 2048; }
        if (j > 0) load_tile(j - 1, kn, vn2);
        else {
#pragma unroll
            for (int d0 = 0; d0 < 4; ++d0) kn[d0] = kf[d0];
#pragma unroll
            for (int dh = 0; dh < 2; ++dh)
#pragma unroll
                for (int ks = 0; ks < 2; ++ks) { vn2[dh][ks][0] = vf[dh][ks][0]; vn2[dh][ks][1] = vf[dh][ks][1]; }
        }
        f32x16 s = {};
#pragma unroll
        for (int d0 = 0; d0 < 4; ++d0) s = __builtin_amdgcn_mfma_f32_32x32x16_bf16(kf[d0], qr[d0], s, 0, 0, 0);
        float sp[16];
        const bool diag = (j == qblk);
#pragma unroll
        for (int r = 0; r < 16; ++r) {
            const int kvl = (r & 3) + 8 * (r >> 2) + 4 * hi;
            const float z = s[r];
            float v = fmaxf(z, 0.f) + __builtin_amdgcn_logf(1.0f + __builtin_amdgcn_exp2f(-fabsf(z)));
            if (diag && kvl >= r32) v = 0.f;
            sp[r] = v;
        }
        float G[4], Gp[4];
#pragma unroll
        for (int k = 0; k < 4; ++k) { G[k] = (sp[4 * k] + sp[4 * k + 1]) + (sp[4 * k + 2] + sp[4 * k + 3]); Gp[k] = __shfl_xor(G[k], 32); }
        const float T3 = G[3] + Gp[3], T2 = G[2] + Gp[2], T1 = G[1] + Gp[1], T0 = G[0] + Gp[0];
        float off[4];
        off[3] = 0.f; off[2] = T3; off[1] = T3 + T2; off[0] = T3 + T2 + T1;
        const float tile_total = off[0] + T0;
#pragma unroll
        for (int k = 0; k < 4; ++k) off[k] += carry + (hi == 0 ? Gp[k] : 0.f);
        float a[16];
#pragma unroll
        for (int k = 0; k < 4; ++k) {
            float c = off[k];
#pragma unroll
            for (int i = 3; i >= 0; --i) { const int r = 4 * k + i; c += sp[r]; float av = __builtin_amdgcn_exp2f(s[r] - c);
                if (diag && ((r & 3) + 8 * (r >> 2) + 4 * hi) >= r32) av = 0.f;
                a[r] = av; }
        }
        carry += tile_total;
        u32x4 p0, p1;
        p0.x = cvt_pk_bf16(a[0], a[1]); p0.y = cvt_pk_bf16(a[2], a[3]); p0.z = cvt_pk_bf16(a[4], a[5]); p0.w = cvt_pk_bf16(a[6], a[7]);
        p1.x = cvt_pk_bf16(a[8], a[9]); p1.y = cvt_pk_bf16(a[10], a[11]); p1.z = cvt_pk_bf16(a[12], a[13]); p1.w = cvt_pk_bf16(a[14], a[15]);
        const bf16x8 pf0 = __builtin_bit_cast(bf16x8, p0), pf1 = __builtin_bit_cast(bf16x8, p1);
#define MK_VF(dh, ks) (bf16x8){vf[dh][ks][0][0], vf[dh][ks][0][1], vf[dh][ks][0][2], vf[dh][ks][0][3], vf[dh][ks][1][0], vf[dh][ks][1][1], vf[dh][ks][1][2], vf[dh][ks][1][3]}
        o0 = __builtin_amdgcn_mfma_f32_32x32x16_bf16(MK_VF(0, 0), pf0, o0, 0, 0, 0);
        o0 = __builtin_amdgcn_mfma_f32_32x32x16_bf16(MK_VF(0, 1), pf1, o0, 0, 0, 0);
        o1 = __builtin_amdgcn_mfma_f32_32x32x16_bf16(MK_VF(1, 0), pf0, o1, 0, 0, 0);
        o1 = __builtin_amdgcn_mfma_f32_32x32x16_bf16(MK_VF(1, 1), pf1, o1, 0, 0, 0);
#undef MK_VF
        if (cv) moe_conv_finish(citem, cvv, scr, lane);
        if (cv2) moe_conv_finish(citem2, cvw, scr, lane);
        if (__all(carry > SB_THR)) break;
#pragma unroll
        for (int d0 = 0; d0 < 4; ++d0) kf[d0] = kn[d0];
#pragma unroll
        for (int dh = 0; dh < 2; ++dh)
#pragma unroll
            for (int ks = 0; ks < 2; ++ks) { vf[dh][ks][0] = vn2[dh][ks][0]; vf[dh][ks][1] = vn2[dh][ks][1]; }
    }
    float ss = 0.f;
#pragma unroll
    for (int r = 0; r < 16; ++r) ss += o0[r] * o0[r] + o1[r] * o1[r];
    ss += __shfl_xor(ss, 32);
    const float rs = 1.0f / sqrtf(ss * (1.0f / 64.0f) + EPS);
    const float* nw = F.out_norm_b_w() + h * 64 + 4 * hi; bf16_t* dst = F.Y() + tokq * 1024 + 512 + h * 64 + 4 * hi;
#pragma unroll
    for (int dh = 0; dh < 2; ++dh)
#pragma unroll
        for (int g = 0; g < 4; ++g) { const f32x4 w = *(const f32x4*)(nw + 32 * dh + 8 * g); const f32x16& o = dh ? o1 : o0;
            u32x2 pk; pk.x = cvt_pk_bf16(o[4 * g] * rs * w[0], o[4 * g + 1] * rs * w[1]); pk.y = cvt_pk_bf16(o[4 * g + 2] * rs * w[2], o[4 * g + 3] * rs * w[3]);
            *(u32x2*)(dst + 32 * dh + 8 * g) = pk; }
}
__device__ __forceinline__ void p2_mixers(Frame& F) {
    for (int i = 0; i < 4; ++i) { const int u = i * 256 + F.vcu; gmlp_unit(F, u >> 2, u & 3, CONV_P4_ITEMS + i * CONV_G_PER_UNIT * 2048 + F.vcu * NWAVES + F.wave); }
    const int gw = F.vcu * NWAVES + F.wave;
    LAS float* scr = (LAS float*)(F.lds + F.wave * 16384);
    int cit = CONV_P4_ITEMS + CONV_G_ITEMS + gw; const int cend = MOE_ITEMS;
    for (int i = 0; i < ((MK_REP == 21 || MK_REP == 22) ? 8 : 4); ++i) { if (MK_REP == 22 && i == 4) cit = CONV_P4_ITEMS + gw; const int u = (i & 3) * 2048 + gw; const int qblk = u & 127, bh = u >> 7; attn_wave_unit(F, bh >> 3, bh & 7, qblk, cit, cend, scr); }
    for (; cit < cend; cit += 2048) { const ConvItem c = moe_conv_decode(F, cit); float v[16]; moe_conv_issue(c, v, F.lane); moe_conv_finish(c, v, scr, F.lane); }
}

struct ProgOut {
    static constexpr bool GATHER = false, FP8 = false; static constexpr int ID = 3, BN = 0, AR = 0;
    const Frame* F;
    __device__ __forceinline__ bool next(int i, Unit& u) const {
        if (i >= 2) return false;
        const int uu = i * 256 + F->vcu, grp = uu >> 5, w = uu & 31; u.pm = grp * 8 + (w & 7); u.pn = w >> 3; u.kind = 0; u.e = 0; u.r0 = 0;
        u.A = (const char*)(F->Y() + (size_t)u.pm * 256 * KD); u.B = (const char*)(F->WOUT() + (size_t)u.pn * 256 * KD); return true;
    }
    __device__ __forceinline__ void epi(const Acc& acc, const Unit& u, int wr, int wc, int fr, int fq) const {
        asm volatile("" : "+v"(fr), "+v"(fq));
        const size_t off0 = (size_t)(u.pm * 256 + wr * 64 + fr) * DM + u.pn * 256 + wc * 32 + 8 * fq;
        const float* xb = F->x() + off0; float* ob = F->out() + off0;
        f32x4 xv[2][2][2];
#define MK_LDX(g, slot) do { const size_t go_ = (size_t)(((g) >> 2) * 128 + ((g) & 3) * 16) * DM; _Pragma("unroll") for (int bj = 0; bj < 2; ++bj) _Pragma("unroll") for (int n = 0; n < 2; ++n) xv[slot][bj][n] = *(const f32x4*)(xb + go_ + bj * 128 + 4 * n); } while (0)
        MK_LDX(0, 0);
#pragma unroll
        for (int g = 0; g < 8; ++g) { const int ai = g >> 2, m = g & 3; const size_t go = (size_t)(ai * 128 + m * 16) * DM; float ss = 0.f;
            if (g + 1 < 8) MK_LDX(g + 1, (g + 1) & 1);
#pragma unroll
            for (int bj = 0; bj < 2; ++bj)
#pragma unroll
                for (int n = 0; n < 2; ++n) { const f32x4 o = xv[g & 1][bj][n] + acc[ai][bj][m][n];
                    ss += (o[0] * o[0] + o[1] * o[1]) + (o[2] * o[2] + o[3] * o[3]); *(f32x4*)(ob + go + bj * 128 + 4 * n) = o; }
            ss += __shfl_xor(ss, 16); ss += __shfl_xor(ss, 32);
            if (fq == 0) F->SSPART()[(size_t)(u.pm * 256 + ai * 128 + wr * 64 + m * 16 + fr) * 16 + u.pn * 4 + wc] = ss; }
#undef MK_LDX
    }
};

template <bool DRY> __device__ __forceinline__ void router_wave_unit(Frame& F, int unit) {
    const int lane = F.lane, r32 = lane & 31, hh = lane >> 5; const int tok = unit * 32 + r32;
    float ssum = 0.f;
    { const f32x4* sp = (const f32x4*)(F.SSPART() + (size_t)tok * 16);
#pragma unroll
      for (int i = 0; i < 4; ++i) { const f32x4 v = sp[i]; ssum += v[0]; ssum += v[1]; ssum += v[2]; ssum += v[3]; } }
    const float rs = 1.0f / sqrtf(ssum * (1.0f / DM) + EPS);
    f32x16 acc = {};
    const float* xrow = F.out() + (size_t)tok * DM + 8 * hh; const float* w2 = F.norm2_w() + 8 * hh; unsigned char* hrow = F.HB() + (size_t)tok * DM + 8 * hh;
    const bf16_t* rth = F.RT() + (size_t)r32 * KD + 8 * hh; const bf16_t* rtl = rth + NE * KD;
#pragma unroll 4
    for (int s = 0; s < 64; ++s) {
        const f32x4 x0 = *(const f32x4*)(xrow + 16 * s), x1 = *(const f32x4*)(xrow + 16 * s + 4);
        const f32x4 g0 = *(const f32x4*)(w2 + 16 * s), g1 = *(const f32x4*)(w2 + 16 * s + 4);
        const f32x4 h0 = x0 * g0 * rs, h1 = x1 * g1 * rs;
        u32x4 hw; hw.x = cvt_pk_bf16(h0[0], h0[1]); hw.y = cvt_pk_bf16(h0[2], h0[3]); hw.z = cvt_pk_bf16(h1[0], h1[1]); hw.w = cvt_pk_bf16(h1[2], h1[3]);
        { u32x2 h8; h8.x = pk4_fp8(h0[0], h0[1], h0[2], h0[3]); h8.y = pk4_fp8(h1[0], h1[1], h1[2], h1[3]); *(u32x2*)(hrow + 16 * s) = h8; }
        u32x4 lw; lw.x = cvt_pk_bf16(h0[0] - bflo(hw.x), h0[1] - bfhi(hw.x)); lw.y = cvt_pk_bf16(h0[2] - bflo(hw.y), h0[3] - bfhi(hw.y));
        lw.z = cvt_pk_bf16(h1[0] - bflo(hw.z), h1[1] - bfhi(hw.z)); lw.w = cvt_pk_bf16(h1[2] - bflo(hw.w), h1[3] - bfhi(hw.w));
        const bf16x8 bh = __builtin_bit_cast(bf16x8, hw), bl = __builtin_bit_cast(bf16x8, lw);
        const bf16x8 ah = *(const bf16x8*)(rth + 16 * s), al = *(const bf16x8*)(rtl + 16 * s);
        acc = __builtin_amdgcn_mfma_f32_32x32x16_bf16(ah, bh, acc, 0, 0, 0);
        acc = __builtin_amdgcn_mfma_f32_32x32x16_bf16(al, bh, acc, 0, 0, 0);
        acc = __builtin_amdgcn_mfma_f32_32x32x16_bf16(ah, bl, acc, 0, 0, 0);
    }
    float lv[16];
#pragma unroll
    for (int r = 0; r < 16; ++r) lv[r] = acc[r] + F.router_b()[(r & 3) + 8 * (r >> 2) + 4 * hh];
    float cv[8]; int ce[8];
#pragma unroll
    for (int k = 0; k < 4; ++k) { float bv = -INFINITY; int be = 0;
#pragma unroll
        for (int r = 0; r < 16; ++r) { const int e = (r & 3) + 8 * (r >> 2) + 4 * hh; if (lv[r] > bv) { bv = lv[r]; be = e; } }
#pragma unroll
        for (int r = 0; r < 16; ++r) { const int e = (r & 3) + 8 * (r >> 2) + 4 * hh; if (e == be) lv[r] = -INFINITY; }
        cv[k] = bv; ce[k] = be; }
#pragma unroll
    for (int k = 0; k < 4; ++k) { cv[4 + k] = __shfl_xor(cv[k], 32); ce[4 + k] = __shfl_xor(ce[k], 32); }
    float tv[4]; int te[4];
#pragma unroll
    for (int k = 0; k < 4; ++k) { float bv = -INFINITY; int be = 1 << 20;
#pragma unroll
        for (int c = 0; c < 8; ++c) if (cv[c] > bv || (cv[c] == bv && ce[c] < be)) { bv = cv[c]; be = ce[c]; }
#pragma unroll
        for (int c = 0; c < 8; ++c) if (ce[c] == be) cv[c] = -INFINITY;
        tv[k] = bv; te[k] = be; }
    float ex[4], den = 0.f;
#pragma unroll
    for (int k = 0; k < 4; ++k) { ex[k] = __builtin_amdgcn_exp2f((tv[k] - tv[0]) * LOG2E); den += ex[k]; }
    const float rden = 1.0f / den;
    const int e0 = hh ? te[2] : te[0], e1 = hh ? te[3] : te[1]; const float g0 = (hh ? ex[2] : ex[0]) * rden, g1 = (hh ? ex[3] : ex[1]) * rden;
    if (DRY) { asm volatile("" :: "v"(e0), "v"(e1), "v"(g0), "v"(g1)); return; }
    int myc = 0; int rank0 = 0, rank1 = 0;
    const unsigned long long ltmask = (1ull << lane) - 1ull;
    for (int e = 0; e < NE; ++e) {
        const unsigned long long m0 = __ballot(e0 == e), m1 = __ballot(e1 == e);
        const int c0 = __popcll(m0), c1 = __popcll(m1);
        if (lane == e) myc = c0 + c1;
        if (e0 == e) rank0 = __popcll(m0 & ltmask);
        if (e1 == e) rank1 = c0 + __popcll(m1 & ltmask);
    }
    int base = 0;
    if (lane < NE && myc > 0) base = (int)__hip_atomic_fetch_add(F.ctl() + CW_CNT + lane, (unsigned)myc, __ATOMIC_RELAXED, __HIP_MEMORY_SCOPE_AGENT);
    const int p0 = __shfl(base, e0) + rank0, p1 = __shfl(base, e1) + rank1;
    F.LISTTOK()[(size_t)e0 * NTOK + p0] = tok; F.LISTGATE()[(size_t)e0 * NTOK + p0] = g0;
    F.LISTTOK()[(size_t)e1 * NTOK + p1] = tok; F.LISTGATE()[(size_t)e1 * NTOK + p1] = g1;
    F.TOKINFO()[tok * 4 + 2 * hh] = (e0 << 16) | p0; F.TOKINFO()[tok * 4 + 2 * hh + 1] = (e1 << 16) | p1;
}

__device__ __forceinline__ void moe_build_table(Frame& F) {
    LAS int* tab = (LAS int*)(F.lds + TAB_OFF);
    if (F.tid < NE) tab[F.tid] = (int)__hip_atomic_load(F.ctl() + CW_CNT + F.tid, __ATOMIC_RELAXED, __HIP_MEMORY_SCOPE_AGENT);
    __syncthreads();
    if (F.tid == 0) { int acc = 0; for (int e = 0; e < NE; ++e) { tab[32 + e] = acc; acc += (tab[e] + 255) >> 8; } tab[64] = acc; }
    __syncthreads();
}
__device__ __forceinline__ int sgpr(int v) { return __builtin_amdgcn_readfirstlane(v); }
template <int WGM, int NN>
__device__ __forceinline__ bool moe_decode(const Frame* F, int T, int i, Unit& u) {
    const LAS int* tab = (const LAS int*)(F->lds + TAB_OFF);
    const int uu = i * 256 + F->vcu, grp = uu >> 5, w = uu & 31; const int mt = grp * WGM + (w % WGM); u.pn = w / WGM;
    if (mt >= T) return false;
    int e = 0;
    for (int k = 1; k < NE; ++k) if (sgpr(tab[32 + k]) <= mt) e = k;
    u.e = e; u.pm = mt; u.r0 = (mt - sgpr(tab[32 + e])) * 256; u.kind = sgpr(tab[e]); return true;
}
struct ProgMoe1 {
    static constexpr bool GATHER = true, FP8 = true; static constexpr int ID = 5, BN = 2048, AR = NTOK;
    const Frame* F; int T;
    __device__ __forceinline__ bool next(int i, Unit& u) const {
        if (!moe_decode<4, 8>(F, T, i, u)) return false;
        u.A = (const char*)F->HB(); u.B = (const char*)(F->WGU() + (size_t)u.e * 2048 * KD + (size_t)u.pn * 256 * 16); return true;
    }
    __device__ __forceinline__ void aoffs(const Unit& u, int wid, unsigned (&vo)[2][2]) const {
        const int cnt = u.kind; const int tid = wid * 64 + lane_id_fresh();
#pragma unroll
        for (int i = 0; i < 2; ++i) { int R_, C_; stage_rc(tid * 16 + i * 8192, R_, C_);
#pragma unroll
            for (int h = 0; h < 2; ++h) { const int idx = u.r0 + h * 128 + R_; const int tok = idx < cnt ? F->LISTTOK()[(size_t)u.e * NTOK + idx] : 0; vo[h][i] = (unsigned)(tok * KD + C_ * 2); } }
    }
    __device__ __forceinline__ void epi(const Acc& acc, const Unit& u, int wr, int wc, int fr, int fq) const {
        asm volatile("" : "+v"(fr), "+v"(fq));
        const float* bp = F->b_gate_up() + (size_t)u.e * 2048 + u.pn * 256 + wc * 32 + 8 * fq;
        f32x4 bv[2][2];
#pragma unroll
        for (int bj = 0; bj < 2; ++bj)
#pragma unroll
            for (int n = 0; n < 2; ++n) bv[bj][n] = *(const f32x4*)(bp + bj * 128 + 4 * n);
#pragma unroll
        for (int ai = 0; ai < 2; ++ai)
#pragma unroll
            for (int m = 0; m < 4; ++m) { const size_t slot = (size_t)u.pm * 256 + ai * 128 + wr * 64 + m * 16 + fr; unsigned char* rowp = F->ACT() + ((size_t)(8 * u.pn + wc) * SLOTS + slot) * 16 + 4 * fq;
#pragma unroll
                for (int bj = 0; bj < 2; ++bj) { const f32x4 v0 = acc[ai][bj][m][0] * WSCALE_INV + bv[bj][0], v1 = acc[ai][bj][m][1] * WSCALE_INV + bv[bj][1];
                    f32x2 ga = {fminf(v0[0], 7.0f), fminf(v0[2], 7.0f)}, gb = {fminf(v1[0], 7.0f), fminf(v1[2], 7.0f)};
                    f32x2 ua = {__builtin_amdgcn_fmed3f(v0[1], -7.0f, 7.0f), __builtin_amdgcn_fmed3f(v0[3], -7.0f, 7.0f)}, ub = {__builtin_amdgcn_fmed3f(v1[1], -7.0f, 7.0f), __builtin_amdgcn_fmed3f(v1[3], -7.0f, 7.0f)};
                    const f32x2 xa = ga * (-1.702f * LOG2E), xb = gb * (-1.702f * LOG2E);
                    f32x2 ea = {__builtin_amdgcn_exp2f(xa[0]), __builtin_amdgcn_exp2f(xa[1])}, eb = {__builtin_amdgcn_exp2f(xb[0]), __builtin_amdgcn_exp2f(xb[1])};
                    ea = ea + 1.0f; eb = eb + 1.0f;
                    const f32x2 ra = {__builtin_amdgcn_rcpf(ea[0]), __builtin_amdgcn_rcpf(ea[1])}, rb = {__builtin_amdgcn_rcpf(eb[0]), __builtin_amdgcn_rcpf(eb[1])};
                    const f32x2 gla = ga * ra, glb = gb * rb;
                    const f32x2 oa = ua * gla + gla, ob = ub * glb + glb;
                    float r4[4] = {oa[0], oa[1], ob[0], ob[1]};
                    *(unsigned*)(rowp + (size_t)bj * 4 * SLOTS * 16) = pk4_fp8(r4[0], r4[1], r4[2], r4[3]); } }
    }
};
struct ProgMoe2 {
    static constexpr bool GATHER = false, FP8 = true; static constexpr int ID = 6, BN = 1024, AR = SLOTS;
    const Frame* F; int T;
    __device__ __forceinline__ bool next(int i, Unit& u) const {
        if (!moe_decode<8, 4>(F, T, i, u)) return false;
        u.A = (const char*)(F->ACT() + (size_t)u.pm * 256 * 16); u.B = (const char*)(F->WD() + (size_t)u.e * 1024 * KD + (size_t)u.pn * 256 * 16); return true;
    }
    __device__ __forceinline__ void epi(const Acc& acc, const Unit& u, int wr, int wc, int fr, int fq) const {
        asm volatile("" : "+v"(fr), "+v"(fq));
        const int cnt = u.kind;
        const float* bp = F->b_down() + (size_t)u.e * 1024 + u.pn * 256 + wc * 32 + 8 * fq;
        f32x4 bv[2][2];
#pragma unroll
        for (int bj = 0; bj < 2; ++bj)
#pragma unroll
            for (int n = 0; n < 2; ++n) bv[bj][n] = *(const f32x4*)(bp + bj * 128 + 4 * n);
#pragma unroll
        for (int ai = 0; ai < 2; ++ai) {
            float gt[4];
#pragma unroll
            for (int m = 0; m < 4; ++m) { const int idx = u.r0 + ai * 128 + wr * 64 + m * 16 + fr; gt[m] = idx < cnt ? F->LISTGATE()[(size_t)u.e * NTOK + idx] : 0.f; }
#pragma unroll
            for (int m = 0; m < 4; ++m) { const int rl = ai * 128 + wr * 64 + m * 16 + fr; const float gate = gt[m] * YSCALE;
                unsigned char* rowp = F->YS() + ((size_t)u.pm * 256 + rl) * 1024 + u.pn * 256 + wc * 32 + 8 * fq;
#pragma unroll
                for (int bj = 0; bj < 2; ++bj) { const f32x4 v0 = (acc[ai][bj][m][0] * WSCALE_INV + bv[bj][0]) * gate, v1 = (acc[ai][bj][m][1] * WSCALE_INV + bv[bj][1]) * gate;
                    u32x2 w; w.x = pk4_fp8(v0[0], v0[1], v0[2], v0[3]); w.y = pk4_fp8(v1[0], v1[1], v1[2], v1[3]);
                    *(u32x2*)(rowp + bj * 128) = w; } }
        }
    }
};

template <bool DRY> __device__ __forceinline__ void p7_combine(Frame& F) {
    const LAS int* tab = (const LAS int*)(F.lds + TAB_OFF);
    const int gw = F.vcu * NWAVES + F.wave, NGW = F.G * NWAVES, lane = F.lane;
    for (int tok = gw; tok < NTOK; tok += NGW) {
        f32x4* orow = (f32x4*)(F.out() + (size_t)tok * DM) + lane; f32x4 v[4];
#pragma unroll
        for (int j = 0; j < 4; ++j) v[j] = orow[64 * j];
#pragma unroll
        for (int k = 0; k < 4; ++k) { const int info = F.TOKINFO()[tok * 4 + k]; const int e = info >> 16, pos = info & 0xffff; const size_t slot = (size_t)tab[32 + e] * 256 + pos;
            const unsigned* yr = (const unsigned*)(F.YS() + slot * 1024) + lane;
#pragma unroll
            for (int j = 0; j < 4; ++j) { const unsigned w = yr[64 * j]; const f32x2 lo = __builtin_amdgcn_cvt_pk_f32_fp8((int)w, false), hi = __builtin_amdgcn_cvt_pk_f32_fp8((int)w, true);
                v[j][0] += lo[0] * YSCALE_INV; v[j][1] += lo[1] * YSCALE_INV; v[j][2] += hi[0] * YSCALE_INV; v[j][3] += hi[1] * YSCALE_INV; } }
        f32x4* wrow = DRY ? (f32x4*)((float*)(F.ws() + WS_EARLY) + (size_t)tok * DM) + lane : orow;
#pragma unroll
        for (int j = 0; j < 4; ++j) wrow[64 * j] = v[j];
    }
}

__global__ void __launch_bounds__(NWAVES * 64, 2) mk_fwd(Args args) {
    extern __shared__ __attribute__((aligned(16))) unsigned char lds_raw[];
    Frame F;
    F.lds = (LAS unsigned char*)lds_raw;
    F.tid = threadIdx.x; F.lane = F.tid & 63; F.wave = __builtin_amdgcn_readfirstlane(F.tid >> 6);
    F.G = gridDim.x; { const int bx = blockIdx.x; F.vcu = (bx % 8) * (F.G / 8) + bx / 8; }
    F.ka = (const CAS Args*)__builtin_amdgcn_kernarg_segment_ptr();
    for (int u = F.tid; u < (LDS_BYTES - LDSCTL_OFF) / 4; u += NWAVES * 64) ((LAS unsigned*)(F.lds + LDSCTL_OFF))[u] = 0u;
    __syncthreads();
    XcdBarrier bar = xcd_barrier_post(F.ctl() + CW_BAR, (volatile LAS unsigned*)(F.lds + MISC_OFF) + 8);
    const int lo = F.ka->ph_lo, hi = F.ka->ph_hi;
#define IN(k) (lo <= (k) && (k) < hi)
#define REFRESH() do { int l_ = lane_id(); asm volatile("" : "+v"(l_)); F.lane = l_; F.tid = F.wave * 64 + l_; } while (0)
#define SEAM(k) do { if (IN(k) && IN((k) + 1)) { xcd_barrier(bar, F.wave); if (MK_REP == 100 + (k)) { xcd_barrier(bar, F.wave); xcd_barrier(bar, F.wave); xcd_barrier(bar, F.wave); xcd_barrier(bar, F.wave); } } } while (0)
    if (IN(0)) { REFRESH(); p0_prologue(F); if (MK_REP == 0) p0_prologue(F); } SEAM(0);
    if (IN(1)) { { ProgIn P{&F}; gemm_phase(F.lds, P); } if (MK_REP == 1) { ProgIn P{&F}; gemm_phase(F.lds, P); } } SEAM(1);
    if (IN(2)) { REFRESH(); p2_mixers(F); if (MK_REP == 2) p2_mixers(F); } SEAM(2);
    if (IN(3)) { { ProgOut P{&F}; gemm_phase(F.lds, P); } if (MK_REP == 3) { ProgOut P{&F}; gemm_phase(F.lds, P); } } SEAM(3);
    if (IN(4)) { REFRESH(); if (F.wave < 4) { if (MK_REP == 4) router_wave_unit<true>(F, F.wave * 256 + F.vcu); router_wave_unit<false>(F, F.wave * 256 + F.vcu); }
                 else { LAS float* scr = (LAS float*)(F.lds + F.wave * 16384); const int cw = F.vcu * 4 + (F.wave - 4);
                        for (int rep_ = 0; rep_ < (MK_REP == 41 ? 2 : 1); ++rep_) {
                        ConvItem ca = moe_conv_decode(F, cw); float va[16], vb[16]; moe_conv_issue(ca, va, F.lane);
                        for (int j = 0; j < CONV_P4_PER_WAVE; j += 2) {
                            const ConvItem cb = moe_conv_decode(F, (j + 1) * 1024 + cw); moe_conv_issue(cb, vb, F.lane);
                            moe_conv_finish(ca, va, scr, F.lane);
                            if (j + 2 < CONV_P4_PER_WAVE) { ca = moe_conv_decode(F, (j + 2) * 1024 + cw); moe_conv_issue(ca, va, F.lane); }
                            moe_conv_finish(cb, vb, scr, F.lane); } } } } SEAM(4);
    if (lo <= 7 && hi > 5) { REFRESH(); moe_build_table(F); }
    if (IN(5)) { { ProgMoe1 P{&F, sgpr(((const LAS int*)(F.lds + TAB_OFF))[64])}; gemm_phase(F.lds, P); } if (MK_REP == 5) { ProgMoe1 P{&F, sgpr(((const LAS int*)(F.lds + TAB_OFF))[64])}; gemm_phase(F.lds, P); } } SEAM(5);
    if (IN(6)) { { ProgMoe2 P{&F, sgpr(((const LAS int*)(F.lds + TAB_OFF))[64])}; gemm_phase(F.lds, P); } if (MK_REP == 6) { ProgMoe2 P{&F, sgpr(((const LAS int*)(F.lds + TAB_OFF))[64])}; gemm_phase(F.lds, P); } } SEAM(6);
    if (IN(7)) { REFRESH(); if (MK_REP == 7) p7_combine<true>(F); p7_combine<false>(F); }
#undef IN
#undef SEAM
}
}
#ifndef MK_CUT
#define MK_CUT 8
#endif
extern "C" void kernel_launch(void* const* d_in, const int* in_sizes, int n_in, void* d_out, int out_size, void* d_ws, size_t ws_size, hipStream_t stream) {
    static int ready = 0;
    if (ready == 0) {
        if (n_in != 18 || out_size != mk::NTOK * mk::DM || ws_size < mk::WS_END) { fprintf(stderr, "kernel_launch: unexpected problem (n_in %d out %d ws %zu)\n", n_in, out_size, ws_size); ready = -1; return; }
        if (hipFuncSetAttribute((const void*)mk::mk_fwd, hipFuncAttributeMaxDynamicSharedMemorySize, mk::LDS_BYTES) != hipSuccess) { fprintf(stderr, "kernel_launch: hipFuncSetAttribute failed\n"); ready = -1; return; }
        ready = 1;
    }
    if (ready < 0) return;
    (void)hipMemsetAsync((char*)d_ws + mk::WS_CTL, 0, mk::CTL_ZERO_BYTES, stream);
    mk::Args a{};
    for (int i = 0; i < 18; ++i) a.in[i] = (const float*)d_in[i];
    a.out = (float*)d_out; a.ws = (unsigned char*)d_ws; a.ph_lo = 0; a.ph_hi = MK_CUT;
    hipLaunchKernelGGL(mk::mk_fwd, dim3(256), dim3(mk::NWAVES * 64), mk::LDS_BYTES, stream, a);
#if MK_CUT < 8
    {
        using namespace nv;
        const float* x = (const float*)d_in[0]; const float* w_out = (const float*)d_in[10]; const float* norm2_w = (const float*)d_in[11];
        const float* router_w = (const float*)d_in[12]; const float* router_b = (const float*)d_in[13]; const float* w_gate_up = (const float*)d_in[14];
        const float* b_gate_up = (const float*)d_in[15]; const float* w_down = (const float*)d_in[16]; const float* b_down = (const float*)d_in[17];
        float* out = (float*)d_out; char* ws = (char*)d_ws; const size_t MiB = 1u << 20;
        int* cnt = (int*)ws + mk::CW_CNT; int* list_tok = (int*)(ws + mk::WS_LISTTOK); float* list_gate = (float*)(ws + mk::WS_LISTGATE);
        float* hn = (float*)(ws + 16 * MiB); float* gu = (float*)(ws + 272 * MiB); float* act = (float*)(ws + (272 + 256) * MiB);
#if MK_CUT <= 3
        k_gemm<1, true><<<dim3(DM / 64, NTOK / 64), 256, 0, stream>>>((const void*)(ws + mk::WS_Y), nullptr, nullptr, nullptr, w_out, nullptr, x, nullptr, out, NTOK, DM, DM, DM, DM);
#endif
#if MK_CUT <= 4
        k_router<<<NTOK, 256, 0, stream>>>(out, norm2_w, router_w, router_b, hn, cnt, list_tok, list_gate);
#else
        k_bf2f<<<4096, 256, 0, stream>>>((const unsigned short*)(ws + mk::WS_HB), hn, (size_t)NTOK * DM);
#endif
        for (int e = 0; e < NE; ++e) {
            const int* lt = list_tok + (size_t)e * NTOK; const float* lgp = list_gate + (size_t)e * NTOK;
            k_gemm<0, false><<<dim3(2 * DFF / 64, NTOK / 64), 256, 0, stream>>>(hn, lt, nullptr, cnt + e, w_gate_up + (size_t)e * DM * 2 * DFF, b_gate_up + (size_t)e * 2 * DFF, nullptr, nullptr, gu, NTOK, 2 * DFF, DM, DM, 2 * DFF);
            k_swiglu<<<NTOK, 256, 0, stream>>>(gu, cnt + e, act);
            k_gemm<3, false><<<dim3(DM / 64, NTOK / 64), 256, 0, stream>>>(act, nullptr, lt, cnt + e, w_down + (size_t)e * DFF * DM, b_down + (size_t)e * DM, nullptr, lgp, out, NTOK, DM, DFF, DFF, DM);
        }
    }
#endif
}
```

```cpp
#include <hip/hip_runtime.h>
#include <cstdio>
#include <cstdint>
#ifndef MK_REP
#define MK_REP -1
#endif
namespace mk {
#define LAS __attribute__((address_space(3)))
#define GAS __attribute__((address_space(1)))
typedef unsigned short bf16_t;
typedef short bf16x8 __attribute__((ext_vector_type(8)));
typedef short s16x4 __attribute__((ext_vector_type(4)));
typedef float f32x4 __attribute__((ext_vector_type(4)));
typedef float f32x2 __attribute__((ext_vector_type(2)));
typedef float f32x16 __attribute__((ext_vector_type(16)));
typedef unsigned u32x4 __attribute__((ext_vector_type(4)));
typedef unsigned u32x2 __attribute__((ext_vector_type(2)));
typedef int i32x4 __attribute__((ext_vector_type(4)));
typedef int i32x8 __attribute__((ext_vector_type(8)));

constexpr int NTOK = 32768, DM = 1024, SEQ = 4096, NB = 8, NH = 8, HD = 64, NE = 32, DFF = 1024, KD = 1024;
constexpr float EPS = 1e-5f;
constexpr float LOG2E = 1.4426950408889634f;
constexpr float QSCALE = 0.125f * LOG2E;
constexpr float SB_THR = 64.0f;
constexpr int NWAVES = 8;
constexpr int SLOTS = NTOK * 4 + NE * 256;

constexpr size_t MiB = 1u << 20;
constexpr size_t WS_CTL = 0, CTL_ZERO_BYTES = 1 * MiB;
constexpr size_t WS_LISTTOK = 1 * MiB;
constexpr size_t WS_LISTGATE = 5 * MiB;
constexpr size_t WS_TOKINFO = 9 * MiB;
constexpr size_t WS_RSTD1 = 10 * MiB;
constexpr size_t WS_SSPART = 11 * MiB;
constexpr size_t WS_RT = 13 * MiB;
constexpr size_t WS_WGU = 16 * MiB;
constexpr size_t WS_WD = 80 * MiB;
constexpr size_t WS_HB = 112 * MiB;
constexpr size_t WS_YS = 144 * MiB;
constexpr size_t WS_EARLY = 416 * MiB;
constexpr size_t WS_XB = WS_EARLY;
constexpr size_t WS_WIN = WS_EARLY + 64 * MiB;
constexpr size_t WS_WOUT = WS_EARLY + 70 * MiB;
constexpr size_t WS_UV = WS_EARLY + 72 * MiB;
constexpr size_t WS_Q = WS_EARLY + 136 * MiB;
constexpr size_t WS_K = WS_EARLY + 168 * MiB;
constexpr size_t WS_VT = WS_EARLY + 200 * MiB;
constexpr size_t WS_Y = WS_EARLY + 232 * MiB;
constexpr size_t WS_ACT = WS_EARLY;
constexpr size_t WS_END = WS_EARLY + 296 * MiB;
constexpr float WSCALE = 32.0f, WSCALE_INV = 1.0f / 32.0f;
constexpr float YSCALE = 16.0f, YSCALE_INV = 1.0f / 16.0f;
constexpr int CW_CNT = 64;
constexpr int CW_BAR = 4096;

constexpr int RING_BYTES = 131072;
constexpr int LDSCTL_OFF = RING_BYTES, MISC_OFF = LDSCTL_OFF + 320, TAB_OFF = LDSCTL_OFF + 1024;
constexpr int LDS_BYTES = 147456;

__device__ __forceinline__ unsigned cvt_pk_bf16(float lo, float hi) { unsigned r; asm volatile("v_cvt_pk_bf16_f32 %0, %1, %2" : "=v"(r) : "v"(lo), "v"(hi)); return r; }
__device__ __forceinline__ unsigned pk4_fp8(float a, float b, float c, float d) { unsigned w = 0u; w = (unsigned)__builtin_amdgcn_cvt_pk_fp8_f32(a, b, (int)w, false); w = (unsigned)__builtin_amdgcn_cvt_pk_fp8_f32(c, d, (int)w, true); return w; }
__device__ __forceinline__ float bf2f(unsigned short h) { return __uint_as_float((unsigned)h << 16); }
__device__ __forceinline__ float bflo(unsigned w) { return __uint_as_float(w << 16); }
__device__ __forceinline__ float bfhi(unsigned w) { return __uint_as_float(w & 0xffff0000u); }
__device__ __forceinline__ int lane_id() { return (int)__builtin_amdgcn_mbcnt_hi(~0u, __builtin_amdgcn_mbcnt_lo(~0u, 0u)); }
__device__ __forceinline__ int lane_id_fresh() { int l; asm volatile("v_mbcnt_lo_u32_b32 %0, -1, 0\n\tv_mbcnt_hi_u32_b32 %0, -1, %0" : "=v"(l)); return l; }
__device__ __forceinline__ float wave_sum(float v) {
#pragma unroll
    for (int o = 1; o < 64; o <<= 1) v += __shfl_xor(v, o);
    return v;
}
__device__ __forceinline__ float gelu_tanh_f(float x) {
    const float u = 0.7978845608028654f * (x + 0.044715f * x * x * x);
    return x * __builtin_amdgcn_rcpf(1.0f + __builtin_amdgcn_exp2f(-2.0f * LOG2E * u));
}

constexpr int BM = 256, BK = 64, HALF = 128, HTB = HALF * BK * 2;
__device__ __forceinline__ int lds_byte(int r, int c) { const int st = (r >> 4) * 2 + (c >> 5), rr = r & 15, cc = c & 31, ob = rr * 64 + cc * 2; return st * 1024 + (ob ^ (((ob >> 9) & 1) << 5)); }
__device__ __forceinline__ void stage_rc(int b, int& R, int& C) { const int st = b / 1024, sb = b % 1024, swz = sb ^ (((sb >> 9) & 1) << 5); R = (st >> 1) * 16 + swz / 64; C = (st & 1) * 32 + (swz % 64) / 2; }
__device__ __forceinline__ int swz8(int r) { const int q = r & 15; return ((q >> 1) & 7) ^ ((((q + 4) >> 3) & 1) << 1); }
__device__ __forceinline__ int lds_byte8(int r, int c) { return r * 128 + ((c ^ swz8(r)) << 4); }
__device__ __forceinline__ void stage_rc8(int b, int& R, int& Cb) { R = b >> 7; Cb = (((b & 127) >> 4) ^ swz8(R)) << 4; }
__device__ __forceinline__ int lds_byteN(int r, int c8) { return r * 128 + ((c8 ^ ((r >> 1) & 7)) << 4); }
__device__ __forceinline__ void stage_rcN(int b, int& R, int& C) { R = b >> 7; C = ((((b & 127) >> 4) ^ ((R >> 1) & 7)) << 3); }
__device__ __forceinline__ int perm32(int rho) { const int n = rho >> 4, i = rho & 15; return 8 * (i >> 2) + 4 * n + (i & 3); }

struct Unit { const char* A; const char* B; int kind, pm, pn, e, r0; };

template <class Prog>
__device__ __forceinline__ void gemm_phase(LAS unsigned char* lds, const Prog& P) {
    const int wid = P.F->wave, lane = lane_id(), tid = wid * 64 + lane, wr = wid >> 2, wc = wid & 3;
    constexpr bool F8 = Prog::FP8;
    constexpr int K = KD, ESZ = F8 ? 1 : 2, nt = F8 ? K / 128 : K / BK;
    unsigned voffB[2];
#pragma unroll
    for (int i = 0; i < 2; ++i) {
        if constexpr (F8) { const int b_ = tid * 16 + i * 8192, k16_ = b_ >> 11, sl_ = (b_ & 2047) >> 4; voffB[i] = (unsigned)((k16_ * Prog::BN + (sl_ & ~31) + perm32(sl_ & 31)) * 16); }
        else { int R_, C_; stage_rcN(tid * 16 + i * 8192, R_, C_); const int Rb = (R_ & ~31) + perm32(R_ & 31); voffB[i] = (unsigned)(Rb * K * ESZ + C_ * 2); } }
    constexpr size_t kstep = (size_t)(BK * 2);
    constexpr size_t hstep = (size_t)HALF * K * ESZ;
    constexpr bool AK16 = F8 && !Prog::GATHER;
    constexpr size_t kstepA = AK16 ? (size_t)8 * Prog::AR * 16 : kstep;
    constexpr size_t hstepA = AK16 ? (size_t)HALF * 16 : hstep;
    constexpr size_t kstepB = F8 ? (size_t)8 * Prog::BN * 16 : kstep;
    constexpr size_t hstepB = F8 ? (size_t)HALF * 16 : hstep;
    const unsigned ldsw = (unsigned)wid * 1024u;
    constexpr bool AG8 = F8 && Prog::GATHER;
    const int aoff = AK16 ? (2 * (lane >> 4)) * 2048 + (wr * 64 + (lane & 15)) * 16 : AG8 ? lds_byte8(wr * 64 + (lane & 15), 2 * (lane >> 4)) : lds_byteN(wr * 64 + (lane & 15), lane >> 4);
    const int boff = F8 ? (2 * (lane >> 4)) * 2048 + (wc * 32 + (lane & 15)) * 16 : lds_byteN(wc * 32 + (lane & 15), lane >> 4);
    constexpr int ANS = AK16 ? 256 : 2048, AKS = 2048;
    const int aks8 = lds_byte8(lane & 15, 2 * (lane >> 4) + 1) - lds_byte8(lane & 15, 2 * (lane >> 4));
    const int aksN = lds_byteN(lane & 15, (lane >> 4) + 4) - lds_byteN(lane & 15, lane >> 4);
    constexpr int BNS = F8 ? 256 : 2048, BKS = 2048;
    constexpr int KOFF = F8 ? 16 : 1024;
#define MK_SA(b, h) (((b) * 2 + (h)) * HTB)
#define MK_SB(b, h) ((4 + (b) * 2 + (h)) * HTB)
#define MK_STAGE(bufoff, gbase, voff) do { _Pragma("unroll") for (int _i = 0; _i < 2; ++_i) { unsigned o_ = (voff)[_i]; asm volatile("" : "+v"(o_));     \
        __builtin_amdgcn_global_load_lds((const unsigned*)((const char*)(gbase) + o_), (LAS unsigned*)(lds + (bufoff) + ldsw + _i * 8192), 16, 0, 0); } } while (0)
#define MK_STAGE_A(bufoff, gbase, h) do { if constexpr (GA) MK_STAGE(bufoff, gbase, voC[h]); else MK_STAGE(bufoff, (gbase) + (h) * hstepA, voC[0]); } while (0)
#define MK_LDA(dst, b, h) do { _Pragma("unroll") for (int m = 0; m < 4; ++m) _Pragma("unroll") for (int k = 0; k < 2; ++k) dst[m][k] = *(const LAS bf16x8*)(lds + MK_SA(b, h) + aoff + m * ANS + k * (AK16 ? AKS : AG8 ? aks8 : aksN)); } while (0)
#define MK_LDB(dst, b, h) do { _Pragma("unroll") for (int n = 0; n < 2; ++n) _Pragma("unroll") for (int k = 0; k < 2; ++k) dst[n][k] = *(const LAS bf16x8*)(lds + MK_SB(b, h) + boff + n * BNS + k * (F8 ? BKS : aksN)); } while (0)
#define MK_CAT8(x) __builtin_shufflevector(__builtin_bit_cast(i32x4, (x)[0]), __builtin_bit_cast(i32x4, (x)[1]), 0, 1, 2, 3, 4, 5, 6, 7)
#define MK_MMA(ai, bj, At, Bt) do { __builtin_amdgcn_s_setprio(1); \
        if constexpr (F8) { _Pragma("unroll") for (int m = 0; m < 4; ++m) _Pragma("unroll") for (int n = 0; n < 2; ++n) \
            acc[ai][bj][m][n] = __builtin_amdgcn_mfma_scale_f32_16x16x128_f8f6f4(MK_CAT8(Bt[n]), MK_CAT8(At[m]), acc[ai][bj][m][n], 0, 0, 0, 0, 0, 0); } \
        else { _Pragma("unroll") for (int m = 0; m < 4; ++m) _Pragma("unroll") for (int n = 0; n < 2; ++n) _Pragma("unroll") for (int k = 0; k < 2; ++k) \
            acc[ai][bj][m][n] = __builtin_amdgcn_mfma_f32_16x16x32_bf16(Bt[n][k], At[m][k], acc[ai][bj][m][n], 0, 0, 0); } \
        __builtin_amdgcn_s_setprio(0); } while (0)
#define MK_WAIT_V(n) asm volatile("s_waitcnt vmcnt(" #n ")" ::: "memory")
#define MK_WAIT_L(n) asm volatile("s_waitcnt lgkmcnt(" #n ")" ::: "memory")
#define MK_BAR __builtin_amdgcn_s_barrier()
#define MK_SCHED __builtin_amdgcn_sched_barrier(0)
    Unit cur, nxt; int ui = 0;
    if (!P.next(0, cur)) return;
    constexpr bool GA = Prog::GATHER;
    unsigned voC[2][2];
    if constexpr (GA) P.aoffs(cur, wid, voC);
    else {
#pragma unroll
        for (int i = 0; i < 2; ++i) { if constexpr (AK16) { const int b_ = tid * 16 + i * 8192; voC[0][i] = (unsigned)(((b_ >> 11) * Prog::AR + ((b_ & 2047) >> 4)) * 16); } else { int R_, C_; stage_rcN(tid * 16 + i * 8192, R_, C_); voC[0][i] = (unsigned)(R_ * K * ESZ + C_ * 2); } voC[1][i] = 0u; }
    }
    f32x4 acc[2][2][4][2];
#pragma unroll
    for (int a = 0; a < 2; ++a)
#pragma unroll
        for (int b = 0; b < 2; ++b)
#pragma unroll
            for (int m = 0; m < 4; ++m)
#pragma unroll
                for (int n = 0; n < 2; ++n) acc[a][b][m][n] = (f32x4){0.f, 0.f, 0.f, 0.f};
    bf16x8 At[4][2], B0[2][2], B1[2][2];
    const char* cA = cur.A; const char* cB = cur.B;
    MK_STAGE(MK_SB(0, 0), cB, voffB); MK_STAGE(MK_SB(0, 1), cB + hstepB, voffB); MK_STAGE_A(MK_SA(0, 0), cA, 0); MK_STAGE_A(MK_SA(0, 1), cA, 1);
    if (wr == 1) MK_BAR;
    MK_WAIT_V(2); MK_BAR;
    MK_STAGE(MK_SB(1, 0), cB + kstepB, voffB); MK_STAGE_A(MK_SA(1, 0), cA + kstepA, 0); MK_STAGE(MK_SB(1, 1), cB + hstepB + kstepB, voffB);
    MK_WAIT_V(6); MK_BAR;
    for (;;) {
        const bool has_next = P.next(ui + 1, nxt);
        if (!has_next) nxt = cur;
        const char* nA = nxt.A; const char* nB = nxt.B;
#pragma unroll 1
        for (int t = 0; t < nt; t += 2) {
            const bool last = (t == nt - 2);
            const char* a1 = cA + (size_t)(t + 1) * kstepA;
            const char* a2 = last ? nA : cA + (size_t)(t + 2) * kstepA; const char* b2 = last ? nB : cB + (size_t)(t + 2) * kstepB;
            const char* a3 = a2 + kstepA; const char* b3 = b2 + kstepB;
            MK_LDB(B0, 0, 0); MK_LDB(B1, 0, 1); MK_SCHED; MK_LDA(At, 0, 0); MK_STAGE_A(MK_SA(1, 1), a1, 1);
            if constexpr (GA) { if (last && has_next) P.aoffs(nxt, wid, voC); }
            MK_WAIT_V(8); MK_WAIT_L(0); MK_BAR; MK_MMA(0, 0, At, B0); MK_MMA(0, 1, At, B1); MK_BAR; MK_SCHED;
            MK_LDA(At, 0, 1); MK_STAGE(MK_SB(0, 0), b2, voffB); MK_STAGE(MK_SB(0, 1), b2 + hstepB, voffB); MK_STAGE_A(MK_SA(0, 0), a2, 0);
            MK_WAIT_V(8); MK_WAIT_L(0); MK_BAR; MK_MMA(1, 0, At, B0); MK_MMA(1, 1, At, B1); MK_BAR; MK_SCHED;
            MK_LDB(B0, 1, 0); MK_LDB(B1, 1, 1); MK_SCHED; MK_LDA(At, 1, 0); MK_STAGE_A(MK_SA(0, 1), a2, 1);
            MK_WAIT_V(8); MK_WAIT_L(0); MK_BAR; MK_MMA(0, 0, At, B0); MK_MMA(0, 1, At, B1); MK_BAR; MK_SCHED;
            MK_LDA(At, 1, 1); MK_STAGE(MK_SB(1, 0), b3, voffB); MK_STAGE(MK_SB(1, 1), b3 + hstepB, voffB); MK_STAGE_A(MK_SA(1, 0), a3, 0);
            MK_WAIT_V(8); MK_WAIT_L(0); MK_BAR; MK_MMA(1, 0, At, B0); MK_MMA(1, 1, At, B1); MK_BAR; MK_SCHED;
        }
        if (wr == 0) MK_BAR;
        { const int l_ = lane_id_fresh(); P.epi(acc, cur, wr, wc, l_ & 15, l_ >> 4); }
#ifdef MK_EPI2
        if (Prog::ID == MK_EPI2) { const int l_ = lane_id_fresh(); P.epi(acc, cur, wr, wc, l_ & 15, l_ >> 4); }
#endif
        if (!has_next) break;
#pragma unroll
        for (int a = 0; a < 2; ++a)
#pragma unroll
            for (int b = 0; b < 2; ++b)
#pragma unroll
                for (int m = 0; m < 4; ++m)
#pragma unroll
                    for (int n = 0; n < 2; ++n) acc[a][b][m][n] = (f32x4){0.f, 0.f, 0.f, 0.f};
        cur = nxt; cA = nA; cB = nB; ++ui;
        if (wr == 1) MK_BAR;
    }
    MK_WAIT_V(0);
    MK_BAR;
#undef MK_SA
#undef MK_SB
#undef MK_STAGE
#undef MK_STAGE_A
#undef MK_LDA
#undef MK_LDB
#undef MK_MMA
#undef MK_CAT8
}
typedef f32x4 Acc[2][2][4][2];

#define XB_TMO      128
#define XB_XCNT(j)  (256  + 64 * (j))
#define XB_XSUB(j)  (1280 + 64 * (j))
#define XB_XGEN(j)  (2304 + 64 * (j))
#define XB_TOP      3328
#define XB_TOPGEN   3392
#define XCD_BAR_WORDS 3456
#define XB_SPIN_CAP (1u << 18)
__device__ __forceinline__ unsigned xb_ld(unsigned* p)              { return __hip_atomic_load(p, __ATOMIC_RELAXED, __HIP_MEMORY_SCOPE_AGENT); }
__device__ __forceinline__ unsigned xb_add(unsigned* p, unsigned v) { return __hip_atomic_fetch_add(p, v, __ATOMIC_RELAXED, __HIP_MEMORY_SCOPE_AGENT); }
__device__ __forceinline__ unsigned xb_xcc_id() { return (unsigned)__builtin_amdgcn_s_getreg((3 << 11) | 20) & 0xFu; }
#define XB_SPIN(cond, bar) do { unsigned _sp = 0; while (cond) { __builtin_amdgcn_s_sleep(1); \
    if ((++_sp & 255u) == 0u) { if (xb_ld(&(bar)[XB_TMO])) break; if (_sp > XB_SPIN_CAP) { atomicAdd(&(bar)[XB_TMO], 1u); break; } } } } while (0)
struct XcdBarrier { unsigned* bar; unsigned x; volatile LAS unsigned* st; };
__device__ __forceinline__ XcdBarrier xcd_barrier_post(unsigned* bar, volatile LAS unsigned* st) {
    XcdBarrier b; b.bar = bar; b.x = xb_xcc_id(); b.st = st;
    if (threadIdx.x == 0) (void)xb_add(&bar[XB_XCNT(b.x)], 1u);
    return b;
}
__device__ __forceinline__ void xcd_barrier_complete(unsigned* bar, unsigned x, unsigned& nloc, unsigned& nx) {
    const unsigned G = gridDim.x * gridDim.y * gridDim.z;
    unsigned sum, cnt, mine, sp = 0u;
    for (;;) {
        sum = 0u; cnt = 0u; mine = 0u;
#pragma unroll
        for (unsigned j = 0; j < 16; ++j) { const unsigned c = xb_ld(&bar[XB_XCNT(j)]); sum += c; cnt += (c > 0u) ? 1u : 0u; mine = (j == x) ? c : mine; }
        if (sum == G) break;
        __builtin_amdgcn_s_sleep(1);
        if ((++sp & 255u) == 0u) { if (xb_ld(&bar[XB_TMO])) break; if (sp > XB_SPIN_CAP) { atomicAdd(&bar[XB_TMO], 1u); break; } }
    }
    nloc = mine > 0u ? mine : 1u; nx = cnt > 0u ? cnt : 1u;
}
__device__ __forceinline__ void xcd_barrier(const XcdBarrier& b, int wave) {
    asm volatile("s_waitcnt vmcnt(0)" ::: "memory");
    __syncthreads();
    if (wave == 0 && lane_id() == 0) {
        unsigned* bar = b.bar;
        __builtin_amdgcn_s_waitcnt(0);
        unsigned nloc = b.st[0], nx = b.st[1];
        if (nloc == 0u) { xcd_barrier_complete(bar, b.x, nloc, nx); b.st[0] = nloc; b.st[1] = nx; }
        const unsigned old = xb_add(&bar[XB_XSUB(b.x)], 1u);
        const unsigned gen = old / nloc;
        if (old + 1u == (gen + 1u) * nloc) {
            __builtin_amdgcn_fence(__ATOMIC_RELEASE, "agent");
            asm volatile("s_waitcnt vmcnt(0)" ::: "memory");
            const unsigned og = xb_add(&bar[XB_TOP], 1u);
            const unsigned tg = og / nx;
            if (og + 1u == (tg + 1u) * nx) xb_add(&bar[XB_TOPGEN], 1u);
            else XB_SPIN(xb_ld(&bar[XB_TOPGEN]) == tg, bar);
            __builtin_amdgcn_fence(__ATOMIC_ACQUIRE, "agent");
            xb_add(&bar[XB_XGEN(b.x)], 1u);
            asm volatile("s_waitcnt vmcnt(0)" ::: "memory");
        } else {
            XB_SPIN(xb_ld(&bar[XB_XGEN(b.x)]) == gen, bar);
            __builtin_amdgcn_fence(__ATOMIC_ACQUIRE, "agent");
            asm volatile("s_waitcnt vmcnt(0)" ::: "memory");
        }
    }
    __syncthreads();
}

struct Args {
    const float* in[18]; float* out; unsigned char* ws; int ph_lo, ph_hi;
};
#define CAS __attribute__((address_space(4)))
struct Frame {
    LAS unsigned char* lds; int tid, lane, wave, vcu, G;
    const CAS Args* ka;
    __device__ __forceinline__ const float* inp(int k) const { return ka->in[k]; }
    __device__ __forceinline__ unsigned char* ws() const { return ka->ws; }
    __device__ __forceinline__ float* out() const { return ka->out; }
    __device__ __forceinline__ const float* x() const { return inp(0); }
    __device__ __forceinline__ const float* norm1_w() const { return inp(1); }
    __device__ __forceinline__ const float* w_in() const { return inp(2); }
    __device__ __forceinline__ const float* sgu_norm_w() const { return inp(3); }
    __device__ __forceinline__ const float* sgu_w() const { return inp(4); }
    __device__ __forceinline__ const float* sgu_b() const { return inp(5); }
    __device__ __forceinline__ const float* q_norm_w() const { return inp(6); }
    __device__ __forceinline__ const float* k_norm_w() const { return inp(7); }
    __device__ __forceinline__ const float* out_norm_a_w() const { return inp(8); }
    __device__ __forceinline__ const float* out_norm_b_w() const { return inp(9); }
    __device__ __forceinline__ const float* w_out() const { return inp(10); }
    __device__ __forceinline__ const float* norm2_w() const { return inp(11); }
    __device__ __forceinline__ const float* router_w() const { return inp(12); }
    __device__ __forceinline__ const float* router_b() const { return inp(13); }
    __device__ __forceinline__ const float* w_gate_up() const { return inp(14); }
    __device__ __forceinline__ const float* b_gate_up() const { return inp(15); }
    __device__ __forceinline__ const float* w_down() const { return inp(16); }
    __device__ __forceinline__ const float* b_down() const { return inp(17); }
    __device__ __forceinline__ bf16_t* XB() const { return (bf16_t*)(ws() + WS_XB); }
    __device__ __forceinline__ bf16_t* WIN() const { return (bf16_t*)(ws() + WS_WIN); }
    __device__ __forceinline__ bf16_t* WOUT() const { return (bf16_t*)(ws() + WS_WOUT); }
    __device__ __forceinline__ bf16_t* UV() const { return (bf16_t*)(ws() + WS_UV); }
    __device__ __forceinline__ bf16_t* Q() const { return (bf16_t*)(ws() + WS_Q); }
    __device__ __forceinline__ bf16_t* K() const { return (bf16_t*)(ws() + WS_K); }
    __device__ __forceinline__ bf16_t* VT() const { return (bf16_t*)(ws() + WS_VT); }
    __device__ __forceinline__ bf16_t* Y() const { return (bf16_t*)(ws() + WS_Y); }
    __device__ __forceinline__ unsigned char* YS() const { return ws() + WS_YS; }
    __device__ __forceinline__ bf16_t* RT() const { return (bf16_t*)(ws() + WS_RT); }
    __device__ __forceinline__ unsigned char* HB() const { return ws() + WS_HB; }
    __device__ __forceinline__ unsigned char* WGU() const { return ws() + WS_WGU; }
    __device__ __forceinline__ unsigned char* WD() const { return ws() + WS_WD; }
    __device__ __forceinline__ unsigned char* ACT() const { return ws() + WS_ACT; }
    __device__ __forceinline__ float* RSTD1() const { return (float*)(ws() + WS_RSTD1); }
    __device__ __forceinline__ float* SSPART() const { return (float*)(ws() + WS_SSPART); }
    __device__ __forceinline__ float* LISTGATE() const { return (float*)(ws() + WS_LISTGATE); }
    __device__ __forceinline__ int* LISTTOK() const { return (int*)(ws() + WS_LISTTOK); }
    __device__ __forceinline__ int* TOKINFO() const { return (int*)(ws() + WS_TOKINFO); }
    __device__ __forceinline__ unsigned* ctl() const { return (unsigned*)(ws() + WS_CTL); }
};

__device__ __forceinline__ void p0_transpose_item(const float* W, int K, int N, bf16_t* WT, int k0, int n0, int drow0, const float* kscale, LAS float* scr, int lane) {
#pragma unroll 8
    for (int i = 0; i < 32; ++i) { const int kk = 2 * i + (lane >> 5); float v = W[(size_t)(k0 + kk) * N + n0 + (lane & 31)]; if (kscale) v *= kscale[k0 + kk]; scr[kk * 33 + (lane & 31)] = v; }
    asm volatile("s_waitcnt lgkmcnt(0)" ::: "memory");
    const int c = lane & 7;
#pragma unroll
    for (int j = 0; j < 4; ++j) { const int n = (lane >> 3) + 8 * j; const LAS float* s = scr + (8 * c) * 33 + n;
        u32x4 o; o.x = cvt_pk_bf16(s[0 * 33], s[1 * 33]); o.y = cvt_pk_bf16(s[2 * 33], s[3 * 33]); o.z = cvt_pk_bf16(s[4 * 33], s[5 * 33]); o.w = cvt_pk_bf16(s[6 * 33], s[7 * 33]);
        *(u32x4*)(WT + (size_t)(drow0 + n) * K + k0 + 8 * c) = o; }
    asm volatile("s_waitcnt lgkmcnt(0)" ::: "memory");
}
__device__ __forceinline__ void p0_transpose_item_f8(const float* W, int K, int N, unsigned char* WT, int k0, int n0, LAS float* scr, int lane) {
#pragma unroll 8
    for (int i = 0; i < 32; ++i) { const int kk = 2 * i + (lane >> 5); scr[kk * 33 + (lane & 31)] = W[(size_t)(k0 + kk) * N + n0 + (lane & 31)] * WSCALE; }
    asm volatile("s_waitcnt lgkmcnt(0)" ::: "memory");
    const int c = lane & 7;
#pragma unroll
    for (int j = 0; j < 4; ++j) { const int n = (lane >> 3) + 8 * j; const LAS float* s = scr + (8 * c) * 33 + n;
        u32x2 o; o.x = pk4_fp8(s[0 * 33], s[1 * 33], s[2 * 33], s[3 * 33]); o.y = pk4_fp8(s[4 * 33], s[5 * 33], s[6 * 33], s[7 * 33]);
        *(u32x2*)(WT + (size_t)(n0 + n) * K + k0 + 8 * c) = o; }
    asm volatile("s_waitcnt lgkmcnt(0)" ::: "memory");
}
__device__ __forceinline__ int win_drow(int n0) {
    if (n0 < 1024 || n0 >= 2048) return n0;
    const int rel = n0 - 1024, isk = rel >> 9, head = (rel & 511) >> 6, dh = (rel & 63) >> 5;
    return 256 * (4 + 2 * isk + (head >> 2)) + 128 * dh + 32 * (head & 3);
}
constexpr int MOE_I_GU = 64 * 32, MOE_I_D = 64 * 16, MOE_ITEMS = NE * (MOE_I_GU + MOE_I_D);
struct ConvItem { const float* src; unsigned char* dst; int N; };
__device__ __forceinline__ ConvItem moe_conv_decode(const Frame& F, int it) {
    ConvItem c;
    if (it < NE * MOE_I_GU) { const int e = it / MOE_I_GU, q = it % MOE_I_GU, k16 = q >> 5, n64 = q & 31; c.N = 2048;
        c.src = F.w_gate_up() + (size_t)e * KD * 2048 + (size_t)(16 * k16) * 2048 + 64 * n64; c.dst = F.WGU() + (size_t)e * 2048 * KD + ((size_t)k16 * 2048 + 64 * n64) * 16; }
    else { const int r = it - NE * MOE_I_GU; const int e = r / MOE_I_D, q = r % MOE_I_D, k16 = q >> 4, n64 = q & 15; c.N = 1024;
        c.src = F.w_down() + (size_t)e * KD * 1024 + (size_t)(16 * k16) * 1024 + 64 * n64; c.dst = F.WD() + (size_t)e * 1024 * KD + ((size_t)k16 * 1024 + 64 * n64) * 16; }
    return c;
}
__device__ __forceinline__ void moe_conv_issue(const ConvItem& c, float (&v)[16], int lane) {
    const float* p = c.src + lane;
#pragma unroll
    for (int i = 0; i < 16; ++i) v[i] = __builtin_nontemporal_load(p + (size_t)i * c.N);
}
__device__ __forceinline__ void moe_conv_finish(const ConvItem& c, const float (&v)[16], LAS float*, int lane) {
    u32x4 o;
    o.x = pk4_fp8(v[0] * WSCALE, v[1] * WSCALE, v[2] * WSCALE, v[3] * WSCALE); o.y = pk4_fp8(v[4] * WSCALE, v[5] * WSCALE, v[6] * WSCALE, v[7] * WSCALE);
    o.z = pk4_fp8(v[8] * WSCALE, v[9] * WSCALE, v[10] * WSCALE, v[11] * WSCALE); o.w = pk4_fp8(v[12] * WSCALE, v[13] * WSCALE, v[14] * WSCALE, v[15] * WSCALE);
    *(u32x4*)(c.dst + (size_t)lane * 16) = o;
}
constexpr int CONV_P4_PER_WAVE = 56, CONV_P4_ITEMS = CONV_P4_PER_WAVE * 1024;
constexpr int CONV_G_PER_UNIT = 3, CONV_G_ITEMS = CONV_G_PER_UNIT * 4 * 2048;
constexpr int CONV_P2_ITEMS = MOE_ITEMS - CONV_P4_ITEMS - CONV_G_ITEMS, CONV_P2_PER_WAVE = CONV_P2_ITEMS / 2048;
static_assert(CONV_P2_ITEMS % 2048 == 0 && CONV_P4_PER_WAVE % 2 == 0, "conversion split");
__device__ __forceinline__ void p0_prologue(Frame& F) {
    LAS float* scr = (LAS float*)(F.lds + F.wave * 16384);
    const int gw = F.vcu * NWAVES + F.wave, NGW = F.G * NWAVES, lane = F.lane;
    for (int m = gw; m < NTOK; m += 2 * NGW) {
        const int m2 = m + NGW;
        const f32x4* xr = (const f32x4*)(F.x() + (size_t)m * DM) + lane; const f32x4* xr2 = (const f32x4*)(F.x() + (size_t)m2 * DM) + lane; f32x4 v[4], w[4]; float s = 0.f, s2 = 0.f;
#pragma unroll
        for (int j = 0; j < 4; ++j) v[j] = __builtin_nontemporal_load(xr + 64 * j);
#pragma unroll
        for (int j = 0; j < 4; ++j) w[j] = __builtin_nontemporal_load(xr2 + 64 * j);
#pragma unroll
        for (int j = 0; j < 4; ++j) { s += (v[j].x * v[j].x + v[j].y * v[j].y) + (v[j].z * v[j].z + v[j].w * v[j].w); s2 += (w[j].x * w[j].x + w[j].y * w[j].y) + (w[j].z * w[j].z + w[j].w * w[j].w); }
        const float tot = wave_sum(s), tot2 = wave_sum(s2);
        if (lane == 0) { F.RSTD1()[m] = 1.0f / sqrtf(tot * (1.0f / DM) + EPS); F.RSTD1()[m2] = 1.0f / sqrtf(tot2 * (1.0f / DM) + EPS); }
        u32x2* o8 = (u32x2*)(F.XB() + (size_t)m * DM) + lane; u32x2* o82 = (u32x2*)(F.XB() + (size_t)m2 * DM) + lane;
#pragma unroll
        for (int j = 0; j < 4; ++j) { u32x2 a; a.x = cvt_pk_bf16(v[j].x, v[j].y); a.y = cvt_pk_bf16(v[j].z, v[j].w); o8[64 * j] = a; u32x2 b; b.x = cvt_pk_bf16(w[j].x, w[j].y); b.y = cvt_pk_bf16(w[j].z, w[j].w); o82[64 * j] = b; }
    }
    constexpr int I_IN = 16 * 80, I_OUT = 16 * 32;
    for (int it = gw; it < I_IN + I_OUT; it += NGW) {
        int r = it;
        if (r < I_IN) { const int kb = r / 80, nb = r % 80; p0_transpose_item(F.w_in(), KD, 2560, F.WIN(), 64 * kb, 32 * nb, win_drow(32 * nb), F.norm1_w(), scr, lane); continue; } r -= I_IN;
        { const int kb = r / 32, nb = r % 32; p0_transpose_item(F.w_out(), KD, 1024, F.WOUT(), 64 * kb, 32 * nb, 32 * nb, nullptr, scr, lane); }
    }
    for (int idx = gw * 64 + lane; idx < NE * KD; idx += NGW * 64) {
        const int e = idx >> 10, k = idx & 1023; const float w = F.router_w()[(size_t)k * NE + e];
        const unsigned hi = cvt_pk_bf16(w, 0.f) & 0xffffu; const float rem = w - __uint_as_float(hi << 16);
        F.RT()[idx] = (bf16_t)hi; F.RT()[NE * KD + idx] = (bf16_t)(cvt_pk_bf16(rem, 0.f) & 0xffffu);
    }
}

struct ProgIn {
    static constexpr bool GATHER = false, FP8 = false; static constexpr int ID = 1, BN = 0, AR = 0;
    const Frame* F;
    __device__ __forceinline__ bool next(int i, Unit& u) const {
        const int v = F->vcu;
        if (i < 4) { const int uu = i * 256 + v, grp = uu >> 5, w = uu & 31; u.pm = grp * 4 + (w & 3); u.pn = w >> 2; u.kind = u.pn < 4 ? 0 : 1;
            u.A = (const char*)(F->XB() + (size_t)u.pm * 256 * KD); u.B = (const char*)(F->WIN() + (size_t)u.pn * 256 * KD); u.e = 0; u.r0 = 0; return true; }
        if (i == 4) { u.kind = 2; u.pm = v & 1; u.pn = v >> 1; u.A = (const char*)(F->WIN() + (size_t)(2048 + u.pm * 256) * KD); u.B = (const char*)(F->XB() + (size_t)u.pn * 256 * KD); u.e = 0; u.r0 = 0; return true; }
        return false;
    }
    __device__ __forceinline__ void epi(const Acc& acc, const Unit& u, int wr, int wc, int fr, int fq) const {
        asm volatile("" : "+v"(fr), "+v"(fq));
        if (u.kind == 2) {
            const int tk0 = u.pn * 256 + wc * 32 + 8 * fq;
            f32x4 rs[2][2];
#pragma unroll
            for (int bj = 0; bj < 2; ++bj)
#pragma unroll
                for (int n = 0; n < 2; ++n) rs[bj][n] = *(const f32x4*)(F->RSTD1() + tk0 + bj * 128 + 4 * n);
#pragma unroll
            for (int ai = 0; ai < 2; ++ai)
#pragma unroll
                for (int m = 0; m < 4; ++m) { const int cp = u.pm * 256 + ai * 128 + wr * 64 + m * 16 + fr; bf16_t* rowp = F->VT() + (size_t)cp * NTOK + tk0;
#pragma unroll
                    for (int bj = 0; bj < 2; ++bj) { const f32x4 v0 = acc[ai][bj][m][0] * rs[bj][0], v1 = acc[ai][bj][m][1] * rs[bj][1];
                        u32x4 w; w.x = cvt_pk_bf16(v0[0], v0[1]); w.y = cvt_pk_bf16(v0[2], v0[3]); w.z = cvt_pk_bf16(v1[0], v1[1]); w.w = cvt_pk_bf16(v1[2], v1[3]);
                        *(u32x4*)(rowp + bj * 128) = w; } }
            return;
        }
        float rsr[2][4];
#pragma unroll
        for (int ai = 0; ai < 2; ++ai)
#pragma unroll
            for (int m = 0; m < 4; ++m) rsr[ai][m] = F->RSTD1()[u.pm * 256 + ai * 128 + wr * 64 + m * 16 + fr];
        if (u.kind == 0) {
#pragma unroll
            for (int ai = 0; ai < 2; ++ai)
#pragma unroll
                for (int m = 0; m < 4; ++m) { const int r = u.pm * 256 + ai * 128 + wr * 64 + m * 16 + fr; bf16_t* rowp = F->UV() + (size_t)r * 1024 + u.pn * 256 + wc * 32 + 8 * fq; const float rs = rsr[ai][m];
#pragma unroll
                    for (int bj = 0; bj < 2; ++bj) { f32x4 v0 = acc[ai][bj][m][0] * rs, v1 = acc[ai][bj][m][1] * rs;
#pragma unroll
                        for (int j = 0; j < 4; ++j) { v0[j] = gelu_tanh_f(v0[j]); v1[j] = gelu_tanh_f(v1[j]); }
                        u32x4 w; w.x = cvt_pk_bf16(v0[0], v0[1]); w.y = cvt_pk_bf16(v0[2], v0[3]); w.z = cvt_pk_bf16(v1[0], v1[1]); w.w = cvt_pk_bf16(v1[2], v1[3]);
                        *(u32x4*)(rowp + bj * 128) = w; } }
            return;
        }
        {
            const int isk = (u.pn - 4) >> 1, head = 4 * (u.pn & 1) + wc; const float* nw = isk ? F->k_norm_w() : F->q_norm_w(); bf16_t* dst = isk ? F->K() : F->Q();
            const float osc = isk ? 1.0f : QSCALE;
            f32x4 nwv[2][2];
#pragma unroll
            for (int bj = 0; bj < 2; ++bj)
#pragma unroll
                for (int n = 0; n < 2; ++n) nwv[bj][n] = *(const f32x4*)(nw + 32 * bj + 8 * fq + 4 * n);
#pragma unroll
            for (int ai = 0; ai < 2; ++ai)
#pragma unroll
                for (int m = 0; m < 4; ++m) { const int r = u.pm * 256 + ai * 128 + wr * 64 + m * 16 + fr; const float rs = rsr[ai][m];
                    f32x4 t[2][2]; float ss = 0.f;
#pragma unroll
                    for (int bj = 0; bj < 2; ++bj)
#pragma unroll
                        for (int n = 0; n < 2; ++n) { t[bj][n] = acc[ai][bj][m][n] * rs; ss += (t[bj][n][0] * t[bj][n][0] + t[bj][n][1] * t[bj][n][1]) + (t[bj][n][2] * t[bj][n][2] + t[bj][n][3] * t[bj][n][3]); }
                    ss += __shfl_xor(ss, 16); ss += __shfl_xor(ss, 32);
                    const float rn = osc / sqrtf(ss * (1.0f / 64.0f) + EPS);
                    bf16_t* rowp = dst + (size_t)r * 512 + head * 64 + 8 * fq;
#pragma unroll
                    for (int bj = 0; bj < 2; ++bj) { const f32x4 v0 = t[bj][0] * nwv[bj][0] * rn, v1 = t[bj][1] * nwv[bj][1] * rn;
                        u32x4 w; w.x = cvt_pk_bf16(v0[0], v0[1]); w.y = cvt_pk_bf16(v0[2], v0[3]); w.z = cvt_pk_bf16(v1[0], v1[1]); w.w = cvt_pk_bf16(v1[2], v1[3]);
                        *(u32x4*)(rowp + bj * 32) = w; } }
        }
    }
};

constexpr int VN_PITCH = 136, YT_PITCH = 132, YT_OFF = 36864;
__device__ __forceinline__ void gmlp_unit(const Frame& F, int chunk, int g, int cbase) {
    const int tid = F.tid, lane = F.lane, wid = F.wave;
    ConvItem gci[CONV_G_PER_UNIT]; float gcv[CONV_G_PER_UNIT][16];
#pragma unroll
    for (int q = 0; q < CONV_G_PER_UNIT; ++q) { gci[q] = moe_conv_decode(F, cbase + q * 2048); moe_conv_issue(gci[q], gcv[q], lane); }
    LAS bf16_t* vn = (LAS bf16_t*)F.lds; LAS float* yt = (LAS float*)(F.lds + YT_OFF);
    const size_t tok0 = (size_t)chunk * 128;
    {
        const int row = tid >> 2, qd = tid & 3; const bf16_t* src = F.UV() + (tok0 + row) * 1024 + 512 + g * 128 + qd * 32;
        u32x4 w[4]; float v[32]; float ss = 0.f;
#pragma unroll
        for (int i = 0; i < 4; ++i) w[i] = *(const u32x4*)(src + 8 * i);
#pragma unroll
        for (int i = 0; i < 4; ++i)
#pragma unroll
            for (int j = 0; j < 4; ++j) { v[8 * i + 2 * j] = bflo(w[i][j]); v[8 * i + 2 * j + 1] = bfhi(w[i][j]); }
#pragma unroll
        for (int i = 0; i < 32; ++i) ss += v[i] * v[i];
        ss += __shfl_xor(ss, 1); ss += __shfl_xor(ss, 2);
        const float rs = 1.0f / sqrtf(ss * (1.0f / 128.0f) + EPS);
        const float* nw = F.sgu_norm_w() + g * 128 + qd * 32;
#pragma unroll
        for (int i = 0; i < 4; ++i) { const f32x4 n0 = *(const f32x4*)(nw + 8 * i), n1 = *(const f32x4*)(nw + 8 * i + 4);
            u32x4 o; o.x = cvt_pk_bf16(v[8 * i] * rs * n0[0], v[8 * i + 1] * rs * n0[1]); o.y = cvt_pk_bf16(v[8 * i + 2] * rs * n0[2], v[8 * i + 3] * rs * n0[3]);
            o.z = cvt_pk_bf16(v[8 * i + 4] * rs * n1[0], v[8 * i + 5] * rs * n1[1]); o.w = cvt_pk_bf16(v[8 * i + 6] * rs * n1[2], v[8 * i + 7] * rs * n1[3]);
            *(LAS u32x4*)(vn + row * VN_PITCH + qd * 32 + 8 * i) = o; }
    }
    __syncthreads();
    {
        const int tb = wid >> 1, cb0 = 2 * (wid & 1), r32 = lane & 31, hh = lane >> 5;
        f32x16 a0 = {}, a1 = {};
        const int t = 32 * tb + r32; const float* wrow = F.sgu_w() + ((size_t)g * 128 + t) * 128;
        for (int ks = 0; ks < 2 * (tb + 1); ++ks) {
            const int s0 = 16 * ks + 8 * hh;
            const f32x4 w0 = *(const f32x4*)(wrow + s0), w1 = *(const f32x4*)(wrow + s0 + 4);
            float wv[8] = {w0[0], w0[1], w0[2], w0[3], w1[0], w1[1], w1[2], w1[3]};
#pragma unroll
            for (int j = 0; j < 8; ++j) if (s0 + j > t) wv[j] = 0.f;
            u32x4 aw; aw.x = cvt_pk_bf16(wv[0], wv[1]); aw.y = cvt_pk_bf16(wv[2], wv[3]); aw.z = cvt_pk_bf16(wv[4], wv[5]); aw.w = cvt_pk_bf16(wv[6], wv[7]);
            const bf16x8 af = __builtin_bit_cast(bf16x8, aw);
            bf16x8 b0, b1;
#pragma unroll
            for (int j = 0; j < 8; ++j) { b0[j] = (short)vn[(s0 + j) * VN_PITCH + 32 * cb0 + r32]; b1[j] = (short)vn[(s0 + j) * VN_PITCH + 32 * (cb0 + 1) + r32]; }
            a0 = __builtin_amdgcn_mfma_f32_32x32x16_bf16(af, b0, a0, 0, 0, 0);
            a1 = __builtin_amdgcn_mfma_f32_32x32x16_bf16(af, b1, a1, 0, 0, 0);
        }
#pragma unroll
        for (int reg = 0; reg < 16; ++reg) {
            const int tt = 32 * tb + (reg & 3) + 8 * (reg >> 2) + 4 * hh; const float bb = F.sgu_b()[g * 128 + tt];
            const bf16_t* up = F.UV() + (tok0 + tt) * 1024 + g * 128;
            const int c0 = 32 * cb0 + r32, c1 = c0 + 32;
            yt[tt * YT_PITCH + c0] = bf2f(up[c0]) * (a0[reg] + bb);
            yt[tt * YT_PITCH + c1] = bf2f(up[c1]) * (a1[reg] + bb);
        }
    }
    __syncthreads();
    {
        const int row = tid >> 2, qd = tid & 3; const LAS float* src = yt + row * YT_PITCH + qd * 32; f32x4 v[8]; float ss = 0.f;
#pragma unroll
        for (int i = 0; i < 8; ++i) { v[i] = *(const LAS f32x4*)(src + 4 * i); ss += (v[i][0] * v[i][0] + v[i][1] * v[i][1]) + (v[i][2] * v[i][2] + v[i][3] * v[i][3]); }
        ss += __shfl_xor(ss, 1); ss += __shfl_xor(ss, 2);
        const float rs = 1.0f / sqrtf(ss * (1.0f / 128.0f) + EPS);
        const float* nw = F.out_norm_a_w() + g * 128 + qd * 32; bf16_t* dst = F.Y() + (tok0 + row) * 1024 + g * 128 + qd * 32;
#pragma unroll
        for (int i = 0; i < 4; ++i) { const f32x4 n0 = *(const f32x4*)(nw + 8 * i), n1 = *(const f32x4*)(nw + 8 * i + 4); const f32x4 x0 = v[2 * i] * n0 * rs, x1 = v[2 * i + 1] * n1 * rs;
            u32x4 o; o.x = cvt_pk_bf16(x0[0], x0[1]); o.y = cvt_pk_bf16(x0[2], x0[3]); o.z = cvt_pk_bf16(x1[0], x1[1]); o.w = cvt_pk_bf16(x1[2], x1[3]);
            *(u32x4*)(dst + 8 * i) = o; }
    }
#pragma unroll
    for (int q = 0; q < CONV_G_PER_UNIT; ++q) moe_conv_finish(gci[q], gcv[q], nullptr, lane);
    __syncthreads();
}

__device__ __forceinline__ void attn_wave_unit(const Frame& F, int b, int h, int qblk, int& cit, int cend, LAS float* scr) {
    const int lane = F.lane, r32 = lane & 31, hi = lane >> 5;
    const size_t tokq = (size_t)b * SEQ + 32 * qblk + r32;
    bf16x8 qr[4];
#pragma unroll
    for (int d0 = 0; d0 < 4; ++d0) qr[d0] = *(const bf16x8*)(F.Q() + tokq * 512 + h * 64 + 16 * d0 + 8 * hi);
    f32x16 o0 = {}, o1 = {};
    float carry = 0.f;
    const bf16_t* Kb = F.K() + ((size_t)b * SEQ + r32) * 512 + h * 64 + 8 * hi;
    const bf16_t* V0 = F.VT() + (size_t)(h * 64 + r32) * NTOK + (size_t)b * SEQ + 4 * hi;
    bf16x8 kf[4]; s16x4 vf[2][2][2];
    auto load_tile = [&](int j, bf16x8 (&kk)[4], s16x4 (&vv)[2][2][2]) {
#pragma unroll
        for (int d0 = 0; d0 < 4; ++d0) kk[d0] = *(const bf16x8*)(Kb + (size_t)(32 * j) * 512 + 16 * d0);
#pragma unroll
        for (int dh = 0; dh < 2; ++dh)
#pragma unroll
            for (int ks = 0; ks < 2; ++ks) { const bf16_t* p = V0 + (size_t)dh * 32 * NTOK + 32 * j + 16 * ks; vv[dh][ks][0] = *(const s16x4*)p; vv[dh][ks][1] = *(const s16x4*)(p + 8); }
    };
    load_tile(qblk, kf, vf);
    for (int j = qblk; j >= 0; --j) {
        bf16x8 kn[4]; s16x4 vn2[2][2][2];
        const bool cv = cit < cend; ConvItem citem; float cvv[16];
        if (cv) { citem = moe_conv_decode(F, cit); moe_conv_issue(citem, cvv, lane); cit += 2048; }
        const bool cv2 = cit < cend; ConvItem citem2; float cvw[16];
        if (cv2) { citem2 = moe_conv_decode(F, cit); moe_conv_issue(citem2, cvw, lane); cit += 2048; }
        if (j > 0) load_tile(j - 1, kn, vn2);
        else {
#pragma unroll
            for (int d0 = 0; d0 < 4; ++d0) kn[d0] = kf[d0];
#pragma unroll
            for (int dh = 0; dh < 2; ++dh)
#pragma unroll
                for (int ks = 0; ks < 2; ++ks) { vn2[dh][ks][0] = vf[dh][ks][0]; vn2[dh][ks][1] = vf[dh][ks][1]; }
        }
        f32x16 s = {};
#pragma unroll
        for (int d0 = 0; d0 < 4; ++d0) s = __builtin_amdgcn_mfma_f32_32x32x16_bf16(kf[d0], qr[d0], s, 0, 0, 0);
        float sp[16];
        const bool diag = (j == qblk);
#pragma unroll
        for (int r = 0; r < 16; ++r) {
            const int kvl = (r & 3) + 8 * (r >> 2) + 4 * hi;
            const float z = s[r];
            float v = fmaxf(z, 0.f) + __builtin_amdgcn_logf(1.0f + __builtin_amdgcn_exp2f(-fabsf(z)));
            if (diag && kvl >= r32) v = 0.f;
            sp[r] = v;
        }
        float G[4], Gp[4];
#pragma unroll
        for (int k = 0; k < 4; ++k) { G[k] = (sp[4 * k] + sp[4 * k + 1]) + (sp[4 * k + 2] + sp[4 * k + 3]); Gp[k] = __shfl_xor(G[k], 32); }
        const float T3 = G[3] + Gp[3], T2 = G[2] + Gp[2], T1 = G[1] + Gp[1], T0 = G[0] + Gp[0];
        float off[4];
        off[3] = 0.f; off[2] = T3; off[1] = T3 + T2; off[0] = T3 + T2 + T1;
        const float tile_total = off[0] + T0;
#pragma unroll
        for (int k = 0; k < 4; ++k) off[k] += carry + (hi == 0 ? Gp[k] : 0.f);
        float a[16];
#pragma unroll
        for (int k = 0; k < 4; ++k) {
            float c = off[k];
#pragma unroll
            for (int i = 3; i >= 0; --i) { const int r = 4 * k + i; c += sp[r]; float av = __builtin_amdgcn_exp2f(s[r] - c);
                if (diag && ((r & 3) + 8 * (r >> 2) + 4 * hi) >= r32) av = 0.f;
                a[r] = av; }
        }
        carry += tile_total;
        u32x4 p0, p1;
        p0.x = cvt_pk_bf16(a[0], a[1]); p0.y = cvt_pk_bf16(a[2], a[3]); p0.z = cvt_pk_bf16(a[4], a[5]); p0.w = cvt_pk_bf16(a[6], a[7]);
        p1.x = cvt_pk_bf16(a[8], a[9]); p1.y = cvt_pk_bf16(a[10], a[11]); p1.z = cvt_pk_bf16(a[12], a[13]); p1.w = cvt_pk_bf16(a[14], a[15]);
        const bf16x8 pf0 = __builtin_bit_cast(bf16x8, p0), pf1 = __builtin_bit_cast(bf16x8, p1);
#define MK_VF(dh, ks) (bf16x8){vf[dh][ks][0][0], vf[dh][ks][0][1], vf[dh][ks][0][2], vf[dh][ks][0][3], vf[dh][ks][1][0], vf[dh][ks][1][1], vf[dh][ks][1][2], vf[dh][ks][1][3]}
        o0 = __builtin_amdgcn_mfma_f32_32x32x16_bf16(MK_VF(0, 0), pf0, o0, 0, 0, 0);
        o0 = __builtin_amdgcn_mfma_f32_32x32x16_bf16(MK_VF(0, 1), pf1, o0, 0, 0, 0);
        o1 = __builtin_amdgcn_mfma_f32_32x32x16_bf16(MK_VF(1, 0), pf0, o1, 0, 0, 0);
        o1 = __builtin_amdgcn_mfma_f32_32x32x16_bf16(MK_VF(1, 1), pf1, o1, 0, 0, 0);
#undef MK_VF
        if (cv) moe_conv_finish(citem, cvv, scr, lane);
        if (cv2) moe_conv_finish(citem2, cvw, scr, lane);
        if (__all(carry > SB_THR)) break;
#pragma unroll
        for (int d0 = 0; d0 < 4; ++d0) kf[d0] = kn[d0];
#pragma unroll
        for (int dh = 0; dh < 2; ++dh)
#pragma unroll
            for (int ks = 0; ks < 2; ++ks) { vf[dh][ks][0] = vn2[dh][ks][0]; vf[dh][ks][1] = vn2[dh][ks][1]; }
    }
    float ss = 0.f;
#pragma unroll
    for (int r = 0; r < 16; ++r) ss += o0[r] * o0[r] + o1[r] * o1[r];
    ss += __shfl_xor(ss, 32);
    const float rs = 1.0f / sqrtf(ss * (1.0f / 64.0f) + EPS);
    const float* nw = F.out_norm_b_w() + h * 64 + 4 * hi; bf16_t* dst = F.Y() + tokq * 1024 + 512 + h * 64 + 4 * hi;
#pragma unroll
    for (int dh = 0; dh < 2; ++dh)
#pragma unroll
        for (int g = 0; g < 4; ++g) { const f32x4 w = *(const f32x4*)(nw + 32 * dh + 8 * g); const f32x16& o = dh ? o1 : o0;
            u32x2 pk; pk.x = cvt_pk_bf16(o[4 * g] * rs * w[0], o[4 * g + 1] * rs * w[1]); pk.y = cvt_pk_bf16(o[4 * g + 2] * rs * w[2], o[4 * g + 3] * rs * w[3]);
            *(u32x2*)(dst + 32 * dh + 8 * g) = pk; }
}
__device__ __forceinline__ void p2_mixers(Frame& F) {
    for (int i = 0; i < 4; ++i) { const int u = i * 256 + F.vcu; gmlp_unit(F, u >> 2, u & 3, CONV_P4_ITEMS + i * CONV_G_PER_UNIT * 2048 + F.vcu * NWAVES + F.wave); }
    const int gw = F.vcu * NWAVES + F.wave;
    LAS float* scr = (LAS float*)(F.lds + F.wave * 16384);
    int cit = CONV_P4_ITEMS + CONV_G_ITEMS + gw; const int cend = MOE_ITEMS;
    for (int i = 0; i < ((MK_REP == 21 || MK_REP == 22) ? 8 : 4); ++i) { if (MK_REP == 22 && i == 4) cit = CONV_P4_ITEMS + gw; const int u = (i & 3) * 2048 + gw; const int qblk = u & 127, bh = u >> 7; attn_wave_unit(F, bh >> 3, bh & 7, qblk, cit, cend, scr); }
    for (; cit < cend; cit += 2048) { const ConvItem c = moe_conv_decode(F, cit); float v[16]; moe_conv_issue(c, v, F.lane); moe_conv_finish(c, v, scr, F.lane); }
}

struct ProgOut {
    static constexpr bool GATHER = false, FP8 = false; static constexpr int ID = 3, BN = 0, AR = 0;
    const Frame* F;
    __device__ __forceinline__ bool next(int i, Unit& u) const {
        if (i >= 2) return false;
        const int uu = i * 256 + F->vcu, grp = uu >> 5, w = uu & 31; u.pm = grp * 8 + (w & 7); u.pn = w >> 3; u.kind = 0; u.e = 0; u.r0 = 0;
        u.A = (const char*)(F->Y() + (size_t)u.pm * 256 * KD); u.B = (const char*)(F->WOUT() + (size_t)u.pn * 256 * KD); return true;
    }
    __device__ __forceinline__ void epi(const Acc& acc, const Unit& u, int wr, int wc, int fr, int fq) const {
        asm volatile("" : "+v"(fr), "+v"(fq));
        const size_t off0 = (size_t)(u.pm * 256 + wr * 64 + fr) * DM + u.pn * 256 + wc * 32 + 8 * fq;
        const float* xb = F->x() + off0; float* ob = F->out() + off0;
        f32x4 xv[2][2][2];
#define MK_LDX(g, slot) do { const size_t go_ = (size_t)(((g) >> 2) * 128 + ((g) & 3) * 16) * DM; _Pragma("unroll") for (int bj = 0; bj < 2; ++bj) _Pragma("unroll") for (int n = 0; n < 2; ++n) xv[slot][bj][n] = *(const f32x4*)(xb + go_ + bj * 128 + 4 * n); } while (0)
        MK_LDX(0, 0);
#pragma unroll
        for (int g = 0; g < 8; ++g) { const int ai = g >> 2, m = g & 3; const size_t go = (size_t)(ai * 128 + m * 16) * DM; float ss = 0.f;
            if (g + 1 < 8) MK_LDX(g + 1, (g + 1) & 1);
#pragma unroll
            for (int bj = 0; bj < 2; ++bj)
#pragma unroll
                for (int n = 0; n < 2; ++n) { const f32x4 o = xv[g & 1][bj][n] + acc[ai][bj][m][n];
                    ss += (o[0] * o[0] + o[1] * o[1]) + (o[2] * o[2] + o[3] * o[3]); *(f32x4*)(ob + go + bj * 128 + 4 * n) = o; }
            ss += __shfl_xor(ss, 16); ss += __shfl_xor(ss, 32);
            if (fq == 0) F->SSPART()[(size_t)(u.pm * 256 + ai * 128 + wr * 64 + m * 16 + fr) * 16 + u.pn * 4 + wc] = ss; }
#undef MK_LDX
    }
};

template <bool DRY> __device__ __forceinline__ void router_wave_unit(Frame& F, int unit) {
    const int lane = F.lane, r32 = lane & 31, hh = lane >> 5; const int tok = unit * 32 + r32;
    float ssum = 0.f;
    { const f32x4* sp = (const f32x4*)(F.SSPART() + (size_t)tok * 16);
#pragma unroll
      for (int i = 0; i < 4; ++i) { const f32x4 v = sp[i]; ssum += v[0]; ssum += v[1]; ssum += v[2]; ssum += v[3]; } }
    const float rs = 1.0f / sqrtf(ssum * (1.0f / DM) + EPS);
    f32x16 acc = {};
    const float* xrow = F.out() + (size_t)tok * DM + 8 * hh; const float* w2 = F.norm2_w() + 8 * hh; unsigned char* hrow = F.HB() + (size_t)tok * DM + 8 * hh;
    const bf16_t* rth = F.RT() + (size_t)r32 * KD + 8 * hh; const bf16_t* rtl = rth + NE * KD;
#pragma unroll 4
    for (int s = 0; s < 64; ++s) {
        const f32x4 x0 = *(const f32x4*)(xrow + 16 * s), x1 = *(const f32x4*)(xrow + 16 * s + 4);
        const f32x4 g0 = *(const f32x4*)(w2 + 16 * s), g1 = *(const f32x4*)(w2 + 16 * s + 4);
        const f32x4 h0 = x0 * g0 * rs, h1 = x1 * g1 * rs;
        u32x4 hw; hw.x = cvt_pk_bf16(h0[0], h0[1]); hw.y = cvt_pk_bf16(h0[2], h0[3]); hw.z = cvt_pk_bf16(h1[0], h1[1]); hw.w = cvt_pk_bf16(h1[2], h1[3]);
        { u32x2 h8; h8.x = pk4_fp8(h0[0], h0[1], h0[2], h0[3]); h8.y = pk4_fp8(h1[0], h1[1], h1[2], h1[3]); *(u32x2*)(hrow + 16 * s) = h8; }
        u32x4 lw; lw.x = cvt_pk_bf16(h0[0] - bflo(hw.x), h0[1] - bfhi(hw.x)); lw.y = cvt_pk_bf16(h0[2] - bflo(hw.y), h0[3] - bfhi(hw.y));
        lw.z = cvt_pk_bf16(h1[0] - bflo(hw.z), h1[1] - bfhi(hw.z)); lw.w = cvt_pk_bf16(h1[2] - bflo(hw.w), h1[3] - bfhi(hw.w));
        const bf16x8 bh = __builtin_bit_cast(bf16x8, hw), bl = __builtin_bit_cast(bf16x8, lw);
        const bf16x8 ah = *(const bf16x8*)(rth + 16 * s), al = *(const bf16x8*)(rtl + 16 * s);
        acc = __builtin_amdgcn_mfma_f32_32x32x16_bf16(ah, bh, acc, 0, 0, 0);
        acc = __builtin_amdgcn_mfma_f32_32x32x16_bf16(al, bh, acc, 0, 0, 0);
        acc = __builtin_amdgcn_mfma_f32_32x32x16_bf16(ah, bl, acc, 0, 0, 0);
    }
    float lv[16];
#pragma unroll
    for (int r = 0; r < 16; ++r) lv[r] = acc[r] + F.router_b()[(r & 3) + 8 * (r >> 2) + 4 * hh];
    float cv[8]; int ce[8];
#pragma unroll
    for (int k = 0; k < 4; ++k) { float bv = -INFINITY; int be = 0;
#pragma unroll
        for (int r = 0; r < 16; ++r) { const int e = (r & 3) + 8 * (r >> 2) + 4 * hh; if (lv[r] > bv) { bv = lv[r]; be = e; } }
#pragma unroll
        for (int r = 0; r < 16; ++r) { const int e = (r & 3) + 8 * (r >> 2) + 4 * hh; if (e == be) lv[r] = -INFINITY; }
        cv[k] = bv; ce[k] = be; }
#pragma unroll
    for (int k = 0; k < 4; ++k) { cv[4 + k] = __shfl_xor(cv[k], 32); ce[4 + k] = __shfl_xor(ce[k], 32); }
    float tv[4]; int te[4];
#pragma unroll
    for (int k = 0; k < 4; ++k) { float bv = -INFINITY; int be = 1 << 20;
#pragma unroll
        for (int c = 0; c < 8; ++c) if (cv[c] > bv || (cv[c] == bv && ce[c] < be)) { bv = cv[c]; be = ce[c]; }
#pragma unroll
        for (int c = 0; c < 8; ++c) if (ce[c] == be) cv[c] = -INFINITY;
        tv[k] = bv; te[k] = be; }
    float ex[4], den = 0.f;
#pragma unroll
    for (int k = 0; k < 4; ++k) { ex[k] = __builtin_amdgcn_exp2f((tv[k] - tv[0]) * LOG2E); den += ex[k]; }
    const float rden = 1.0f / den;
    const int e0 = hh ? te[2] : te[0], e1 = hh ? te[3] : te[1]; const float g0 = (hh ? ex[2] : ex[0]) * rden, g1 = (hh ? ex[3] : ex[1]) * rden;
    if (DRY) { asm volatile("" :: "v"(e0), "v"(e1), "v"(g0), "v"(g1)); return; }
    int myc = 0; int rank0 = 0, rank1 = 0;
    const unsigned long long ltmask = (1ull << lane) - 1ull;
    for (int e = 0; e < NE; ++e) {
        const unsigned long long m0 = __ballot(e0 == e), m1 = __ballot(e1 == e);
        const int c0 = __popcll(m0), c1 = __popcll(m1);
        if (lane == e) myc = c0 + c1;
        if (e0 == e) rank0 = __popcll(m0 & ltmask);
        if (e1 == e) rank1 = c0 + __popcll(m1 & ltmask);
    }
    int base = 0;
    if (lane < NE && myc > 0) base = (int)__hip_atomic_fetch_add(F.ctl() + CW_CNT + lane, (unsigned)myc, __ATOMIC_RELAXED, __HIP_MEMORY_SCOPE_AGENT);
    const int p0 = __shfl(base, e0) + rank0, p1 = __shfl(base, e1) + rank1;
    F.LISTTOK()[(size_t)e0 * NTOK + p0] = tok; F.LISTGATE()[(size_t)e0 * NTOK + p0] = g0;
    F.LISTTOK()[(size_t)e1 * NTOK + p1] = tok; F.LISTGATE()[(size_t)e1 * NTOK + p1] = g1;
    F.TOKINFO()[tok * 4 + 2 * hh] = (e0 << 16) | p0; F.TOKINFO()[tok * 4 + 2 * hh + 1] = (e1 << 16) | p1;
}

__device__ __forceinline__ void moe_build_table(Frame& F) {
    LAS int* tab = (LAS int*)(F.lds + TAB_OFF);
    if (F.tid < NE) tab[F.tid] = (int)__hip_atomic_load(F.ctl() + CW_CNT + F.tid, __ATOMIC_RELAXED, __HIP_MEMORY_SCOPE_AGENT);
    __syncthreads();
    if (F.tid == 0) { int acc = 0; for (int e = 0; e < NE; ++e) { tab[32 + e] = acc; acc += (tab[e] + 255) >> 8; } tab[64] = acc; }
    __syncthreads();
}
__device__ __forceinline__ int sgpr(int v) { return __builtin_amdgcn_readfirstlane(v); }
template <int WGM, int NN>
__device__ __forceinline__ bool moe_decode(const Frame* F, int T, int i, Unit& u) {
    const LAS int* tab = (const LAS int*)(F->lds + TAB_OFF);
    const int uu = i * 256 + F->vcu, grp = uu >> 5, w = uu & 31; const int mt = grp * WGM + (w % WGM); u.pn = w / WGM;
    if (mt >= T) return false;
    int e = 0;
    for (int k = 1; k < NE; ++k) if (sgpr(tab[32 + k]) <= mt) e = k;
    u.e = e; u.pm = mt; u.r0 = (mt - sgpr(tab[32 + e])) * 256; u.kind = sgpr(tab[e]); return true;
}
struct ProgMoe1 {
    static constexpr bool GATHER = true, FP8 = true; static constexpr int ID = 5, BN = 2048, AR = NTOK;
    const Frame* F; int T;
    __device__ __forceinline__ bool next(int i, Unit& u) const {
        if (!moe_decode<4, 8>(F, T, i, u)) return false;
        u.A = (const char*)F->HB(); u.B = (const char*)(F->WGU() + (size_t)u.e * 2048 * KD + (size_t)u.pn * 256 * 16); return true;
    }
    __device__ __forceinline__ void aoffs(const Unit& u, int wid, unsigned (&vo)[2][2]) const {
        const int cnt = u.kind; const int tid = wid * 64 + lane_id_fresh();
#pragma unroll
        for (int i = 0; i < 2; ++i) { int R_, Cb_; stage_rc8(tid * 16 + i * 8192, R_, Cb_);
#pragma unroll
            for (int h = 0; h < 2; ++h) { const int idx = u.r0 + h * 128 + R_; const int tok = idx < cnt ? F->LISTTOK()[(size_t)u.e * NTOK + idx] : 0; vo[h][i] = (unsigned)(tok * KD + Cb_); } }
    }
    __device__ __forceinline__ void epi(const Acc& acc, const Unit& u, int wr, int wc, int fr, int fq) const {
        asm volatile("" : "+v"(fr), "+v"(fq));
        const float* bp = F->b_gate_up() + (size_t)u.e * 2048 + u.pn * 256 + wc * 32 + 8 * fq;
        f32x4 bv[2][2];
#pragma unroll
        for (int bj = 0; bj < 2; ++bj)
#pragma unroll
            for (int n = 0; n < 2; ++n) bv[bj][n] = *(const f32x4*)(bp + bj * 128 + 4 * n);
#pragma unroll
        for (int ai = 0; ai < 2; ++ai)
#pragma unroll
            for (int m = 0; m < 4; ++m) { const size_t slot = (size_t)u.pm * 256 + ai * 128 + wr * 64 + m * 16 + fr; unsigned char* rowp = F->ACT() + ((size_t)(8 * u.pn + wc) * SLOTS + slot) * 16 + 4 * fq;
#pragma unroll
                for (int bj = 0; bj < 2; ++bj) { const f32x4 v0 = acc[ai][bj][m][0] * WSCALE_INV + bv[bj][0], v1 = acc[ai][bj][m][1] * WSCALE_INV + bv[bj][1];
                    f32x2 ga = {fminf(v0[0], 7.0f), fminf(v0[2], 7.0f)}, gb = {fminf(v1[0], 7.0f), fminf(v1[2], 7.0f)};
                    f32x2 ua = {__builtin_amdgcn_fmed3f(v0[1], -7.0f, 7.0f), __builtin_amdgcn_fmed3f(v0[3], -7.0f, 7.0f)}, ub = {__builtin_amdgcn_fmed3f(v1[1], -7.0f, 7.0f), __builtin_amdgcn_fmed3f(v1[3], -7.0f, 7.0f)};
                    const f32x2 xa = ga * (-1.702f * LOG2E), xb = gb * (-1.702f * LOG2E);
                    f32x2 ea = {__builtin_amdgcn_exp2f(xa[0]), __builtin_amdgcn_exp2f(xa[1])}, eb = {__builtin_amdgcn_exp2f(xb[0]), __builtin_amdgcn_exp2f(xb[1])};
                    ea = ea + 1.0f; eb = eb + 1.0f;
                    const f32x2 ra = {__builtin_amdgcn_rcpf(ea[0]), __builtin_amdgcn_rcpf(ea[1])}, rb = {__builtin_amdgcn_rcpf(eb[0]), __builtin_amdgcn_rcpf(eb[1])};
                    const f32x2 gla = ga * ra, glb = gb * rb;
                    const f32x2 oa = ua * gla + gla, ob = ub * glb + glb;
                    float r4[4] = {oa[0], oa[1], ob[0], ob[1]};
                    *(unsigned*)(rowp + (size_t)bj * 4 * SLOTS * 16) = pk4_fp8(r4[0], r4[1], r4[2], r4[3]); } }
    }
};
struct ProgMoe2 {
    static constexpr bool GATHER = false, FP8 = true; static constexpr int ID = 6, BN = 1024, AR = SLOTS;
    const Frame* F; int T;
    __device__ __forceinline__ bool next(int i, Unit& u) const {
        if (!moe_decode<8, 4>(F, T, i, u)) return false;
        u.A = (const char*)(F->ACT() + (size_t)u.pm * 256 * 16); u.B = (const char*)(F->WD() + (size_t)u.e * 1024 * KD + (size_t)u.pn * 256 * 16); return true;
    }
    __device__ __forceinline__ void epi(const Acc& acc, const Unit& u, int wr, int wc, int fr, int fq) const {
        asm volatile("" : "+v"(fr), "+v"(fq));
        const int cnt = u.kind;
        const float* bp = F->b_down() + (size_t)u.e * 1024 + u.pn * 256 + wc * 32 + 8 * fq;
        f32x4 bv[2][2];
#pragma unroll
        for (int bj = 0; bj < 2; ++bj)
#pragma unroll
            for (int n = 0; n < 2; ++n) bv[bj][n] = *(const f32x4*)(bp + bj * 128 + 4 * n);
#pragma unroll
        for (int ai = 0; ai < 2; ++ai) {
            float gt[4];
#pragma unroll
            for (int m = 0; m < 4; ++m) { const int idx = u.r0 + ai * 128 + wr * 64 + m * 16 + fr; gt[m] = idx < cnt ? F->LISTGATE()[(size_t)u.e * NTOK + idx] : 0.f; }
#pragma unroll
            for (int m = 0; m < 4; ++m) { const int rl = ai * 128 + wr * 64 + m * 16 + fr; const float gate = gt[m] * YSCALE;
                unsigned char* rowp = F->YS() + ((size_t)u.pm * 256 + rl) * 1024 + u.pn * 256 + wc * 32 + 8 * fq;
#pragma unroll
                for (int bj = 0; bj < 2; ++bj) { const f32x4 v0 = (acc[ai][bj][m][0] * WSCALE_INV + bv[bj][0]) * gate, v1 = (acc[ai][bj][m][1] * WSCALE_INV + bv[bj][1]) * gate;
                    u32x2 w; w.x = pk4_fp8(v0[0], v0[1], v0[2], v0[3]); w.y = pk4_fp8(v1[0], v1[1], v1[2], v1[3]);
                    *(u32x2*)(rowp + bj * 128) = w; } }
        }
    }
};

template <bool DRY> __device__ __forceinline__ void p7_combine(Frame& F) {
    const LAS int* tab = (const LAS int*)(F.lds + TAB_OFF);
    const int gw = F.vcu * NWAVES + F.wave, NGW = F.G * NWAVES, lane = F.lane;
    for (int tok = gw; tok < NTOK; tok += NGW) {
        f32x4* orow = (f32x4*)(F.out() + (size_t)tok * DM) + lane; f32x4 v[4];
#pragma unroll
        for (int j = 0; j < 4; ++j) v[j] = orow[64 * j];
#pragma unroll
        for (int k = 0; k < 4; ++k) { const int info = F.TOKINFO()[tok * 4 + k]; const int e = info >> 16, pos = info & 0xffff; const size_t slot = (size_t)tab[32 + e] * 256 + pos;
            const unsigned* yr = (const unsigned*)(F.YS() + slot * 1024) + lane;
#pragma unroll
            for (int j = 0; j < 4; ++j) { const unsigned w = yr[64 * j]; const f32x2 lo = __builtin_amdgcn_cvt_pk_f32_fp8((int)w, false), hi = __builtin_amdgcn_cvt_pk_f32_fp8((int)w, true);
                v[j][0] += lo[0] * YSCALE_INV; v[j][1] += lo[1] * YSCALE_INV; v[j][2] += hi[0] * YSCALE_INV; v[j][3] += hi[1] * YSCALE_INV; } }
        f32x4* wrow = DRY ? (f32x4*)((float*)(F.ws() + WS_EARLY) + (size_t)tok * DM) + lane : orow;
#pragma unroll
        for (int j = 0; j < 4; ++j) wrow[64 * j] = v[j];
    }
}

__global__ void __launch_bounds__(NWAVES * 64, 2) mk_fwd(Args args) {
    extern __shared__ __attribute__((aligned(16))) unsigned char lds_raw[];
    Frame F;
    F.lds = (LAS unsigned char*)lds_raw;
    F.tid = threadIdx.x; F.lane = F.tid & 63; F.wave = __builtin_amdgcn_readfirstlane(F.tid >> 6);
    F.G = gridDim.x; { const int bx = blockIdx.x; F.vcu = (bx % 8) * (F.G / 8) + bx / 8; }
    F.ka = (const CAS Args*)__builtin_amdgcn_kernarg_segment_ptr();
    for (int u = F.tid; u < (LDS_BYTES - LDSCTL_OFF) / 4; u += NWAVES * 64) ((LAS unsigned*)(F.lds + LDSCTL_OFF))[u] = 0u;
    __syncthreads();
    XcdBarrier bar = xcd_barrier_post(F.ctl() + CW_BAR, (volatile LAS unsigned*)(F.lds + MISC_OFF) + 8);
    const int lo = F.ka->ph_lo, hi = F.ka->ph_hi;
#define IN(k) (lo <= (k) && (k) < hi)
#define REFRESH() do { int l_ = lane_id(); asm volatile("" : "+v"(l_)); F.lane = l_; F.tid = F.wave * 64 + l_; } while (0)
#define SEAM(k) do { if (IN(k) && IN((k) + 1)) { xcd_barrier(bar, F.wave); if (MK_REP == 100 + (k)) { xcd_barrier(bar, F.wave); xcd_barrier(bar, F.wave); xcd_barrier(bar, F.wave); xcd_barrier(bar, F.wave); } } } while (0)
#ifdef MK_TPROBE
    unsigned long long ts_[9]; ts_[0] = __builtin_amdgcn_s_memrealtime();
#define TS(k) ts_[k] = __builtin_amdgcn_s_memrealtime()
#else
#define TS(k) do {} while (0)
#endif
    if (IN(0)) { REFRESH(); p0_prologue(F); if (MK_REP == 0) p0_prologue(F); } SEAM(0); TS(1);
    if (IN(1)) { { ProgIn P{&F}; gemm_phase(F.lds, P); } if (MK_REP == 1) { ProgIn P{&F}; gemm_phase(F.lds, P); } } SEAM(1); TS(2);
    if (IN(2)) { REFRESH(); p2_mixers(F); if (MK_REP == 2) p2_mixers(F); } SEAM(2); TS(3);
    if (IN(3)) { { ProgOut P{&F}; gemm_phase(F.lds, P); } if (MK_REP == 3) { ProgOut P{&F}; gemm_phase(F.lds, P); } } SEAM(3); TS(4);
    if (IN(4)) { REFRESH(); if (F.wave < 4) { if (MK_REP == 4) router_wave_unit<true>(F, F.wave * 256 + F.vcu); router_wave_unit<false>(F, F.wave * 256 + F.vcu); }
                 else { LAS float* scr = (LAS float*)(F.lds + F.wave * 16384); const int cw = F.vcu * 4 + (F.wave - 4);
                        for (int rep_ = 0; rep_ < (MK_REP == 41 ? 2 : 1); ++rep_) {
                        ConvItem ca = moe_conv_decode(F, cw); float va[16], vb[16]; moe_conv_issue(ca, va, F.lane);
                        for (int j = 0; j < CONV_P4_PER_WAVE; j += 2) {
                            const ConvItem cb = moe_conv_decode(F, (j + 1) * 1024 + cw); moe_conv_issue(cb, vb, F.lane);
                            moe_conv_finish(ca, va, scr, F.lane);
                            if (j + 2 < CONV_P4_PER_WAVE) { ca = moe_conv_decode(F, (j + 2) * 1024 + cw); moe_conv_issue(ca, va, F.lane); }
                            moe_conv_finish(cb, vb, scr, F.lane); } } } } SEAM(4); TS(5);
    if (lo <= 7 && hi > 5) { REFRESH(); moe_build_table(F); }
    if (IN(5)) { { ProgMoe1 P{&F, sgpr(((const LAS int*)(F.lds + TAB_OFF))[64])}; gemm_phase(F.lds, P); } if (MK_REP == 5) { ProgMoe1 P{&F, sgpr(((const LAS int*)(F.lds + TAB_OFF))[64])}; gemm_phase(F.lds, P); } } SEAM(5); TS(6);
    if (IN(6)) { { ProgMoe2 P{&F, sgpr(((const LAS int*)(F.lds + TAB_OFF))[64])}; gemm_phase(F.lds, P); } if (MK_REP == 6) { ProgMoe2 P{&F, sgpr(((const LAS int*)(F.lds + TAB_OFF))[64])}; gemm_phase(F.lds, P); } } SEAM(6); TS(7);
    if (IN(7)) { REFRESH(); if (MK_REP == 7) p7_combine<true>(F); p7_combine<false>(F); }
#ifdef MK_TPROBE
    TS(8);
    if (blockIdx.x == 0 && F.wave == 0) { const unsigned long long d = (MK_TPROBE == 9 ? (ts_[8] - ts_[0]) / 8 : ts_[MK_TPROBE + 1] - ts_[MK_TPROBE]) * 8ull; const unsigned long long t0 = __builtin_amdgcn_s_memrealtime();
        while (__builtin_amdgcn_s_memrealtime() - t0 < d) __builtin_amdgcn_s_sleep(8); }
#endif
#undef IN
#undef SEAM
}
}
#ifndef MK_CUT
#define MK_CUT 8
#endif
extern "C" void kernel_launch(void* const* d_in, const int* in_sizes, int n_in, void* d_out, int out_size, void* d_ws, size_t ws_size, hipStream_t stream) {
    static int ready = 0;
    if (ready == 0) {
        if (n_in != 18 || out_size != mk::NTOK * mk::DM || ws_size < mk::WS_END) { fprintf(stderr, "kernel_launch: unexpected problem (n_in %d out %d ws %zu)\n", n_in, out_size, ws_size); ready = -1; return; }
        if (hipFuncSetAttribute((const void*)mk::mk_fwd, hipFuncAttributeMaxDynamicSharedMemorySize, mk::LDS_BYTES) != hipSuccess) { fprintf(stderr, "kernel_launch: hipFuncSetAttribute failed\n"); ready = -1; return; }
        ready = 1;
    }
    if (ready < 0) return;
    (void)hipMemsetAsync((char*)d_ws + mk::WS_CTL, 0, mk::CTL_ZERO_BYTES, stream);
    mk::Args a{};
    for (int i = 0; i < 18; ++i) a.in[i] = (const float*)d_in[i];
    a.out = (float*)d_out; a.ws = (unsigned char*)d_ws; a.ph_lo = 0; a.ph_hi = MK_CUT;
    hipLaunchKernelGGL(mk::mk_fwd, dim3(256), dim3(mk::NWAVES * 64), mk::LDS_BYTES, stream, a);
#if MK_CUT < 8
    {
        using namespace nv;
        const float* x = (const float*)d_in[0]; const float* w_out = (const float*)d_in[10]; const float* norm2_w = (const float*)d_in[11];
        const float* router_w = (const float*)d_in[12]; const float* router_b = (const float*)d_in[13]; const float* w_gate_up = (const float*)d_in[14];
        const float* b_gate_up = (const float*)d_in[15]; const float* w_down = (const float*)d_in[16]; const float* b_down = (const float*)d_in[17];
        float* out = (float*)d_out; char* ws = (char*)d_ws; const size_t MiB = 1u << 20;
        int* cnt = (int*)ws + mk::CW_CNT; int* list_tok = (int*)(ws + mk::WS_LISTTOK); float* list_gate = (float*)(ws + mk::WS_LISTGATE);
        float* hn = (float*)(ws + 16 * MiB); float* gu = (float*)(ws + 272 * MiB); float* act = (float*)(ws + (272 + 256) * MiB);
#if MK_CUT <= 3
        k_gemm<1, true><<<dim3(DM / 64, NTOK / 64), 256, 0, stream>>>((const void*)(ws + mk::WS_Y), nullptr, nullptr, nullptr, w_out, nullptr, x, nullptr, out, NTOK, DM, DM, DM, DM);
#endif
#if MK_CUT <= 4
        k_router<<<NTOK, 256, 0, stream>>>(out, norm2_w, router_w, router_b, hn, cnt, list_tok, list_gate);
#else
        k_bf2f<<<4096, 256, 0, stream>>>((const unsigned short*)(ws + mk::WS_HB), hn, (size_t)NTOK * DM);
#endif
        for (int e = 0; e < NE; ++e) {
            const int* lt = list_tok + (size_t)e * NTOK; const float* lgp = list_gate + (size_t)e * NTOK;
            k_gemm<0, false><<<dim3(2 * DFF / 64, NTOK / 64), 256, 0, stream>>>(hn, lt, nullptr, cnt + e, w_gate_up + (size_t)e * DM * 2 * DFF, b_gate_up + (size_t)e * 2 * DFF, nullptr, nullptr, gu, NTOK, 2 * DFF, DM, DM, 2 * DFF);
            k_swiglu<<<NTOK, 256, 0, stream>>>(gu, cnt + e, act);
            k_gemm<3, false><<<dim3(DM / 64, NTOK / 64), 256, 0, stream>>>(act, nullptr, lt, cnt + e, w_down + (size_t)e * DFF * DM, b_down + (size_t)e * DM, nullptr, lgp, out, NTOK, DM, DFF, DFF, DM);
        }
    }
#endif
}
```

```cpp
#include <hip/hip_runtime.h>
#include <cstdio>
#include <cstdint>
#ifndef MK_REP
#define MK_REP -1
#endif
namespace mk {
#define LAS __attribute__((address_space(3)))
#define GAS __attribute__((address_space(1)))
typedef unsigned short bf16_t;
typedef short bf16x8 __attribute__((ext_vector_type(8)));
typedef short s16x4 __attribute__((ext_vector_type(4)));
typedef float f32x4 __attribute__((ext_vector_type(4)));
typedef float f32x2 __attribute__((ext_vector_type(2)));
typedef float f32x16 __attribute__((ext_vector_type(16)));
typedef unsigned u32x4 __attribute__((ext_vector_type(4)));
typedef unsigned u32x2 __attribute__((ext_vector_type(2)));
typedef int i32x4 __attribute__((ext_vector_type(4)));
typedef int i32x8 __attribute__((ext_vector_type(8)));

constexpr int NTOK = 32768, DM = 1024, SEQ = 4096, NB = 8, NH = 8, HD = 64, NE = 32, DFF = 1024, KD = 1024;
constexpr float EPS = 1e-5f;
constexpr float LOG2E = 1.4426950408889634f;
constexpr float QSCALE = 0.125f * LOG2E;
constexpr float SB_THR = 64.0f;
constexpr int NWAVES = 8;
constexpr int SLOTS = NTOK * 4 + NE * 256;

constexpr size_t MiB = 1u << 20;
constexpr size_t WS_CTL = 0, CTL_ZERO_BYTES = 1 * MiB;
constexpr size_t WS_LISTTOK = 1 * MiB;
constexpr size_t WS_LISTGATE = 5 * MiB;
constexpr size_t WS_TOKINFO = 9 * MiB;
constexpr size_t WS_RSTD1 = 10 * MiB;
constexpr size_t WS_SSPART = 11 * MiB;
constexpr size_t WS_RT = 13 * MiB;
constexpr size_t WS_WGU = 16 * MiB;
constexpr size_t WS_WD = 80 * MiB;
constexpr size_t WS_HB = 112 * MiB;
constexpr size_t WS_YS = 144 * MiB;
constexpr size_t WS_EARLY = 416 * MiB;
constexpr size_t WS_XB = WS_EARLY;
constexpr size_t WS_WIN = WS_EARLY + 64 * MiB;
constexpr size_t WS_WOUT = WS_EARLY + 70 * MiB;
constexpr size_t WS_UV = WS_EARLY + 72 * MiB;
constexpr size_t WS_Q = WS_EARLY + 136 * MiB;
constexpr size_t WS_K = WS_EARLY + 168 * MiB;
constexpr size_t WS_VT = WS_EARLY + 200 * MiB;
constexpr size_t WS_Y = WS_EARLY + 232 * MiB;
constexpr size_t WS_ACT = WS_EARLY;
constexpr size_t WS_END = WS_EARLY + 296 * MiB;
constexpr float WSCALE = 32.0f, WSCALE_INV = 1.0f / 32.0f;
constexpr float YSCALE = 16.0f, YSCALE_INV = 1.0f / 16.0f;
constexpr int CW_CNT = 64;
constexpr int CW_BAR = 4096;

constexpr int RING_BYTES = 131072;
constexpr int LDSCTL_OFF = RING_BYTES, MISC_OFF = LDSCTL_OFF + 320, TAB_OFF = LDSCTL_OFF + 1024;
constexpr int LDS_BYTES = 147456;

__device__ __forceinline__ unsigned cvt_pk_bf16(float lo, float hi) { unsigned r; asm volatile("v_cvt_pk_bf16_f32 %0, %1, %2" : "=v"(r) : "v"(lo), "v"(hi)); return r; }
__device__ __forceinline__ unsigned pk4_fp8(float a, float b, float c, float d) { unsigned w = 0u; w = (unsigned)__builtin_amdgcn_cvt_pk_fp8_f32(a, b, (int)w, false); w = (unsigned)__builtin_amdgcn_cvt_pk_fp8_f32(c, d, (int)w, true); return w; }
__device__ __forceinline__ float bf2f(unsigned short h) { return __uint_as_float((unsigned)h << 16); }
__device__ __forceinline__ float bflo(unsigned w) { return __uint_as_float(w << 16); }
__device__ __forceinline__ float bfhi(unsigned w) { return __uint_as_float(w & 0xffff0000u); }
__device__ __forceinline__ int lane_id() { return (int)__builtin_amdgcn_mbcnt_hi(~0u, __builtin_amdgcn_mbcnt_lo(~0u, 0u)); }
__device__ __forceinline__ int lane_id_fresh() { int l; asm volatile("v_mbcnt_lo_u32_b32 %0, -1, 0\n\tv_mbcnt_hi_u32_b32 %0, -1, %0" : "=v"(l)); return l; }
__device__ __forceinline__ float wave_sum(float v) {
#pragma unroll
    for (int o = 1; o < 64; o <<= 1) v += __shfl_xor(v, o);
    return v;
}
__device__ __forceinline__ float gelu_tanh_f(float x) {
    const float u = 0.7978845608028654f * (x + 0.044715f * x * x * x);
    return x * __builtin_amdgcn_rcpf(1.0f + __builtin_amdgcn_exp2f(-2.0f * LOG2E * u));
}

constexpr int BM = 256, BK = 64, HALF = 128, HTB = HALF * BK * 2;
__device__ __forceinline__ int lds_byte(int r, int c) { const int st = (r >> 4) * 2 + (c >> 5), rr = r & 15, cc = c & 31, ob = rr * 64 + cc * 2; return st * 1024 + (ob ^ (((ob >> 9) & 1) << 5)); }
__device__ __forceinline__ void stage_rc(int b, int& R, int& C) { const int st = b / 1024, sb = b % 1024, swz = sb ^ (((sb >> 9) & 1) << 5); R = (st >> 1) * 16 + swz / 64; C = (st & 1) * 32 + (swz % 64) / 2; }
__device__ __forceinline__ int swz8(int r) { const int q = r & 15; return ((q >> 1) & 7) ^ ((((q + 4) >> 3) & 1) << 1); }
__device__ __forceinline__ int lds_byte8(int r, int c) { return r * 128 + ((c ^ swz8(r)) << 4); }
__device__ __forceinline__ void stage_rc8(int b, int& R, int& Cb) { R = b >> 7; Cb = (((b & 127) >> 4) ^ swz8(R)) << 4; }
__device__ __forceinline__ int lds_byteN(int r, int c8) { return r * 128 + ((c8 ^ ((r >> 1) & 7)) << 4); }
__device__ __forceinline__ void stage_rcN(int b, int& R, int& C) { R = b >> 7; C = ((((b & 127) >> 4) ^ ((R >> 1) & 7)) << 3); }
__device__ __forceinline__ int perm32(int rho) { const int n = rho >> 4, i = rho & 15; return 8 * (i >> 2) + 4 * n + (i & 3); }

struct Unit { const char* A; const char* B; int kind, pm, pn, e, r0; };

template <class Prog>
__device__ __forceinline__ void gemm_phase(LAS unsigned char* lds, const Prog& P) {
    const int wid = P.F->wave, lane = lane_id(), tid = wid * 64 + lane, wr = wid >> 2, wc = wid & 3;
    constexpr bool F8 = Prog::FP8;
    constexpr int K = KD, ESZ = F8 ? 1 : 2, nt = F8 ? K / 128 : K / BK;
    unsigned voffB[2];
#pragma unroll
    for (int i = 0; i < 2; ++i) {
        if constexpr (F8) { const int b_ = tid * 16 + i * 8192, k16_ = b_ >> 11, sl_ = (b_ & 2047) >> 4; voffB[i] = (unsigned)((k16_ * Prog::BN + (sl_ & ~31) + perm32(sl_ & 31)) * 16); }
        else { int R_, C_; stage_rcN(tid * 16 + i * 8192, R_, C_); const int Rb = (R_ & ~31) + perm32(R_ & 31); voffB[i] = (unsigned)(Rb * K * ESZ + C_ * 2); } }
    constexpr size_t kstep = (size_t)(BK * 2);
    constexpr size_t hstep = (size_t)HALF * K * ESZ;
    constexpr bool AK16 = F8 && !Prog::GATHER;
    constexpr size_t kstepA = AK16 ? (size_t)8 * Prog::AR * 16 : kstep;
    constexpr size_t hstepA = AK16 ? (size_t)HALF * 16 : hstep;
    constexpr size_t kstepB = F8 ? (size_t)8 * Prog::BN * 16 : kstep;
    constexpr size_t hstepB = F8 ? (size_t)HALF * 16 : hstep;
    const unsigned ldsw = (unsigned)wid * 1024u;
    constexpr bool AG8 = F8 && Prog::GATHER;
    const int aoff = AK16 ? (2 * (lane >> 4)) * 2048 + (wr * 64 + (lane & 15)) * 16 : AG8 ? lds_byte8(wr * 64 + (lane & 15), 2 * (lane >> 4)) : lds_byteN(wr * 64 + (lane & 15), lane >> 4);
    const int boff = F8 ? (2 * (lane >> 4)) * 2048 + (wc * 32 + (lane & 15)) * 16 : lds_byteN(wc * 32 + (lane & 15), lane >> 4);
    constexpr int ANS = AK16 ? 256 : 2048, AKS = 2048;
    const int aks8 = lds_byte8(lane & 15, 2 * (lane >> 4) + 1) - lds_byte8(lane & 15, 2 * (lane >> 4));
    const int aksN = lds_byteN(lane & 15, (lane >> 4) + 4) - lds_byteN(lane & 15, lane >> 4);
    constexpr int BNS = F8 ? 256 : 2048, BKS = 2048;
    constexpr int KOFF = F8 ? 16 : 1024;
#define MK_SA(b, h) (((b) * 2 + (h)) * HTB)
#define MK_SB(b, h) ((4 + (b) * 2 + (h)) * HTB)
#define MK_STAGE(bufoff, gbase, voff) do { _Pragma("unroll") for (int _i = 0; _i < 2; ++_i) { unsigned o_ = (voff)[_i]; asm volatile("" : "+v"(o_));     \
        __builtin_amdgcn_global_load_lds((const unsigned*)((const char*)(gbase) + o_), (LAS unsigned*)(lds + (bufoff) + ldsw + _i * 8192), 16, 0, 0); } } while (0)
#define MK_STAGE_A(bufoff, gbase, h) do { if constexpr (GA) MK_STAGE(bufoff, gbase, voC[h]); else MK_STAGE(bufoff, (gbase) + (h) * hstepA, voC[0]); } while (0)
#define MK_LDA(dst, b, h) do { _Pragma("unroll") for (int m = 0; m < 4; ++m) _Pragma("unroll") for (int k = 0; k < 2; ++k) dst[m][k] = *(const LAS bf16x8*)(lds + MK_SA(b, h) + aoff + m * ANS + k * (AK16 ? AKS : AG8 ? aks8 : aksN)); } while (0)
#define MK_LDB(dst, b, h) do { _Pragma("unroll") for (int n = 0; n < 2; ++n) _Pragma("unroll") for (int k = 0; k < 2; ++k) dst[n][k] = *(const LAS bf16x8*)(lds + MK_SB(b, h) + boff + n * BNS + k * (F8 ? BKS : aksN)); } while (0)
#define MK_CAT8(x) __builtin_shufflevector(__builtin_bit_cast(i32x4, (x)[0]), __builtin_bit_cast(i32x4, (x)[1]), 0, 1, 2, 3, 4, 5, 6, 7)
#define MK_MMA(ai, bj, At, Bt) do { __builtin_amdgcn_s_setprio(1); \
        if constexpr (F8) { _Pragma("unroll") for (int m = 0; m < 4; ++m) _Pragma("unroll") for (int n = 0; n < 2; ++n) \
            acc[ai][bj][m][n] = __builtin_amdgcn_mfma_scale_f32_16x16x128_f8f6f4(MK_CAT8(Bt[n]), MK_CAT8(At[m]), acc[ai][bj][m][n], 0, 0, 0, 0, 0, 0); } \
        else { _Pragma("unroll") for (int m = 0; m < 4; ++m) _Pragma("unroll") for (int n = 0; n < 2; ++n) _Pragma("unroll") for (int k = 0; k < 2; ++k) \
            acc[ai][bj][m][n] = __builtin_amdgcn_mfma_f32_16x16x32_bf16(Bt[n][k], At[m][k], acc[ai][bj][m][n], 0, 0, 0); } \
        __builtin_amdgcn_s_setprio(0); } while (0)
#define MK_WAIT_V(n) asm volatile("s_waitcnt vmcnt(" #n ")" ::: "memory")
#define MK_WAIT_L(n) asm volatile("s_waitcnt lgkmcnt(" #n ")" ::: "memory")
#define MK_BAR __builtin_amdgcn_s_barrier()
#define MK_SCHED __builtin_amdgcn_sched_barrier(0)
    Unit cur, nxt; int ui = 0;
    if (!P.next(0, cur)) return;
    constexpr bool GA = Prog::GATHER;
    unsigned voC[2][2];
    if constexpr (GA) P.aoffs(cur, wid, voC);
    else {
#pragma unroll
        for (int i = 0; i < 2; ++i) { if constexpr (AK16) { const int b_ = tid * 16 + i * 8192; voC[0][i] = (unsigned)(((b_ >> 11) * Prog::AR + ((b_ & 2047) >> 4)) * 16); } else { int R_, C_; stage_rcN(tid * 16 + i * 8192, R_, C_); voC[0][i] = (unsigned)(R_ * K * ESZ + C_ * 2); } voC[1][i] = 0u; }
    }
    f32x4 acc[2][2][4][2];
#pragma unroll
    for (int a = 0; a < 2; ++a)
#pragma unroll
        for (int b = 0; b < 2; ++b)
#pragma unroll
            for (int m = 0; m < 4; ++m)
#pragma unroll
                for (int n = 0; n < 2; ++n) acc[a][b][m][n] = (f32x4){0.f, 0.f, 0.f, 0.f};
    bf16x8 At[4][2], B0[2][2], B1[2][2];
    const char* cA = cur.A; const char* cB = cur.B;
    MK_STAGE(MK_SB(0, 0), cB, voffB); MK_STAGE(MK_SB(0, 1), cB + hstepB, voffB); MK_STAGE_A(MK_SA(0, 0), cA, 0); MK_STAGE_A(MK_SA(0, 1), cA, 1);
    if (wr == 1) MK_BAR;
    MK_WAIT_V(2); MK_BAR;
    MK_STAGE(MK_SB(1, 0), cB + kstepB, voffB); MK_STAGE_A(MK_SA(1, 0), cA + kstepA, 0); MK_STAGE(MK_SB(1, 1), cB + hstepB + kstepB, voffB);
    MK_WAIT_V(6); MK_BAR;
    for (;;) {
        const bool has_next = P.next(ui + 1, nxt);
        if (!has_next) nxt = cur;
        const char* nA = nxt.A; const char* nB = nxt.B;
#pragma unroll 1
        for (int t = 0; t < nt; t += 2) {
            const bool last = (t == nt - 2);
            const char* a1 = cA + (size_t)(t + 1) * kstepA;
            const char* a2 = last ? nA : cA + (size_t)(t + 2) * kstepA; const char* b2 = last ? nB : cB + (size_t)(t + 2) * kstepB;
            const char* a3 = a2 + kstepA; const char* b3 = b2 + kstepB;
            MK_LDB(B0, 0, 0); MK_LDB(B1, 0, 1); MK_SCHED; MK_LDA(At, 0, 0); MK_STAGE_A(MK_SA(1, 1), a1, 1);
            if constexpr (GA) { if (last && has_next) P.aoffs(nxt, wid, voC); }
            MK_WAIT_V(8); MK_WAIT_L(0); MK_BAR; MK_MMA(0, 0, At, B0); MK_MMA(0, 1, At, B1); MK_BAR; MK_SCHED;
            MK_LDA(At, 0, 1); MK_STAGE(MK_SB(0, 0), b2, voffB); MK_STAGE(MK_SB(0, 1), b2 + hstepB, voffB); MK_STAGE_A(MK_SA(0, 0), a2, 0);
            MK_WAIT_V(8); MK_WAIT_L(0); MK_BAR; MK_MMA(1, 0, At, B0); MK_MMA(1, 1, At, B1); MK_BAR; MK_SCHED;
            MK_LDB(B0, 1, 0); MK_LDB(B1, 1, 1); MK_SCHED; MK_LDA(At, 1, 0); MK_STAGE_A(MK_SA(0, 1), a2, 1);
            MK_WAIT_V(8); MK_WAIT_L(0); MK_BAR; MK_MMA(0, 0, At, B0); MK_MMA(0, 1, At, B1); MK_BAR; MK_SCHED;
            MK_LDA(At, 1, 1); MK_STAGE(MK_SB(1, 0), b3, voffB); MK_STAGE(MK_SB(1, 1), b3 + hstepB, voffB); MK_STAGE_A(MK_SA(1, 0), a3, 0);
            MK_WAIT_V(8); MK_WAIT_L(0); MK_BAR; MK_MMA(1, 0, At, B0); MK_MMA(1, 1, At, B1); MK_BAR; MK_SCHED;
        }
        if (wr == 0) MK_BAR;
        { const int l_ = lane_id_fresh(); P.epi(acc, cur, wr, wc, l_ & 15, l_ >> 4); }
#ifdef MK_EPI2
        if (Prog::ID == MK_EPI2) { const int l_ = lane_id_fresh(); P.epi(acc, cur, wr, wc, l_ & 15, l_ >> 4); }
#endif
        if (!has_next) break;
#pragma unroll
        for (int a = 0; a < 2; ++a)
#pragma unroll
            for (int b = 0; b < 2; ++b)
#pragma unroll
                for (int m = 0; m < 4; ++m)
#pragma unroll
                    for (int n = 0; n < 2; ++n) acc[a][b][m][n] = (f32x4){0.f, 0.f, 0.f, 0.f};
        cur = nxt; cA = nA; cB = nB; ++ui;
        if (wr == 1) MK_BAR;
    }
    MK_WAIT_V(0);
    MK_BAR;
#undef MK_SA
#undef MK_SB
#undef MK_STAGE
#undef MK_STAGE_A
#undef MK_LDA
#undef MK_LDB
#undef MK_MMA
#undef MK_CAT8
}
typedef f32x4 Acc[2][2][4][2];

#define XB_TMO      128
#define XB_XCNT(j)  (256  + 64 * (j))
#define XB_XSUB(j)  (1280 + 64 * (j))
#define XB_XGEN(j)  (2304 + 64 * (j))
#define XB_TOP      3328
#define XB_TOPGEN   3392
#define XCD_BAR_WORDS 3456
#define XB_SPIN_CAP (1u << 18)
__device__ __forceinline__ unsigned xb_ld(unsigned* p)              { return __hip_atomic_load(p, __ATOMIC_RELAXED, __HIP_MEMORY_SCOPE_AGENT); }
__device__ __forceinline__ unsigned xb_add(unsigned* p, unsigned v) { return __hip_atomic_fetch_add(p, v, __ATOMIC_RELAXED, __HIP_MEMORY_SCOPE_AGENT); }
__device__ __forceinline__ unsigned xb_xcc_id() { return (unsigned)__builtin_amdgcn_s_getreg((3 << 11) | 20) & 0xFu; }
#define XB_SPIN(cond, bar) do { unsigned _sp = 0; while (cond) { __builtin_amdgcn_s_sleep(1); \
    if ((++_sp & 255u) == 0u) { if (xb_ld(&(bar)[XB_TMO])) break; if (_sp > XB_SPIN_CAP) { atomicAdd(&(bar)[XB_TMO], 1u); break; } } } } while (0)
struct XcdBarrier { unsigned* bar; unsigned x; volatile LAS unsigned* st; };
__device__ __forceinline__ XcdBarrier xcd_barrier_post(unsigned* bar, volatile LAS unsigned* st) {
    XcdBarrier b; b.bar = bar; b.x = xb_xcc_id(); b.st = st;
    if (threadIdx.x == 0) (void)xb_add(&bar[XB_XCNT(b.x)], 1u);
    return b;
}
__device__ __forceinline__ void xcd_barrier_complete(unsigned* bar, unsigned x, unsigned& nloc, unsigned& nx) {
    const unsigned G = gridDim.x * gridDim.y * gridDim.z;
    unsigned sum, cnt, mine, sp = 0u;
    for (;;) {
        sum = 0u; cnt = 0u; mine = 0u;
#pragma unroll
        for (unsigned j = 0; j < 16; ++j) { const unsigned c = xb_ld(&bar[XB_XCNT(j)]); sum += c; cnt += (c > 0u) ? 1u : 0u; mine = (j == x) ? c : mine; }
        if (sum == G) break;
        __builtin_amdgcn_s_sleep(1);
        if ((++sp & 255u) == 0u) { if (xb_ld(&bar[XB_TMO])) break; if (sp > XB_SPIN_CAP) { atomicAdd(&bar[XB_TMO], 1u); break; } }
    }
    nloc = mine > 0u ? mine : 1u; nx = cnt > 0u ? cnt : 1u;
}
__device__ __forceinline__ void xcd_barrier(const XcdBarrier& b, int wave) {
    asm volatile("s_waitcnt vmcnt(0)" ::: "memory");
    __syncthreads();
    if (wave == 0 && lane_id() == 0) {
        unsigned* bar = b.bar;
        __builtin_amdgcn_s_waitcnt(0);
        unsigned nloc = b.st[0], nx = b.st[1];
        if (nloc == 0u) { xcd_barrier_complete(bar, b.x, nloc, nx); b.st[0] = nloc; b.st[1] = nx; }
        const unsigned old = xb_add(&bar[XB_XSUB(b.x)], 1u);
        const unsigned gen = old / nloc;
        if (old + 1u == (gen + 1u) * nloc) {
            __builtin_amdgcn_fence(__ATOMIC_RELEASE, "agent");
            asm volatile("s_waitcnt vmcnt(0)" ::: "memory");
            const unsigned og = xb_add(&bar[XB_TOP], 1u);
            const unsigned tg = og / nx;
            if (og + 1u == (tg + 1u) * nx) xb_add(&bar[XB_TOPGEN], 1u);
            else XB_SPIN(xb_ld(&bar[XB_TOPGEN]) == tg, bar);
            __builtin_amdgcn_fence(__ATOMIC_ACQUIRE, "agent");
            xb_add(&bar[XB_XGEN(b.x)], 1u);
            asm volatile("s_waitcnt vmcnt(0)" ::: "memory");
        } else {
            XB_SPIN(xb_ld(&bar[XB_XGEN(b.x)]) == gen, bar);
            __builtin_amdgcn_fence(__ATOMIC_ACQUIRE, "agent");
            asm volatile("s_waitcnt vmcnt(0)" ::: "memory");
        }
    }
    __syncthreads();
}

struct Args {
    const float* in[18]; float* out; unsigned char* ws; int ph_lo, ph_hi;
};
#define CAS __attribute__((address_space(4)))
struct Frame {
    LAS unsigned char* lds; int tid, lane, wave, vcu, G;
    const CAS Args* ka;
    __device__ __forceinline__ const float* inp(int k) const { return ka->in[k]; }
    __device__ __forceinline__ unsigned char* ws() const { return ka->ws; }
    __device__ __forceinline__ float* out() const { return ka->out; }
    __device__ __forceinline__ const float* x() const { return inp(0); }
    __device__ __forceinline__ const float* norm1_w() const { return inp(1); }
    __device__ __forceinline__ const float* w_in() const { return inp(2); }
    __device__ __forceinline__ const float* sgu_norm_w() const { return inp(3); }
    __device__ __forceinline__ const float* sgu_w() const { return inp(4); }
    __device__ __forceinline__ const float* sgu_b() const { return inp(5); }
    __device__ __forceinline__ const float* q_norm_w() const { return inp(6); }
    __device__ __forceinline__ const float* k_norm_w() const { return inp(7); }
    __device__ __forceinline__ const float* out_norm_a_w() const { return inp(8); }
    __device__ __forceinline__ const float* out_norm_b_w() const { return inp(9); }
    __device__ __forceinline__ const float* w_out() const { return inp(10); }
    __device__ __forceinline__ const float* norm2_w() const { return inp(11); }
    __device__ __forceinline__ const float* router_w() const { return inp(12); }
    __device__ __forceinline__ const float* router_b() const { return inp(13); }
    __device__ __forceinline__ const float* w_gate_up() const { return inp(14); }
    __device__ __forceinline__ const float* b_gate_up() const { return inp(15); }
    __device__ __forceinline__ const float* w_down() const { return inp(16); }
    __device__ __forceinline__ const float* b_down() const { return inp(17); }
    __device__ __forceinline__ bf16_t* XB() const { return (bf16_t*)(ws() + WS_XB); }
    __device__ __forceinline__ bf16_t* WIN() const { return (bf16_t*)(ws() + WS_WIN); }
    __device__ __forceinline__ bf16_t* WOUT() const { return (bf16_t*)(ws() + WS_WOUT); }
    __device__ __forceinline__ bf16_t* UV() const { return (bf16_t*)(ws() + WS_UV); }
    __device__ __forceinline__ bf16_t* Q() const { return (bf16_t*)(ws() + WS_Q); }
    __device__ __forceinline__ bf16_t* K() const { return (bf16_t*)(ws() + WS_K); }
    __device__ __forceinline__ bf16_t* VT() const { return (bf16_t*)(ws() + WS_VT); }
    __device__ __forceinline__ bf16_t* Y() const { return (bf16_t*)(ws() + WS_Y); }
    __device__ __forceinline__ unsigned char* YS() const { return ws() + WS_YS; }
    __device__ __forceinline__ bf16_t* RT() const { return (bf16_t*)(ws() + WS_RT); }
    __device__ __forceinline__ unsigned char* HB() const { return ws() + WS_HB; }
    __device__ __forceinline__ unsigned char* WGU() const { return ws() + WS_WGU; }
    __device__ __forceinline__ unsigned char* WD() const { return ws() + WS_WD; }
    __device__ __forceinline__ unsigned char* ACT() const { return ws() + WS_ACT; }
    __device__ __forceinline__ float* RSTD1() const { return (float*)(ws() + WS_RSTD1); }
    __device__ __forceinline__ float* SSPART() const { return (float*)(ws() + WS_SSPART); }
    __device__ __forceinline__ float* LISTGATE() const { return (float*)(ws() + WS_LISTGATE); }
    __device__ __forceinline__ int* LISTTOK() const { return (int*)(ws() + WS_LISTTOK); }
    __device__ __forceinline__ int* TOKINFO() const { return (int*)(ws() + WS_TOKINFO); }
    __device__ __forceinline__ unsigned* ctl() const { return (unsigned*)(ws() + WS_CTL); }
};

__device__ __forceinline__ void p0_transpose_item(const float* W, int K, int N, bf16_t* WT, int k0, int n0, int drow0, const float* kscale, LAS float* scr, int lane) {
#pragma unroll 8
    for (int i = 0; i < 32; ++i) { const int kk = 2 * i + (lane >> 5); float v = W[(size_t)(k0 + kk) * N + n0 + (lane & 31)]; if (kscale) v *= kscale[k0 + kk]; scr[kk * 33 + (lane & 31)] = v; }
    asm volatile("s_waitcnt lgkmcnt(0)" ::: "memory");
    const int c = lane & 7;
#pragma unroll
    for (int j = 0; j < 4; ++j) { const int n = (lane >> 3) + 8 * j; const LAS float* s = scr + (8 * c) * 33 + n;
        u32x4 o; o.x = cvt_pk_bf16(s[0 * 33], s[1 * 33]); o.y = cvt_pk_bf16(s[2 * 33], s[3 * 33]); o.z = cvt_pk_bf16(s[4 * 33], s[5 * 33]); o.w = cvt_pk_bf16(s[6 * 33], s[7 * 33]);
        *(u32x4*)(WT + (size_t)(drow0 + n) * K + k0 + 8 * c) = o; }
    asm volatile("s_waitcnt lgkmcnt(0)" ::: "memory");
}
__device__ __forceinline__ void p0_transpose_item_f8(const float* W, int K, int N, unsigned char* WT, int k0, int n0, LAS float* scr, int lane) {
#pragma unroll 8
    for (int i = 0; i < 32; ++i) { const int kk = 2 * i + (lane >> 5); scr[kk * 33 + (lane & 31)] = W[(size_t)(k0 + kk) * N + n0 + (lane & 31)] * WSCALE; }
    asm volatile("s_waitcnt lgkmcnt(0)" ::: "memory");
    const int c = lane & 7;
#pragma unroll
    for (int j = 0; j < 4; ++j) { const int n = (lane >> 3) + 8 * j; const LAS float* s = scr + (8 * c) * 33 + n;
        u32x2 o; o.x = pk4_fp8(s[0 * 33], s[1 * 33], s[2 * 33], s[3 * 33]); o.y = pk4_fp8(s[4 * 33], s[5 * 33], s[6 * 33], s[7 * 33]);
        *(u32x2*)(WT + (size_t)(n0 + n) * K + k0 + 8 * c) = o; }
    asm volatile("s_waitcnt lgkmcnt(0)" ::: "memory");
}
__device__ __forceinline__ int win_drow(int n0) {
    if (n0 < 1024 || n0 >= 2048) return n0;
    const int rel = n0 - 1024, isk = rel >> 9, head = (rel & 511) >> 6, dh = (rel & 63) >> 5;
    return 256 * (4 + 2 * isk + (head >> 2)) + 128 * dh + 32 * (head & 3);
}
constexpr int MOE_I_GU = 64 * 32, MOE_I_D = 64 * 16, MOE_ITEMS = NE * (MOE_I_GU + MOE_I_D);
struct ConvItem { const float* src; unsigned char* dst; int N; };
__device__ __forceinline__ ConvItem moe_conv_decode(const Frame& F, int it) {
    ConvItem c;
    if (it < NE * MOE_I_GU) { const int e = it / MOE_I_GU, q = it % MOE_I_GU, k16 = q >> 5, n64 = q & 31; c.N = 2048;
        c.src = F.w_gate_up() + (size_t)e * KD * 2048 + (size_t)(16 * k16) * 2048 + 64 * n64; c.dst = F.WGU() + (size_t)e * 2048 * KD + ((size_t)k16 * 2048 + 64 * n64) * 16; }
    else { const int r = it - NE * MOE_I_GU; const int e = r / MOE_I_D, q = r % MOE_I_D, k16 = q >> 4, n64 = q & 15; c.N = 1024;
        c.src = F.w_down() + (size_t)e * KD * 1024 + (size_t)(16 * k16) * 1024 + 64 * n64; c.dst = F.WD() + (size_t)e * 1024 * KD + ((size_t)k16 * 1024 + 64 * n64) * 16; }
    return c;
}
__device__ __forceinline__ void moe_conv_issue(const ConvItem& c, float (&v)[16], int lane) {
    const float* p = c.src + lane;
#pragma unroll
    for (int i = 0; i < 16; ++i) v[i] = __builtin_nontemporal_load(p + (size_t)i * c.N);
}
__device__ __forceinline__ void moe_conv_finish(const ConvItem& c, const float (&v)[16], LAS float*, int lane) {
    u32x4 o;
    o.x = pk4_fp8(v[0] * WSCALE, v[1] * WSCALE, v[2] * WSCALE, v[3] * WSCALE); o.y = pk4_fp8(v[4] * WSCALE, v[5] * WSCALE, v[6] * WSCALE, v[7] * WSCALE);
    o.z = pk4_fp8(v[8] * WSCALE, v[9] * WSCALE, v[10] * WSCALE, v[11] * WSCALE); o.w = pk4_fp8(v[12] * WSCALE, v[13] * WSCALE, v[14] * WSCALE, v[15] * WSCALE);
    *(u32x4*)(c.dst + (size_t)lane * 16) = o;
}
constexpr int CONV_P4_PER_WAVE = 40, CONV_P4_ITEMS = CONV_P4_PER_WAVE * 1024;
constexpr int CONV_G_PER_UNIT = 3, CONV_G_ITEMS = CONV_G_PER_UNIT * 4 * 2048;
constexpr int CONV_P2_ITEMS = MOE_ITEMS - CONV_P4_ITEMS - CONV_G_ITEMS, CONV_P2_PER_WAVE = CONV_P2_ITEMS / 2048;
static_assert(CONV_P2_ITEMS % 2048 == 0 && CONV_P4_PER_WAVE % 2 == 0, "conversion split");
__device__ __forceinline__ void p0_prologue(Frame& F) {
    LAS float* scr = (LAS float*)(F.lds + F.wave * 16384);
    const int gw = F.vcu * NWAVES + F.wave, NGW = F.G * NWAVES, lane = F.lane;
    for (int m = gw; m < NTOK; m += 2 * NGW) {
        const int m2 = m + NGW;
        const f32x4* xr = (const f32x4*)(F.x() + (size_t)m * DM) + lane; const f32x4* xr2 = (const f32x4*)(F.x() + (size_t)m2 * DM) + lane; f32x4 v[4], w[4]; float s = 0.f, s2 = 0.f;
#pragma unroll
        for (int j = 0; j < 4; ++j) v[j] = __builtin_nontemporal_load(xr + 64 * j);
#pragma unroll
        for (int j = 0; j < 4; ++j) w[j] = __builtin_nontemporal_load(xr2 + 64 * j);
#pragma unroll
        for (int j = 0; j < 4; ++j) { s += (v[j].x * v[j].x + v[j].y * v[j].y) + (v[j].z * v[j].z + v[j].w * v[j].w); s2 += (w[j].x * w[j].x + w[j].y * w[j].y) + (w[j].z * w[j].z + w[j].w * w[j].w); }
        const float tot = wave_sum(s), tot2 = wave_sum(s2);
        if (lane == 0) { F.RSTD1()[m] = 1.0f / sqrtf(tot * (1.0f / DM) + EPS); F.RSTD1()[m2] = 1.0f / sqrtf(tot2 * (1.0f / DM) + EPS); }
        u32x2* o8 = (u32x2*)(F.XB() + (size_t)m * DM) + lane; u32x2* o82 = (u32x2*)(F.XB() + (size_t)m2 * DM) + lane;
#pragma unroll
        for (int j = 0; j < 4; ++j) { u32x2 a; a.x = cvt_pk_bf16(v[j].x, v[j].y); a.y = cvt_pk_bf16(v[j].z, v[j].w); o8[64 * j] = a; u32x2 b; b.x = cvt_pk_bf16(w[j].x, w[j].y); b.y = cvt_pk_bf16(w[j].z, w[j].w); o82[64 * j] = b; }
    }
    constexpr int I_IN = 16 * 80, I_OUT = 16 * 32;
    for (int it = gw; it < I_IN + I_OUT; it += NGW) {
        int r = it;
        if (r < I_IN) { const int kb = r / 80, nb = r % 80; p0_transpose_item(F.w_in(), KD, 2560, F.WIN(), 64 * kb, 32 * nb, win_drow(32 * nb), F.norm1_w(), scr, lane); continue; } r -= I_IN;
        { const int kb = r / 32, nb = r % 32; p0_transpose_item(F.w_out(), KD, 1024, F.WOUT(), 64 * kb, 32 * nb, 32 * nb, nullptr, scr, lane); }
    }
    for (int idx = gw * 64 + lane; idx < NE * KD; idx += NGW * 64) {
        const int e = idx >> 10, k = idx & 1023; const float w = F.router_w()[(size_t)k * NE + e];
        const unsigned hi = cvt_pk_bf16(w, 0.f) & 0xffffu; const float rem = w - __uint_as_float(hi << 16);
        F.RT()[idx] = (bf16_t)hi; F.RT()[NE * KD + idx] = (bf16_t)(cvt_pk_bf16(rem, 0.f) & 0xffffu);
    }
}

struct ProgIn {
    static constexpr bool GATHER = false, FP8 = false; static constexpr int ID = 1, BN = 0, AR = 0;
    const Frame* F;
    __device__ __forceinline__ bool next(int i, Unit& u) const {
        const int v = F->vcu;
        if (i < 4) { const int uu = i * 256 + v, grp = uu >> 5, w = uu & 31; u.pm = grp * 4 + (w & 3); u.pn = w >> 2; u.kind = u.pn < 4 ? 0 : 1;
            u.A = (const char*)(F->XB() + (size_t)u.pm * 256 * KD); u.B = (const char*)(F->WIN() + (size_t)u.pn * 256 * KD); u.e = 0; u.r0 = 0; return true; }
        if (i == 4) { u.kind = 2; u.pm = v & 1; u.pn = v >> 1; u.A = (const char*)(F->WIN() + (size_t)(2048 + u.pm * 256) * KD); u.B = (const char*)(F->XB() + (size_t)u.pn * 256 * KD); u.e = 0; u.r0 = 0; return true; }
        return false;
    }
    __device__ __forceinline__ void epi(const Acc& acc, const Unit& u, int wr, int wc, int fr, int fq) const {
        asm volatile("" : "+v"(fr), "+v"(fq));
        if (u.kind == 2) {
            const int tk0 = u.pn * 256 + wc * 32 + 8 * fq;
            f32x4 rs[2][2];
#pragma unroll
            for (int bj = 0; bj < 2; ++bj)
#pragma unroll
                for (int n = 0; n < 2; ++n) rs[bj][n] = *(const f32x4*)(F->RSTD1() + tk0 + bj * 128 + 4 * n);
#pragma unroll
            for (int ai = 0; ai < 2; ++ai)
#pragma unroll
                for (int m = 0; m < 4; ++m) { const int cp = u.pm * 256 + ai * 128 + wr * 64 + m * 16 + fr; bf16_t* rowp = F->VT() + (size_t)cp * NTOK + tk0;
#pragma unroll
                    for (int bj = 0; bj < 2; ++bj) { const f32x4 v0 = acc[ai][bj][m][0] * rs[bj][0], v1 = acc[ai][bj][m][1] * rs[bj][1];
                        u32x4 w; w.x = cvt_pk_bf16(v0[0], v0[1]); w.y = cvt_pk_bf16(v0[2], v0[3]); w.z = cvt_pk_bf16(v1[0], v1[1]); w.w = cvt_pk_bf16(v1[2], v1[3]);
                        *(u32x4*)(rowp + bj * 128) = w; } }
            return;
        }
        float rsr[2][4];
#pragma unroll
        for (int ai = 0; ai < 2; ++ai)
#pragma unroll
            for (int m = 0; m < 4; ++m) rsr[ai][m] = F->RSTD1()[u.pm * 256 + ai * 128 + wr * 64 + m * 16 + fr];
        if (u.kind == 0) {
#pragma unroll
            for (int ai = 0; ai < 2; ++ai)
#pragma unroll
                for (int m = 0; m < 4; ++m) { const int r = u.pm * 256 + ai * 128 + wr * 64 + m * 16 + fr; bf16_t* rowp = F->UV() + (size_t)r * 1024 + u.pn * 256 + wc * 32 + 8 * fq; const float rs = rsr[ai][m];
#pragma unroll
                    for (int bj = 0; bj < 2; ++bj) { f32x4 v0 = acc[ai][bj][m][0] * rs, v1 = acc[ai][bj][m][1] * rs;
#pragma unroll
                        for (int j = 0; j < 4; ++j) { v0[j] = gelu_tanh_f(v0[j]); v1[j] = gelu_tanh_f(v1[j]); }
                        u32x4 w; w.x = cvt_pk_bf16(v0[0], v0[1]); w.y = cvt_pk_bf16(v0[2], v0[3]); w.z = cvt_pk_bf16(v1[0], v1[1]); w.w = cvt_pk_bf16(v1[2], v1[3]);
                        *(u32x4*)(rowp + bj * 128) = w; } }
            return;
        }
        {
            const int isk = (u.pn - 4) >> 1, head = 4 * (u.pn & 1) + wc; const float* nw = isk ? F->k_norm_w() : F->q_norm_w(); bf16_t* dst = isk ? F->K() : F->Q();
            const float osc = isk ? 1.0f : QSCALE;
            f32x4 nwv[2][2];
#pragma unroll
            for (int bj = 0; bj < 2; ++bj)
#pragma unroll
                for (int n = 0; n < 2; ++n) nwv[bj][n] = *(const f32x4*)(nw + 32 * bj + 8 * fq + 4 * n);
#pragma unroll
            for (int ai = 0; ai < 2; ++ai)
#pragma unroll
                for (int m = 0; m < 4; ++m) { const int r = u.pm * 256 + ai * 128 + wr * 64 + m * 16 + fr; const float rs = rsr[ai][m];
                    f32x4 t[2][2]; float ss = 0.f;
#pragma unroll
                    for (int bj = 0; bj < 2; ++bj)
#pragma unroll
                        for (int n = 0; n < 2; ++n) { t[bj][n] = acc[ai][bj][m][n] * rs; ss += (t[bj][n][0] * t[bj][n][0] + t[bj][n][1] * t[bj][n][1]) + (t[bj][n][2] * t[bj][n][2] + t[bj][n][3] * t[bj][n][3]); }
                    ss += __shfl_xor(ss, 16); ss += __shfl_xor(ss, 32);
                    const float rn = osc / sqrtf(ss * (1.0f / 64.0f) + EPS);
                    bf16_t* rowp = dst + (size_t)r * 512 + head * 64 + 8 * fq;
#pragma unroll
                    for (int bj = 0; bj < 2; ++bj) { const f32x4 v0 = t[bj][0] * nwv[bj][0] * rn, v1 = t[bj][1] * nwv[bj][1] * rn;
                        u32x4 w; w.x = cvt_pk_bf16(v0[0], v0[1]); w.y = cvt_pk_bf16(v0[2], v0[3]); w.z = cvt_pk_bf16(v1[0], v1[1]); w.w = cvt_pk_bf16(v1[2], v1[3]);
                        *(u32x4*)(rowp + bj * 32) = w; } }
        }
    }
};

constexpr int VN_PITCH = 136, YT_PITCH = 132, YT_OFF = 36864;
__device__ __forceinline__ void gmlp_unit(const Frame& F, int chunk, int g, int cbase) {
    const int tid = F.tid, lane = F.lane, wid = F.wave;
    ConvItem gci[CONV_G_PER_UNIT]; float gcv[CONV_G_PER_UNIT][16];
#pragma unroll
    for (int q = 0; q < CONV_G_PER_UNIT; ++q) { gci[q] = moe_conv_decode(F, cbase + q * 2048); moe_conv_issue(gci[q], gcv[q], lane); }
    LAS bf16_t* vn = (LAS bf16_t*)F.lds; LAS float* yt = (LAS float*)(F.lds + YT_OFF);
    const size_t tok0 = (size_t)chunk * 128;
    {
        const int row = tid >> 2, qd = tid & 3; const bf16_t* src = F.UV() + (tok0 + row) * 1024 + 512 + g * 128 + qd * 32;
        u32x4 w[4]; float v[32]; float ss = 0.f;
#pragma unroll
        for (int i = 0; i < 4; ++i) w[i] = *(const u32x4*)(src + 8 * i);
#pragma unroll
        for (int i = 0; i < 4; ++i)
#pragma unroll
            for (int j = 0; j < 4; ++j) { v[8 * i + 2 * j] = bflo(w[i][j]); v[8 * i + 2 * j + 1] = bfhi(w[i][j]); }
#pragma unroll
        for (int i = 0; i < 32; ++i) ss += v[i] * v[i];
        ss += __shfl_xor(ss, 1); ss += __shfl_xor(ss, 2);
        const float rs = 1.0f / sqrtf(ss * (1.0f / 128.0f) + EPS);
        const float* nw = F.sgu_norm_w() + g * 128 + qd * 32;
#pragma unroll
        for (int i = 0; i < 4; ++i) { const f32x4 n0 = *(const f32x4*)(nw + 8 * i), n1 = *(const f32x4*)(nw + 8 * i + 4);
            u32x4 o; o.x = cvt_pk_bf16(v[8 * i] * rs * n0[0], v[8 * i + 1] * rs * n0[1]); o.y = cvt_pk_bf16(v[8 * i + 2] * rs * n0[2], v[8 * i + 3] * rs * n0[3]);
            o.z = cvt_pk_bf16(v[8 * i + 4] * rs * n1[0], v[8 * i + 5] * rs * n1[1]); o.w = cvt_pk_bf16(v[8 * i + 6] * rs * n1[2], v[8 * i + 7] * rs * n1[3]);
            *(LAS u32x4*)(vn + row * VN_PITCH + qd * 32 + 8 * i) = o; }
    }
    __syncthreads();
    {
        const int tb = wid >> 1, cb0 = 2 * (wid & 1), r32 = lane & 31, hh = lane >> 5;
        f32x16 a0 = {}, a1 = {};
        const int t = 32 * tb + r32; const float* wrow = F.sgu_w() + ((size_t)g * 128 + t) * 128;
        for (int ks = 0; ks < 2 * (tb + 1); ++ks) {
            const int s0 = 16 * ks + 8 * hh;
            const f32x4 w0 = *(const f32x4*)(wrow + s0), w1 = *(const f32x4*)(wrow + s0 + 4);
            float wv[8] = {w0[0], w0[1], w0[2], w0[3], w1[0], w1[1], w1[2], w1[3]};
#pragma unroll
            for (int j = 0; j < 8; ++j) if (s0 + j > t) wv[j] = 0.f;
            u32x4 aw; aw.x = cvt_pk_bf16(wv[0], wv[1]); aw.y = cvt_pk_bf16(wv[2], wv[3]); aw.z = cvt_pk_bf16(wv[4], wv[5]); aw.w = cvt_pk_bf16(wv[6], wv[7]);
            const bf16x8 af = __builtin_bit_cast(bf16x8, aw);
            bf16x8 b0, b1;
#pragma unroll
            for (int j = 0; j < 8; ++j) { b0[j] = (short)vn[(s0 + j) * VN_PITCH + 32 * cb0 + r32]; b1[j] = (short)vn[(s0 + j) * VN_PITCH + 32 * (cb0 + 1) + r32]; }
            a0 = __builtin_amdgcn_mfma_f32_32x32x16_bf16(af, b0, a0, 0, 0, 0);
            a1 = __builtin_amdgcn_mfma_f32_32x32x16_bf16(af, b1, a1, 0, 0, 0);
        }
#pragma unroll
        for (int reg = 0; reg < 16; ++reg) {
            const int tt = 32 * tb + (reg & 3) + 8 * (reg >> 2) + 4 * hh; const float bb = F.sgu_b()[g * 128 + tt];
            const bf16_t* up = F.UV() + (tok0 + tt) * 1024 + g * 128;
            const int c0 = 32 * cb0 + r32, c1 = c0 + 32;
            yt[tt * YT_PITCH + c0] = bf2f(up[c0]) * (a0[reg] + bb);
            yt[tt * YT_PITCH + c1] = bf2f(up[c1]) * (a1[reg] + bb);
        }
    }
    __syncthreads();
    {
        const int row = tid >> 2, qd = tid & 3; const LAS float* src = yt + row * YT_PITCH + qd * 32; f32x4 v[8]; float ss = 0.f;
#pragma unroll
        for (int i = 0; i < 8; ++i) { v[i] = *(const LAS f32x4*)(src + 4 * i); ss += (v[i][0] * v[i][0] + v[i][1] * v[i][1]) + (v[i][2] * v[i][2] + v[i][3] * v[i][3]); }
        ss += __shfl_xor(ss, 1); ss += __shfl_xor(ss, 2);
        const float rs = 1.0f / sqrtf(ss * (1.0f / 128.0f) + EPS);
        const float* nw = F.out_norm_a_w() + g * 128 + qd * 32; bf16_t* dst = F.Y() + (tok0 + row) * 1024 + g * 128 + qd * 32;
#pragma unroll
        for (int i = 0; i < 4; ++i) { const f32x4 n0 = *(const f32x4*)(nw + 8 * i), n1 = *(const f32x4*)(nw + 8 * i + 4); const f32x4 x0 = v[2 * i] * n0 * rs, x1 = v[2 * i + 1] * n1 * rs;
            u32x4 o; o.x = cvt_pk_bf16(x0[0], x0[1]); o.y = cvt_pk_bf16(x0[2], x0[3]); o.z = cvt_pk_bf16(x1[0], x1[1]); o.w = cvt_pk_bf16(x1[2], x1[3]);
            *(u32x4*)(dst + 8 * i) = o; }
    }
#pragma unroll
    for (int q = 0; q < CONV_G_PER_UNIT; ++q) moe_conv_finish(gci[q], gcv[q], nullptr, lane);
    __syncthreads();
}

__device__ __forceinline__ void attn_wave_unit(const Frame& F, int b, int h, int qblk, int& cit, int cend, LAS float* scr) {
    const int lane = F.lane, r32 = lane & 31, hi = lane >> 5;
    const size_t tokq = (size_t)b * SEQ + 32 * qblk + r32;
    bf16x8 qr[4];
#pragma unroll
    for (int d0 = 0; d0 < 4; ++d0) qr[d0] = *(const bf16x8*)(F.Q() + tokq * 512 + h * 64 + 16 * d0 + 8 * hi);
    f32x16 o0 = {}, o1 = {};
    float carry = 0.f;
    const bf16_t* Kb = F.K() + ((size_t)b * SEQ + r32) * 512 + h * 64 + 8 * hi;
    const bf16_t* V0 = F.VT() + (size_t)(h * 64 + r32) * NTOK + (size_t)b * SEQ + 4 * hi;
    bf16x8 kf[4]; s16x4 vf[2][2][2];
    auto load_tile = [&](int j, bf16x8 (&kk)[4], s16x4 (&vv)[2][2][2]) {
#pragma unroll
        for (int d0 = 0; d0 < 4; ++d0) kk[d0] = *(const bf16x8*)(Kb + (size_t)(32 * j) * 512 + 16 * d0);
#pragma unroll
        for (int dh = 0; dh < 2; ++dh)
#pragma unroll
            for (int ks = 0; ks < 2; ++ks) { const bf16_t* p = V0 + (size_t)dh * 32 * NTOK + 32 * j + 16 * ks; vv[dh][ks][0] = *(const s16x4*)p; vv[dh][ks][1] = *(const s16x4*)(p + 8); }
    };
    load_tile(qblk, kf, vf);
    bool pcv = false; ConvItem pitem; float pvv[16];
    for (int j = qblk; j >= 0; --j) {
        bf16x8 kn[4]; s16x4 vn2[2][2][2];
        if (j > 0) load_tile(j - 1, kn, vn2);
        else {
#pragma unroll
            for (int d0 = 0; d0 < 4; ++d0) kn[d0] = kf[d0];
#pragma unroll
            for (int dh = 0; dh < 2; ++dh)
#pragma unroll
                for (int ks = 0; ks < 2; ++ks) { vn2[dh][ks][0] = vf[dh][ks][0]; vn2[dh][ks][1] = vf[dh][ks][1]; }
        }
        const bool cv = cit < cend; ConvItem citem; float cvv[16];
        if (cv) { citem = moe_conv_decode(F, cit); moe_conv_issue(citem, cvv, lane); cit += 2048; }
        f32x16 s = {};
#pragma unroll
        for (int d0 = 0; d0 < 4; ++d0) s = __builtin_amdgcn_mfma_f32_32x32x16_bf16(kf[d0], qr[d0], s, 0, 0, 0);
        float sp[16];
        const bool diag = (j == qblk);
#pragma unroll
        for (int r = 0; r < 16; ++r) {
            const int kvl = (r & 3) + 8 * (r >> 2) + 4 * hi;
            const float z = s[r];
            float v = fmaxf(z, 0.f) + __builtin_amdgcn_logf(1.0f + __builtin_amdgcn_exp2f(-fabsf(z)));
            if (diag && kvl >= r32) v = 0.f;
            sp[r] = v;
        }
        float G[4], Gp[4];
#pragma unroll
        for (int k = 0; k < 4; ++k) { G[k] = (sp[4 * k] + sp[4 * k + 1]) + (sp[4 * k + 2] + sp[4 * k + 3]); Gp[k] = __shfl_xor(G[k], 32); }
        const float T3 = G[3] + Gp[3], T2 = G[2] + Gp[2], T1 = G[1] + Gp[1], T0 = G[0] + Gp[0];
        float off[4];
        off[3] = 0.f; off[2] = T3; off[1] = T3 + T2; off[0] = T3 + T2 + T1;
        const float tile_total = off[0] + T0;
#pragma unroll
        for (int k = 0; k < 4; ++k) off[k] += carry + (hi == 0 ? Gp[k] : 0.f);
        float a[16];
#pragma unroll
        for (int k = 0; k < 4; ++k) {
            float c = off[k];
#pragma unroll
            for (int i = 3; i >= 0; --i) { const int r = 4 * k + i; c += sp[r]; float av = __builtin_amdgcn_exp2f(s[r] - c);
                if (diag && ((r & 3) + 8 * (r >> 2) + 4 * hi) >= r32) av = 0.f;
                a[r] = av; }
        }
        carry += tile_total;
        u32x4 p0, p1;
        p0.x = cvt_pk_bf16(a[0], a[1]); p0.y = cvt_pk_bf16(a[2], a[3]); p0.z = cvt_pk_bf16(a[4], a[5]); p0.w = cvt_pk_bf16(a[6], a[7]);
        p1.x = cvt_pk_bf16(a[8], a[9]); p1.y = cvt_pk_bf16(a[10], a[11]); p1.z = cvt_pk_bf16(a[12], a[13]); p1.w = cvt_pk_bf16(a[14], a[15]);
        const bf16x8 pf0 = __builtin_bit_cast(bf16x8, p0), pf1 = __builtin_bit_cast(bf16x8, p1);
#define MK_VF(dh, ks) (bf16x8){vf[dh][ks][0][0], vf[dh][ks][0][1], vf[dh][ks][0][2], vf[dh][ks][0][3], vf[dh][ks][1][0], vf[dh][ks][1][1], vf[dh][ks][1][2], vf[dh][ks][1][3]}
        o0 = __builtin_amdgcn_mfma_f32_32x32x16_bf16(MK_VF(0, 0), pf0, o0, 0, 0, 0);
        o0 = __builtin_amdgcn_mfma_f32_32x32x16_bf16(MK_VF(0, 1), pf1, o0, 0, 0, 0);
        o1 = __builtin_amdgcn_mfma_f32_32x32x16_bf16(MK_VF(1, 0), pf0, o1, 0, 0, 0);
        o1 = __builtin_amdgcn_mfma_f32_32x32x16_bf16(MK_VF(1, 1), pf1, o1, 0, 0, 0);
#undef MK_VF
        if (pcv) moe_conv_finish(pitem, pvv, scr, lane);
        pcv = cv; pitem = citem;
#pragma unroll
        for (int i = 0; i < 16; ++i) pvv[i] = cvv[i];
        if (__all(carry > SB_THR)) break;
#pragma unroll
        for (int d0 = 0; d0 < 4; ++d0) kf[d0] = kn[d0];
#pragma unroll
        for (int dh = 0; dh < 2; ++dh)
#pragma unroll
            for (int ks = 0; ks < 2; ++ks) { vf[dh][ks][0] = vn2[dh][ks][0]; vf[dh][ks][1] = vn2[dh][ks][1]; }
    }
    if (pcv) moe_conv_finish(pitem, pvv, scr, lane);
    float ss = 0.f;
#pragma unroll
    for (int r = 0; r < 16; ++r) ss += o0[r] * o0[r] + o1[r] * o1[r];
    ss += __shfl_xor(ss, 32);
    const float rs = 1.0f / sqrtf(ss * (1.0f / 64.0f) + EPS);
    const float* nw = F.out_norm_b_w() + h * 64 + 4 * hi; bf16_t* dst = F.Y() + tokq * 1024 + 512 + h * 64 + 4 * hi;
#pragma unroll
    for (int dh = 0; dh < 2; ++dh)
#pragma unroll
        for (int g = 0; g < 4; ++g) { const f32x4 w = *(const f32x4*)(nw + 32 * dh + 8 * g); const f32x16& o = dh ? o1 : o0;
            u32x2 pk; pk.x = cvt_pk_bf16(o[4 * g] * rs * w[0], o[4 * g + 1] * rs * w[1]); pk.y = cvt_pk_bf16(o[4 * g + 2] * rs * w[2], o[4 * g + 3] * rs * w[3]);
            *(u32x2*)(dst + 32 * dh + 8 * g) = pk; }
}
__device__ __forceinline__ void p2_mixers(Frame& F) {
    for (int i = 0; i < 4; ++i) { const int u = i * 256 + F.vcu; gmlp_unit(F, u >> 2, u & 3, CONV_P4_ITEMS + i * CONV_G_PER_UNIT * 2048 + F.vcu * NWAVES + F.wave); }
    const int gw = F.vcu * NWAVES + F.wave;
    LAS float* scr = (LAS float*)(F.lds + F.wave * 16384);
    int cit = CONV_P4_ITEMS + CONV_G_ITEMS + gw; const int cend = MOE_ITEMS;
    for (int i = 0; i < ((MK_REP == 21 || MK_REP == 22) ? 8 : 4); ++i) { if (MK_REP == 22 && i == 4) cit = CONV_P4_ITEMS + gw; const int u = (i & 3) * 2048 + gw; const int qblk = u & 127, bh = u >> 7; attn_wave_unit(F, bh >> 3, bh & 7, qblk, cit, cend, scr); }
    for (; cit < cend; cit += 2048) { const ConvItem c = moe_conv_decode(F, cit); float v[16]; moe_conv_issue(c, v, F.lane); moe_conv_finish(c, v, scr, F.lane); }
}

struct ProgOut {
    static constexpr bool GATHER = false, FP8 = false; static constexpr int ID = 3, BN = 0, AR = 0;
    const Frame* F;
    __device__ __forceinline__ bool next(int i, Unit& u) const {
        if (i >= 2) return false;
        const int uu = i * 256 + F->vcu, grp = uu >> 5, w = uu & 31; u.pm = grp * 8 + (w & 7); u.pn = w >> 3; u.kind = 0; u.e = 0; u.r0 = 0;
        u.A = (const char*)(F->Y() + (size_t)u.pm * 256 * KD); u.B = (const char*)(F->WOUT() + (size_t)u.pn * 256 * KD); return true;
    }
    __device__ __forceinline__ void epi(const Acc& acc, const Unit& u, int wr, int wc, int fr, int fq) const {
        asm volatile("" : "+v"(fr), "+v"(fq));
        const size_t off0 = (size_t)(u.pm * 256 + wr * 64 + fr) * DM + u.pn * 256 + wc * 32 + 8 * fq;
        const float* xb = F->x() + off0; float* ob = F->out() + off0;
        f32x4 xv[2][2][2];
#define MK_LDX(g, slot) do { const size_t go_ = (size_t)(((g) >> 2) * 128 + ((g) & 3) * 16) * DM; _Pragma("unroll") for (int bj = 0; bj < 2; ++bj) _Pragma("unroll") for (int n = 0; n < 2; ++n) xv[slot][bj][n] = *(const f32x4*)(xb + go_ + bj * 128 + 4 * n); } while (0)
        MK_LDX(0, 0);
#pragma unroll
        for (int g = 0; g < 8; ++g) { const int ai = g >> 2, m = g & 3; const size_t go = (size_t)(ai * 128 + m * 16) * DM; float ss = 0.f;
            if (g + 1 < 8) MK_LDX(g + 1, (g + 1) & 1);
#pragma unroll
            for (int bj = 0; bj < 2; ++bj)
#pragma unroll
                for (int n = 0; n < 2; ++n) { const f32x4 o = xv[g & 1][bj][n] + acc[ai][bj][m][n];
                    ss += (o[0] * o[0] + o[1] * o[1]) + (o[2] * o[2] + o[3] * o[3]); *(f32x4*)(ob + go + bj * 128 + 4 * n) = o; }
            ss += __shfl_xor(ss, 16); ss += __shfl_xor(ss, 32);
            if (fq == 0) F->SSPART()[(size_t)(u.pm * 256 + ai * 128 + wr * 64 + m * 16 + fr) * 16 + u.pn * 4 + wc] = ss; }
#undef MK_LDX
    }
};

template <bool DRY> __device__ __forceinline__ void router_wave_unit(Frame& F, int unit) {
    const int lane = F.lane, r32 = lane & 31, hh = lane >> 5; const int tok = unit * 32 + r32;
    float ssum = 0.f;
    { const f32x4* sp = (const f32x4*)(F.SSPART() + (size_t)tok * 16);
#pragma unroll
      for (int i = 0; i < 4; ++i) { const f32x4 v = sp[i]; ssum += v[0]; ssum += v[1]; ssum += v[2]; ssum += v[3]; } }
    const float rs = 1.0f / sqrtf(ssum * (1.0f / DM) + EPS);
    f32x16 acc = {};
    const float* xrow = F.out() + (size_t)tok * DM + 8 * hh; const float* w2 = F.norm2_w() + 8 * hh; unsigned char* hrow = F.HB() + (size_t)tok * DM + 8 * hh;
    const bf16_t* rth = F.RT() + (size_t)r32 * KD + 8 * hh; const bf16_t* rtl = rth + NE * KD;
#pragma unroll 4
    for (int s = 0; s < 64; ++s) {
        const f32x4 x0 = *(const f32x4*)(xrow + 16 * s), x1 = *(const f32x4*)(xrow + 16 * s + 4);
        const f32x4 g0 = *(const f32x4*)(w2 + 16 * s), g1 = *(const f32x4*)(w2 + 16 * s + 4);
        const f32x4 h0 = x0 * g0 * rs, h1 = x1 * g1 * rs;
        u32x4 hw; hw.x = cvt_pk_bf16(h0[0], h0[1]); hw.y = cvt_pk_bf16(h0[2], h0[3]); hw.z = cvt_pk_bf16(h1[0], h1[1]); hw.w = cvt_pk_bf16(h1[2], h1[3]);
        { u32x2 h8; h8.x = pk4_fp8(h0[0], h0[1], h0[2], h0[3]); h8.y = pk4_fp8(h1[0], h1[1], h1[2], h1[3]); *(u32x2*)(hrow + 16 * s) = h8; }
        u32x4 lw; lw.x = cvt_pk_bf16(h0[0] - bflo(hw.x), h0[1] - bfhi(hw.x)); lw.y = cvt_pk_bf16(h0[2] - bflo(hw.y), h0[3] - bfhi(hw.y));
        lw.z = cvt_pk_bf16(h1[0] - bflo(hw.z), h1[1] - bfhi(hw.z)); lw.w = cvt_pk_bf16(h1[2] - bflo(hw.w), h1[3] - bfhi(hw.w));
        const bf16x8 bh = __builtin_bit_cast(bf16x8, hw), bl = __builtin_bit_cast(bf16x8, lw);
        const bf16x8 ah = *(const bf16x8*)(rth + 16 * s), al = *(const bf16x8*)(rtl + 16 * s);
        acc = __builtin_amdgcn_mfma_f32_32x32x16_bf16(ah, bh, acc, 0, 0, 0);
        acc = __builtin_amdgcn_mfma_f32_32x32x16_bf16(al, bh, acc, 0, 0, 0);
        acc = __builtin_amdgcn_mfma_f32_32x32x16_bf16(ah, bl, acc, 0, 0, 0);
    }
    float lv[16];
#pragma unroll
    for (int r = 0; r < 16; ++r) lv[r] = acc[r] + F.router_b()[(r & 3) + 8 * (r >> 2) + 4 * hh];
    float cv[8]; int ce[8];
#pragma unroll
    for (int k = 0; k < 4; ++k) { float bv = -INFINITY; int be = 0;
#pragma unroll
        for (int r = 0; r < 16; ++r) { const int e = (r & 3) + 8 * (r >> 2) + 4 * hh; if (lv[r] > bv) { bv = lv[r]; be = e; } }
#pragma unroll
        for (int r = 0; r < 16; ++r) { const int e = (r & 3) + 8 * (r >> 2) + 4 * hh; if (e == be) lv[r] = -INFINITY; }
        cv[k] = bv; ce[k] = be; }
#pragma unroll
    for (int k = 0; k < 4; ++k) { cv[4 + k] = __shfl_xor(cv[k], 32); ce[4 + k] = __shfl_xor(ce[k], 32); }
    float tv[4]; int te[4];
#pragma unroll
    for (int k = 0; k < 4; ++k) { float bv = -INFINITY; int be = 1 << 20;
#pragma unroll
        for (int c = 0; c < 8; ++c) if (cv[c] > bv || (cv[c] == bv && ce[c] < be)) { bv = cv[c]; be = ce[c]; }
#pragma unroll
        for (int c = 0; c < 8; ++c) if (ce[c] == be) cv[c] = -INFINITY;
        tv[k] = bv; te[k] = be; }
    float ex[4], den = 0.f;
#pragma unroll
    for (int k = 0; k < 4; ++k) { ex[k] = __builtin_amdgcn_exp2f((tv[k] - tv[0]) * LOG2E); den += ex[k]; }
    const float rden = 1.0f / den;
    const int e0 = hh ? te[2] : te[0], e1 = hh ? te[3] : te[1]; const float g0 = (hh ? ex[2] : ex[0]) * rden, g1 = (hh ? ex[3] : ex[1]) * rden;
    if (DRY) { asm volatile("" :: "v"(e0), "v"(e1), "v"(g0), "v"(g1)); return; }
    int myc = 0; int rank0 = 0, rank1 = 0;
    const unsigned long long ltmask = (1ull << lane) - 1ull;
    for (int e = 0; e < NE; ++e) {
        const unsigned long long m0 = __ballot(e0 == e), m1 = __ballot(e1 == e);
        const int c0 = __popcll(m0), c1 = __popcll(m1);
        if (lane == e) myc = c0 + c1;
        if (e0 == e) rank0 = __popcll(m0 & ltmask);
        if (e1 == e) rank1 = c0 + __popcll(m1 & ltmask);
    }
    int base = 0;
    if (lane < NE && myc > 0) base = (int)__hip_atomic_fetch_add(F.ctl() + CW_CNT + lane, (unsigned)myc, __ATOMIC_RELAXED, __HIP_MEMORY_SCOPE_AGENT);
    const int p0 = __shfl(base, e0) + rank0, p1 = __shfl(base, e1) + rank1;
    F.LISTTOK()[(size_t)e0 * NTOK + p0] = tok; F.LISTGATE()[(size_t)e0 * NTOK + p0] = g0;
    F.LISTTOK()[(size_t)e1 * NTOK + p1] = tok; F.LISTGATE()[(size_t)e1 * NTOK + p1] = g1;
    F.TOKINFO()[tok * 4 + 2 * hh] = (e0 << 16) | p0; F.TOKINFO()[tok * 4 + 2 * hh + 1] = (e1 << 16) | p1;
}

__device__ __forceinline__ void moe_build_table(Frame& F) {
    LAS int* tab = (LAS int*)(F.lds + TAB_OFF);
    if (F.tid < NE) tab[F.tid] = (int)__hip_atomic_load(F.ctl() + CW_CNT + F.tid, __ATOMIC_RELAXED, __HIP_MEMORY_SCOPE_AGENT);
    __syncthreads();
    if (F.tid == 0) { int acc = 0; for (int e = 0; e < NE; ++e) { tab[32 + e] = acc; acc += (tab[e] + 255) >> 8; } tab[64] = acc; }
    __syncthreads();
}
__device__ __forceinline__ int sgpr(int v) { return __builtin_amdgcn_readfirstlane(v); }
template <int WGM, int NN>
__device__ __forceinline__ bool moe_decode(const Frame* F, int T, int i, Unit& u) {
    const LAS int* tab = (const LAS int*)(F->lds + TAB_OFF);
    const int uu = i * 256 + F->vcu, grp = uu >> 5, w = uu & 31; const int mt = grp * WGM + (w % WGM); u.pn = w / WGM;
    if (mt >= T) return false;
    int e = 0;
    for (int k = 1; k < NE; ++k) if (sgpr(tab[32 + k]) <= mt) e = k;
    u.e = e; u.pm = mt; u.r0 = (mt - sgpr(tab[32 + e])) * 256; u.kind = sgpr(tab[e]); return true;
}
struct ProgMoe1 {
    static constexpr bool GATHER = true, FP8 = true; static constexpr int ID = 5, BN = 2048, AR = NTOK;
    const Frame* F; int T;
    __device__ __forceinline__ bool next(int i, Unit& u) const {
        if (!moe_decode<4, 8>(F, T, i, u)) return false;
        u.A = (const char*)F->HB(); u.B = (const char*)(F->WGU() + (size_t)u.e * 2048 * KD + (size_t)u.pn * 256 * 16); return true;
    }
    __device__ __forceinline__ void aoffs(const Unit& u, int wid, unsigned (&vo)[2][2]) const {
        const int cnt = u.kind; const int tid = wid * 64 + lane_id_fresh();
#pragma unroll
        for (int i = 0; i < 2; ++i) { int R_, Cb_; stage_rc8(tid * 16 + i * 8192, R_, Cb_);
#pragma unroll
            for (int h = 0; h < 2; ++h) { const int idx = u.r0 + h * 128 + R_; const int tok = idx < cnt ? F->LISTTOK()[(size_t)u.e * NTOK + idx] : 0; vo[h][i] = (unsigned)(tok * KD + Cb_); } }
    }
    __device__ __forceinline__ void epi(const Acc& acc, const Unit& u, int wr, int wc, int fr, int fq) const {
        asm volatile("" : "+v"(fr), "+v"(fq));
        const float* bp = F->b_gate_up() + (size_t)u.e * 2048 + u.pn * 256 + wc * 32 + 8 * fq;
        f32x4 bv[2][2];
#pragma unroll
        for (int bj = 0; bj < 2; ++bj)
#pragma unroll
            for (int n = 0; n < 2; ++n) bv[bj][n] = *(const f32x4*)(bp + bj * 128 + 4 * n);
#pragma unroll
        for (int ai = 0; ai < 2; ++ai)
#pragma unroll
            for (int m = 0; m < 4; ++m) { const size_t slot = (size_t)u.pm * 256 + ai * 128 + wr * 64 + m * 16 + fr; unsigned char* rowp = F->ACT() + ((size_t)(8 * u.pn + wc) * SLOTS + slot) * 16 + 4 * fq;
#pragma unroll
                for (int bj = 0; bj < 2; ++bj) { const f32x4 v0 = acc[ai][bj][m][0] * WSCALE_INV + bv[bj][0], v1 = acc[ai][bj][m][1] * WSCALE_INV + bv[bj][1];
                    f32x2 ga = {fminf(v0[0], 7.0f), fminf(v0[2], 7.0f)}, gb = {fminf(v1[0], 7.0f), fminf(v1[2], 7.0f)};
                    f32x2 ua = {__builtin_amdgcn_fmed3f(v0[1], -7.0f, 7.0f), __builtin_amdgcn_fmed3f(v0[3], -7.0f, 7.0f)}, ub = {__builtin_amdgcn_fmed3f(v1[1], -7.0f, 7.0f), __builtin_amdgcn_fmed3f(v1[3], -7.0f, 7.0f)};
                    const f32x2 xa = ga * (-1.702f * LOG2E), xb = gb * (-1.702f * LOG2E);
                    f32x2 ea = {__builtin_amdgcn_exp2f(xa[0]), __builtin_amdgcn_exp2f(xa[1])}, eb = {__builtin_amdgcn_exp2f(xb[0]), __builtin_amdgcn_exp2f(xb[1])};
                    ea = ea + 1.0f; eb = eb + 1.0f;
                    const f32x2 ra = {__builtin_amdgcn_rcpf(ea[0]), __builtin_amdgcn_rcpf(ea[1])}, rb = {__builtin_amdgcn_rcpf(eb[0]), __builtin_amdgcn_rcpf(eb[1])};
                    const f32x2 gla = ga * ra, glb = gb * rb;
                    const f32x2 oa = ua * gla + gla, ob = ub * glb + glb;
                    float r4[4] = {oa[0], oa[1], ob[0], ob[1]};
                    *(unsigned*)(rowp + (size_t)bj * 4 * SLOTS * 16) = pk4_fp8(r4[0], r4[1], r4[2], r4[3]); } }
    }
};
struct ProgMoe2 {
    static constexpr bool GATHER = false, FP8 = true; static constexpr int ID = 6, BN = 1024, AR = SLOTS;
    const Frame* F; int T;
    __device__ __forceinline__ bool next(int i, Unit& u) const {
        if (!moe_decode<8, 4>(F, T, i, u)) return false;
        u.A = (const char*)(F->ACT() + (size_t)u.pm * 256 * 16); u.B = (const char*)(F->WD() + (size_t)u.e * 1024 * KD + (size_t)u.pn * 256 * 16); return true;
    }
    __device__ __forceinline__ void epi(const Acc& acc, const Unit& u, int wr, int wc, int fr, int fq) const {
        asm volatile("" : "+v"(fr), "+v"(fq));
        const int cnt = u.kind;
        const float* bp = F->b_down() + (size_t)u.e * 1024 + u.pn * 256 + wc * 32 + 8 * fq;
        f32x4 bv[2][2];
#pragma unroll
        for (int bj = 0; bj < 2; ++bj)
#pragma unroll
            for (int n = 0; n < 2; ++n) bv[bj][n] = *(const f32x4*)(bp + bj * 128 + 4 * n);
#pragma unroll
        for (int ai = 0; ai < 2; ++ai) {
            float gt[4];
#pragma unroll
            for (int m = 0; m < 4; ++m) { const int idx = u.r0 + ai * 128 + wr * 64 + m * 16 + fr; gt[m] = idx < cnt ? F->LISTGATE()[(size_t)u.e * NTOK + idx] : 0.f; }
#pragma unroll
            for (int m = 0; m < 4; ++m) { const int rl = ai * 128 + wr * 64 + m * 16 + fr; const float gate = gt[m] * YSCALE;
                unsigned char* rowp = F->YS() + ((size_t)u.pm * 256 + rl) * 1024 + u.pn * 256 + wc * 32 + 8 * fq;
#pragma unroll
                for (int bj = 0; bj < 2; ++bj) { const f32x4 v0 = (acc[ai][bj][m][0] * WSCALE_INV + bv[bj][0]) * gate, v1 = (acc[ai][bj][m][1] * WSCALE_INV + bv[bj][1]) * gate;
                    u32x2 w; w.x = pk4_fp8(v0[0], v0[1], v0[2], v0[3]); w.y = pk4_fp8(v1[0], v1[1], v1[2], v1[3]);
                    *(u32x2*)(rowp + bj * 128) = w; } }
        }
    }
};

template <bool DRY> __device__ __forceinline__ void p7_combine(Frame& F) {
    const LAS int* tab = (const LAS int*)(F.lds + TAB_OFF);
    const int gw = F.vcu * NWAVES + F.wave, NGW = F.G * NWAVES, lane = F.lane;
    for (int tok = gw; tok < NTOK; tok += NGW) {
        f32x4* orow = (f32x4*)(F.out() + (size_t)tok * DM) + lane; f32x4 v[4];
#pragma unroll
        for (int j = 0; j < 4; ++j) v[j] = orow[64 * j];
#pragma unroll
        for (int k = 0; k < 4; ++k) { const int info = F.TOKINFO()[tok * 4 + k]; const int e = info >> 16, pos = info & 0xffff; const size_t slot = (size_t)tab[32 + e] * 256 + pos;
            const unsigned* yr = (const unsigned*)(F.YS() + slot * 1024) + lane;
#pragma unroll
            for (int j = 0; j < 4; ++j) { const unsigned w = yr[64 * j]; const f32x2 lo = __builtin_amdgcn_cvt_pk_f32_fp8((int)w, false), hi = __builtin_amdgcn_cvt_pk_f32_fp8((int)w, true);
                v[j][0] += lo[0] * YSCALE_INV; v[j][1] += lo[1] * YSCALE_INV; v[j][2] += hi[0] * YSCALE_INV; v[j][3] += hi[1] * YSCALE_INV; } }
        f32x4* wrow = DRY ? (f32x4*)((float*)(F.ws() + WS_EARLY) + (size_t)tok * DM) + lane : orow;
#pragma unroll
        for (int j = 0; j < 4; ++j) wrow[64 * j] = v[j];
    }
}

__global__ void __launch_bounds__(NWAVES * 64, 2) mk_fwd(Args args) {
    extern __shared__ __attribute__((aligned(16))) unsigned char lds_raw[];
    Frame F;
    F.lds = (LAS unsigned char*)lds_raw;
    F.tid = threadIdx.x; F.lane = F.tid & 63; F.wave = __builtin_amdgcn_readfirstlane(F.tid >> 6);
    F.G = gridDim.x; { const int bx = blockIdx.x; F.vcu = (bx % 8) * (F.G / 8) + bx / 8; }
    F.ka = (const CAS Args*)__builtin_amdgcn_kernarg_segment_ptr();
    for (int u = F.tid; u < (LDS_BYTES - LDSCTL_OFF) / 4; u += NWAVES * 64) ((LAS unsigned*)(F.lds + LDSCTL_OFF))[u] = 0u;
    __syncthreads();
    XcdBarrier bar = xcd_barrier_post(F.ctl() + CW_BAR, (volatile LAS unsigned*)(F.lds + MISC_OFF) + 8);
    const int lo = F.ka->ph_lo, hi = F.ka->ph_hi;
#define IN(k) (lo <= (k) && (k) < hi)
#define REFRESH() do { int l_ = lane_id(); asm volatile("" : "+v"(l_)); F.lane = l_; F.tid = F.wave * 64 + l_; } while (0)
#define SEAM(k) do { if (IN(k) && IN((k) + 1)) { xcd_barrier(bar, F.wave); if (MK_REP == 100 + (k)) { xcd_barrier(bar, F.wave); xcd_barrier(bar, F.wave); xcd_barrier(bar, F.wave); xcd_barrier(bar, F.wave); } } } while (0)
#ifdef MK_TPROBE
    unsigned long long ts_[9]; ts_[0] = __builtin_amdgcn_s_memrealtime();
#define TS(k) ts_[k] = __builtin_amdgcn_s_memrealtime()
#else
#define TS(k) do {} while (0)
#endif
    if (IN(0)) { REFRESH(); p0_prologue(F); if (MK_REP == 0) p0_prologue(F); } SEAM(0); TS(1);
    if (IN(1)) { { ProgIn P{&F}; gemm_phase(F.lds, P); } if (MK_REP == 1) { ProgIn P{&F}; gemm_phase(F.lds, P); } } SEAM(1); TS(2);
    if (IN(2)) { REFRESH(); p2_mixers(F); if (MK_REP == 2) p2_mixers(F); } SEAM(2); TS(3);
    if (IN(3)) { { ProgOut P{&F}; gemm_phase(F.lds, P); } if (MK_REP == 3) { ProgOut P{&F}; gemm_phase(F.lds, P); } } SEAM(3); TS(4);
    if (IN(4)) { REFRESH(); if (F.wave < 4) { if (MK_REP == 4) router_wave_unit<true>(F, F.wave * 256 + F.vcu); router_wave_unit<false>(F, F.wave * 256 + F.vcu); }
                 else { LAS float* scr = (LAS float*)(F.lds + F.wave * 16384); const int cw = F.vcu * 4 + (F.wave - 4);
                        for (int rep_ = 0; rep_ < (MK_REP == 41 ? 2 : 1); ++rep_) {
                        ConvItem ca = moe_conv_decode(F, cw); float va[16], vb[16]; moe_conv_issue(ca, va, F.lane);
                        for (int j = 0; j < CONV_P4_PER_WAVE; j += 2) {
                            const ConvItem cb = moe_conv_decode(F, (j + 1) * 1024 + cw); moe_conv_issue(cb, vb, F.lane);
                            moe_conv_finish(ca, va, scr, F.lane);
                            if (j + 2 < CONV_P4_PER_WAVE) { ca = moe_conv_decode(F, (j + 2) * 1024 + cw); moe_conv_issue(ca, va, F.lane); }
                            moe_conv_finish(cb, vb, scr, F.lane); } } } } SEAM(4); TS(5);
    if (lo <= 7 && hi > 5) { REFRESH(); moe_build_table(F); }
    if (IN(5)) { { ProgMoe1 P{&F, sgpr(((const LAS int*)(F.lds + TAB_OFF))[64])}; gemm_phase(F.lds, P); } if (MK_REP == 5) { ProgMoe1 P{&F, sgpr(((const LAS int*)(F.lds + TAB_OFF))[64])}; gemm_phase(F.lds, P); } } SEAM(5); TS(6);
    if (IN(6)) { { ProgMoe2 P{&F, sgpr(((const LAS int*)(F.lds + TAB_OFF))[64])}; gemm_phase(F.lds, P); } if (MK_REP == 6) { ProgMoe2 P{&F, sgpr(((const LAS int*)(F.lds + TAB_OFF))[64])}; gemm_phase(F.lds, P); } } SEAM(6); TS(7);
    if (IN(7)) { REFRESH(); if (MK_REP == 7) p7_combine<true>(F); p7_combine<false>(F); }
#ifdef MK_TPROBE
    TS(8);
    if (blockIdx.x == 0 && F.wave == 0) { const unsigned long long d = (MK_TPROBE == 9 ? (ts_[8] - ts_[0]) / 8 : ts_[MK_TPROBE + 1] - ts_[MK_TPROBE]) * 8ull; const unsigned long long t0 = __builtin_amdgcn_s_memrealtime();
        while (__builtin_amdgcn_s_memrealtime() - t0 < d) __builtin_amdgcn_s_sleep(8); }
#endif
#undef IN
#undef SEAM
}
}
#ifndef MK_CUT
#define MK_CUT 8
#endif
extern "C" void kernel_launch(void* const* d_in, const int* in_sizes, int n_in, void* d_out, int out_size, void* d_ws, size_t ws_size, hipStream_t stream) {
    static int ready = 0;
    if (ready == 0) {
        if (n_in != 18 || out_size != mk::NTOK * mk::DM || ws_size < mk::WS_END) { fprintf(stderr, "kernel_launch: unexpected problem (n_in %d out %d ws %zu)\n", n_in, out_size, ws_size); ready = -1; return; }
        if (hipFuncSetAttribute((const void*)mk::mk_fwd, hipFuncAttributeMaxDynamicSharedMemorySize, mk::LDS_BYTES) != hipSuccess) { fprintf(stderr, "kernel_launch: hipFuncSetAttribute failed\n"); ready = -1; return; }
        ready = 1;
    }
    if (ready < 0) return;
    (void)hipMemsetAsync((char*)d_ws + mk::WS_CTL, 0, mk::CTL_ZERO_BYTES, stream);
    mk::Args a{};
    for (int i = 0; i < 18; ++i) a.in[i] = (const float*)d_in[i];
    a.out = (float*)d_out; a.ws = (unsigned char*)d_ws; a.ph_lo = 0; a.ph_hi = MK_CUT;
    hipLaunchKernelGGL(mk::mk_fwd, dim3(256), dim3(mk::NWAVES * 64), mk::LDS_BYTES, stream, a);
#if MK_CUT < 8
    {
        using namespace nv;
        const float* x = (const float*)d_in[0]; const float* w_out = (const float*)d_in[10]; const float* norm2_w = (const float*)d_in[11];
        const float* router_w = (const float*)d_in[12]; const float* router_b = (const float*)d_in[13]; const float* w_gate_up = (const float*)d_in[14];
        const float* b_gate_up = (const float*)d_in[15]; const float* w_down = (const float*)d_in[16]; const float* b_down = (const float*)d_in[17];
        float* out = (float*)d_out; char* ws = (char*)d_ws; const size_t MiB = 1u << 20;
        int* cnt = (int*)ws + mk::CW_CNT; int* list_tok = (int*)(ws + mk::WS_LISTTOK); float* list_gate = (float*)(ws + mk::WS_LISTGATE);
        float* hn = (float*)(ws + 16 * MiB); float* gu = (float*)(ws + 272 * MiB); float* act = (float*)(ws + (272 + 256) * MiB);
#if MK_CUT <= 3
        k_gemm<1, true><<<dim3(DM / 64, NTOK / 64), 256, 0, stream>>>((const void*)(ws + mk::WS_Y), nullptr, nullptr, nullptr, w_out, nullptr, x, nullptr, out, NTOK, DM, DM, DM, DM);
#endif
#if MK_CUT <= 4
        k_router<<<NTOK, 256, 0, stream>>>(out, norm2_w, router_w, router_b, hn, cnt, list_tok, list_gate);
#else
        k_bf2f<<<4096, 256, 0, stream>>>((const unsigned short*)(ws + mk::WS_HB), hn, (size_t)NTOK * DM);
#endif
        for (int e = 0; e < NE; ++e) {
            const int* lt = list_tok + (size_t)e * NTOK; const float* lgp = list_gate + (size_t)e * NTOK;
            k_gemm<0, false><<<dim3(2 * DFF / 64, NTOK / 64), 256, 0, stream>>>(hn, lt, nullptr, cnt + e, w_gate_up + (size_t)e * DM * 2 * DFF, b_gate_up + (size_t)e * 2 * DFF, nullptr, nullptr, gu, NTOK, 2 * DFF, DM, DM, 2 * DFF);
            k_swiglu<<<NTOK, 256, 0, stream>>>(gu, cnt + e, act);
            k_gemm<3, false><<<dim3(DM / 64, NTOK / 64), 256, 0, stream>>>(act, nullptr, lt, cnt + e, w_down + (size_t)e * DFF * DM, b_down + (size_t)e * DM, nullptr, lgp, out, NTOK, DM, DFF, DFF, DM);
        }
    }
#endif
}
```

```cpp
#include <hip/hip_runtime.h>
#include <cstdio>
#include <cstdint>
#ifndef MK_REP
#define MK_REP -1
#endif
namespace mk {
#define LAS __attribute__((address_space(3)))
#define GAS __attribute__((address_space(1)))
typedef unsigned short bf16_t;
typedef short bf16x8 __attribute__((ext_vector_type(8)));
typedef short s16x4 __attribute__((ext_vector_type(4)));
typedef float f32x4 __attribute__((ext_vector_type(4)));
typedef float f32x2 __attribute__((ext_vector_type(2)));
typedef float f32x16 __attribute__((ext_vector_type(16)));
typedef unsigned u32x4 __attribute__((ext_vector_type(4)));
typedef unsigned u32x2 __attribute__((ext_vector_type(2)));
typedef int i32x4 __attribute__((ext_vector_type(4)));
typedef int i32x8 __attribute__((ext_vector_type(8)));

constexpr int NTOK = 32768, DM = 1024, SEQ = 4096, NB = 8, NH = 8, HD = 64, NE = 32, DFF = 1024, KD = 1024;
constexpr float EPS = 1e-5f;
constexpr float LOG2E = 1.4426950408889634f;
constexpr float QSCALE = 0.125f * LOG2E;
constexpr float SB_THR = 40.0f;
constexpr int NWAVES = 8;
constexpr int SLOTS = NTOK * 4 + NE * 256;

constexpr size_t MiB = 1u << 20;
constexpr size_t WS_CTL = 0, CTL_ZERO_BYTES = 1 * MiB;
constexpr size_t WS_LISTTOK = 1 * MiB;
constexpr size_t WS_LISTGATE = 5 * MiB;
constexpr size_t WS_TOKINFO = 9 * MiB;
constexpr size_t WS_RSTD1 = 10 * MiB;
constexpr size_t WS_SSPART = 11 * MiB;
constexpr size_t WS_RT = 13 * MiB;
constexpr size_t WS_WGU = 16 * MiB;
constexpr size_t WS_WD = 80 * MiB;
constexpr size_t WS_HB = 112 * MiB;
constexpr size_t WS_YS = 144 * MiB;
constexpr size_t WS_EARLY = 416 * MiB;
constexpr size_t WS_XB = WS_EARLY;
constexpr size_t WS_WIN = WS_EARLY + 64 * MiB;
constexpr size_t WS_WOUT = WS_EARLY + 70 * MiB;
constexpr size_t WS_UV = WS_EARLY + 72 * MiB;
constexpr size_t WS_Q = WS_EARLY + 136 * MiB;
constexpr size_t WS_K = WS_EARLY + 168 * MiB;
constexpr size_t WS_VT = WS_EARLY + 200 * MiB;
constexpr size_t WS_Y = WS_EARLY + 232 * MiB;
constexpr size_t WS_ACT = WS_EARLY;
constexpr size_t WS_END = WS_EARLY + 296 * MiB;
constexpr float WSCALE = 32.0f, WSCALE_INV = 1.0f / 32.0f;
constexpr float YSCALE = 16.0f, YSCALE_INV = 1.0f / 16.0f;
constexpr int CW_CNT = 64;
constexpr int CW_ATT = 2048;
constexpr int CW_P4C = 2048 + 16;
constexpr int CW_BAR = 4096;

constexpr int RING_BYTES = 131072;
constexpr int LDSCTL_OFF = RING_BYTES, MISC_OFF = LDSCTL_OFF + 320, TAB_OFF = LDSCTL_OFF + 1024;
constexpr int LDS_BYTES = 147456;

__device__ __forceinline__ unsigned cvt_pk_bf16(float lo, float hi) { unsigned r; asm volatile("v_cvt_pk_bf16_f32 %0, %1, %2" : "=v"(r) : "v"(lo), "v"(hi)); return r; }
__device__ __forceinline__ unsigned pk4_fp8(float a, float b, float c, float d) { unsigned w = 0u; w = (unsigned)__builtin_amdgcn_cvt_pk_fp8_f32(a, b, (int)w, false); w = (unsigned)__builtin_amdgcn_cvt_pk_fp8_f32(c, d, (int)w, true); return w; }
__device__ __forceinline__ float bf2f(unsigned short h) { return __uint_as_float((unsigned)h << 16); }
__device__ __forceinline__ float bflo(unsigned w) { return __uint_as_float(w << 16); }
__device__ __forceinline__ float bfhi(unsigned w) { return __uint_as_float(w & 0xffff0000u); }
__device__ __forceinline__ int lane_id() { return (int)__builtin_amdgcn_mbcnt_hi(~0u, __builtin_amdgcn_mbcnt_lo(~0u, 0u)); }
__device__ __forceinline__ int lane_id_fresh() { int l; asm volatile("v_mbcnt_lo_u32_b32 %0, -1, 0\n\tv_mbcnt_hi_u32_b32 %0, -1, %0" : "=v"(l)); return l; }
__device__ __forceinline__ float wave_sum(float v) {
#pragma unroll
    for (int o = 1; o < 64; o <<= 1) v += __shfl_xor(v, o);
    return v;
}
__device__ __forceinline__ float gelu_tanh_f(float x) {
    const float u = 0.7978845608028654f * (x + 0.044715f * x * x * x);
    return x * __builtin_amdgcn_rcpf(1.0f + __builtin_amdgcn_exp2f(-2.0f * LOG2E * u));
}
__device__ __forceinline__ f32x2 gelu_tanh_pk(f32x2 x) {
    constexpr float K1 = -2.0f * LOG2E * 0.7978845608028654f, K2 = K1 * 0.044715f;
    const f32x2 x2 = x * x; const f32x2 p = x2 * K2 + K1; const f32x2 a = x * p;
    f32x2 e = {__builtin_amdgcn_exp2f(a[0]), __builtin_amdgcn_exp2f(a[1])}; e = e + 1.0f;
    const f32x2 r = {__builtin_amdgcn_rcpf(e[0]), __builtin_amdgcn_rcpf(e[1])};
    return x * r;
}

constexpr int BM = 256, BK = 64, HALF = 128, HTB = HALF * BK * 2;
__device__ __forceinline__ int lds_byte(int r, int c) { const int st = (r >> 4) * 2 + (c >> 5), rr = r & 15, cc = c & 31, ob = rr * 64 + cc * 2; return st * 1024 + (ob ^ (((ob >> 9) & 1) << 5)); }
__device__ __forceinline__ void stage_rc(int b, int& R, int& C) { const int st = b / 1024, sb = b % 1024, swz = sb ^ (((sb >> 9) & 1) << 5); R = (st >> 1) * 16 + swz / 64; C = (st & 1) * 32 + (swz % 64) / 2; }
__device__ __forceinline__ int swz8(int r) { const int q = r & 15; return ((q >> 1) & 7) ^ ((((q + 4) >> 3) & 1) << 1); }
__device__ __forceinline__ int lds_byte8(int r, int c) { return r * 128 + ((c ^ swz8(r)) << 4); }
__device__ __forceinline__ void stage_rc8(int b, int& R, int& Cb) { R = b >> 7; Cb = (((b & 127) >> 4) ^ swz8(R)) << 4; }
__device__ __forceinline__ int lds_byteN(int r, int c8) { return r * 128 + ((c8 ^ ((r >> 1) & 7)) << 4); }
__device__ __forceinline__ void stage_rcN(int b, int& R, int& C) { R = b >> 7; C = ((((b & 127) >> 4) ^ ((R >> 1) & 7)) << 3); }
__device__ __forceinline__ int perm32(int rho) { const int n = rho >> 4, i = rho & 15; return 8 * (i >> 2) + 4 * n + (i & 3); }

struct Unit { const char* A; const char* B; int kind, pm, pn, e, r0; };

template <class Prog>
__device__ __forceinline__ void gemm_phase(LAS unsigned char* lds, const Prog& P) {
    const int wid = P.F->wave, lane = lane_id(), tid = wid * 64 + lane, wr = wid >> 2, wc = wid & 3;
    constexpr bool F8 = Prog::FP8;
    constexpr int K = KD, ESZ = F8 ? 1 : 2, nt = F8 ? K / 128 : K / BK;
    unsigned voffB[2];
#pragma unroll
    for (int i = 0; i < 2; ++i) {
        if constexpr (F8) { const int b_ = tid * 16 + i * 8192, k16_ = b_ >> 11, sl_ = (b_ & 2047) >> 4; voffB[i] = (unsigned)((k16_ * Prog::BN + Prog::bcol(sl_)) * 16); }
        else { int R_, C_; stage_rcN(tid * 16 + i * 8192, R_, C_); const int Rb = (R_ & ~31) + perm32(R_ & 31); voffB[i] = (unsigned)(Rb * K * ESZ + C_ * 2); } }
    constexpr size_t kstep = (size_t)(BK * 2);
    constexpr size_t hstep = (size_t)HALF * K * ESZ;
    constexpr bool AK16 = F8 && !Prog::GATHER;
    constexpr size_t kstepA = AK16 ? (size_t)8 * Prog::AR * 16 : kstep;
    constexpr size_t hstepA = AK16 ? (size_t)HALF * 16 : hstep;
    constexpr size_t kstepB = F8 ? (size_t)8 * Prog::BN * 16 : kstep;
    constexpr size_t hstepB = F8 ? (size_t)Prog::BHS * 16 : hstep;
    const unsigned ldsw = (unsigned)wid * 1024u;
    constexpr bool AG8 = F8 && Prog::GATHER;
    const int aoff = AK16 ? (2 * (lane >> 4)) * 2048 + (wr * 64 + (lane & 15)) * 16 : AG8 ? lds_byte8(wr * 64 + (lane & 15), 2 * (lane >> 4)) : lds_byteN(wr * 64 + (lane & 15), lane >> 4);
    const int boff = F8 ? (2 * (lane >> 4)) * 2048 + (wc * 32 + (lane & 15)) * 16 : lds_byteN(wc * 32 + (lane & 15), lane >> 4);
    constexpr int ANS = AK16 ? 256 : 2048, AKS = 2048;
    const int aks8 = lds_byte8(lane & 15, 2 * (lane >> 4) + 1) - lds_byte8(lane & 15, 2 * (lane >> 4));
    const int aksN = lds_byteN(lane & 15, (lane >> 4) + 4) - lds_byteN(lane & 15, lane >> 4);
    constexpr int BNS = F8 ? 256 : 2048, BKS = 2048;
    constexpr int KOFF = F8 ? 16 : 1024;
#define MK_SA(b, h) (((b) * 2 + (h)) * HTB)
#define MK_SB(b, h) ((4 + (b) * 2 + (h)) * HTB)
#define MK_STAGE(bufoff, gbase, voff) do { _Pragma("unroll") for (int _i = 0; _i < 2; ++_i) { unsigned o_ = (voff)[_i]; asm volatile("" : "+v"(o_));     \
        __builtin_amdgcn_global_load_lds((const unsigned*)((const char*)(gbase) + o_), (LAS unsigned*)(lds + (bufoff) + ldsw + _i * 8192), 16, 0, 0); } } while (0)
#define MK_STAGE_A(bufoff, gbase, h) do { if constexpr (GA) MK_STAGE(bufoff, gbase, voC[h]); else MK_STAGE(bufoff, (gbase) + (h) * hstepA, voC[0]); } while (0)
#define MK_LDA(dst, b, h) do { _Pragma("unroll") for (int m = 0; m < 4; ++m) _Pragma("unroll") for (int k = 0; k < 2; ++k) dst[m][k] = *(const LAS bf16x8*)(lds + MK_SA(b, h) + aoff + m * ANS + k * (AK16 ? AKS : AG8 ? aks8 : aksN)); } while (0)
#define MK_LDB(dst, b, h) do { _Pragma("unroll") for (int n = 0; n < 2; ++n) _Pragma("unroll") for (int k = 0; k < 2; ++k) dst[n][k] = *(const LAS bf16x8*)(lds + MK_SB(b, h) + boff + n * BNS + k * (F8 ? BKS : aksN)); } while (0)
#define MK_CAT8(x) __builtin_shufflevector(__builtin_bit_cast(i32x4, (x)[0]), __builtin_bit_cast(i32x4, (x)[1]), 0, 1, 2, 3, 4, 5, 6, 7)
#define MK_MMA(ai, bj, At, Bt) do { __builtin_amdgcn_s_setprio(1); \
        if constexpr (F8) { _Pragma("unroll") for (int m = 0; m < 4; ++m) _Pragma("unroll") for (int n = 0; n < 2; ++n) \
            acc[ai][bj][m][n] = __builtin_amdgcn_mfma_scale_f32_16x16x128_f8f6f4(MK_CAT8(Bt[n]), MK_CAT8(At[m]), acc[ai][bj][m][n], 0, 0, 0, 0, 0, 0); } \
        else { _Pragma("unroll") for (int m = 0; m < 4; ++m) _Pragma("unroll") for (int n = 0; n < 2; ++n) _Pragma("unroll") for (int k = 0; k < 2; ++k) \
            acc[ai][bj][m][n] = __builtin_amdgcn_mfma_f32_16x16x32_bf16(Bt[n][k], At[m][k], acc[ai][bj][m][n], 0, 0, 0); } \
        __builtin_amdgcn_s_setprio(0); } while (0)
#define MK_WAIT_V(n) asm volatile("s_waitcnt vmcnt(" #n ")" ::: "memory")
#define MK_WAIT_L(n) asm volatile("s_waitcnt lgkmcnt(" #n ")" ::: "memory")
#define MK_BAR __builtin_amdgcn_s_barrier()
#define MK_SCHED __builtin_amdgcn_sched_barrier(0)
    Unit cur, nxt; int ui = 0;
    if (!P.next(0, cur)) return;
    constexpr bool GA = Prog::GATHER;
    unsigned voC[2][2];
    if constexpr (GA) P.aoffs(cur, wid, voC);
    else {
#pragma unroll
        for (int i = 0; i < 2; ++i) { if constexpr (AK16) { const int b_ = tid * 16 + i * 8192; voC[0][i] = (unsigned)(((b_ >> 11) * Prog::AR + ((b_ & 2047) >> 4)) * 16); } else { int R_, C_; stage_rcN(tid * 16 + i * 8192, R_, C_); voC[0][i] = (unsigned)(R_ * K * ESZ + C_ * 2); } voC[1][i] = 0u; }
    }
    f32x4 acc[2][2][4][2];
#pragma unroll
    for (int a = 0; a < 2; ++a)
#pragma unroll
        for (int b = 0; b < 2; ++b)
#pragma unroll
            for (int m = 0; m < 4; ++m)
#pragma unroll
                for (int n = 0; n < 2; ++n) acc[a][b][m][n] = (f32x4){0.f, 0.f, 0.f, 0.f};
    bf16x8 At[4][2], B0[2][2], B1[2][2];
    const char* cA = cur.A; const char* cB = cur.B;
    MK_STAGE(MK_SB(0, 0), cB, voffB); MK_STAGE(MK_SB(0, 1), cB + hstepB, voffB); MK_STAGE_A(MK_SA(0, 0), cA, 0); MK_STAGE_A(MK_SA(0, 1), cA, 1);
    if (wr == 1) MK_BAR;
    MK_WAIT_V(2); MK_BAR;
    MK_STAGE(MK_SB(1, 0), cB + kstepB, voffB); MK_STAGE_A(MK_SA(1, 0), cA + kstepA, 0); MK_STAGE(MK_SB(1, 1), cB + hstepB + kstepB, voffB);
    MK_WAIT_V(6); MK_BAR;
    for (;;) {
        const bool has_next = P.next(ui + 1, nxt);
        if (!has_next) nxt = cur;
        const char* nA = nxt.A; const char* nB = nxt.B;
#pragma unroll 1
        for (int t = 0; t < nt; t += 2) {
            const bool last = (t == nt - 2);
            const char* a1 = cA + (size_t)(t + 1) * kstepA;
            const char* a2 = last ? nA : cA + (size_t)(t + 2) * kstepA; const char* b2 = last ? nB : cB + (size_t)(t + 2) * kstepB;
            const char* a3 = a2 + kstepA; const char* b3 = b2 + kstepB;
            MK_LDB(B0, 0, 0); MK_LDB(B1, 0, 1); MK_SCHED; MK_LDA(At, 0, 0); MK_STAGE_A(MK_SA(1, 1), a1, 1);
            if constexpr (GA) { if (last && has_next) P.aoffs(nxt, wid, voC); }
            MK_WAIT_V(8); MK_WAIT_L(0); MK_BAR; MK_MMA(0, 0, At, B0); MK_MMA(0, 1, At, B1); MK_BAR; MK_SCHED;
            MK_LDA(At, 0, 1); MK_STAGE(MK_SB(0, 0), b2, voffB); MK_STAGE(MK_SB(0, 1), b2 + hstepB, voffB); MK_STAGE_A(MK_SA(0, 0), a2, 0);
            MK_WAIT_V(8); MK_WAIT_L(0); MK_BAR; MK_MMA(1, 0, At, B0); MK_MMA(1, 1, At, B1); MK_BAR; MK_SCHED;
            MK_LDB(B0, 1, 0); MK_LDB(B1, 1, 1); MK_SCHED; MK_LDA(At, 1, 0); MK_STAGE_A(MK_SA(0, 1), a2, 1);
            MK_WAIT_V(8); MK_WAIT_L(0); MK_BAR; MK_MMA(0, 0, At, B0); MK_MMA(0, 1, At, B1); MK_BAR; MK_SCHED;
            MK_LDA(At, 1, 1); MK_STAGE(MK_SB(1, 0), b3, voffB); MK_STAGE(MK_SB(1, 1), b3 + hstepB, voffB); MK_STAGE_A(MK_SA(1, 0), a3, 0);
            MK_WAIT_V(8); MK_WAIT_L(0); MK_BAR; MK_MMA(1, 0, At, B0); MK_MMA(1, 1, At, B1); MK_BAR; MK_SCHED;
        }
        if (wr == 0) MK_BAR;
        { const int l_ = lane_id_fresh(); P.epi(acc, cur, wr, wc, l_ & 15, l_ >> 4); }
#ifdef MK_EPI2
        if (Prog::ID == MK_EPI2) { const int l_ = lane_id_fresh(); P.epi(acc, cur, wr, wc, l_ & 15, l_ >> 4); }
#endif
        if (!has_next) break;
#pragma unroll
        for (int a = 0; a < 2; ++a)
#pragma unroll
            for (int b = 0; b < 2; ++b)
#pragma unroll
                for (int m = 0; m < 4; ++m)
#pragma unroll
                    for (int n = 0; n < 2; ++n) acc[a][b][m][n] = (f32x4){0.f, 0.f, 0.f, 0.f};
        cur = nxt; cA = nA; cB = nB; ++ui;
        if (wr == 1) MK_BAR;
    }
    MK_WAIT_V(0);
    MK_BAR;
#undef MK_SA
#undef MK_SB
#undef MK_STAGE
#undef MK_STAGE_A
#undef MK_LDA
#undef MK_LDB
#undef MK_MMA
#undef MK_CAT8
}
typedef f32x4 Acc[2][2][4][2];

#define XB_TMO      128
#define XB_XCNT(j)  (256  + 64 * (j))
#define XB_XSUB(j)  (1280 + 64 * (j))
#define XB_XGEN(j)  (2304 + 64 * (j))
#define XB_TOP      3328
#define XB_TOPGEN   3392
#define XCD_BAR_WORDS 3456
#define XB_SPIN_CAP (1u << 18)
__device__ __forceinline__ unsigned xb_ld(unsigned* p)              { return __hip_atomic_load(p, __ATOMIC_RELAXED, __HIP_MEMORY_SCOPE_AGENT); }
__device__ __forceinline__ unsigned xb_add(unsigned* p, unsigned v) { return __hip_atomic_fetch_add(p, v, __ATOMIC_RELAXED, __HIP_MEMORY_SCOPE_AGENT); }
__device__ __forceinline__ unsigned xb_xcc_id() { return (unsigned)__builtin_amdgcn_s_getreg((3 << 11) | 20) & 0xFu; }
#define XB_SPIN(cond, bar) do { unsigned _sp = 0; while (cond) { __builtin_amdgcn_s_sleep(1); \
    if ((++_sp & 255u) == 0u) { if (xb_ld(&(bar)[XB_TMO])) break; if (_sp > XB_SPIN_CAP) { atomicAdd(&(bar)[XB_TMO], 1u); break; } } } } while (0)
struct XcdBarrier { unsigned* bar; unsigned x; volatile LAS unsigned* st; };
__device__ __forceinline__ XcdBarrier xcd_barrier_post(unsigned* bar, volatile LAS unsigned* st) {
    XcdBarrier b; b.bar = bar; b.x = xb_xcc_id(); b.st = st;
    if (threadIdx.x == 0) (void)xb_add(&bar[XB_XCNT(b.x)], 1u);
    return b;
}
__device__ __forceinline__ void xcd_barrier_complete(unsigned* bar, unsigned x, unsigned& nloc, unsigned& nx) {
    const unsigned G = gridDim.x * gridDim.y * gridDim.z;
    unsigned sum, cnt, mine, sp = 0u;
    for (;;) {
        sum = 0u; cnt = 0u; mine = 0u;
#pragma unroll
        for (unsigned j = 0; j < 16; ++j) { const unsigned c = xb_ld(&bar[XB_XCNT(j)]); sum += c; cnt += (c > 0u) ? 1u : 0u; mine = (j == x) ? c : mine; }
        if (sum == G) break;
        __builtin_amdgcn_s_sleep(1);
        if ((++sp & 255u) == 0u) { if (xb_ld(&bar[XB_TMO])) break; if (sp > XB_SPIN_CAP) { atomicAdd(&bar[XB_TMO], 1u); break; } }
    }
    nloc = mine > 0u ? mine : 1u; nx = cnt > 0u ? cnt : 1u;
}
__device__ __forceinline__ void xcd_barrier(const XcdBarrier& b, int wave) {
    asm volatile("s_waitcnt vmcnt(0)" ::: "memory");
    __syncthreads();
    if (wave == 0 && lane_id() == 0) {
        unsigned* bar = b.bar;
        __builtin_amdgcn_s_waitcnt(0);
        unsigned nloc = b.st[0], nx = b.st[1];
        if (nloc == 0u) { xcd_barrier_complete(bar, b.x, nloc, nx); b.st[0] = nloc; b.st[1] = nx; }
        const unsigned old = xb_add(&bar[XB_XSUB(b.x)], 1u);
        const unsigned gen = old / nloc;
        if (old + 1u == (gen + 1u) * nloc) {
            __builtin_amdgcn_fence(__ATOMIC_RELEASE, "agent");
            asm volatile("s_waitcnt vmcnt(0)" ::: "memory");
            const unsigned og = xb_add(&bar[XB_TOP], 1u);
            const unsigned tg = og / nx;
            if (og + 1u == (tg + 1u) * nx) xb_add(&bar[XB_TOPGEN], 1u);
            else XB_SPIN(xb_ld(&bar[XB_TOPGEN]) == tg, bar);
            __builtin_amdgcn_fence(__ATOMIC_ACQUIRE, "agent");
            xb_add(&bar[XB_XGEN(b.x)], 1u);
            asm volatile("s_waitcnt vmcnt(0)" ::: "memory");
        } else {
            XB_SPIN(xb_ld(&bar[XB_XGEN(b.x)]) == gen, bar);
            __builtin_amdgcn_fence(__ATOMIC_ACQUIRE, "agent");
            asm volatile("s_waitcnt vmcnt(0)" ::: "memory");
        }
    }
    __syncthreads();
}

struct Args {
    const float* in[18]; float* out; unsigned char* ws; int ph_lo, ph_hi;
};
#define CAS __attribute__((address_space(4)))
struct Frame {
    LAS unsigned char* lds; int tid, lane, wave, vcu, G;
    const CAS Args* ka;
    __device__ __forceinline__ const float* inp(int k) const { return ka->in[k]; }
    __device__ __forceinline__ unsigned char* ws() const { return ka->ws; }
    __device__ __forceinline__ float* out() const { return ka->out; }
    __device__ __forceinline__ const float* x() const { return inp(0); }
    __device__ __forceinline__ const float* norm1_w() const { return inp(1); }
    __device__ __forceinline__ const float* w_in() const { return inp(2); }
    __device__ __forceinline__ const float* sgu_norm_w() const { return inp(3); }
    __device__ __forceinline__ const float* sgu_w() const { return inp(4); }
    __device__ __forceinline__ const float* sgu_b() const { return inp(5); }
    __device__ __forceinline__ const float* q_norm_w() const { return inp(6); }
    __device__ __forceinline__ const float* k_norm_w() const { return inp(7); }
    __device__ __forceinline__ const float* out_norm_a_w() const { return inp(8); }
    __device__ __forceinline__ const float* out_norm_b_w() const { return inp(9); }
    __device__ __forceinline__ const float* w_out() const { return inp(10); }
    __device__ __forceinline__ const float* norm2_w() const { return inp(11); }
    __device__ __forceinline__ const float* router_w() const { return inp(12); }
    __device__ __forceinline__ const float* router_b() const { return inp(13); }
    __device__ __forceinline__ const float* w_gate_up() const { return inp(14); }
    __device__ __forceinline__ const float* b_gate_up() const { return inp(15); }
    __device__ __forceinline__ const float* w_down() const { return inp(16); }
    __device__ __forceinline__ const float* b_down() const { return inp(17); }
    __device__ __forceinline__ bf16_t* XB() const { return (bf16_t*)(ws() + WS_XB); }
    __device__ __forceinline__ bf16_t* WIN() const { return (bf16_t*)(ws() + WS_WIN); }
    __device__ __forceinline__ bf16_t* WOUT() const { return (bf16_t*)(ws() + WS_WOUT); }
    __device__ __forceinline__ bf16_t* UV() const { return (bf16_t*)(ws() + WS_UV); }
    __device__ __forceinline__ bf16_t* Q() const { return (bf16_t*)(ws() + WS_Q); }
    __device__ __forceinline__ bf16_t* K() const { return (bf16_t*)(ws() + WS_K); }
    __device__ __forceinline__ bf16_t* VT() const { return (bf16_t*)(ws() + WS_VT); }
    __device__ __forceinline__ bf16_t* Y() const { return (bf16_t*)(ws() + WS_Y); }
    __device__ __forceinline__ unsigned char* YS() const { return ws() + WS_YS; }
    __device__ __forceinline__ bf16_t* RT() const { return (bf16_t*)(ws() + WS_RT); }
    __device__ __forceinline__ unsigned char* HB() const { return ws() + WS_HB; }
    __device__ __forceinline__ unsigned char* WGU() const { return ws() + WS_WGU; }
    __device__ __forceinline__ unsigned char* WD() const { return ws() + WS_WD; }
    __device__ __forceinline__ unsigned char* ACT() const { return ws() + WS_ACT; }
    __device__ __forceinline__ float* RSTD1() const { return (float*)(ws() + WS_RSTD1); }
    __device__ __forceinline__ float* SSPART() const { return (float*)(ws() + WS_SSPART); }
    __device__ __forceinline__ float* LISTGATE() const { return (float*)(ws() + WS_LISTGATE); }
    __device__ __forceinline__ int* LISTTOK() const { return (int*)(ws() + WS_LISTTOK); }
    __device__ __forceinline__ int* TOKINFO() const { return (int*)(ws() + WS_TOKINFO); }
    __device__ __forceinline__ unsigned* ctl() const { return (unsigned*)(ws() + WS_CTL); }
};

__device__ __forceinline__ void p0_transpose_item(const float* W, int K, int N, bf16_t* WT, int k0, int n0, int drow0, const float* kscale, LAS float* scr, int lane) {
#pragma unroll 8
    for (int i = 0; i < 32; ++i) { const int kk = 2 * i + (lane >> 5); float v = W[(size_t)(k0 + kk) * N + n0 + (lane & 31)]; if (kscale) v *= kscale[k0 + kk]; scr[kk * 33 + (lane & 31)] = v; }
    asm volatile("s_waitcnt lgkmcnt(0)" ::: "memory");
    const int c = lane & 7;
#pragma unroll
    for (int j = 0; j < 4; ++j) { const int n = (lane >> 3) + 8 * j; const LAS float* s = scr + (8 * c) * 33 + n;
        u32x4 o; o.x = cvt_pk_bf16(s[0 * 33], s[1 * 33]); o.y = cvt_pk_bf16(s[2 * 33], s[3 * 33]); o.z = cvt_pk_bf16(s[4 * 33], s[5 * 33]); o.w = cvt_pk_bf16(s[6 * 33], s[7 * 33]);
        *(u32x4*)(WT + (size_t)(drow0 + n) * K + k0 + 8 * c) = o; }
    asm volatile("s_waitcnt lgkmcnt(0)" ::: "memory");
}
__device__ __forceinline__ void p0_transpose_item_f8(const float* W, int K, int N, unsigned char* WT, int k0, int n0, LAS float* scr, int lane) {
#pragma unroll 8
    for (int i = 0; i < 32; ++i) { const int kk = 2 * i + (lane >> 5); scr[kk * 33 + (lane & 31)] = W[(size_t)(k0 + kk) * N + n0 + (lane & 31)] * WSCALE; }
    asm volatile("s_waitcnt lgkmcnt(0)" ::: "memory");
    const int c = lane & 7;
#pragma unroll
    for (int j = 0; j < 4; ++j) { const int n = (lane >> 3) + 8 * j; const LAS float* s = scr + (8 * c) * 33 + n;
        u32x2 o; o.x = pk4_fp8(s[0 * 33], s[1 * 33], s[2 * 33], s[3 * 33]); o.y = pk4_fp8(s[4 * 33], s[5 * 33], s[6 * 33], s[7 * 33]);
        *(u32x2*)(WT + (size_t)(n0 + n) * K + k0 + 8 * c) = o; }
    asm volatile("s_waitcnt lgkmcnt(0)" ::: "memory");
}
__device__ __forceinline__ int win_drow(int n0) {
    if (n0 < 1024 || n0 >= 2048) return n0;
    const int rel = n0 - 1024, isk = rel >> 9, head = (rel & 511) >> 6, dh = (rel & 63) >> 5;
    return 256 * (4 + 2 * isk + (head >> 2)) + 128 * dh + 32 * (head & 3);
}
constexpr int MOE_I_GU = 64 * 32, MOE_I_D = 64 * 16, MOE_ITEMS = NE * (MOE_I_GU + MOE_I_D);
struct ConvItem { const float* src; unsigned char* dst; int N; };
__device__ __forceinline__ ConvItem moe_conv_decode(const Frame& F, int it) {
    ConvItem c;
    if (it < NE * MOE_I_GU) { const int e = it / MOE_I_GU, q = it % MOE_I_GU, k16 = q >> 5, n64 = q & 31; c.N = 2048;
        c.src = F.w_gate_up() + (size_t)e * KD * 2048 + (size_t)(16 * k16) * 2048 + 64 * n64; c.dst = F.WGU() + (size_t)e * 2048 * KD + ((size_t)k16 * 2048 + 64 * n64) * 16; }
    else { const int r = it - NE * MOE_I_GU; const int e = r / MOE_I_D, q = r % MOE_I_D, k16 = q >> 4, n64 = q & 15; c.N = 1024;
        c.src = F.w_down() + (size_t)e * KD * 1024 + (size_t)(16 * k16) * 1024 + 64 * n64; c.dst = F.WD() + (size_t)e * 1024 * KD + ((size_t)k16 * 1024 + 64 * n64) * 16; }
    return c;
}
__device__ __forceinline__ void moe_conv_issue(const ConvItem& c, float (&v)[16], int lane) {
    const float* p = c.src + lane;
#pragma unroll
    for (int i = 0; i < 16; ++i) v[i] = __builtin_nontemporal_load(p + (size_t)i * c.N);
}
__device__ __forceinline__ void moe_conv_finish(const ConvItem& c, const float (&v)[16], LAS float*, int lane) {
    u32x4 o;
    o.x = pk4_fp8(v[0] * WSCALE, v[1] * WSCALE, v[2] * WSCALE, v[3] * WSCALE); o.y = pk4_fp8(v[4] * WSCALE, v[5] * WSCALE, v[6] * WSCALE, v[7] * WSCALE);
    o.z = pk4_fp8(v[8] * WSCALE, v[9] * WSCALE, v[10] * WSCALE, v[11] * WSCALE); o.w = pk4_fp8(v[12] * WSCALE, v[13] * WSCALE, v[14] * WSCALE, v[15] * WSCALE);
    *(u32x4*)(c.dst + (size_t)lane * 16) = o;
}
constexpr int CONV_P4_PER_WAVE = 40, CONV_P4_ITEMS = CONV_P4_PER_WAVE * 1024;
constexpr int CONV_G_PER_UNIT = 4, CONV_G_ITEMS = CONV_G_PER_UNIT * 4 * 2048;
constexpr int CONV_P2_ITEMS = MOE_ITEMS - CONV_P4_ITEMS - CONV_G_ITEMS, CONV_P2_PER_WAVE = CONV_P2_ITEMS / 2048;
static_assert(CONV_P2_ITEMS % 2048 == 0 && CONV_P4_PER_WAVE % 2 == 0 && (CONV_P4_ITEMS / 8) % 4 == 0, "conversion split");
__device__ __forceinline__ void p0_prologue(Frame& F) {
    LAS float* scr = (LAS float*)(F.lds + F.wave * 16384);
    const int gw = F.vcu * NWAVES + F.wave, NGW = F.G * NWAVES, lane = F.lane;
    for (int m = gw; m < NTOK; m += 2 * NGW) {
        const int m2 = m + NGW;
        const f32x4* xr = (const f32x4*)(F.x() + (size_t)m * DM) + lane; const f32x4* xr2 = (const f32x4*)(F.x() + (size_t)m2 * DM) + lane; f32x4 v[4], w[4]; float s = 0.f, s2 = 0.f;
#pragma unroll
        for (int j = 0; j < 4; ++j) v[j] = __builtin_nontemporal_load(xr + 64 * j);
#pragma unroll
        for (int j = 0; j < 4; ++j) w[j] = __builtin_nontemporal_load(xr2 + 64 * j);
#pragma unroll
        for (int j = 0; j < 4; ++j) { s += (v[j].x * v[j].x + v[j].y * v[j].y) + (v[j].z * v[j].z + v[j].w * v[j].w); s2 += (w[j].x * w[j].x + w[j].y * w[j].y) + (w[j].z * w[j].z + w[j].w * w[j].w); }
        const float tot = wave_sum(s), tot2 = wave_sum(s2);
        if (lane == 0) { F.RSTD1()[m] = 1.0f / sqrtf(tot * (1.0f / DM) + EPS); F.RSTD1()[m2] = 1.0f / sqrtf(tot2 * (1.0f / DM) + EPS); }
        u32x2* o8 = (u32x2*)(F.XB() + (size_t)m * DM) + lane; u32x2* o82 = (u32x2*)(F.XB() + (size_t)m2 * DM) + lane;
#pragma unroll
        for (int j = 0; j < 4; ++j) { u32x2 a; a.x = cvt_pk_bf16(v[j].x, v[j].y); a.y = cvt_pk_bf16(v[j].z, v[j].w); o8[64 * j] = a; u32x2 b; b.x = cvt_pk_bf16(w[j].x, w[j].y); b.y = cvt_pk_bf16(w[j].z, w[j].w); o82[64 * j] = b; }
    }
    constexpr int I_IN = 16 * 80, I_OUT = 16 * 32;
    for (int it = gw; it < I_IN + I_OUT; it += NGW) {
        int r = it;
        if (r < I_IN) { const int kb = r / 80, nb = r % 80; p0_transpose_item(F.w_in(), KD, 2560, F.WIN(), 64 * kb, 32 * nb, win_drow(32 * nb), F.norm1_w(), scr, lane); continue; } r -= I_IN;
        { const int kb = r / 32, nb = r % 32; p0_transpose_item(F.w_out(), KD, 1024, F.WOUT(), 64 * kb, 32 * nb, 32 * nb, nullptr, scr, lane); }
    }
    for (int idx = gw * 64 + lane; idx < NE * KD; idx += NGW * 64) {
        const int e = idx >> 10, k = idx & 1023; const float w = F.router_w()[(size_t)k * NE + e];
        const unsigned hi = cvt_pk_bf16(w, 0.f) & 0xffffu; const float rem = w - __uint_as_float(hi << 16);
        F.RT()[idx] = (bf16_t)hi; F.RT()[NE * KD + idx] = (bf16_t)(cvt_pk_bf16(rem, 0.f) & 0xffffu);
    }
}

struct ProgIn {
    static constexpr bool GATHER = false, FP8 = false; static constexpr int ID = 1, BN = 0, AR = 0, BHS = 0;
    const Frame* F;
    __device__ __forceinline__ bool next(int i, Unit& u) const {
        const int v = F->vcu;
        if (i < 4) { const int uu = i * 256 + v, grp = uu >> 5, w = uu & 31; u.pm = grp * 4 + (w & 3); u.pn = w >> 2; u.kind = u.pn < 4 ? 0 : 1;
            u.A = (const char*)(F->XB() + (size_t)u.pm * 256 * KD); u.B = (const char*)(F->WIN() + (size_t)u.pn * 256 * KD); u.e = 0; u.r0 = 0; return true; }
        if (i == 4) { u.kind = 2; u.pm = v & 1; u.pn = v >> 1; u.A = (const char*)(F->WIN() + (size_t)(2048 + u.pm * 256) * KD); u.B = (const char*)(F->XB() + (size_t)u.pn * 256 * KD); u.e = 0; u.r0 = 0; return true; }
        return false;
    }
    __device__ __forceinline__ void epi(const Acc& acc, const Unit& u, int wr, int wc, int fr, int fq) const {
        asm volatile("" : "+v"(fr), "+v"(fq));
        if (u.kind == 2) {
            const int tk0 = u.pn * 256 + wc * 32 + 8 * fq;
            f32x4 rs[2][2];
#pragma unroll
            for (int bj = 0; bj < 2; ++bj)
#pragma unroll
                for (int n = 0; n < 2; ++n) rs[bj][n] = *(const f32x4*)(F->RSTD1() + tk0 + bj * 128 + 4 * n);
#pragma unroll
            for (int ai = 0; ai < 2; ++ai)
#pragma unroll
                for (int m = 0; m < 4; ++m) { const int cp = u.pm * 256 + ai * 128 + wr * 64 + m * 16 + fr; const int hv_ = cp >> 6, dv_ = cp & 63;
#pragma unroll
                    for (int bj = 0; bj < 2; ++bj) { const f32x4 v0 = acc[ai][bj][m][0] * rs[bj][0], v1 = acc[ai][bj][m][1] * rs[bj][1];
                        u32x4 w; w.x = cvt_pk_bf16(v0[0], v0[1]); w.y = cvt_pk_bf16(v0[2], v0[3]); w.z = cvt_pk_bf16(v1[0], v1[1]); w.w = cvt_pk_bf16(v1[2], v1[3]);
                        const int T0 = tk0 + bj * 128, bb_ = T0 >> 12, t_ = T0 & (SEQ - 1);
                        *(u32x4*)(F->VT() + ((((size_t)(bb_ * 8 + hv_) * 128 + (t_ >> 5)) * 64 + dv_) * 32 + (t_ & 31))) = w; } }
            return;
        }
        float rsr[2][4];
#pragma unroll
        for (int ai = 0; ai < 2; ++ai)
#pragma unroll
            for (int m = 0; m < 4; ++m) rsr[ai][m] = F->RSTD1()[u.pm * 256 + ai * 128 + wr * 64 + m * 16 + fr];
        if (u.kind == 0) {
#pragma unroll
            for (int ai = 0; ai < 2; ++ai)
#pragma unroll
                for (int m = 0; m < 4; ++m) { const int r = u.pm * 256 + ai * 128 + wr * 64 + m * 16 + fr; bf16_t* rowp = F->UV() + (size_t)r * 1024 + u.pn * 256 + wc * 32 + 8 * fq; const float rs = rsr[ai][m];
#pragma unroll
                    for (int bj = 0; bj < 2; ++bj) { f32x4 v0 = acc[ai][bj][m][0] * rs, v1 = acc[ai][bj][m][1] * rs;
                        const f32x2 g0 = gelu_tanh_pk((f32x2){v0[0], v0[1]}), g1 = gelu_tanh_pk((f32x2){v0[2], v0[3]}), g2 = gelu_tanh_pk((f32x2){v1[0], v1[1]}), g3 = gelu_tanh_pk((f32x2){v1[2], v1[3]});
                        u32x4 w; w.x = cvt_pk_bf16(g0[0], g0[1]); w.y = cvt_pk_bf16(g1[0], g1[1]); w.z = cvt_pk_bf16(g2[0], g2[1]); w.w = cvt_pk_bf16(g3[0], g3[1]);
                        *(u32x4*)(rowp + bj * 128) = w; } }
            return;
        }
        {
            const int isk = (u.pn - 4) >> 1, head = 4 * (u.pn & 1) + wc; const float* nw = isk ? F->k_norm_w() : F->q_norm_w(); bf16_t* dst = isk ? F->K() : F->Q();
            const float osc = isk ? 1.0f : QSCALE;
            f32x4 nwv[2][2];
#pragma unroll
            for (int bj = 0; bj < 2; ++bj)
#pragma unroll
                for (int n = 0; n < 2; ++n) nwv[bj][n] = *(const f32x4*)(nw + 32 * bj + 8 * fq + 4 * n);
#pragma unroll
            for (int ai = 0; ai < 2; ++ai)
#pragma unroll
                for (int m = 0; m < 4; ++m) { const int r = u.pm * 256 + ai * 128 + wr * 64 + m * 16 + fr; const float rs = rsr[ai][m];
                    f32x4 t[2][2]; float ss = 0.f;
#pragma unroll
                    for (int bj = 0; bj < 2; ++bj)
#pragma unroll
                        for (int n = 0; n < 2; ++n) { t[bj][n] = acc[ai][bj][m][n] * rs; ss += (t[bj][n][0] * t[bj][n][0] + t[bj][n][1] * t[bj][n][1]) + (t[bj][n][2] * t[bj][n][2] + t[bj][n][3] * t[bj][n][3]); }
                    ss += __shfl_xor(ss, 16); ss += __shfl_xor(ss, 32);
                    const float rn = osc / sqrtf(ss * (1.0f / 64.0f) + EPS);
                    bf16_t* rowp = dst + ((size_t)((r >> 12) * 8 + head) * SEQ + (r & (SEQ - 1))) * 64 + 8 * fq;
#pragma unroll
                    for (int bj = 0; bj < 2; ++bj) { const f32x4 v0 = t[bj][0] * nwv[bj][0] * rn, v1 = t[bj][1] * nwv[bj][1] * rn;
                        u32x4 w; w.x = cvt_pk_bf16(v0[0], v0[1]); w.y = cvt_pk_bf16(v0[2], v0[3]); w.z = cvt_pk_bf16(v1[0], v1[1]); w.w = cvt_pk_bf16(v1[2], v1[3]);
                        *(u32x4*)(rowp + bj * 32) = w; } }
        }
    }
};

constexpr int VN_PITCH = 136, YT_PITCH = 132, YT_OFF = 36864;
__device__ __forceinline__ void gmlp_unit(const Frame& F, int chunk, int g, int cbase) {
    const int tid = F.tid, lane = F.lane, wid = F.wave;
    ConvItem gci[CONV_G_PER_UNIT]; float gcv[CONV_G_PER_UNIT][16];
#pragma unroll
    for (int q = 0; q < CONV_G_PER_UNIT; ++q) { gci[q] = moe_conv_decode(F, cbase + q * 2048); moe_conv_issue(gci[q], gcv[q], lane); }
    LAS bf16_t* vn = (LAS bf16_t*)F.lds; LAS float* yt = (LAS float*)(F.lds + YT_OFF);
    const size_t tok0 = (size_t)chunk * 128;
    {
        const int row = tid >> 2, qd = tid & 3; const bf16_t* src = F.UV() + (tok0 + row) * 1024 + 512 + g * 128 + qd * 32;
        u32x4 w[4]; float v[32]; float ss = 0.f;
#pragma unroll
        for (int i = 0; i < 4; ++i) w[i] = *(const u32x4*)(src + 8 * i);
#pragma unroll
        for (int i = 0; i < 4; ++i)
#pragma unroll
            for (int j = 0; j < 4; ++j) { v[8 * i + 2 * j] = bflo(w[i][j]); v[8 * i + 2 * j + 1] = bfhi(w[i][j]); }
#pragma unroll
        for (int i = 0; i < 32; ++i) ss += v[i] * v[i];
        ss += __shfl_xor(ss, 1); ss += __shfl_xor(ss, 2);
        const float rs = 1.0f / sqrtf(ss * (1.0f / 128.0f) + EPS);
        const float* nw = F.sgu_norm_w() + g * 128 + qd * 32;
#pragma unroll
        for (int i = 0; i < 4; ++i) { const f32x4 n0 = *(const f32x4*)(nw + 8 * i), n1 = *(const f32x4*)(nw + 8 * i + 4);
            u32x4 o; o.x = cvt_pk_bf16(v[8 * i] * rs * n0[0], v[8 * i + 1] * rs * n0[1]); o.y = cvt_pk_bf16(v[8 * i + 2] * rs * n0[2], v[8 * i + 3] * rs * n0[3]);
            o.z = cvt_pk_bf16(v[8 * i + 4] * rs * n1[0], v[8 * i + 5] * rs * n1[1]); o.w = cvt_pk_bf16(v[8 * i + 6] * rs * n1[2], v[8 * i + 7] * rs * n1[3]);
            *(LAS u32x4*)(vn + row * VN_PITCH + qd * 32 + 8 * i) = o; }
    }
    __syncthreads();
    {
        const int tb = wid >> 1, cb0 = 2 * (wid & 1), r32 = lane & 31, hh = lane >> 5;
        f32x16 a0 = {}, a1 = {};
        const int t = 32 * tb + r32; const float* wrow = F.sgu_w() + ((size_t)g * 128 + t) * 128;
        for (int ks = 0; ks < 2 * (tb + 1); ++ks) {
            const int s0 = 16 * ks + 8 * hh;
            const f32x4 w0 = *(const f32x4*)(wrow + s0), w1 = *(const f32x4*)(wrow + s0 + 4);
            float wv[8] = {w0[0], w0[1], w0[2], w0[3], w1[0], w1[1], w1[2], w1[3]};
#pragma unroll
            for (int j = 0; j < 8; ++j) if (s0 + j > t) wv[j] = 0.f;
            u32x4 aw; aw.x = cvt_pk_bf16(wv[0], wv[1]); aw.y = cvt_pk_bf16(wv[2], wv[3]); aw.z = cvt_pk_bf16(wv[4], wv[5]); aw.w = cvt_pk_bf16(wv[6], wv[7]);
            const bf16x8 af = __builtin_bit_cast(bf16x8, aw);
            bf16x8 b0, b1;
#pragma unroll
            for (int j = 0; j < 8; ++j) { b0[j] = (short)vn[(s0 + j) * VN_PITCH + 32 * cb0 + r32]; b1[j] = (short)vn[(s0 + j) * VN_PITCH + 32 * (cb0 + 1) + r32]; }
            a0 = __builtin_amdgcn_mfma_f32_32x32x16_bf16(af, b0, a0, 0, 0, 0);
            a1 = __builtin_amdgcn_mfma_f32_32x32x16_bf16(af, b1, a1, 0, 0, 0);
        }
#pragma unroll
        for (int reg = 0; reg < 16; ++reg) {
            const int tt = 32 * tb + (reg & 3) + 8 * (reg >> 2) + 4 * hh; const float bb = F.sgu_b()[g * 128 + tt];
            const bf16_t* up = F.UV() + (tok0 + tt) * 1024 + g * 128;
            const int c0 = 32 * cb0 + r32, c1 = c0 + 32;
            yt[tt * YT_PITCH + c0] = bf2f(up[c0]) * (a0[reg] + bb);
            yt[tt * YT_PITCH + c1] = bf2f(up[c1]) * (a1[reg] + bb);
        }
    }
    __syncthreads();
    {
        const int row = tid >> 2, qd = tid & 3; const LAS float* src = yt + row * YT_PITCH + qd * 32; f32x4 v[8]; float ss = 0.f;
#pragma unroll
        for (int i = 0; i < 8; ++i) { v[i] = *(const LAS f32x4*)(src + 4 * i); ss += (v[i][0] * v[i][0] + v[i][1] * v[i][1]) + (v[i][2] * v[i][2] + v[i][3] * v[i][3]); }
        ss += __shfl_xor(ss, 1); ss += __shfl_xor(ss, 2);
        const float rs = 1.0f / sqrtf(ss * (1.0f / 128.0f) + EPS);
        const float* nw = F.out_norm_a_w() + g * 128 + qd * 32; bf16_t* dst = F.Y() + (tok0 + row) * 1024 + g * 128 + qd * 32;
#pragma unroll
        for (int i = 0; i < 4; ++i) { const f32x4 n0 = *(const f32x4*)(nw + 8 * i), n1 = *(const f32x4*)(nw + 8 * i + 4); const f32x4 x0 = v[2 * i] * n0 * rs, x1 = v[2 * i + 1] * n1 * rs;
            u32x4 o; o.x = cvt_pk_bf16(x0[0], x0[1]); o.y = cvt_pk_bf16(x0[2], x0[3]); o.z = cvt_pk_bf16(x1[0], x1[1]); o.w = cvt_pk_bf16(x1[2], x1[3]);
            *(u32x4*)(dst + 8 * i) = o; }
    }
#pragma unroll
    for (int q = 0; q < CONV_G_PER_UNIT; ++q) moe_conv_finish(gci[q], gcv[q], nullptr, lane);
    __syncthreads();
}

__device__ __forceinline__ void attn_wave_unit(const Frame& F, int b, int h, int qblk, int& cit, int cend, LAS float* scr) {
    const int lane = F.lane, r32 = lane & 31, hi = lane >> 5;
    const size_t tokq = (size_t)b * SEQ + 32 * qblk + r32;
    bf16x8 qr[4];
#pragma unroll
    for (int d0 = 0; d0 < 4; ++d0) qr[d0] = *(const bf16x8*)(F.Q() + ((size_t)(b * 8 + h) * SEQ + 32 * qblk + r32) * 64 + 16 * d0 + 8 * hi);
    f32x16 o0 = {}, o1 = {};
    float carry = 0.f;
    const bf16_t* Kb = F.K() + ((size_t)(b * 8 + h) * SEQ + r32) * 64 + 8 * hi;
    const bf16_t* V0 = F.VT() + ((size_t)(b * 8 + h) * 128 * 64 + r32) * 32 + 4 * hi;
    bf16x8 kf[4]; s16x4 vf[2][2][2];
    auto load_tile = [&](int j, bf16x8 (&kk)[4], s16x4 (&vv)[2][2][2]) {
#pragma unroll
        for (int d0 = 0; d0 < 4; ++d0) kk[d0] = *(const bf16x8*)(Kb + (size_t)(32 * j) * 64 + 16 * d0);
#pragma unroll
        for (int dh = 0; dh < 2; ++dh)
#pragma unroll
            for (int ks = 0; ks < 2; ++ks) { const bf16_t* p = V0 + (size_t)j * 2048 + dh * 1024 + 16 * ks; vv[dh][ks][0] = *(const s16x4*)p; vv[dh][ks][1] = *(const s16x4*)(p + 8); }
    };
    load_tile(qblk, kf, vf);
    bool pcv = false; ConvItem pitem; float pvv[16];
    for (int j = qblk; j >= 0; --j) {
        bf16x8 kn[4]; s16x4 vn2[2][2][2];
        if (j > 0) load_tile(j - 1, kn, vn2);
        else {
#pragma unroll
            for (int d0 = 0; d0 < 4; ++d0) kn[d0] = kf[d0];
#pragma unroll
            for (int dh = 0; dh < 2; ++dh)
#pragma unroll
                for (int ks = 0; ks < 2; ++ks) { vn2[dh][ks][0] = vf[dh][ks][0]; vn2[dh][ks][1] = vf[dh][ks][1]; }
        }
        const bool cv = cit < cend; ConvItem citem; float cvv[16];
        if (cv) { citem = moe_conv_decode(F, cit); moe_conv_issue(citem, cvv, lane); cit += 2048; }
        f32x16 s = {};
#pragma unroll
        for (int d0 = 0; d0 < 4; ++d0) s = __builtin_amdgcn_mfma_f32_32x32x16_bf16(kf[d0], qr[d0], s, 0, 0, 0);
        float sp[16];
        const bool diag = (j == qblk);
#pragma unroll
        for (int r = 0; r < 16; ++r) {
            const int kvl = (r & 3) + 8 * (r >> 2) + 4 * hi;
            const float z = s[r];
            float v = fmaxf(z, 0.f) + __builtin_amdgcn_logf(1.0f + __builtin_amdgcn_exp2f(-fabsf(z)));
            if (diag && kvl >= r32) v = 0.f;
            sp[r] = v;
        }
        float G[4], Gp[4];
#pragma unroll
        for (int k = 0; k < 4; ++k) { G[k] = (sp[4 * k] + sp[4 * k + 1]) + (sp[4 * k + 2] + sp[4 * k + 3]); Gp[k] = __shfl_xor(G[k], 32); }
        const float T3 = G[3] + Gp[3], T2 = G[2] + Gp[2], T1 = G[1] + Gp[1], T0 = G[0] + Gp[0];
        float off[4];
        off[3] = 0.f; off[2] = T3; off[1] = T3 + T2; off[0] = T3 + T2 + T1;
        const float tile_total = off[0] + T0;
#pragma unroll
        for (int k = 0; k < 4; ++k) off[k] += carry + (hi == 0 ? Gp[k] : 0.f);
        float a[16];
#pragma unroll
        for (int k = 0; k < 4; ++k) {
            float c = off[k];
#pragma unroll
            for (int i = 3; i >= 0; --i) { const int r = 4 * k + i; c += sp[r]; float av = __builtin_amdgcn_exp2f(s[r] - c);
                if (diag && ((r & 3) + 8 * (r >> 2) + 4 * hi) >= r32) av = 0.f;
                a[r] = av; }
        }
        carry += tile_total;
        u32x4 p0, p1;
        p0.x = cvt_pk_bf16(a[0], a[1]); p0.y = cvt_pk_bf16(a[2], a[3]); p0.z = cvt_pk_bf16(a[4], a[5]); p0.w = cvt_pk_bf16(a[6], a[7]);
        p1.x = cvt_pk_bf16(a[8], a[9]); p1.y = cvt_pk_bf16(a[10], a[11]); p1.z = cvt_pk_bf16(a[12], a[13]); p1.w = cvt_pk_bf16(a[14], a[15]);
        const bf16x8 pf0 = __builtin_bit_cast(bf16x8, p0), pf1 = __builtin_bit_cast(bf16x8, p1);
#define MK_VF(dh, ks) (bf16x8){vf[dh][ks][0][0], vf[dh][ks][0][1], vf[dh][ks][0][2], vf[dh][ks][0][3], vf[dh][ks][1][0], vf[dh][ks][1][1], vf[dh][ks][1][2], vf[dh][ks][1][3]}
        o0 = __builtin_amdgcn_mfma_f32_32x32x16_bf16(MK_VF(0, 0), pf0, o0, 0, 0, 0);
        o0 = __builtin_amdgcn_mfma_f32_32x32x16_bf16(MK_VF(0, 1), pf1, o0, 0, 0, 0);
        o1 = __builtin_amdgcn_mfma_f32_32x32x16_bf16(MK_VF(1, 0), pf0, o1, 0, 0, 0);
        o1 = __builtin_amdgcn_mfma_f32_32x32x16_bf16(MK_VF(1, 1), pf1, o1, 0, 0, 0);
#undef MK_VF
        if (pcv) moe_conv_finish(pitem, pvv, scr, lane);
        pcv = cv; pitem = citem;
#pragma unroll
        for (int i = 0; i < 16; ++i) pvv[i] = cvv[i];
        if (__all(carry > SB_THR)) break;
#pragma unroll
        for (int d0 = 0; d0 < 4; ++d0) kf[d0] = kn[d0];
#pragma unroll
        for (int dh = 0; dh < 2; ++dh)
#pragma unroll
            for (int ks = 0; ks < 2; ++ks) { vf[dh][ks][0] = vn2[dh][ks][0]; vf[dh][ks][1] = vn2[dh][ks][1]; }
    }
    if (pcv) moe_conv_finish(pitem, pvv, scr, lane);
    float ss = 0.f;
#pragma unroll
    for (int r = 0; r < 16; ++r) ss += o0[r] * o0[r] + o1[r] * o1[r];
    ss += __shfl_xor(ss, 32);
    const float rs = 1.0f / sqrtf(ss * (1.0f / 64.0f) + EPS);
    const float* nw = F.out_norm_b_w() + h * 64 + 4 * hi; bf16_t* dst = F.Y() + tokq * 1024 + 512 + h * 64 + 16 * hi;
#pragma unroll
    for (int dh = 0; dh < 2; ++dh) { const f32x16& o = dh ? o1 : o0; u32x2 pk[4];
#pragma unroll
        for (int g = 0; g < 4; ++g) { const f32x4 w = *(const f32x4*)(nw + 32 * dh + 8 * g);
            pk[g].x = cvt_pk_bf16(o[4 * g] * rs * w[0], o[4 * g + 1] * rs * w[1]); pk[g].y = cvt_pk_bf16(o[4 * g + 2] * rs * w[2], o[4 * g + 3] * rs * w[3]); }
#pragma unroll
        for (int k = 0; k < 2; ++k) { const u32x2 a = pk[k], b = pk[2 + k];
            const u32x2 keep = hi ? b : a, send = hi ? a : b; u32x2 recv; recv.x = (unsigned)__shfl_xor((int)send.x, 32); recv.y = (unsigned)__shfl_xor((int)send.y, 32);
            u32x4 w4; if (hi) { w4.x = recv.x; w4.y = recv.y; w4.z = keep.x; w4.w = keep.y; } else { w4.x = keep.x; w4.y = keep.y; w4.z = recv.x; w4.w = recv.y; }
            *(u32x4*)(dst + 32 * dh + 8 * k) = w4; } }
}
__device__ __forceinline__ void p2_mixers(Frame& F) {
    for (int i = 0; i < 4; ++i) { const int u = i * 256 + F.vcu; gmlp_unit(F, u >> 2, u & 3, CONV_P4_ITEMS + i * CONV_G_PER_UNIT * 2048 + F.vcu * NWAVES + F.wave); }
    const int gw = F.vcu * NWAVES + F.wave;
    LAS float* scr = (LAS float*)(F.lds + F.wave * 16384);
    int cit = CONV_P4_ITEMS + CONV_G_ITEMS + gw; const int cend = MOE_ITEMS;
    { unsigned* q = F.ctl() + CW_ATT + (F.vcu >> 5) * 32; const int ub = 256 * (F.vcu >> 5);
      unsigned t0_ = 0; if (F.lane == 0) t0_ = __hip_atomic_fetch_add(q, 1u, __ATOMIC_RELAXED, __HIP_MEMORY_SCOPE_AGENT);
      int t = __builtin_amdgcn_readfirstlane((int)t0_);
      while (t < 1024) {
          unsigned tn_ = 0; if (F.lane == 0) tn_ = __hip_atomic_fetch_add(q, 1u, __ATOMIC_RELAXED, __HIP_MEMORY_SCOPE_AGENT);
          const int u = (t >> 8) * 2048 + ub + (t & 255); const int qblk = u & 127, bh = u >> 7;
          attn_wave_unit(F, bh >> 3, bh & 7, qblk, cit, cend, scr);
          t = __builtin_amdgcn_readfirstlane((int)tn_); } }
    if (cit < cend) {
        ConvItem ca = moe_conv_decode(F, cit); float va[16], vb[16]; moe_conv_issue(ca, va, F.lane); cit += 2048;
        while (cit < cend) {
            const ConvItem cb = moe_conv_decode(F, cit); moe_conv_issue(cb, vb, F.lane); cit += 2048;
            moe_conv_finish(ca, va, scr, F.lane);
            if (cit < cend) { ca = moe_conv_decode(F, cit); moe_conv_issue(ca, va, F.lane); cit += 2048; moe_conv_finish(cb, vb, scr, F.lane); }
            else { moe_conv_finish(cb, vb, scr, F.lane); ca.dst = nullptr; break; }
        }
        if (ca.dst) moe_conv_finish(ca, va, scr, F.lane);
    }
}

struct ProgOut {
    static constexpr bool GATHER = false, FP8 = false; static constexpr int ID = 3, BN = 0, AR = 0, BHS = 0;
    const Frame* F;
    __device__ __forceinline__ bool next(int i, Unit& u) const {
        if (i >= 2) return false;
        const int uu = i * 256 + F->vcu, grp = uu >> 5, w = uu & 31; u.pm = grp * 8 + (w & 7); u.pn = w >> 3; u.kind = 0; u.e = 0; u.r0 = 0;
        u.A = (const char*)(F->Y() + (size_t)u.pm * 256 * KD); u.B = (const char*)(F->WOUT() + (size_t)u.pn * 256 * KD); return true;
    }
    __device__ __forceinline__ void epi(const Acc& acc, const Unit& u, int wr, int wc, int fr, int fq) const {
        asm volatile("" : "+v"(fr), "+v"(fq));
        const size_t off0 = (size_t)(u.pm * 256 + wr * 64 + fr) * DM + u.pn * 256 + wc * 32 + 8 * fq;
        const float* xb = F->x() + off0; float* ob = F->out() + off0;
        f32x4 xv[2][2][2];
#define MK_LDX(g, slot) do { const size_t go_ = (size_t)(((g) >> 2) * 128 + ((g) & 3) * 16) * DM; _Pragma("unroll") for (int bj = 0; bj < 2; ++bj) _Pragma("unroll") for (int n = 0; n < 2; ++n) xv[slot][bj][n] = *(const f32x4*)(xb + go_ + bj * 128 + 4 * n); } while (0)
        MK_LDX(0, 0);
#pragma unroll
        for (int g = 0; g < 8; ++g) { const int ai = g >> 2, m = g & 3; const size_t go = (size_t)(ai * 128 + m * 16) * DM; float ss = 0.f;
            if (g + 1 < 8) MK_LDX(g + 1, (g + 1) & 1);
#pragma unroll
            for (int bj = 0; bj < 2; ++bj)
#pragma unroll
                for (int n = 0; n < 2; ++n) { const f32x4 o = xv[g & 1][bj][n] + acc[ai][bj][m][n];
                    ss += (o[0] * o[0] + o[1] * o[1]) + (o[2] * o[2] + o[3] * o[3]); *(f32x4*)(ob + go + bj * 128 + 4 * n) = o; }
            ss += __shfl_xor(ss, 16); ss += __shfl_xor(ss, 32);
            if (fq == 0) F->SSPART()[(size_t)(u.pm * 256 + ai * 128 + wr * 64 + m * 16 + fr) * 16 + u.pn * 4 + wc] = ss; }
#undef MK_LDX
    }
};

constexpr int RG_OFF = RING_BYTES + 4096;
__device__ __forceinline__ void router_fill_lds(const Frame& F) {
    const bf16_t* rt = F.RT();
#pragma unroll 4
    for (int idx = F.tid; idx < 8192; idx += NWAVES * 64) { const int rest = idx >> 6, row = (rest & 7) * 8 + (idx & 7), c = (rest >> 3) * 8 + ((idx >> 3) & 7);
        *(LAS u32x4*)(F.lds + (c * 64 + row) * 16) = *(const u32x4*)(rt + (size_t)row * KD + 8 * c); }
    if (F.tid < 256) *(LAS f32x4*)(F.lds + RG_OFF + F.tid * 16) = *(const f32x4*)(F.norm2_w() + 4 * F.tid);
    __syncthreads();
}
template <bool DRY> __device__ __forceinline__ void router_wave_unit(Frame& F, int unit) {
    const int lane = F.lane, r32 = lane & 31, hh = lane >> 5; const int tok = unit * 32 + r32;
    f32x16 acc = {};
    const float* xrow = F.out() + (size_t)tok * DM + 8 * hh; const float* w2 = F.norm2_w() + 8 * hh; unsigned char* hrow = F.HB() + (size_t)tok * DM + 8 * hh;
    const LAS unsigned char* rtl = F.lds + hh * 1024 + r32 * 16; const LAS unsigned char* gl = F.lds + RG_OFF + 32 * hh;
    f32x4 xa[8][2], xb[8][2], xc[8][2]; float rs = 0.f;
#define MK_RLD(dst, b) do { _Pragma("unroll") for (int j_ = 0; j_ < 8; ++j_) { dst[j_][0] = *(const f32x4*)(xrow + 16 * (8 * (b) + j_)); dst[j_][1] = *(const f32x4*)(xrow + 16 * (8 * (b) + j_) + 4); } } while (0)
    auto rblock = [&](int b, const f32x4 (&xs)[8][2]) {
#pragma unroll
        for (int j = 0; j < 8; ++j) { const int s = 8 * b + j;
            const f32x4 g0 = *(const LAS f32x4*)(gl + 64 * s), g1 = *(const LAS f32x4*)(gl + 64 * s + 16);
            const f32x4 h0 = xs[j][0] * g0 * rs, h1 = xs[j][1] * g1 * rs;
            u32x4 hw; hw.x = cvt_pk_bf16(h0[0], h0[1]); hw.y = cvt_pk_bf16(h0[2], h0[3]); hw.z = cvt_pk_bf16(h1[0], h1[1]); hw.w = cvt_pk_bf16(h1[2], h1[3]);
            { u32x2 h8; h8.x = pk4_fp8(h0[0], h0[1], h0[2], h0[3]); h8.y = pk4_fp8(h1[0], h1[1], h1[2], h1[3]); *(u32x2*)(hrow + 16 * s) = h8; }
            u32x4 lw; lw.x = cvt_pk_bf16(h0[0] - bflo(hw.x), h0[1] - bfhi(hw.x)); lw.y = cvt_pk_bf16(h0[2] - bflo(hw.y), h0[3] - bfhi(hw.y));
            lw.z = cvt_pk_bf16(h1[0] - bflo(hw.z), h1[1] - bfhi(hw.z)); lw.w = cvt_pk_bf16(h1[2] - bflo(hw.w), h1[3] - bfhi(hw.w));
            const bf16x8 bh = __builtin_bit_cast(bf16x8, hw), bl = __builtin_bit_cast(bf16x8, lw);
            const bf16x8 ah = *(const LAS bf16x8*)(rtl + s * 2048), al = *(const LAS bf16x8*)(rtl + s * 2048 + 512);
            acc = __builtin_amdgcn_mfma_f32_32x32x16_bf16(ah, bh, acc, 0, 0, 0);
            acc = __builtin_amdgcn_mfma_f32_32x32x16_bf16(al, bh, acc, 0, 0, 0);
            acc = __builtin_amdgcn_mfma_f32_32x32x16_bf16(ah, bl, acc, 0, 0, 0); } };
    MK_RLD(xa, 0); MK_RLD(xb, 1);
    float ssum = 0.f;
    { const f32x4* sp = (const f32x4*)(F.SSPART() + (size_t)tok * 16);
#pragma unroll
      for (int i = 0; i < 4; ++i) { const f32x4 v = sp[i]; ssum += v[0]; ssum += v[1]; ssum += v[2]; ssum += v[3]; } }
    rs = 1.0f / sqrtf(ssum * (1.0f / DM) + EPS);
    MK_RLD(xc, 2); rblock(0, xa);
    MK_RLD(xa, 3); rblock(1, xb);
    MK_RLD(xb, 4); rblock(2, xc);
    MK_RLD(xc, 5); rblock(3, xa);
    MK_RLD(xa, 6); rblock(4, xb);
    MK_RLD(xb, 7); rblock(5, xc);
    rblock(6, xa); rblock(7, xb);
#undef MK_RLD
    float lv[16];
#pragma unroll
    for (int r = 0; r < 16; ++r) lv[r] = acc[r] + F.router_b()[(r & 3) + 8 * (r >> 2) + 4 * hh];
    float cv[8]; int ce[8];
#pragma unroll
    for (int k = 0; k < 4; ++k) { float bv = -INFINITY; int be = 0;
#pragma unroll
        for (int r = 0; r < 16; ++r) { const int e = (r & 3) + 8 * (r >> 2) + 4 * hh; if (lv[r] > bv) { bv = lv[r]; be = e; } }
#pragma unroll
        for (int r = 0; r < 16; ++r) { const int e = (r & 3) + 8 * (r >> 2) + 4 * hh; if (e == be) lv[r] = -INFINITY; }
        cv[k] = bv; ce[k] = be; }
#pragma unroll
    for (int k = 0; k < 4; ++k) { cv[4 + k] = __shfl_xor(cv[k], 32); ce[4 + k] = __shfl_xor(ce[k], 32); }
    float tv[4]; int te[4];
#pragma unroll
    for (int k = 0; k < 4; ++k) { float bv = -INFINITY; int be = 1 << 20;
#pragma unroll
        for (int c = 0; c < 8; ++c) if (cv[c] > bv || (cv[c] == bv && ce[c] < be)) { bv = cv[c]; be = ce[c]; }
#pragma unroll
        for (int c = 0; c < 8; ++c) if (ce[c] == be) cv[c] = -INFINITY;
        tv[k] = bv; te[k] = be; }
    float ex[4], den = 0.f;
#pragma unroll
    for (int k = 0; k < 4; ++k) { ex[k] = __builtin_amdgcn_exp2f((tv[k] - tv[0]) * LOG2E); den += ex[k]; }
    const float rden = 1.0f / den;
    const int e0 = hh ? te[2] : te[0], e1 = hh ? te[3] : te[1]; const float g0 = (hh ? ex[2] : ex[0]) * rden, g1 = (hh ? ex[3] : ex[1]) * rden;
    if (DRY) { asm volatile("" :: "v"(e0), "v"(e1), "v"(g0), "v"(g1)); return; }
    int myc = 0; int rank0 = 0, rank1 = 0;
    const unsigned long long ltmask = (1ull << lane) - 1ull;
    for (int e = 0; e < NE; ++e) {
        const unsigned long long m0 = __ballot(e0 == e), m1 = __ballot(e1 == e);
        const int c0 = __popcll(m0), c1 = __popcll(m1);
        if (lane == e) myc = c0 + c1;
        if (e0 == e) rank0 = __popcll(m0 & ltmask);
        if (e1 == e) rank1 = c0 + __popcll(m1 & ltmask);
    }
    int base = 0;
    if (lane < NE && myc > 0) base = (int)__hip_atomic_fetch_add(F.ctl() + CW_CNT + lane, (unsigned)myc, __ATOMIC_RELAXED, __HIP_MEMORY_SCOPE_AGENT);
    const int p0 = __shfl(base, e0) + rank0, p1 = __shfl(base, e1) + rank1;
    F.LISTTOK()[(size_t)e0 * NTOK + p0] = tok; F.LISTGATE()[(size_t)e0 * NTOK + p0] = g0;
    F.LISTTOK()[(size_t)e1 * NTOK + p1] = tok; F.LISTGATE()[(size_t)e1 * NTOK + p1] = g1;
    F.TOKINFO()[tok * 4 + 2 * hh] = (e0 << 16) | p0; F.TOKINFO()[tok * 4 + 2 * hh + 1] = (e1 << 16) | p1;
}

__device__ __forceinline__ void moe_build_table(Frame& F) {
    LAS int* tab = (LAS int*)(F.lds + TAB_OFF);
    if (F.tid < NE) tab[F.tid] = (int)__hip_atomic_load(F.ctl() + CW_CNT + F.tid, __ATOMIC_RELAXED, __HIP_MEMORY_SCOPE_AGENT);
    __syncthreads();
    if (F.tid == 0) { int acc = 0; for (int e = 0; e < NE; ++e) { tab[32 + e] = acc; acc += (tab[e] + 255) >> 8; } tab[64] = acc; }
    __syncthreads();
}
__device__ __forceinline__ int sgpr(int v) { return __builtin_amdgcn_readfirstlane(v); }
template <int WGM, int NN>
__device__ __forceinline__ bool moe_decode(const Frame* F, int T, int i, Unit& u) {
    const LAS int* tab = (const LAS int*)(F->lds + TAB_OFF);
    const int uu = i * 256 + F->vcu, grp = uu >> 5, w = uu & 31; const int mt = grp * WGM + (w % WGM); u.pn = w / WGM;
    if (mt >= T) return false;
    int e = 0;
    for (int k = 1; k < NE; ++k) if (sgpr(tab[32 + k]) <= mt) e = k;
    u.e = e; u.pm = mt; u.r0 = (mt - sgpr(tab[32 + e])) * 256; u.kind = sgpr(tab[e]); return true;
}
struct ProgMoe1 {
    static constexpr int BHS = 128;
    __device__ static __forceinline__ int bcol(int s) { return (s & ~31) + perm32(s & 31); }
    static constexpr bool GATHER = true, FP8 = true; static constexpr int ID = 5, BN = 2048, AR = NTOK;
    const Frame* F; int T;
    __device__ __forceinline__ bool next(int i, Unit& u) const {
        if (!moe_decode<4, 8>(F, T, i, u)) return false;
        u.A = (const char*)F->HB(); u.B = (const char*)(F->WGU() + (size_t)u.e * 2048 * KD + (size_t)u.pn * 256 * 16); return true;
    }
    __device__ __forceinline__ void aoffs(const Unit& u, int wid, unsigned (&vo)[2][2]) const {
        const int cnt = u.kind; const int tid = wid * 64 + lane_id_fresh();
#pragma unroll
        for (int i = 0; i < 2; ++i) { int R_, Cb_; stage_rc8(tid * 16 + i * 8192, R_, Cb_);
#pragma unroll
            for (int h = 0; h < 2; ++h) { const int idx = u.r0 + h * 128 + R_; const int tok = idx < cnt ? F->LISTTOK()[(size_t)u.e * NTOK + idx] : 0; vo[h][i] = (unsigned)(tok * KD + Cb_); } }
    }
    __device__ __forceinline__ void epi(const Acc& acc, const Unit& u, int wr, int wc, int fr, int fq) const {
        asm volatile("" : "+v"(fr), "+v"(fq));
        const float* bp = F->b_gate_up() + (size_t)u.e * 2048 + u.pn * 256 + wc * 32 + 8 * fq;
        f32x4 bv[2][2];
#pragma unroll
        for (int bj = 0; bj < 2; ++bj)
#pragma unroll
            for (int n = 0; n < 2; ++n) bv[bj][n] = *(const f32x4*)(bp + bj * 128 + 4 * n);
#pragma unroll
        for (int ai = 0; ai < 2; ++ai)
#pragma unroll
            for (int m = 0; m < 4; ++m) { const size_t slot = (size_t)u.pm * 256 + ai * 128 + wr * 64 + m * 16 + fr; unsigned char* rowp = F->ACT() + ((size_t)(8 * u.pn + wc) * SLOTS + slot) * 16 + 4 * fq;
#pragma unroll
                for (int bj = 0; bj < 2; ++bj) { const f32x4 v0 = acc[ai][bj][m][0] * WSCALE_INV + bv[bj][0], v1 = acc[ai][bj][m][1] * WSCALE_INV + bv[bj][1];
                    f32x2 ga = {fminf(v0[0], 7.0f), fminf(v0[2], 7.0f)}, gb = {fminf(v1[0], 7.0f), fminf(v1[2], 7.0f)};
                    f32x2 ua = {__builtin_amdgcn_fmed3f(v0[1], -7.0f, 7.0f), __builtin_amdgcn_fmed3f(v0[3], -7.0f, 7.0f)}, ub = {__builtin_amdgcn_fmed3f(v1[1], -7.0f, 7.0f), __builtin_amdgcn_fmed3f(v1[3], -7.0f, 7.0f)};
                    const f32x2 xa = ga * (-1.702f * LOG2E), xb = gb * (-1.702f * LOG2E);
                    f32x2 ea = {__builtin_amdgcn_exp2f(xa[0]), __builtin_amdgcn_exp2f(xa[1])}, eb = {__builtin_amdgcn_exp2f(xb[0]), __builtin_amdgcn_exp2f(xb[1])};
                    ea = ea + 1.0f; eb = eb + 1.0f;
                    const f32x2 ra = {__builtin_amdgcn_rcpf(ea[0]), __builtin_amdgcn_rcpf(ea[1])}, rb = {__builtin_amdgcn_rcpf(eb[0]), __builtin_amdgcn_rcpf(eb[1])};
                    const f32x2 gla = ga * ra, glb = gb * rb;
                    const f32x2 oa = ua * gla + gla, ob = ub * glb + glb;
                    float r4[4] = {oa[0], oa[1], ob[0], ob[1]};
                    *(unsigned*)(rowp + (size_t)bj * 4 * SLOTS * 16) = pk4_fp8(r4[0], r4[1], r4[2], r4[3]); } }
    }
};
struct ProgMoe2 {
    static constexpr int BHS = 8;
    __device__ static __forceinline__ int bcol(int s) { const int c = perm32(s & 31); return (s >> 5) * 64 + (c >> 3) * 16 + (c & 7); }
    static constexpr bool GATHER = false, FP8 = true; static constexpr int ID = 6, BN = 1024, AR = SLOTS;
    const Frame* F; int T;
    __device__ __forceinline__ bool next(int i, Unit& u) const {
        if (!moe_decode<8, 4>(F, T, i, u)) return false;
        u.A = (const char*)(F->ACT() + (size_t)u.pm * 256 * 16); u.B = (const char*)(F->WD() + (size_t)u.e * 1024 * KD + (size_t)u.pn * 256 * 16); return true;
    }
    __device__ __forceinline__ void epi(const Acc& acc, const Unit& u, int wr, int wc, int fr, int fq) const {
        asm volatile("" : "+v"(fr), "+v"(fq));
        const int cnt = u.kind;
        const float* bp = F->b_down() + (size_t)u.e * 1024 + u.pn * 256 + wc * 64 + 16 * fq;
        f32x4 bv[2][2];
#pragma unroll
        for (int bj = 0; bj < 2; ++bj)
#pragma unroll
            for (int n = 0; n < 2; ++n) bv[bj][n] = *(const f32x4*)(bp + bj * 8 + 4 * n);
        float gt[2][4];
#pragma unroll
        for (int ai = 0; ai < 2; ++ai)
#pragma unroll
            for (int m = 0; m < 4; ++m) { const int idx = u.r0 + ai * 128 + wr * 64 + m * 16 + fr; gt[ai][m] = idx < cnt ? F->LISTGATE()[(size_t)u.e * NTOK + idx] : 0.f; }
#pragma unroll
        for (int ai = 0; ai < 2; ++ai) {
#pragma unroll
            for (int m = 0; m < 4; ++m) { const int rl = ai * 128 + wr * 64 + m * 16 + fr; const float gate = gt[ai][m] * YSCALE;
                unsigned char* rowp = F->YS() + ((size_t)u.pm * 256 + rl) * 1024 + u.pn * 256 + wc * 64 + 16 * fq;
                u32x4 w;
#pragma unroll
                for (int bj = 0; bj < 2; ++bj) { const f32x4 v0 = (acc[ai][bj][m][0] * WSCALE_INV + bv[bj][0]) * gate, v1 = (acc[ai][bj][m][1] * WSCALE_INV + bv[bj][1]) * gate;
                    w[2 * bj] = pk4_fp8(v0[0], v0[1], v0[2], v0[3]); w[2 * bj + 1] = pk4_fp8(v1[0], v1[1], v1[2], v1[3]); }
                *(u32x4*)rowp = w; }
        }
    }
};

template <bool DRY> __device__ __forceinline__ void p7_combine(Frame& F) {
    const LAS int* tab = (const LAS int*)(F.lds + TAB_OFF);
    const int gw = F.vcu * NWAVES + F.wave, NGW = F.G * NWAVES, lane = F.lane;
    for (int tok = gw; tok < NTOK; tok += NGW) {
        f32x4* orow = (f32x4*)(F.out() + (size_t)tok * DM) + lane; f32x4 v[4];
#pragma unroll
        for (int j = 0; j < 4; ++j) v[j] = orow[64 * j];
#pragma unroll
        for (int k = 0; k < 4; ++k) { const int info = F.TOKINFO()[tok * 4 + k]; const int e = info >> 16, pos = info & 0xffff; const size_t slot = (size_t)tab[32 + e] * 256 + pos;
            const unsigned* yr = (const unsigned*)(F.YS() + slot * 1024) + lane;
#pragma unroll
            for (int j = 0; j < 4; ++j) { const unsigned w = yr[64 * j]; const f32x2 lo = __builtin_amdgcn_cvt_pk_f32_fp8((int)w, false), hi = __builtin_amdgcn_cvt_pk_f32_fp8((int)w, true);
                v[j][0] += lo[0] * YSCALE_INV; v[j][1] += lo[1] * YSCALE_INV; v[j][2] += hi[0] * YSCALE_INV; v[j][3] += hi[1] * YSCALE_INV; } }
        f32x4* wrow = DRY ? (f32x4*)((float*)(F.ws() + WS_EARLY) + (size_t)tok * DM) + lane : orow;
#pragma unroll
        for (int j = 0; j < 4; ++j) wrow[64 * j] = v[j];
    }
}

__global__ void __launch_bounds__(NWAVES * 64, 2) mk_fwd(Args args) {
    extern __shared__ __attribute__((aligned(16))) unsigned char lds_raw[];
    Frame F;
    F.lds = (LAS unsigned char*)lds_raw;
    F.tid = threadIdx.x; F.lane = F.tid & 63; F.wave = __builtin_amdgcn_readfirstlane(F.tid >> 6);
    F.G = gridDim.x; { const int bx = blockIdx.x; F.vcu = (bx % 8) * (F.G / 8) + bx / 8; }
    F.ka = (const CAS Args*)__builtin_amdgcn_kernarg_segment_ptr();
    for (int u = F.tid; u < (LDS_BYTES - LDSCTL_OFF) / 4; u += NWAVES * 64) ((LAS unsigned*)(F.lds + LDSCTL_OFF))[u] = 0u;
    __syncthreads();
    XcdBarrier bar = xcd_barrier_post(F.ctl() + CW_BAR, (volatile LAS unsigned*)(F.lds + MISC_OFF) + 8);
    const int lo = F.ka->ph_lo, hi = F.ka->ph_hi;
#define IN(k) (lo <= (k) && (k) < hi)
#define REFRESH() do { int l_ = lane_id(); asm volatile("" : "+v"(l_)); F.lane = l_; F.tid = F.wave * 64 + l_; } while (0)
#define SEAM(k) do { if (IN(k) && IN((k) + 1)) { xcd_barrier(bar, F.wave); if (MK_REP == 100 + (k)) { xcd_barrier(bar, F.wave); xcd_barrier(bar, F.wave); xcd_barrier(bar, F.wave); xcd_barrier(bar, F.wave); } } } while (0)
#ifdef MK_TPROBE
    unsigned long long ts_[9]; ts_[0] = __builtin_amdgcn_s_memrealtime();
#define TS(k) ts_[k] = __builtin_amdgcn_s_memrealtime()
#else
#define TS(k) do {} while (0)
#endif
    if (IN(0)) { REFRESH(); p0_prologue(F); if (MK_REP == 0) p0_prologue(F); } SEAM(0); TS(1);
    if (IN(1)) { { ProgIn P{&F}; gemm_phase(F.lds, P); } if (MK_REP == 1) { ProgIn P{&F}; gemm_phase(F.lds, P); } } SEAM(1); TS(2);
    if (IN(2)) { REFRESH(); p2_mixers(F); if (MK_REP == 2) p2_mixers(F); } SEAM(2); TS(3);
    if (IN(3)) { { ProgOut P{&F}; gemm_phase(F.lds, P); } if (MK_REP == 3) { ProgOut P{&F}; gemm_phase(F.lds, P); } } SEAM(3); TS(4);
    if (IN(4)) { REFRESH(); router_fill_lds(F);
                 if (F.wave < 4) { if (MK_REP == 4) router_wave_unit<true>(F, F.wave * 256 + F.vcu); router_wave_unit<false>(F, F.wave * 256 + F.vcu); }
                 { unsigned* q = F.ctl() + CW_P4C + (F.vcu >> 5) * 32; const int pb = (F.vcu >> 5) * (CONV_P4_ITEMS / 8); float va[16], vb[16];
                   unsigned t0_ = 0; if (F.lane == 0) t0_ = __hip_atomic_fetch_add(q, 4u, __ATOMIC_RELAXED, __HIP_MEMORY_SCOPE_AGENT);
                   int t = __builtin_amdgcn_readfirstlane((int)t0_);
                   while (t < CONV_P4_ITEMS / 8) {
                       unsigned tn_ = 0; if (F.lane == 0) tn_ = __hip_atomic_fetch_add(q, 4u, __ATOMIC_RELAXED, __HIP_MEMORY_SCOPE_AGENT);
                       const ConvItem c0 = moe_conv_decode(F, pb + t), c1 = moe_conv_decode(F, pb + t + 1); moe_conv_issue(c0, va, F.lane); moe_conv_issue(c1, vb, F.lane);
                       moe_conv_finish(c0, va, nullptr, F.lane); const ConvItem c2 = moe_conv_decode(F, pb + t + 2); moe_conv_issue(c2, va, F.lane);
                       moe_conv_finish(c1, vb, nullptr, F.lane); const ConvItem c3 = moe_conv_decode(F, pb + t + 3); moe_conv_issue(c3, vb, F.lane);
                       moe_conv_finish(c2, va, nullptr, F.lane); moe_conv_finish(c3, vb, nullptr, F.lane);
                       t = __builtin_amdgcn_readfirstlane((int)tn_); } } } SEAM(4); TS(5);
    if (lo <= 7 && hi > 5) { REFRESH(); moe_build_table(F); }
    if (IN(5)) { { ProgMoe1 P{&F, sgpr(((const LAS int*)(F.lds + TAB_OFF))[64])}; gemm_phase(F.lds, P); } if (MK_REP == 5) { ProgMoe1 P{&F, sgpr(((const LAS int*)(F.lds + TAB_OFF))[64])}; gemm_phase(F.lds, P); } } SEAM(5); TS(6);
    if (IN(6)) { { ProgMoe2 P{&F, sgpr(((const LAS int*)(F.lds + TAB_OFF))[64])}; gemm_phase(F.lds, P); } if (MK_REP == 6) { ProgMoe2 P{&F, sgpr(((const LAS int*)(F.lds + TAB_OFF))[64])}; gemm_phase(F.lds, P); } } SEAM(6); TS(7);
    if (IN(7)) { REFRESH(); if (MK_REP == 7) p7_combine<true>(F); p7_combine<false>(F); }
#ifdef MK_TPROBE
    TS(8);
    if (blockIdx.x == 0 && F.wave == 0) { const unsigned long long d = (MK_TPROBE == 9 ? (ts_[8] - ts_[0]) / 8 : ts_[MK_TPROBE + 1] - ts_[MK_TPROBE]) * 8ull; const unsigned long long t0 = __builtin_amdgcn_s_memrealtime();
        while (__builtin_amdgcn_s_memrealtime() - t0 < d) __builtin_amdgcn_s_sleep(8); }
#endif
#undef IN
#undef SEAM
}
}
#ifndef MK_CUT
#define MK_CUT 8
#endif
extern "C" void kernel_launch(void* const* d_in, const int* in_sizes, int n_in, void* d_out, int out_size, void* d_ws, size_t ws_size, hipStream_t stream) {
    static int ready = 0;
    if (ready == 0) {
        if (n_in != 18 || out_size != mk::NTOK * mk::DM || ws_size < mk::WS_END) { fprintf(stderr, "kernel_launch: unexpected problem (n_in %d out %d ws %zu)\n", n_in, out_size, ws_size); ready = -1; return; }
        if (hipFuncSetAttribute((const void*)mk::mk_fwd, hipFuncAttributeMaxDynamicSharedMemorySize, mk::LDS_BYTES) != hipSuccess) { fprintf(stderr, "kernel_launch: hipFuncSetAttribute failed\n"); ready = -1; return; }
        ready = 1;
    }
    if (ready < 0) return;
    (void)hipMemsetAsync((char*)d_ws + mk::WS_CTL, 0, mk::CTL_ZERO_BYTES, stream);
    mk::Args a{};
    for (int i = 0; i < 18; ++i) a.in[i] = (const float*)d_in[i];
    a.out = (float*)d_out; a.ws = (unsigned char*)d_ws; a.ph_lo = 0; a.ph_hi = MK_CUT;
    hipLaunchKernelGGL(mk::mk_fwd, dim3(256), dim3(mk::NWAVES * 64), mk::LDS_BYTES, stream, a);
#if MK_CUT < 8
    {
        using namespace nv;
        const float* x = (const float*)d_in[0]; const float* w_out = (const float*)d_in[10]; const float* norm2_w = (const float*)d_in[11];
        const float* router_w = (const float*)d_in[12]; const float* router_b = (const float*)d_in[13]; const float* w_gate_up = (const float*)d_in[14];
        const float* b_gate_up = (const float*)d_in[15]; const float* w_down = (const float*)d_in[16]; const float* b_down = (const float*)d_in[17];
        float* out = (float*)d_out; char* ws = (char*)d_ws; const size_t MiB = 1u << 20;
        int* cnt = (int*)ws + mk::CW_CNT; int* list_tok = (int*)(ws + mk::WS_LISTTOK); float* list_gate = (float*)(ws + mk::WS_LISTGATE);
        float* hn = (float*)(ws + 16 * MiB); float* gu = (float*)(ws + 272 * MiB); float* act = (float*)(ws + (272 + 256) * MiB);
#if MK_CUT <= 3
        k_gemm<1, true><<<dim3(DM / 64, NTOK / 64), 256, 0, stream>>>((const void*)(ws + mk::WS_Y), nullptr, nullptr, nullptr, w_out, nullptr, x, nullptr, out, NTOK, DM, DM, DM, DM);
#endif
#if MK_CUT <= 4
        k_router<<<NTOK, 256, 0, stream>>>(out, norm2_w, router_w, router_b, hn, cnt, list_tok, list_gate);
#else
        k_bf2f<<<4096, 256, 0, stream>>>((const unsigned short*)(ws + mk::WS_HB), hn, (size_t)NTOK * DM);
#endif
        for (int e = 0; e < NE; ++e) {
            const int* lt = list_tok + (size_t)e * NTOK; const float* lgp = list_gate + (size_t)e * NTOK;
            k_gemm<0, false><<<dim3(2 * DFF / 64, NTOK / 64), 256, 0, stream>>>(hn, lt, nullptr, cnt + e, w_gate_up + (size_t)e * DM * 2 * DFF, b_gate_up + (size_t)e * 2 * DFF, nullptr, nullptr, gu, NTOK, 2 * DFF, DM, DM, 2 * DFF);
            k_swiglu<<<NTOK, 256, 0, stream>>>(gu, cnt + e, act);
            k_gemm<3, false><<<dim3(DM / 64, NTOK / 64), 256, 0, stream>>>(act, nullptr, lt, cnt + e, w_down + (size_t)e * DFF * DM, b_down + (size_t)e * DM, nullptr, lgp, out, NTOK, DM, DFF, DFF, DM);
        }
    }
#endif
}
```
